# Optimizing an MI355X kernel written in HIP

```python
import jax, jax.numpy as jnp
from jax import lax
import numpy as np

D_MODEL = 1024
BATCH = 1
SEQ = 16384
DEPTH = 2

CHUNK = 64
Q_BLOCK = 128
RMS_EPS = 1e-6

FOX_HEADS = 4
FOX_HEAD_DIM = 64
DSA_HEADS = 4
DSA_HEAD_DIM = 64
DSA_KV_RANK = 128
IDX_HEADS = 8
IDX_HEAD_DIM = 32
IDX_TOPK = 256
RWKV_HEADS = 8
RWKV_HEAD_DIM = 64
RWKV_W_LORA = 64
RWKV_A_LORA = 64
RWKV_V_LORA = 32
RWKV_G_LORA = 128
RWKV_LN_EPS = 64e-5

FOX_W = FOX_HEADS * FOX_HEAD_DIM
DSA_W = DSA_HEADS * DSA_HEAD_DIM
RWKV_W = RWKV_HEADS * RWKV_HEAD_DIM
N_BRANCH = 3
GATE_W = N_BRANCH * D_MODEL

D_FF_DENSE = 2816
N_EXPERTS = 8
TOP_K_EXPERTS = 2
D_FF_EXPERT = 3584

FOX_COLS = (FOX_W, FOX_W, FOX_W, FOX_HEADS)
DSA_COLS = (DSA_W, DSA_KV_RANK, IDX_HEADS * IDX_HEAD_DIM, IDX_HEAD_DIM, IDX_HEADS)
RWKV_COLS = (RWKV_W, RWKV_W, RWKV_W, RWKV_W_LORA, RWKV_A_LORA, RWKV_G_LORA)
FOX_IN = sum(FOX_COLS)
DSA_IN = sum(DSA_COLS)
RWKV_IN = sum(RWKV_COLS)
D_IN = FOX_IN + DSA_IN + RWKV_IN + GATE_W

kernel_name = "hybrid_fox_dsa_rwkv7_moe_trunk"


def _split(t, sizes):
    idx = [int(i) for i in np.cumsum(sizes)[:-1]]
    return jnp.split(t, idx, axis=-1)


def rmsnorm(x, g):
    xf = x.astype(jnp.float32)
    y = xf * lax.rsqrt(jnp.mean(xf * xf, axis=-1, keepdims=True) + RMS_EPS)
    return (y * g.astype(jnp.float32)).astype(x.dtype)


def token_shift_mix(p, mu):
    prev = jnp.pad(p, ((0, 0), (1, 0), (0, 0)))[:, :-1]
    return p + (prev - p) * mu


def fox_attention(q, k, v, f_logit, f_bias):
    B, S, H, Dh = q.shape
    log_f = jax.nn.log_sigmoid(f_logit.astype(jnp.float32) + f_bias.astype(jnp.float32))
    F = jnp.cumsum(log_f, axis=1).transpose(0, 2, 1)
    kpos = jnp.arange(S)
    scale = Dh ** -0.5

    def block(i):
        s0 = i * Q_BLOCK
        qb = lax.dynamic_slice_in_dim(q, s0, Q_BLOCK, axis=1)
        Fq = lax.dynamic_slice_in_dim(F, s0, Q_BLOCK, axis=2)
        logits = (jnp.einsum('bqhd,bkhd->bhqk', qb, k).astype(jnp.float32) * scale
                  + Fq[..., None] - F[:, :, None, :])
        qpos = s0 + jnp.arange(Q_BLOCK)
        logits = jnp.where(kpos[None, :] <= qpos[:, None], logits, -jnp.inf)
        p = jax.nn.softmax(logits, axis=-1).astype(v.dtype)
        return jnp.einsum('bhqk,bkhd->bqhd', p, v)

    out = lax.map(block, jnp.arange(S // Q_BLOCK))
    return out.transpose(1, 0, 2, 3, 4).reshape(B, S, H * Dh)


def dsa_attention(q, c_kv, q_idx, k_idx, w_idx, w_uk, w_uv, topk):
    B, S, H, Dh = q.shape
    q_lat = jnp.einsum('bshd,hdr->bshr', q, w_uk)
    key_chunk = jnp.arange(S) // CHUNK
    idx_scale = (IDX_HEADS * IDX_HEAD_DIM) ** -0.5
    scale = Dh ** -0.5

    def block(i):
        s0 = i * Q_BLOCK
        qi = lax.dynamic_slice_in_dim(q_idx, s0, Q_BLOCK, axis=1)
        wi = lax.dynamic_slice_in_dim(w_idx, s0, Q_BLOCK, axis=1)
        ql = lax.dynamic_slice_in_dim(q_lat, s0, Q_BLOCK, axis=1)
        rel = jax.nn.relu(jnp.einsum('bqhd,bkd->bqhk', qi, k_idx).astype(jnp.float32))
        score = jnp.einsum('bqhk,bqh->bqk', rel, wi.astype(jnp.float32)) * idx_scale
        q_chunk = (s0 + jnp.arange(Q_BLOCK)) // CHUNK
        score = jnp.where(key_chunk[None, :] <= q_chunk[:, None], score, -jnp.inf)
        top_s, top_i = lax.top_k(score, topk)
        valid = jnp.isfinite(top_s)
        c_sel = jax.vmap(lambda c, ix: c[ix])(c_kv, top_i)
        logits = jnp.einsum('bqhr,bqkr->bqhk', ql, c_sel).astype(jnp.float32) * scale
        logits = jnp.where(valid[:, :, None, :], logits, -jnp.inf)
        p = jax.nn.softmax(logits, axis=-1).astype(c_sel.dtype)
        o_lat = jnp.einsum('bqhk,bqkr->bqhr', p, c_sel)
        return jnp.einsum('bqhr,hrd->bqhd', o_lat, w_uv)

    out = lax.map(block, jnp.arange(S // Q_BLOCK))
    return out.transpose(1, 0, 2, 3, 4).reshape(B, S, H * Dh)


def rwkv7_scan(r, w, k, v, kk, a):
    B, S, H, N = r.shape

    def step(state, inp):
        r_t, w_t, k_t, v_t, kk_t, a_t = inp
        sa = jnp.einsum('bhvk,bhk->bhv', state, -kk_t)
        state = (state * w_t[:, :, None, :] + sa[..., None] * (kk_t * a_t)[:, :, None, :]
                 + v_t[..., None] * k_t[:, :, None, :])
        return state, jnp.einsum('bhvk,bhk->bhv', state, r_t)

    xs = tuple(jnp.moveaxis(t, 1, 0) for t in (r, w, k, v, kk, a))
    _, y = lax.scan(step, jnp.zeros((B, H, N, N), jnp.float32), xs)
    return jnp.moveaxis(y, 0, 1)


def rwkv7_time_mix(p, mu, w0, w_up, a0, a_up, g_up, k_k, k_a, r_k, ln_g, ln_b, v_first, v_res_logit):
    B, S, _ = p.shape
    f32 = jnp.float32
    r, k, v, wl, al, gl = [t.astype(f32) for t in _split(token_shift_mix(p, mu), RWKV_COLS)]
    if v_first is None:
        v_first = v
    else:
        v = v + (v_first - v) * jax.nn.sigmoid(v_res_logit.astype(f32))
    log_w = -jax.nn.softplus(-(w0 + jnp.tanh(wl) @ w_up)) - 0.5
    decay = jnp.exp(-jnp.exp(log_w))
    a = jax.nn.sigmoid(a0 + al @ a_up)
    g = jax.nn.sigmoid(gl) @ g_up
    heads = lambda t: t.reshape(B, S, RWKV_HEADS, RWKV_HEAD_DIM)
    kk = heads(k * k_k)
    kk = kk / jnp.sqrt(jnp.sum(kk * kk, axis=-1, keepdims=True) + 1e-12)
    k = k * (1.0 + (a - 1.0) * k_a)
    rh, kh, vh = heads(r), heads(k), heads(v)
    y = rwkv7_scan(rh, heads(decay), kh, vh, kk, heads(a))
    mean = jnp.mean(y, axis=-1, keepdims=True)
    var = jnp.mean(jnp.square(y - mean), axis=-1, keepdims=True)
    y = ((y - mean) * lax.rsqrt(var + RWKV_LN_EPS)).reshape(B, S, RWKV_W) * ln_g + ln_b
    bonus = (jnp.sum(rh * kh * r_k, axis=-1, keepdims=True) * vh).reshape(B, S, RWKV_W)
    return ((y + bonus) * g).astype(p.dtype), v_first


def swiglu(h, w_gate, w_up, w_down):
    return (jax.nn.silu(h @ w_gate) * (h @ w_up)) @ w_down


def moe_ffn(h, router_w, router_b, w_gate, w_up, w_down):
    logits = (h @ router_w).astype(jnp.float32) + router_b.astype(jnp.float32)
    top_v, top_i = lax.top_k(logits, TOP_K_EXPERTS)
    top_p = jax.nn.softmax(top_v, axis=-1)
    gates = jnp.sum(jax.nn.one_hot(top_i, N_EXPERTS, dtype=jnp.float32) * top_p[..., None], axis=-2)
    gates = gates.astype(h.dtype)
    y = jnp.zeros_like(h)
    for e in range(N_EXPERTS):
        y = y + gates[..., e:e + 1] * swiglu(h, w_gate[e], w_up[e], w_down[e])
    return y


def setup_inputs(seed: int = 0) -> dict:
    key = jax.random.key(seed)
    ks = iter(list(jax.random.split(key, 48)))
    f = jnp.float32
    n_dense = (DEPTH + 1) // 2
    n_moe = DEPTH // 2

    def nrm(shape, fan_in, s=1.0):
        return jax.random.normal(next(ks), shape, f) * (s * fan_in ** -0.5)

    def gain(shape):
        return 1.0 + 0.01 * jax.random.normal(next(ks), shape, f)

    def small(shape, s=0.01, c=0.0):
        return c + s * jax.random.normal(next(ks), shape, f)

    def unif(shape, lo, hi):
        return jax.random.uniform(next(ks), shape, f, lo, hi)

    return {
        "x": jax.random.normal(next(ks), (BATCH, SEQ, D_MODEL), f),
        "w_in": nrm((DEPTH, D_MODEL, D_IN), D_MODEL),
        "b_gate": small((DEPTH, GATE_W)),
        "g_mix": gain((DEPTH, D_MODEL)),
        "fox_f_bias": unif((DEPTH, FOX_HEADS), 1.0, 4.0),
        "dsa_kv_norm": gain((DEPTH, DSA_KV_RANK)),
        "dsa_w_uk": nrm((DEPTH, DSA_HEADS, DSA_HEAD_DIM, DSA_KV_RANK), DSA_KV_RANK),
        "dsa_w_uv": nrm((DEPTH, DSA_HEADS, DSA_KV_RANK, DSA_HEAD_DIM), DSA_KV_RANK),
        "rwkv_mu": unif((DEPTH, RWKV_IN), 0.0, 1.0),
        "rwkv_w0": unif((DEPTH, RWKV_W), -6.0, -1.0),
        "rwkv_w_up": nrm((DEPTH, RWKV_W_LORA, RWKV_W), RWKV_W_LORA, 0.5),
        "rwkv_a0": small((DEPTH, RWKV_W), 0.1),
        "rwkv_a_up": nrm((DEPTH, RWKV_A_LORA, RWKV_W), RWKV_A_LORA),
        "rwkv_g_up": nrm((DEPTH, RWKV_G_LORA, RWKV_W), RWKV_G_LORA),
        "rwkv_k_k": small((DEPTH, RWKV_W), 0.02, 0.85),
        "rwkv_k_a": small((DEPTH, RWKV_W), 0.02, 1.0),
        "rwkv_r_k": small((DEPTH, RWKV_HEADS, RWKV_HEAD_DIM), 0.1),
        "rwkv_ln_g": gain((DEPTH, RWKV_W)),
        "rwkv_ln_b": small((DEPTH, RWKV_W)),
        "vres_down": nrm((DEPTH - 1, D_MODEL, RWKV_V_LORA), D_MODEL),
        "vres_mu": unif((DEPTH - 1, RWKV_V_LORA), 0.0, 1.0),
        "vres_up": nrm((DEPTH - 1, RWKV_V_LORA, RWKV_W), RWKV_V_LORA),
        "vres_v0": small((DEPTH - 1, RWKV_W), 0.1, 0.5),
        "p_fox": nrm((DEPTH, FOX_W, D_MODEL), FOX_W),
        "p_dsa": nrm((DEPTH, DSA_W, D_MODEL), DSA_W),
        "p_rwkv": nrm((DEPTH, RWKV_W, D_MODEL), RWKV_W),
        "w_out": nrm((DEPTH, D_MODEL, D_MODEL), D_MODEL),
        "g_ffn": gain((DEPTH, D_MODEL)),
        "ffn_w_gate": nrm((n_dense, D_MODEL, D_FF_DENSE), D_MODEL),
        "ffn_w_up": nrm((n_dense, D_MODEL, D_FF_DENSE), D_MODEL),
        "ffn_w_down": nrm((n_dense, D_FF_DENSE, D_MODEL), D_FF_DENSE),
        "router_w": nrm((n_moe, D_MODEL, N_EXPERTS), D_MODEL),
        "router_b": small((n_moe, N_EXPERTS)),
        "moe_w_gate": nrm((n_moe, N_EXPERTS, D_MODEL, D_FF_EXPERT), D_MODEL),
        "moe_w_up": nrm((n_moe, N_EXPERTS, D_MODEL, D_FF_EXPERT), D_MODEL),
        "moe_w_down": nrm((n_moe, N_EXPERTS, D_FF_EXPERT, D_MODEL), D_FF_EXPERT),
        "g_final": gain((D_MODEL,)),
    }


def reference(x, w_in, b_gate, g_mix, fox_f_bias, dsa_kv_norm, dsa_w_uk, dsa_w_uv,
              rwkv_mu, rwkv_w0, rwkv_w_up, rwkv_a0, rwkv_a_up, rwkv_g_up, rwkv_k_k, rwkv_k_a,
              rwkv_r_k, rwkv_ln_g, rwkv_ln_b, vres_down, vres_mu, vres_up, vres_v0,
              p_fox, p_dsa, p_rwkv, w_out, g_ffn, ffn_w_gate, ffn_w_up, ffn_w_down,
              router_w, router_b, moe_w_gate, moe_w_up, moe_w_down, g_final):
    B, S, _ = x.shape
    topk = min(IDX_TOPK, S // 4)
    v_first = None
    for l in range(DEPTH):
        h = rmsnorm(x, g_mix[l])
        fox_p, dsa_p, rwkv_p, gate_p = _split(h @ w_in[l], (FOX_IN, DSA_IN, RWKV_IN, GATE_W))

        fq, fk, fv, f_logit = _split(fox_p, FOX_COLS)
        fh = lambda t: t.reshape(B, S, FOX_HEADS, FOX_HEAD_DIM)
        o_fox = fox_attention(fh(fq), fh(fk), fh(fv), f_logit, fox_f_bias[l])

        dq, dckv, diq, dik, diw = _split(dsa_p, DSA_COLS)
        o_dsa = dsa_attention(dq.reshape(B, S, DSA_HEADS, DSA_HEAD_DIM),
                              rmsnorm(dckv, dsa_kv_norm[l]),
                              diq.reshape(B, S, IDX_HEADS, IDX_HEAD_DIM), dik, diw,
                              dsa_w_uk[l], dsa_w_uv[l], topk)

        if l == 0:
            v_res_logit = None
        else:
            vl = token_shift_mix(h @ vres_down[l - 1], vres_mu[l - 1])
            v_res_logit = vres_v0[l - 1] + vl @ vres_up[l - 1]
        o_rwkv, v_first = rwkv7_time_mix(rwkv_p, rwkv_mu[l], rwkv_w0[l], rwkv_w_up[l], rwkv_a0[l],
                                         rwkv_a_up[l], rwkv_g_up[l], rwkv_k_k[l], rwkv_k_a[l],
                                         rwkv_r_k[l], rwkv_ln_g[l], rwkv_ln_b[l], v_first, v_res_logit)

        gates = jax.nn.sigmoid((gate_p + b_gate[l]).astype(jnp.float32)).astype(x.dtype)
        gates = gates.reshape(B, S, N_BRANCH, D_MODEL)
        merged = (gates[:, :, 0] * (o_fox @ p_fox[l])
                  + gates[:, :, 1] * (o_dsa @ p_dsa[l])
                  + gates[:, :, 2] * (o_rwkv @ p_rwkv[l]))
        x = x + merged @ w_out[l]

        h2 = rmsnorm(x, g_ffn[l])
        if l % 2 == 0:
            y = swiglu(h2, ffn_w_gate[l // 2], ffn_w_up[l // 2], ffn_w_down[l // 2])
        else:
            y = moe_ffn(h2, router_w[l // 2], router_b[l // 2],
                        moe_w_gate[l // 2], moe_w_up[l // 2], moe_w_down[l // 2])
        x = x + y
    return rmsnorm(x, g_final)
```

```cpp
#include <hip/hip_runtime.h>
#include <stdint.h>
#include <stdio.h>

#ifndef MK_PER_PHASE
#define MK_PER_PHASE 0
#endif

#ifndef PHMASK
#define PHMASK 0xFFFFFFu
#endif
#define SITE(k) (((PHMASK) >> (k)) & 1u)
#define LAS __attribute__((address_space(3)))
typedef unsigned short u16;
typedef unsigned int u32;
typedef unsigned long long u64;
typedef short bf16x8 __attribute__((ext_vector_type(8)));
typedef _Float16 f16x8 __attribute__((ext_vector_type(8)));
typedef float f32x4 __attribute__((ext_vector_type(4)));
typedef float f32x2 __attribute__((ext_vector_type(2)));
typedef unsigned u32x4 __attribute__((ext_vector_type(4)));
typedef unsigned u32x2 __attribute__((ext_vector_type(2)));
typedef __bf16 bf16x2_t __attribute__((ext_vector_type(2)));

constexpr int S = 16384, D = 1024;
constexpr int DIN = 6316;
constexpr float RMS_EPS = 1e-6f;
constexpr float LOG2E = 1.4426950408889634f;
constexpr float C2 = 0.125f * LOG2E;
constexpr int NW1 = 3584;
constexpr int FFD = 2816, FFE = 3584, NEXP = 8;
constexpr int MOE_ROWS = 2 * S + NEXP * 256;
constexpr int NWAVES = 8, NTHR = 512;

constexpr size_t MB = 1u << 20;
constexpr size_t O_CTL = 0;
constexpr size_t CTL_BYTES = 2 * MB;
constexpr size_t O_XR = O_CTL + CTL_BYTES;
constexpr size_t O_SSQ = O_XR + (size_t)S * D * 4;
constexpr size_t O_XB = O_SSQ + (size_t)S * 16 * 4;
constexpr size_t O_M = O_XB + (size_t)S * D * 2;
constexpr size_t O_VFIRST = O_M;
constexpr size_t O_W1 = O_VFIRST + (size_t)S * 512 * 2;
constexpr size_t O_WGT = O_W1 + (size_t)2 * NW1 * D * 2;
constexpr size_t OUTW_L = (size_t)(256 + 512 + 512 + 1024) * 1024 * 2;
constexpr size_t O_OUTW = O_WGT + (size_t)2 * 3072 * D * 2;
constexpr size_t O_T = O_OUTW + 2 * OUTW_L;
constexpr size_t T_QKVF = O_T;
constexpr size_t T_QL = T_QKVF + (size_t)S * 768 * 2;
constexpr size_t T_FL = T_QL + (size_t)S * 512 * 2;
constexpr size_t T_FB = T_FL + (size_t)4 * S * 4;
constexpr size_t T_VT = T_FB + 4096;
constexpr size_t T_CKV = T_VT + (size_t)256 * S * 2;
constexpr size_t T_QI = T_CKV + (size_t)S * 128 * 2;
constexpr size_t T_KI = T_QI + (size_t)S * 288 * 2;
constexpr size_t T_SG = T_KI + (size_t)S * 32 * 2;
constexpr size_t T_BC = T_SG + (size_t)S * 4;
constexpr size_t T_OF = T_BC + (size_t)S * 8 * 4;
constexpr size_t T_OD = T_OF + (size_t)S * 256 * 2;
constexpr size_t T_OR = T_OD + (size_t)S * 512 * 2;
constexpr size_t T_RW = T_OR + (size_t)S * 512 * 2;
constexpr size_t T_RKK = T_RW + (size_t)S * 512 * 4;
constexpr size_t T_RB = T_RKK + (size_t)S * 512 * 2;
constexpr size_t T_RK = T_RB + (size_t)S * 512 * 2;
constexpr size_t T_RR = T_RK + (size_t)S * 512 * 2;
constexpr size_t T_RV = T_RR + (size_t)S * 512 * 2;
constexpr size_t T_RG = T_RV + (size_t)S * 512 * 2;
constexpr size_t T_U1 = T_RG + (size_t)S * 512 * 2;
constexpr size_t T_T56 = T_U1;
constexpr size_t T_PR = T_T56 + (size_t)S * 512 * 4;
constexpr size_t T_YL = T_U1;
constexpr size_t T_RT = T_YL + (size_t)S * 512 * 4;
constexpr size_t T_PC = T_RT + (size_t)S * 512 * 2;
constexpr size_t T_UC = T_PC + (size_t)2048 * 4096 * 4;
constexpr size_t T_U1_END = T_UC + (size_t)2048 * 4096 * 4;
constexpr size_t T_GT = T_U1;
constexpr size_t T_MGF = T_GT + (size_t)S * D * 2;
static_assert(T_MGF + (size_t)S * D * 4 <= T_U1_END, "outproj overlay");
static_assert(T_PR + (size_t)S * 1792 * 2 <= T_U1_END, "g1 overlay");
constexpr size_t T_FFNW = T_RW;
constexpr size_t T_FFNWD = T_FFNW + (size_t)2 * FFD * D * 2;
static_assert(T_FFNWD + (size_t)D * FFD * 2 <= T_RKK, "ffn weights overlay");
constexpr size_t T_ACT = T_RKK;
static_assert(T_ACT + (size_t)S * FFD * 2 <= T_U1, "ffn act overlay");
constexpr size_t M_WGU = O_M;
constexpr size_t M_WD = M_WGU + (size_t)NEXP * 2 * FFE * D * 2;
constexpr size_t M_XS = M_WD + (size_t)NEXP * D * FFE * 2;
constexpr size_t M_ACT = M_XS + (size_t)MOE_ROWS * D * 2;
constexpr int MOE_HALF_ROWS = MOE_ROWS / 2 + 256;
constexpr size_t M_RS = M_ACT + (size_t)MOE_HALF_ROWS * FFE * 2;
constexpr size_t M_RG = M_RS + (size_t)MOE_ROWS * 4;
constexpr size_t M_TOKROW = M_RG + (size_t)MOE_ROWS * 4;
constexpr size_t M_TOPE = M_TOKROW + (size_t)S * 2 * 4;
constexpr size_t M_TOPG = M_TOPE + (size_t)S * 2 * 4;
constexpr size_t M_CNT = M_TOPG + (size_t)S * 2 * 4;
constexpr size_t M_END = M_CNT + 256 * 8 * 4;
constexpr size_t WS_NEED = (T_U1_END > M_END ? T_U1_END : M_END);

constexpr int CW_BAR = 1024;
constexpr int CW_Q_FOX = 8192;
constexpr int CW_Q_DSA = 8192 + 64;

constexpr int LDS_MISC = 147456 - 256;
constexpr int LDS_BYTES = 147456;

__device__ __forceinline__ unsigned pk_bf16(float lo, float hi) { f32x2 v = {lo, hi}; bf16x2_t b = __builtin_convertvector(v, bf16x2_t); return __builtin_bit_cast(unsigned, b); }
__device__ __forceinline__ float bf2f(u16 b) { return __uint_as_float(((unsigned)b) << 16); }
__device__ __forceinline__ float bflo(unsigned w) { return __uint_as_float(w << 16); }
__device__ __forceinline__ float bfhi(unsigned w) { return __uint_as_float(w & 0xffff0000u); }
__device__ __forceinline__ u16 f2bf(float f) { return (u16)(pk_bf16(f, 0.f) & 0xffffu); }
__device__ __forceinline__ float wave_sum(float v) {
#pragma unroll
    for (int o = 1; o < 64; o <<= 1) v += __shfl_xor(v, o);
    return v;
}
__device__ __forceinline__ unsigned lds_addu(LAS unsigned* p, unsigned v) { return __hip_atomic_fetch_add(p, v, __ATOMIC_RELAXED, __HIP_MEMORY_SCOPE_WORKGROUP); }
__device__ __forceinline__ void lds_oru(LAS unsigned* p, unsigned v) { (void)__hip_atomic_fetch_or(p, v, __ATOMIC_RELAXED, __HIP_MEMORY_SCOPE_WORKGROUP); }
__device__ __forceinline__ int lds_addi(LAS int* p, int v) { return __hip_atomic_fetch_add(p, v, __ATOMIC_RELAXED, __HIP_MEMORY_SCOPE_WORKGROUP); }
__device__ __forceinline__ float sigmoidf_(float x) { return 1.0f / (1.0f + __expf(-x)); }
__device__ __forceinline__ float row_rstd(const float* ssq, int row) {
    const f32x4* p = (const f32x4*)(ssq + (size_t)row * 16);
    const f32x4 a = p[0], b = p[1], c = p[2], d = p[3];
    const float s = ((a.x + a.y) + (a.z + a.w)) + ((b.x + b.y) + (b.z + b.w)) + ((c.x + c.y) + (c.z + c.w)) + ((d.x + d.y) + (d.z + d.w));
    return 1.0f / sqrtf(s * (1.0f / D) + RMS_EPS);
}

#define XB_TMO      128
#define XB_XCNT(j)  (256  + 64 * (j))
#define XB_XSUB(j)  (1280 + 64 * (j))
#define XB_XGEN(j)  (2304 + 64 * (j))
#define XB_TOP      3328
#define XB_TOPGEN   3392
#define XCD_BAR_WORDS 3456
#define XB_SPIN_CAP (1u << 22)
__device__ __forceinline__ unsigned xb_ld(unsigned* p)              { return __hip_atomic_load(p, __ATOMIC_RELAXED, __HIP_MEMORY_SCOPE_AGENT); }
__device__ __forceinline__ unsigned xb_add(unsigned* p, unsigned v) { return __hip_atomic_fetch_add(p, v, __ATOMIC_RELAXED, __HIP_MEMORY_SCOPE_AGENT); }
__device__ __forceinline__ unsigned xb_xcc_id() { return (unsigned)__builtin_amdgcn_s_getreg((3 << 11) | 20) & 0xFu; }
#define XB_SPIN(cond, bar) do { unsigned _sp = 0; while (cond) { __builtin_amdgcn_s_sleep(1); \
    if ((++_sp & 255u) == 0u) { if (xb_ld(&(bar)[XB_TMO])) break; if (_sp > XB_SPIN_CAP) { atomicAdd(&(bar)[XB_TMO], 1u); break; } } } } while (0)
struct XcdBarrier { unsigned* bar; unsigned x; volatile LAS unsigned* st; };
__device__ __forceinline__ XcdBarrier xcd_barrier_post(unsigned* bar, volatile LAS unsigned* st) {
    XcdBarrier b; b.bar = bar; b.x = xb_xcc_id(); b.st = st;
    if (threadIdx.x == 0) (void)xb_add(&bar[XB_XCNT(b.x)], 1u);
    return b;
}
__device__ __forceinline__ void xcd_barrier_complete(unsigned* bar, unsigned x, unsigned& nloc, unsigned& nx) {
    const unsigned G = gridDim.x * gridDim.y * gridDim.z;
    unsigned sum, cnt, mine, sp = 0u;
    for (;;) {
        sum = 0u; cnt = 0u; mine = 0u;
#pragma unroll
        for (unsigned j = 0; j < 16; ++j) { const unsigned c = xb_ld(&bar[XB_XCNT(j)]); sum += c; cnt += (c > 0u) ? 1u : 0u; mine = (j == x) ? c : mine; }
        if (sum == G) break;
        __builtin_amdgcn_s_sleep(1);
        if ((++sp & 255u) == 0u) { if (xb_ld(&bar[XB_TMO])) break; if (sp > XB_SPIN_CAP) { atomicAdd(&bar[XB_TMO], 1u); break; } }
    }
    nloc = mine > 0u ? mine : 1u; nx = cnt > 0u ? cnt : 1u;
}
__device__ __forceinline__ void xcd_barrier(const XcdBarrier& b) {
    asm volatile("s_waitcnt vmcnt(0)" ::: "memory");
    __syncthreads();
    if (threadIdx.x == 0) {
        unsigned* bar = b.bar;
        __builtin_amdgcn_s_waitcnt(0);
        unsigned nloc = b.st[0], nx = b.st[1];
        if (nloc == 0u) { xcd_barrier_complete(bar, b.x, nloc, nx); b.st[0] = nloc; b.st[1] = nx; }
        const unsigned old = xb_add(&bar[XB_XSUB(b.x)], 1u);
        const unsigned gen = old / nloc;
        if (old + 1u == (gen + 1u) * nloc) {
            __builtin_amdgcn_fence(__ATOMIC_RELEASE, "agent");
            asm volatile("s_waitcnt vmcnt(0)" ::: "memory");
            const unsigned og = xb_add(&bar[XB_TOP], 1u);
            const unsigned tg = og / nx;
            if (og + 1u == (tg + 1u) * nx) xb_add(&bar[XB_TOPGEN], 1u);
            else XB_SPIN(xb_ld(&bar[XB_TOPGEN]) == tg, bar);
            __builtin_amdgcn_fence(__ATOMIC_ACQUIRE, "agent");
            xb_add(&bar[XB_XGEN(b.x)], 1u);
            asm volatile("s_waitcnt vmcnt(0)" ::: "memory");
        } else {
            XB_SPIN(xb_ld(&bar[XB_XGEN(b.x)]) == gen, bar);
            __builtin_amdgcn_fence(__ATOMIC_ACQUIRE, "agent");
            asm volatile("s_waitcnt vmcnt(0)" ::: "memory");
        }
    }
    __syncthreads();
}

namespace pg8 {
constexpr int BM = 256, BK = 64, HALF = 128, HTB = HALF * BK * 2, STAGE_BYTES = 8 * HTB, NXCD = 8, WGM = 8;
__host__ __device__ __forceinline__ int lds_byte(int r, int c) { const int st = (r >> 4) * 2 + (c >> 5), rr = r & 15, cc = c & 31, ob = rr * 64 + cc * 2; return st * 1024 + (ob ^ (((ob >> 9) & 1) << 5)); }
__host__ __device__ __forceinline__ void stage_rc(int b, int& R, int& C) { const int st = b / 1024, sb = b % 1024, swz = sb ^ (((sb >> 9) & 1) << 5); R = (st >> 1) * 16 + swz / 64; C = (st & 1) * 32 + (swz % 64) / 2; }
__host__ __device__ __forceinline__ int perm32(int rho) { const int n = rho >> 4, i = rho & 15; return 8 * (i >> 2) + 4 * n + (i & 3); }
struct Unit { int pm, pn, cn; };
struct Gemm { const u16* A; const u16* Bt; int K; };
struct StaticOrder {
    int nM, nN, nwg, G, c;
    __device__ void init(int M, int N, int G_, int c_) { nM = M / BM; nN = N / BM; nwg = nM * nN; G = G_; c = c_; }
    __device__ bool next(int i, Unit& u) const {
        const long L = (long)i * G + c; if (L >= nwg) return false;
        int wgid = (int)L; { const int q = nwg / NXCD, r = nwg % NXCD, xcd = wgid % NXCD, off = wgid / NXCD; wgid = (xcd < r ? xcd * (q + 1) : r * (q + 1) + (xcd - r) * q) + off; }
        const int nig = WGM * nN, gid = wgid / nig, fm = gid * WGM, gsz = (nM - fm) < WGM ? (nM - fm) : WGM;
        u.pm = fm + ((wgid % nig) % gsz); u.pn = (wgid % nig) / gsz; u.cn = u.pn; return true;
    }
};
struct MoeOrder {
    int p0, np, ncol, G, c, browtiles; const LAS int* pexp;
    __device__ bool next(int i, Unit& u) const {
        const long L = (long)i * G + c; if (L >= (long)np * ncol) return false;
        const int cn = (int)(L / np), p = p0 + (int)(L % np);
        u.pm = p; u.cn = cn; u.pn = pexp[p] * browtiles + cn; return true;
    }
};

template <class Epi, class Sched>
__device__ __forceinline__ void gemm_phase(LAS unsigned char* lds, const Gemm g, const Sched& S_, const Epi& E) {
    int tid = threadIdx.x; asm volatile("" : "+v"(tid));
    const int wid = __builtin_amdgcn_readfirstlane(tid >> 6), lane = tid & 63, wr = wid >> 2, wc = wid & 3, fr = lane & 15, fq = lane >> 4;
    int K = g.K; asm volatile("" : "+s"(K));
    const int nt = K / BK;
    unsigned voffA[2], voffB[2];
#pragma unroll
    for (int i = 0; i < 2; ++i) { int R, C; stage_rc(tid * 16 + i * 8192, R, C); const int Rb = Epi::PERM ? ((R & ~31) + perm32(R & 31)) : R;
        voffA[i] = (unsigned)(R * K + C) * 2u; voffB[i] = (unsigned)(Rb * K + C) * 2u; }
    const size_t kstep = (size_t)(BK * 2);
    const size_t hstep = (size_t)HALF * K * 2;
    const size_t tstep = 2 * hstep;
    const unsigned ldsw = (unsigned)wid * 1024u;
    const int aoff = lds_byte(wr * 64 + fr, fq * 8), boff = lds_byte(wc * 32 + fr, fq * 8);
#define PG8_SA(b, h) (((b) * 2 + (h)) * HTB)
#define PG8_SB(b, h) ((4 + (b) * 2 + (h)) * HTB)
#define PG8_STAGE(bufoff, gbase, voff) do { _Pragma("unroll") for (int _i = 0; _i < 2; ++_i) \
        __builtin_amdgcn_global_load_lds((const unsigned*)((const char*)(gbase) + (voff)[_i]), (LAS unsigned*)(lds + (bufoff) + ldsw + _i * 8192), 16, 0, 0); } while (0)
#define PG8_LDA(dst, b, h) do { _Pragma("unroll") for (int m = 0; m < 4; ++m) _Pragma("unroll") for (int k = 0; k < 2; ++k) dst[m][k] = *(const LAS bf16x8*)(lds + PG8_SA(b, h) + aoff + m * 2048 + k * 1024); } while (0)
#define PG8_LDB(dst, b, h) do { _Pragma("unroll") for (int n = 0; n < 2; ++n) _Pragma("unroll") for (int k = 0; k < 2; ++k) dst[n][k] = *(const LAS bf16x8*)(lds + PG8_SB(b, h) + boff + n * 2048 + k * 1024); } while (0)
#define PG8_MMA(ai, bj, At, Bt) do { __builtin_amdgcn_s_setprio(1); _Pragma("unroll") for (int m = 0; m < 4; ++m) _Pragma("unroll") for (int n = 0; n < 2; ++n) _Pragma("unroll") for (int k = 0; k < 2; ++k) \
        acc[ai][bj][m][n] = __builtin_amdgcn_mfma_f32_16x16x32_bf16(Bt[n][k], At[m][k], acc[ai][bj][m][n], 0, 0, 0); __builtin_amdgcn_s_setprio(0); } while (0)
#define PG8_WAIT_V(n) asm volatile("s_waitcnt vmcnt(" #n ")" ::: "memory")
#define PG8_WAIT_L(n) asm volatile("s_waitcnt lgkmcnt(" #n ")" ::: "memory")
#define PG8_BAR __builtin_amdgcn_s_barrier()
#define PG8_SCHED __builtin_amdgcn_sched_barrier(0)
    Unit cur, nxt; int ui = 0;
    if (!S_.next(0, cur)) return;
    f32x4 acc[2][2][4][2];
#pragma unroll
    for (int a = 0; a < 2; ++a)
#pragma unroll
        for (int b = 0; b < 2; ++b)
#pragma unroll
            for (int m = 0; m < 4; ++m)
#pragma unroll
                for (int n = 0; n < 2; ++n) acc[a][b][m][n] = (f32x4){0.f, 0.f, 0.f, 0.f};
    bf16x8 At[4][2], B0[2][2], B1[2][2];
    const char* cA = (const char*)g.A + (size_t)cur.pm * tstep; const char* cB = (const char*)g.Bt + (size_t)cur.pn * tstep;
    PG8_STAGE(PG8_SB(0, 0), cB, voffB); PG8_STAGE(PG8_SB(0, 1), cB + hstep, voffB); PG8_STAGE(PG8_SA(0, 0), cA, voffA); PG8_STAGE(PG8_SA(0, 1), cA + hstep, voffA);
    if (wr == 1) PG8_BAR;
    PG8_WAIT_V(2); PG8_BAR;
    PG8_STAGE(PG8_SB(1, 0), cB + kstep, voffB); PG8_STAGE(PG8_SA(1, 0), cA + kstep, voffA); PG8_STAGE(PG8_SB(1, 1), cB + hstep + kstep, voffB);
    PG8_WAIT_V(6); PG8_BAR;
    for (;;) {
        const bool has_next = S_.next(ui + 1, nxt);
        const char* nA = has_next ? (const char*)g.A + (size_t)nxt.pm * tstep : cA; const char* nB = has_next ? (const char*)g.Bt + (size_t)nxt.pn * tstep : cB;
        for (int t = 0; t < nt; t += 2) {
            const bool last = (t == nt - 2);
            const char* a1 = cA + (size_t)(t + 1) * kstep;
            const char* a2 = last ? nA : cA + (size_t)(t + 2) * kstep; const char* b2 = last ? nB : cB + (size_t)(t + 2) * kstep;
            const char* a3 = a2 + kstep; const char* b3 = b2 + kstep;
            PG8_LDB(B0, 0, 0); PG8_LDB(B1, 0, 1); PG8_SCHED; PG8_LDA(At, 0, 0); PG8_STAGE(PG8_SA(1, 1), a1 + hstep, voffA);
            PG8_WAIT_V(8); PG8_WAIT_L(0); PG8_BAR; PG8_MMA(0, 0, At, B0); PG8_MMA(0, 1, At, B1); PG8_BAR; PG8_SCHED;
            PG8_LDA(At, 0, 1); PG8_STAGE(PG8_SB(0, 0), b2, voffB); PG8_STAGE(PG8_SB(0, 1), b2 + hstep, voffB); PG8_STAGE(PG8_SA(0, 0), a2, voffA);
            PG8_WAIT_V(8); PG8_WAIT_L(0); PG8_BAR; PG8_MMA(1, 0, At, B0); PG8_MMA(1, 1, At, B1); PG8_BAR; PG8_SCHED;
            PG8_LDB(B0, 1, 0); PG8_LDB(B1, 1, 1); PG8_SCHED; PG8_LDA(At, 1, 0); PG8_STAGE(PG8_SA(0, 1), a2 + hstep, voffA);
            PG8_WAIT_V(8); PG8_WAIT_L(0); PG8_BAR; PG8_MMA(0, 0, At, B0); PG8_MMA(0, 1, At, B1); PG8_BAR; PG8_SCHED;
            PG8_LDA(At, 1, 1); PG8_STAGE(PG8_SB(1, 0), b3, voffB); PG8_STAGE(PG8_SB(1, 1), b3 + hstep, voffB); PG8_STAGE(PG8_SA(1, 0), a3, voffA);
            PG8_WAIT_V(8); PG8_WAIT_L(0); PG8_BAR; PG8_MMA(1, 0, At, B0); PG8_MMA(1, 1, At, B1); PG8_BAR; PG8_SCHED;
        }
        if (wr == 0) PG8_BAR;
        { int fr2 = fr, fq2 = fq; asm volatile("" : "+v"(fr2), "+v"(fq2)); E(acc, cur, wr, wc, fr2, fq2); }
        if (!has_next) break;
#pragma unroll
        for (int a = 0; a < 2; ++a)
#pragma unroll
            for (int b = 0; b < 2; ++b)
#pragma unroll
                for (int m = 0; m < 4; ++m)
#pragma unroll
                    for (int n = 0; n < 2; ++n) acc[a][b][m][n] = (f32x4){0.f, 0.f, 0.f, 0.f};
        cur = nxt; cA = nA; cB = nB; ++ui;
        if (wr == 1) PG8_BAR;
    }
    PG8_WAIT_V(0);
    PG8_BAR;
#undef PG8_SA
#undef PG8_SB
#undef PG8_STAGE
#undef PG8_LDA
#undef PG8_LDB
#undef PG8_MMA
#undef PG8_WAIT_V
#undef PG8_WAIT_L
#undef PG8_BAR
#undef PG8_SCHED
}
}
using pg8::Unit;
typedef f32x4 AccT[2][2][4][2];

__device__ __forceinline__ void st_bf16x8(u16* p, f32x4 v0, f32x4 v1) { u32x4 w; w.x = pk_bf16(v0[0], v0[1]); w.y = pk_bf16(v0[2], v0[3]); w.z = pk_bf16(v1[0], v1[1]); w.w = pk_bf16(v1[2], v1[3]); *(u32x4*)p = w; }
__device__ __forceinline__ void ld_bf16x8(const u16* p, f32x4& v0, f32x4& v1) { const u32x4 w = *(const u32x4*)p; v0 = (f32x4){bflo(w.x), bfhi(w.x), bflo(w.y), bfhi(w.y)}; v1 = (f32x4){bflo(w.z), bfhi(w.z), bflo(w.w), bfhi(w.w)}; }

struct EpiG1 {
    static constexpr bool PERM = true;
    const float* ssq; u16* qkvf; u16* ql; float* t56; u16* pr;
    __device__ __forceinline__ void operator()(const AccT& acc, const Unit& u, int wr, int wc, int fr, int fq) const {
        const int row0 = u.pm * 256 + wr * 64 + fr, cn = u.cn;
        u16* ob = nullptr; float* of = nullptr; int ld, cb;
        if (cn < 3) { ob = qkvf; ld = 768; cb = cn * 256; } else if (cn < 5) { ob = ql; ld = 512; cb = (cn - 3) * 256; }
        else if (cn < 7) { of = t56; ld = 512; cb = (cn - 5) * 256; } else { ob = pr; ld = 1792; cb = (cn - 7) * 256; }
#pragma unroll
        for (int ai = 0; ai < 2; ++ai)
#pragma unroll
            for (int m = 0; m < 4; ++m) {
                const int row = row0 + ai * 128 + m * 16; const float rs = row_rstd(ssq, row);
#pragma unroll
                for (int bj = 0; bj < 2; ++bj) {
                    const int col = cb + bj * 128 + wc * 32 + 8 * fq;
                    const f32x4 v0 = acc[ai][bj][m][0] * rs, v1 = acc[ai][bj][m][1] * rs;
                    if (of) { float* p = of + (size_t)row * ld + col; *(f32x4*)p = v0; *(f32x4*)(p + 4) = v1; }
                    else st_bf16x8(ob + (size_t)row * ld + col, v0, v1);
                }
                asm volatile("" ::: "memory");
            }
    }
};
struct EpiGate {
    static constexpr bool PERM = true;
    const float* ssq; const float* bias; u16* gt;
    __device__ __forceinline__ void operator()(const AccT& acc, const Unit& u, int wr, int wc, int fr, int fq) const {
        const int row0 = u.pm * 256 + wr * 64 + fr;
#pragma unroll
        for (int ai = 0; ai < 2; ++ai)
#pragma unroll
            for (int m = 0; m < 4; ++m) {
                const int row = row0 + ai * 128 + m * 16; const float rs = row_rstd(ssq, row);
#pragma unroll
                for (int bj = 0; bj < 2; ++bj) {
                    const int col = u.cn * 256 + bj * 128 + wc * 32 + 8 * fq;
                    const f32x4 b0 = *(const f32x4*)(bias + col), b1 = *(const f32x4*)(bias + col + 4);
                    f32x4 v0 = acc[ai][bj][m][0] * rs + b0, v1 = acc[ai][bj][m][1] * rs + b1;
#pragma unroll
                    for (int j = 0; j < 4; ++j) { v0[j] = sigmoidf_(v0[j]); v1[j] = sigmoidf_(v1[j]); }
                    st_bf16x8(gt + (size_t)row * D + col, v0, v1);
                    asm volatile("" ::: "memory");
                }
            }
    }
};
template <int MODE> struct EpiProj {
    static constexpr bool PERM = true;
    u16* gt; float* mgf;
    __device__ __forceinline__ void operator()(const AccT& acc, const Unit& u, int wr, int wc, int fr, int fq) const {
        const int row0 = u.pm * 256 + wr * 64 + fr;
#pragma unroll
        for (int ai = 0; ai < 2; ++ai)
#pragma unroll
            for (int m = 0; m < 4; ++m) {
                const int row = row0 + ai * 128 + m * 16;
#pragma unroll
                for (int bj = 0; bj < 2; ++bj) {
                    const int col = u.cn * 256 + bj * 128 + wc * 32 + 8 * fq; const size_t o = (size_t)row * D + col;
                    f32x4 g0, g1; ld_bf16x8(gt + o, g0, g1);
                    f32x4 v0 = acc[ai][bj][m][0] * g0, v1 = acc[ai][bj][m][1] * g1;
                    if (MODE >= 1) { v0 += *(const f32x4*)(mgf + o); v1 += *(const f32x4*)(mgf + o + 4); }
                    if (MODE <= 1) { *(f32x4*)(mgf + o) = v0; *(f32x4*)(mgf + o + 4) = v1; }
                    else st_bf16x8(gt + o, v0, v1);
                    asm volatile("" ::: "memory");
                }
            }
    }
};
struct EpiResid {
    static constexpr bool PERM = true;
    float* xr; u16* xb; float* ssq;
    __device__ __forceinline__ void operator()(const AccT& acc, const Unit& u, int wr, int wc, int fr, int fq) const {
        const int row0 = u.pm * 256 + wr * 64 + fr;
#pragma unroll
        for (int ai = 0; ai < 2; ++ai)
#pragma unroll
            for (int m = 0; m < 4; ++m) {
                const int row = row0 + ai * 128 + m * 16; float sq = 0.f;
#pragma unroll
                for (int bj = 0; bj < 2; ++bj) {
                    const int col = u.cn * 256 + bj * 128 + wc * 32 + 8 * fq; const size_t o = (size_t)row * D + col;
                    const f32x4 v0 = acc[ai][bj][m][0] + *(const f32x4*)(xr + o), v1 = acc[ai][bj][m][1] + *(const f32x4*)(xr + o + 4);
                    *(f32x4*)(xr + o) = v0; *(f32x4*)(xr + o + 4) = v1;
                    st_bf16x8(xb + o, v0, v1);
                    sq += (v0[0] * v0[0] + v0[1] * v0[1]) + (v0[2] * v0[2] + v0[3] * v0[3]) + (v1[0] * v1[0] + v1[1] * v1[1]) + (v1[2] * v1[2] + v1[3] * v1[3]);
                    asm volatile("" ::: "memory");
                }
                sq += __shfl_xor(sq, 16); sq += __shfl_xor(sq, 32);
                if (fq == 0) ssq[(size_t)row * 16 + u.cn * 4 + wc] = sq;
            }
    }
};
struct EpiSwiglu {
    static constexpr bool PERM = true;
    const float* ssq; const float* rsrow; u16* act; int ld; int row_base;
    __device__ __forceinline__ void operator()(const AccT& acc, const Unit& u, int wr, int wc, int fr, int fq) const {
        const int row0 = u.pm * 256 + wr * 64 + fr;
#pragma unroll
        for (int ai = 0; ai < 2; ++ai)
#pragma unroll
            for (int m = 0; m < 4; ++m) {
                const int row = row0 + ai * 128 + m * 16; const float rs = rsrow ? rsrow[row] : row_rstd(ssq, row);
                f32x4 o[2];
#pragma unroll
                for (int n = 0; n < 2; ++n)
#pragma unroll
                    for (int j = 0; j < 4; ++j) { const float gv = acc[ai][0][m][n][j] * rs, uv = acc[ai][1][m][n][j] * rs; o[n][j] = gv * sigmoidf_(gv) * uv; }
                st_bf16x8(act + (size_t)(row - row_base) * ld + u.cn * 128 + wc * 32 + 8 * fq, o[0], o[1]);
                asm volatile("" ::: "memory");
            }
    }
};
struct EpiMoeDown {
    static constexpr bool PERM = true;
    const float* rg; u16* ys;
    __device__ __forceinline__ void operator()(const AccT& acc, const Unit& u, int wr, int wc, int fr, int fq) const {
        const int row0 = u.pm * 256 + wr * 64 + fr;
#pragma unroll
        for (int ai = 0; ai < 2; ++ai)
#pragma unroll
            for (int m = 0; m < 4; ++m) {
                const int row = row0 + ai * 128 + m * 16; const float gsc = rg[row];
#pragma unroll
                for (int bj = 0; bj < 2; ++bj) {
                    const int col = u.cn * 256 + bj * 128 + wc * 32 + 8 * fq;
                    st_bf16x8(ys + (size_t)row * D + col, acc[ai][bj][m][0] * gsc, acc[ai][bj][m][1] * gsc);
                }
            }
    }
};

struct Args {
    const float* in[37];
    float* out; unsigned char* ws;
    int ph_lo, ph_hi;
};
typedef const __attribute__((address_space(4))) Args* CArgsP;
enum { I_X = 0, I_WIN, I_BGATE, I_GMIX, I_FBIAS, I_KVNORM, I_WUK, I_WUV, I_MU, I_W0, I_WUP, I_A0, I_AUP, I_GUP, I_KK, I_KA, I_RK, I_LNG, I_LNB,
       I_VDOWN, I_VMU, I_VUP, I_VV0, I_PFOX, I_PDSA, I_PRWKV, I_WOUT, I_GFFN, I_FWG, I_FWU, I_FWD, I_RTW, I_RTB, I_MWG, I_MWU, I_MWD, I_GFINAL };

struct Seg { const float* src; const float* src2; const float* gk; const float* aux; u16* dst; int kind, K, ld, col0, nrows, row0, item0; float scale; };
constexpr int MAXSEG = 48;
__device__ __forceinline__ void seg_set(LAS Seg* s, int& n, int& items, int kind, const float* src, const float* src2, const float* gk, const float* aux, u16* dst, int K, int ld, int col0, int nrows, int row0, float scale) {
    LAS Seg& g = s[n]; g.src = src; g.src2 = src2; g.gk = gk; g.aux = aux; g.dst = dst; g.kind = kind; g.K = K; g.ld = ld; g.col0 = col0; g.nrows = nrows; g.row0 = row0; g.item0 = items; g.scale = scale;
    items += (K / 64) * ((nrows + 31) / 32); ++n;
}
__device__ __forceinline__ float seg_val(const LAS Seg& g, int k, int n) {
    if (n >= g.nrows) return 0.f;
    switch (g.kind) {
    case 0: { float v = g.src[(size_t)k * g.ld + g.col0 + n] * g.scale; if (g.gk) v *= g.gk[k]; return v; }
    case 1: { const int within = n & 255, which = within >> 7, j = (n >> 8) * 128 + (within & 127); const float* sp = which ? g.src2 : g.src; float v = sp[(size_t)k * g.ld + j]; if (g.gk) v *= g.gk[k]; return v; }
    case 2: { const int h = n >> 7, r = n & 127; float s = 0.f; const float* sp = g.src + (size_t)k * g.ld + g.col0 + h * 64; const float* ap = g.aux + (size_t)h * 64 * 128 + r;
              for (int d = 0; d < 64; ++d) s += sp[d] * ap[d * 128]; return s * g.scale * g.gk[k]; }
    case 3: { const int h = k >> 7, r = k & 127; float s = 0.f; const float* ap = g.aux + (size_t)(h * 128 + r) * 64; const float* sp = g.src + (size_t)(h * 64) * g.ld + n;
              for (int d = 0; d < 64; ++d) s += ap[d] * sp[(size_t)d * g.ld]; return s; }
    default: return 0.f;
    }
}
__device__ __forceinline__ void convert_items(const LAS Seg* segs, int s_lo, int s_hi, int nitems, LAS float* scr, int gw, int ngw, int lane) {
    for (int it = gw; it < nitems; it += ngw) {
        int si = s_lo;
        for (int j = s_lo + 1; j < s_hi; ++j) if (segs[j].item0 <= it) si = j;
        const LAS Seg& g = segs[si];
        const int r = it - g.item0, nnb = (g.nrows + 31) / 32, kb = r / nnb, nb = r % nnb, k0 = 64 * kb, n0 = 32 * nb;
#pragma unroll 4
        for (int i = 0; i < 32; ++i) { const int kk = 2 * i + (lane >> 5); scr[kk * 33 + (lane & 31)] = seg_val(g, k0 + kk, n0 + (lane & 31)); }
        asm volatile("s_waitcnt lgkmcnt(0)" ::: "memory");
        const int c = lane & 7;
#pragma unroll
        for (int j = 0; j < 4; ++j) { const int n = (lane >> 3) + 8 * j; const LAS float* s = scr + (8 * c) * 33 + n;
            u32x4 o; o.x = pk_bf16(s[0 * 33], s[1 * 33]); o.y = pk_bf16(s[2 * 33], s[3 * 33]); o.z = pk_bf16(s[4 * 33], s[5 * 33]); o.w = pk_bf16(s[6 * 33], s[7 * 33]);
            if (n0 + n < g.nrows) *(u32x4*)(g.dst + (size_t)(g.row0 + n0 + n) * g.K + k0 + 8 * c) = o; }
        asm volatile("s_waitcnt lgkmcnt(0)" ::: "memory");
    }
}

template <int KIND>
__device__ __forceinline__ int convert_seg(const float* src, const float* src2, const float* gk, u16* dst, int K, int ld, int nrows, int item0, LAS float* scr, int gw, int ngw, int lane) {
    const int nnb = (nrows + 31) / 32, nit = (K / 64) * nnb;
    int first = item0 + ((gw - item0) % ngw + ngw) % ngw;
    for (int it = first; it < item0 + nit; it += ngw) {
        const int r = it - item0, kb = r / nnb, nb = r % nnb, k0 = 64 * kb, n0 = 32 * nb;
#pragma unroll 4
        for (int i = 0; i < 32; ++i) { const int kk = 2 * i + (lane >> 5), k = k0 + kk, n = n0 + (lane & 31); float v = 0.f;
            if (n < nrows) { if (KIND == 0) v = src[(size_t)k * ld + n]; else { const int within = n & 255, which = within >> 7, j = (n >> 8) * 128 + (within & 127); v = (which ? src2 : src)[(size_t)k * ld + j]; } if (gk) v *= gk[k]; }
            scr[kk * 33 + (lane & 31)] = v; }
        asm volatile("s_waitcnt lgkmcnt(0)" ::: "memory");
        const int c = lane & 7;
#pragma unroll
        for (int j = 0; j < 4; ++j) { const int n = (lane >> 3) + 8 * j; const LAS float* s = scr + (8 * c) * 33 + n;
            u32x4 o; o.x = pk_bf16(s[0 * 33], s[1 * 33]); o.y = pk_bf16(s[2 * 33], s[3 * 33]); o.z = pk_bf16(s[4 * 33], s[5 * 33]); o.w = pk_bf16(s[6 * 33], s[7 * 33]);
            if (n0 + n < nrows) *(u32x4*)(dst + (size_t)(n0 + n) * K + k0 + 8 * c) = o; }
        asm volatile("s_waitcnt lgkmcnt(0)" ::: "memory");
    }
    return item0 + nit;
}

struct Ctx {
    LAS unsigned char* lds; unsigned char* ws; u32* ctl;
    int tid, lane, wave, gw, ngw, G, bid;
};

__device__ __forceinline__ void phase_prologue(const Ctx& c, CArgsP a) {
    LAS Seg* segs = (LAS Seg*)(c.lds + 69632);
    LAS int* nfo = (LAS int*)(c.lds + 69632 + MAXSEG * sizeof(Seg));
    if (c.tid == 0) {
        int n = 0, items = 0;
        for (int l = 0; l < 2; ++l) {
            const float* win = a->in[I_WIN] + (size_t)l * D * DIN; const float* gm = a->in[I_GMIX] + l * D;
            u16* w1 = (u16*)(c.ws + O_W1) + (size_t)l * NW1 * D;
            seg_set(segs, n, items, 0, win, nullptr, gm, nullptr, w1, D, DIN, 0, 256, 0, C2);
            seg_set(segs, n, items, 0, win, nullptr, gm, nullptr, w1, D, DIN, 256, 512, 256, 1.f);
            seg_set(segs, n, items, 2, win, nullptr, gm, a->in[I_WUK] + (size_t)l * 4 * 64 * 128, w1, D, DIN, 772, 512, 768, C2);
            seg_set(segs, n, items, 0, win, nullptr, gm, nullptr, w1, D, DIN, 1156, 256, 1280, 1.f);
            seg_set(segs, n, items, 0, win, nullptr, gm, nullptr, w1, D, DIN, 1028, 128, 1536, 1.f);
            seg_set(segs, n, items, 0, win, nullptr, gm, nullptr, w1, D, DIN, 1412, 32, 1664, 1.f);
            seg_set(segs, n, items, 0, win, nullptr, gm, nullptr, w1, D, DIN, 1444, 8, 1696, 1.f);
            seg_set(segs, n, items, 0, win, nullptr, gm, nullptr, w1, D, DIN, 768, 4, 1704, 1.f);
            if (l == 1) seg_set(segs, n, items, 0, a->in[I_VDOWN], nullptr, gm, nullptr, w1, D, 32, 0, 32, 1708, 1.f);
            else seg_set(segs, n, items, 4, nullptr, nullptr, nullptr, nullptr, w1, D, 0, 0, 32, 1708, 1.f);
            seg_set(segs, n, items, 4, nullptr, nullptr, nullptr, nullptr, w1, D, 0, 0, 52, 1740, 1.f);
            seg_set(segs, n, items, 0, win, nullptr, gm, nullptr, w1, D, DIN, 1452, 1792, 1792, 1.f);
            seg_set(segs, n, items, 0, win, nullptr, gm, nullptr, (u16*)(c.ws + O_WGT) + (size_t)l * 3072 * D, D, DIN, 3244, 3072, 0, 1.f);
            u16* ow = (u16*)(c.ws + O_OUTW + l * OUTW_L);
            seg_set(segs, n, items, 0, a->in[I_PFOX] + (size_t)l * 256 * D, nullptr, nullptr, nullptr, ow, 256, D, 0, 1024, 0, 1.f);
            seg_set(segs, n, items, 3, a->in[I_PDSA] + (size_t)l * 256 * D, nullptr, nullptr, a->in[I_WUV] + (size_t)l * 4 * 128 * 64, ow + 1024 * 256, 512, D, 0, 1024, 0, 1.f);
            seg_set(segs, n, items, 0, a->in[I_PRWKV] + (size_t)l * 512 * D, nullptr, nullptr, nullptr, ow + 1024 * 256 + 1024 * 512, 512, D, 0, 1024, 0, 1.f);
            seg_set(segs, n, items, 0, a->in[I_WOUT] + (size_t)l * D * D, nullptr, nullptr, nullptr, ow + 1024 * 256 + 2 * 1024 * 512, D, D, 0, 1024, 0, 1.f);
        }
        nfo[0] = n; nfo[1] = items;
    }
    __syncthreads();
    convert_items(segs, 0, nfo[0], nfo[1], (LAS float*)(c.lds + c.wave * 8704), c.gw, c.ngw, c.lane);
    const float* x = a->in[I_X]; float* xr = (float*)(c.ws + O_XR); u16* xb = (u16*)(c.ws + O_XB); float* ssq = (float*)(c.ws + O_SSQ);
    for (int t = c.gw; t < S; t += c.ngw) {
        const f32x4* xp = (const f32x4*)(x + (size_t)t * D) + c.lane; float s = 0.f;
#pragma unroll
        for (int j = 0; j < 4; ++j) { const f32x4 v = xp[64 * j]; s += (v.x * v.x + v.y * v.y) + (v.z * v.z + v.w * v.w);
            ((f32x4*)(xr + (size_t)t * D))[c.lane + 64 * j] = v;
            u32x2 w; w.x = pk_bf16(v.x, v.y); w.y = pk_bf16(v.z, v.w); ((u32x2*)(xb + (size_t)t * D))[c.lane + 64 * j] = w; }
        s = wave_sum(s);
        if (c.lane < 16) ssq[(size_t)t * 16 + c.lane] = (c.lane == 0) ? s : 0.f;
    }
}

__device__ __forceinline__ float log_sigmoid_(float x) { return -(fmaxf(-x, 0.f) + log1pf(__expf(-fabsf(x)))); }
__device__ __forceinline__ void phase_prep(const Ctx& c, CArgsP a, int l) {
    const u16* qkvf = (const u16*)(c.ws + T_QKVF); const float* t56 = (const float*)(c.ws + T_T56); const u16* pr = (const u16*)(c.ws + T_PR);
    float* FL = (float*)(c.ws + T_FL); float* FB = (float*)(c.ws + T_FB); u16* VT = (u16*)(c.ws + T_VT); u16* CKV = (u16*)(c.ws + T_CKV);
    _Float16* QI = (_Float16*)(c.ws + T_QI); _Float16* KI = (_Float16*)(c.ws + T_KI); u32* SG = (u32*)(c.ws + T_SG); float* BC = (float*)(c.ws + T_BC);
    float* RW = (float*)(c.ws + T_RW); _Float16* RKK = (_Float16*)(c.ws + T_RKK); _Float16* RB = (_Float16*)(c.ws + T_RB);
    u16* RK = (u16*)(c.ws + T_RK); u16* RR = (u16*)(c.ws + T_RR); u16* RV = (u16*)(c.ws + T_RV); u16* RG = (u16*)(c.ws + T_RG); u16* VF = (u16*)(c.ws + O_VFIRST);
    const float* fbias = a->in[I_FBIAS] + l * 4; const float* kvn = a->in[I_KVNORM] + l * 128;
    const float* mu = a->in[I_MU] + l * 1792; const float* w0 = a->in[I_W0] + l * 512; const float* wup = a->in[I_WUP] + (size_t)l * 64 * 512;
    const float* a0 = a->in[I_A0] + l * 512; const float* aup = a->in[I_AUP] + (size_t)l * 64 * 512; const float* gup = a->in[I_GUP] + (size_t)l * 128 * 512;
    const float* kkw = a->in[I_KK] + l * 512; const float* kaw = a->in[I_KA] + l * 512; const float* rkw = a->in[I_RK] + l * 512;
    const float* vmu = a->in[I_VMU]; const float* vup = a->in[I_VUP]; const float* vv0 = a->in[I_VV0];
    LAS float* L_lf = (LAS float*)c.lds;
    LAS u16* L_vt = (LAS u16*)(c.lds + 1024);
    LAS float* L_lin = (LAS float*)(c.lds + 36864);
    const int tid = c.tid;
    for (int blk = c.bid; blk < S / 64; blk += c.G) {
        const int t0 = blk * 64;
        __syncthreads();
        if (tid < 256) { const int tok = tid >> 2, h = tid & 3; L_lf[tok * 4 + h] = log_sigmoid_(t56[(size_t)(t0 + tok) * 512 + 256 + 172 - 4 + h] + fbias[h]) * LOG2E; }
        for (int idx = tid; idx < 64 * 256; idx += NTHR) { const int tok = idx >> 8, cc = idx & 255; L_vt[cc * 66 + tok] = qkvf[(size_t)(t0 + tok) * 768 + 512 + cc]; }
        for (int idx = tid; idx < 64 * 256; idx += NTHR) {
            const int tok = idx >> 8, cc = idx & 255, t = t0 + tok; const int col = 1536 + cc;
            const float cur = bf2f(pr[(size_t)t * 1792 + col]); const float prev = t > 0 ? bf2f(pr[(size_t)(t - 1) * 1792 + col]) : 0.f;
            const float xs = cur + (prev - cur) * mu[col];
            L_lin[tok * 288 + cc] = cc < 64 ? tanhf(xs) : (cc < 128 ? xs : sigmoidf_(xs));
        }
        if (l == 1) for (int idx = tid; idx < 64 * 32; idx += NTHR) {
            const int tok = idx >> 5, i = idx & 31, t = t0 + tok;
            const float cur = t56[(size_t)t * 512 + 256 + 172 + i]; const float prev = t > 0 ? t56[(size_t)(t - 1) * 512 + 256 + 172 + i] : 0.f;
            L_lin[tok * 288 + 256 + i] = cur + (prev - cur) * vmu[i];
        }
        __syncthreads();
        if (tid < 4) { float run = 0.f; for (int i = 0; i < 64; ++i) { run += L_lf[i * 4 + tid]; FL[(size_t)tid * S + t0 + i] = run; } FB[tid * 256 + blk] = run; }
        for (int idx = tid; idx < 256 * 64; idx += NTHR) { const int cc = idx >> 6, tok = idx & 63; VT[(size_t)cc * S + t0 + tok] = L_vt[cc * 66 + tok]; }
        {
            const int tok = tid >> 3, sub = tid & 7, t = t0 + tok; const float* tp = t56 + (size_t)t * 512;
            float cv[16]; float ss = 0.f;
#pragma unroll
            for (int i = 0; i < 16; ++i) { cv[i] = tp[256 + sub * 16 + i]; ss += cv[i] * cv[i]; }
            ss += __shfl_xor(ss, 1); ss += __shfl_xor(ss, 2); ss += __shfl_xor(ss, 4);
            const float rs = 1.0f / sqrtf(ss * (1.0f / 128.f) + RMS_EPS);
#pragma unroll
            for (int i = 0; i < 16; i += 2) *(unsigned*)(CKV + (size_t)t * 128 + sub * 16 + i) = pk_bf16(cv[i] * rs * kvn[sub * 16 + i], cv[i + 1] * rs * kvn[sub * 16 + i + 1]);
            const float wv = tp[256 + 160 + sub]; const float sc = 0.5f * 0.0625f;
            const float aw = fabsf(wv) * sc, lw = wv * sc;
            const unsigned sb = __builtin_amdgcn_readfirstlane(0);
            (void)sb;
            unsigned bit = (wv < 0.f) ? (1u << sub) : 0u; bit |= __shfl_xor(bit, 1); bit |= __shfl_xor(bit, 2); bit |= __shfl_xor(bit, 4);
            if (sub == 0) SG[t] = bit;
#pragma unroll
            for (int d = 0; d < 32; ++d) {
                const float qv = tp[sub * 32 + d];
                QI[(size_t)t * 288 + sub * 32 + d] = (_Float16)(qv * aw);
                float lv = qv * lw; lv += __shfl_xor(lv, 1); lv += __shfl_xor(lv, 2); lv += __shfl_xor(lv, 4);
                if (sub == (d & 7)) QI[(size_t)t * 288 + 256 + d] = (_Float16)lv;
            }
#pragma unroll
            for (int i = 0; i < 4; ++i) KI[(size_t)t * 32 + sub * 4 + i] = (_Float16)tp[256 + 128 + sub * 4 + i];
        }
        {
            const int j = tid;
            const float w0j = w0[j], a0j = a0[j], kkj = kkw[j], kaj = kaw[j], rkj = rkw[j], v0j = (l == 1) ? vv0[j] : 0.f;
            const float mur = mu[j], muk = mu[512 + j], muv = mu[1024 + j];
            for (int tb = 0; tb < 64; tb += 16) {
                float aw_[16], aa_[16], ag_[16], av_[16];
#pragma unroll
                for (int q = 0; q < 16; ++q) { aw_[q] = 0.f; aa_[q] = 0.f; ag_[q] = 0.f; av_[q] = 0.f; }
                for (int i = 0; i < 64; i += 4) {
                    float wv[4], av[4];
#pragma unroll
                    for (int e = 0; e < 4; ++e) { wv[e] = wup[(size_t)(i + e) * 512 + j]; av[e] = aup[(size_t)(i + e) * 512 + j]; }
#pragma unroll
                    for (int q = 0; q < 16; ++q) {
                        const f32x4 x1 = *(const LAS f32x4*)(L_lin + (tb + q) * 288 + i), x2 = *(const LAS f32x4*)(L_lin + (tb + q) * 288 + 64 + i);
#pragma unroll
                        for (int e = 0; e < 4; ++e) { aw_[q] += x1[e] * wv[e]; aa_[q] += x2[e] * av[e]; }
                    }
                }
                for (int i = 0; i < 128; i += 4) {
                    float gv[4];
#pragma unroll
                    for (int e = 0; e < 4; ++e) gv[e] = gup[(size_t)(i + e) * 512 + j];
#pragma unroll
                    for (int q = 0; q < 16; ++q) { const f32x4 x3 = *(const LAS f32x4*)(L_lin + (tb + q) * 288 + 128 + i);
#pragma unroll
                        for (int e = 0; e < 4; ++e) ag_[q] += x3[e] * gv[e]; }
                }
                if (l == 1) for (int i = 0; i < 32; i += 4) {
                    float uv[4];
#pragma unroll
                    for (int e = 0; e < 4; ++e) uv[e] = vup[(size_t)(i + e) * 512 + j];
#pragma unroll
                    for (int q = 0; q < 16; ++q) { const f32x4 x4 = *(const LAS f32x4*)(L_lin + (tb + q) * 288 + 256 + i);
#pragma unroll
                        for (int e = 0; e < 4; ++e) av_[q] += x4[e] * uv[e]; }
                }
#pragma unroll
                for (int q = 0; q < 16; ++q) {
                    const int t = t0 + tb + q; const size_t o = (size_t)t * 512 + j;
                    const u16* pc = pr + (size_t)t * 1792; const u16* pp = pc - 1792;
                    const float rc = bf2f(pc[j]), kc = bf2f(pc[512 + j]), vc = bf2f(pc[1024 + j]);
                    const float rp = t > 0 ? bf2f(pp[j]) : 0.f, kp = t > 0 ? bf2f(pp[512 + j]) : 0.f, vp = t > 0 ? bf2f(pp[1024 + j]) : 0.f;
                    const float r = rc + (rp - rc) * mur, k = kc + (kp - kc) * muk; float v = vc + (vp - vc) * muv;
                    if (l == 0) VF[o] = f2bf(v); else v = v + (bf2f(VF[o]) - v) * sigmoidf_(v0j + av_[q]);
                    const float wpre = w0j + aw_[q];
                    const float sp = fmaxf(-wpre, 0.f) + log1pf(__expf(-fabsf(wpre)));
                    const float decay = __expf(-__expf(-sp - 0.5f));
                    const float av2 = sigmoidf_(a0j + aa_[q]);
                    const float kkr = k * kkj; const float nn = wave_sum(kkr * kkr);
                    const float kkn = kkr / sqrtf(nn + 1e-12f);
                    const float k2 = k * (1.0f + (av2 - 1.0f) * kaj);
                    const float bc = wave_sum(r * k2 * rkj);
                    RW[o] = decay; RKK[o] = (_Float16)kkn; RB[o] = (_Float16)(kkn * av2); RK[o] = f2bf(k2); RR[o] = f2bf(r); RV[o] = f2bf(v); RG[o] = f2bf(ag_[q]);
                    if (c.lane == 0) BC[(size_t)t * 8 + c.wave] = bc;
                }
            }
        }
    }
}

__device__ __forceinline__ void fox_unit(const Ctx& c, int u, const LAS float* PB) {
    const u16* qkvf = (const u16*)(c.ws + T_QKVF); const u16* VT = (const u16*)(c.ws + T_VT); const float* FL = (const float*)(c.ws + T_FL); u16* OF = (u16*)(c.ws + T_OF);
    const int lane = c.lane, q = lane & 15, g = lane >> 4;
    const int qb = 511 - (u >> 2), h = u & 3, r0 = qb * 32;
    const u16* Qp = qkvf + (size_t)(r0 + q) * 768 + h * 64 + 8 * g;
    bf16x8 qA[2], qB[2];
    qA[0] = *(const bf16x8*)Qp; qA[1] = *(const bf16x8*)(Qp + 32); qB[0] = *(const bf16x8*)(Qp + 16 * 768); qB[1] = *(const bf16x8*)(Qp + 16 * 768 + 32);
    const float* FLh = FL + (size_t)h * S; const LAS float* PBh = PB + h * 256;
    const float FqA = FLh[r0 + q] + PBh[r0 >> 6], FqB = FLh[r0 + 16 + q] + PBh[r0 >> 6];
    float mA = -INFINITY, mB = -INFINITY, lA = 0.f, lB = 0.f;
    f32x4 oA[4], oB[4];
#pragma unroll
    for (int d = 0; d < 4; ++d) { oA[d] = (f32x4){0.f, 0.f, 0.f, 0.f}; oB[d] = (f32x4){0.f, 0.f, 0.f, 0.f}; }
    const int krow_off = 8 * (q >> 2) + (q & 3);
    const u16* Kbase = qkvf + 256 + h * 64 + 8 * g;
    const u16* Vbase = VT + (size_t)(h * 64 + q) * S + 8 * g;
    for (int kt = 0; kt <= qb; ++kt) {
        const int k0 = kt * 32;
        bf16x8 kf[2][2], vf[4];
#pragma unroll
        for (int rb = 0; rb < 2; ++rb) { const u16* kp = Kbase + (size_t)(k0 + krow_off + 4 * rb) * 768; kf[rb][0] = *(const bf16x8*)kp; kf[rb][1] = *(const bf16x8*)(kp + 32); }
#pragma unroll
        for (int d = 0; d < 4; ++d) vf[d] = *(const bf16x8*)(Vbase + (size_t)(16 * d) * S + k0);
        const float pb = PBh[k0 >> 6];
        const f32x4 f0 = *(const f32x4*)(FLh + k0 + 8 * g), f1 = *(const f32x4*)(FLh + k0 + 8 * g + 4);
        float fk[8] = {f0.x + pb, f0.y + pb, f0.z + pb, f0.w + pb, f1.x + pb, f1.y + pb, f1.z + pb, f1.w + pb};
        f32x4 sA[2], sB[2];
#pragma unroll
        for (int rb = 0; rb < 2; ++rb) {
            sA[rb] = __builtin_amdgcn_mfma_f32_16x16x32_bf16(kf[rb][0], qA[0], (f32x4){0.f, 0.f, 0.f, 0.f}, 0, 0, 0);
            sA[rb] = __builtin_amdgcn_mfma_f32_16x16x32_bf16(kf[rb][1], qA[1], sA[rb], 0, 0, 0);
            sB[rb] = __builtin_amdgcn_mfma_f32_16x16x32_bf16(kf[rb][0], qB[0], (f32x4){0.f, 0.f, 0.f, 0.f}, 0, 0, 0);
            sB[rb] = __builtin_amdgcn_mfma_f32_16x16x32_bf16(kf[rb][1], qB[1], sB[rb], 0, 0, 0);
        }
        float xA[8], xB[8];
#pragma unroll
        for (int j = 0; j < 8; ++j) { xA[j] = sA[j >> 2][j & 3] + (FqA - fk[j]); xB[j] = sB[j >> 2][j & 3] + (FqB - fk[j]); }
        if (kt == qb) {
#pragma unroll
            for (int j = 0; j < 8; ++j) { const int key = 8 * g + j; if (key > q) xA[j] = -INFINITY; if (key > 16 + q) xB[j] = -INFINITY; }
        }
        float mxA = xA[0], mxB = xB[0];
#pragma unroll
        for (int j = 1; j < 8; ++j) { mxA = fmaxf(mxA, xA[j]); mxB = fmaxf(mxB, xB[j]); }
        mxA = fmaxf(mxA, __shfl_xor(mxA, 16)); mxA = fmaxf(mxA, __shfl_xor(mxA, 32));
        mxB = fmaxf(mxB, __shfl_xor(mxB, 16)); mxB = fmaxf(mxB, __shfl_xor(mxB, 32));
        const float mnA = fmaxf(mA, mxA), mnB = fmaxf(mB, mxB);
        const float alA = __builtin_amdgcn_exp2f(mA - mnA), alB = __builtin_amdgcn_exp2f(mB - mnB);
        mA = mnA; mB = mnB;
        float sumA = 0.f, sumB = 0.f;
#pragma unroll
        for (int j = 0; j < 8; ++j) { xA[j] = __builtin_amdgcn_exp2f(xA[j] - mnA); xB[j] = __builtin_amdgcn_exp2f(xB[j] - mnB); sumA += xA[j]; sumB += xB[j]; }
        lA = lA * alA + sumA; lB = lB * alB + sumB;
        u32x4 pwA, pwB;
        pwA.x = pk_bf16(xA[0], xA[1]); pwA.y = pk_bf16(xA[2], xA[3]); pwA.z = pk_bf16(xA[4], xA[5]); pwA.w = pk_bf16(xA[6], xA[7]);
        pwB.x = pk_bf16(xB[0], xB[1]); pwB.y = pk_bf16(xB[2], xB[3]); pwB.z = pk_bf16(xB[4], xB[5]); pwB.w = pk_bf16(xB[6], xB[7]);
        const bf16x8 pA = __builtin_bit_cast(bf16x8, pwA), pB = __builtin_bit_cast(bf16x8, pwB);
#pragma unroll
        for (int d = 0; d < 4; ++d) {
            oA[d] = __builtin_amdgcn_mfma_f32_16x16x32_bf16(vf[d], pA, oA[d] * alA, 0, 0, 0);
            oB[d] = __builtin_amdgcn_mfma_f32_16x16x32_bf16(vf[d], pB, oB[d] * alB, 0, 0, 0);
        }
    }
    lA += __shfl_xor(lA, 16); lA += __shfl_xor(lA, 32); lB += __shfl_xor(lB, 16); lB += __shfl_xor(lB, 32);
    const float iA = 1.0f / lA, iB = 1.0f / lB;
#pragma unroll
    for (int d = 0; d < 4; ++d) {
        u32x2 w; w.x = pk_bf16(oA[d][0] * iA, oA[d][1] * iA); w.y = pk_bf16(oA[d][2] * iA, oA[d][3] * iA);
        *(u32x2*)(OF + (size_t)(r0 + q) * 256 + h * 64 + 16 * d + 4 * g) = w;
        w.x = pk_bf16(oB[d][0] * iB, oB[d][1] * iB); w.y = pk_bf16(oB[d][2] * iB, oB[d][3] * iB);
        *(u32x2*)(OF + (size_t)(r0 + 16 + q) * 256 + h * 64 + 16 * d + 4 * g) = w;
    }
}

__device__ __forceinline__ void r1_task(const Ctx& c, int task, LAS float* lw) {
    const float* RW = (const float*)(c.ws + T_RW); const _Float16* RKK = (const _Float16*)(c.ws + T_RKK); const _Float16* RB = (const _Float16*)(c.ws + T_RB);
    const u16* RK = (const u16*)(c.ws + T_RK); const u16* RR = (const u16*)(c.ws + T_RR); const u16* RV = (const u16*)(c.ws + T_RV);
    float* YL = (float*)(c.ws + T_YL); u16* RT = (u16*)(c.ws + T_RT); float* PC = (float*)(c.ws + T_PC); float* UC = (float*)(c.ws + T_UC);
    const int lane = c.lane, h = task >> 8, ch = task & 255, t0 = ch * 64;
    float U[64], P[64];
#pragma unroll
    for (int j = 0; j < 64; ++j) { U[j] = 0.f; P[j] = (j == lane) ? 1.f : 0.f; }
    const int ls = lane >> 3, lj = (lane & 7) * 8;
    for (int blk = 0; blk < 8; ++blk) {
        const int tb = t0 + blk * 8;
        {
            const size_t o = (size_t)(tb + ls) * 512 + h * 64 + lj;
            const f32x4 w0 = *(const f32x4*)(RW + o), w1 = *(const f32x4*)(RW + o + 4);
            const f16x8 kk = *(const f16x8*)(RKK + o), bb = *(const f16x8*)(RB + o);
            const u32x4 kr = *(const u32x4*)(RK + o), rr = *(const u32x4*)(RR + o);
            LAS float* d = lw + ls * 320 + lj;
            *(LAS f32x4*)(d) = w0; *(LAS f32x4*)(d + 4) = w1;
            *(LAS f32x4*)(d + 64) = (f32x4){(float)kk[0], (float)kk[1], (float)kk[2], (float)kk[3]}; *(LAS f32x4*)(d + 68) = (f32x4){(float)kk[4], (float)kk[5], (float)kk[6], (float)kk[7]};
            *(LAS f32x4*)(d + 128) = (f32x4){(float)bb[0], (float)bb[1], (float)bb[2], (float)bb[3]}; *(LAS f32x4*)(d + 132) = (f32x4){(float)bb[4], (float)bb[5], (float)bb[6], (float)bb[7]};
            *(LAS f32x4*)(d + 192) = (f32x4){bflo(kr.x), bfhi(kr.x), bflo(kr.y), bfhi(kr.y)}; *(LAS f32x4*)(d + 196) = (f32x4){bflo(kr.z), bfhi(kr.z), bflo(kr.w), bfhi(kr.w)};
            *(LAS f32x4*)(d + 256) = (f32x4){bflo(rr.x), bfhi(rr.x), bflo(rr.y), bfhi(rr.y)}; *(LAS f32x4*)(d + 260) = (f32x4){bflo(rr.z), bfhi(rr.z), bflo(rr.w), bfhi(rr.w)};
        }
        asm volatile("s_waitcnt lgkmcnt(0)" ::: "memory");
        for (int s = 0; s < 8; ++s) {
            const LAS float* b = lw + s * 320; const int t = tb + s;
            const float v = bf2f(RV[(size_t)t * 512 + h * 64 + lane]);
            float sau = 0.f, sap = 0.f;
#pragma unroll
            for (int j4 = 0; j4 < 16; ++j4) { const f32x4 k4 = *(const LAS f32x4*)(b + 64 + 4 * j4);
#pragma unroll
                for (int e = 0; e < 4; ++e) { sau = fmaf(U[4 * j4 + e], k4[e], sau); sap = fmaf(P[4 * j4 + e], k4[e], sap); } }
            float y = 0.f, rt = 0.f; const float nsu = -sau, nsp = -sap;
#pragma unroll
            for (int j4 = 0; j4 < 16; ++j4) {
                const f32x4 w4 = *(const LAS f32x4*)(b + 4 * j4), b4 = *(const LAS f32x4*)(b + 128 + 4 * j4), k4 = *(const LAS f32x4*)(b + 192 + 4 * j4), r4 = *(const LAS f32x4*)(b + 256 + 4 * j4);
#pragma unroll
                for (int e = 0; e < 4; ++e) { const int j = 4 * j4 + e;
                    float t1 = v * k4[e]; t1 = fmaf(nsu, b4[e], t1); U[j] = fmaf(U[j], w4[e], t1);
                    P[j] = fmaf(P[j], w4[e], nsp * b4[e]);
                    y = fmaf(U[j], r4[e], y); rt = fmaf(P[j], r4[e], rt); }
            }
            YL[(size_t)t * 512 + h * 64 + lane] = y; RT[(size_t)t * 512 + h * 64 + lane] = f2bf(rt);
        }
    }
    float* pc = PC + ((size_t)task * 64 + lane) * 64; float* uc = UC + ((size_t)task * 64 + lane) * 64;
#pragma unroll
    for (int j = 0; j < 64; j += 4) { *(f32x4*)(pc + j) = (f32x4){P[j], P[j + 1], P[j + 2], P[j + 3]}; *(f32x4*)(uc + j) = (f32x4){U[j], U[j + 1], U[j + 2], U[j + 3]}; }
}

__device__ __forceinline__ void r2_head(const Ctx& c, int h) {
    float* PC = (float*)(c.ws + T_PC); float* UC = (float*)(c.ws + T_UC);
    LAS float* Sl = (LAS float*)c.lds;
    const int i = c.tid >> 3, jb = (c.tid & 7) * 8;
    float so[8];
#pragma unroll
    for (int q = 0; q < 8; ++q) { so[q] = 0.f; Sl[i * 68 + jb + q] = 0.f; }
    __syncthreads();
    for (int ch = 0; ch < 256; ++ch) {
        const float* pc = PC + (size_t)(h * 256 + ch) * 4096; float* uc = UC + (size_t)(h * 256 + ch) * 4096 + i * 64 + jb;
        f32x4 n0 = *(const f32x4*)uc, n1 = *(const f32x4*)(uc + 4);
        for (int m = 0; m < 64; ++m) { const float sv = Sl[i * 68 + m]; const f32x4 p0 = *(const f32x4*)(pc + m * 64 + jb), p1 = *(const f32x4*)(pc + m * 64 + jb + 4); n0 += sv * p0; n1 += sv * p1; }
        *(f32x4*)uc = (f32x4){so[0], so[1], so[2], so[3]}; *(f32x4*)(uc + 4) = (f32x4){so[4], so[5], so[6], so[7]};
        __syncthreads();
#pragma unroll
        for (int q = 0; q < 4; ++q) { so[q] = n0[q]; so[4 + q] = n1[q]; Sl[i * 68 + jb + q] = n0[q]; Sl[i * 68 + jb + 4 + q] = n1[q]; }
        __syncthreads();
    }
}

__device__ __forceinline__ void r3_task(const Ctx& c, CArgsP a, int l, int task) {
    const float* YL = (const float*)(c.ws + T_YL); const u16* RT = (const u16*)(c.ws + T_RT); const float* S0 = (const float*)(c.ws + T_UC);
    const u16* RV = (const u16*)(c.ws + T_RV); const u16* RG = (const u16*)(c.ws + T_RG); const float* BC = (const float*)(c.ws + T_BC); u16* OR_ = (u16*)(c.ws + T_OR);
    const int lane = c.lane, h = task >> 8, ch = task & 255, t0 = ch * 64;
    float s0[64];
    { const float* sp = S0 + ((size_t)task * 64 + lane) * 64;
#pragma unroll
      for (int j = 0; j < 64; j += 4) { const f32x4 v = *(const f32x4*)(sp + j); s0[j] = v.x; s0[j + 1] = v.y; s0[j + 2] = v.z; s0[j + 3] = v.w; } }
    const float lg = a->in[I_LNG][l * 512 + h * 64 + lane], lb = a->in[I_LNB][l * 512 + h * 64 + lane];
    for (int s = 0; s < 64; ++s) {
        const int t = t0 + s; const size_t o = (size_t)t * 512 + h * 64 + lane;
        const float rt = bf2f(RT[o]); float corr = 0.f;
#pragma unroll
        for (int j = 0; j < 64; ++j) corr = fmaf(s0[j], __builtin_bit_cast(float, __builtin_amdgcn_readlane(__builtin_bit_cast(int, rt), j)), corr);
        const float y = YL[o] + corr;
        const float mean = wave_sum(y) * (1.0f / 64.f); const float dlt = y - mean;
        const float var = wave_sum(dlt * dlt) * (1.0f / 64.f);
        const float yn = dlt * (1.0f / sqrtf(var + 64e-5f)) * lg + lb;
        const float outv = (yn + BC[(size_t)t * 8 + h] * bf2f(RV[o])) * bf2f(RG[o]);
        OR_[o] = f2bf(outv);
    }
}

constexpr int DSA_CAP = 768;
constexpr int L_DSA_IMG = 0;
constexpr int L_DSA_BM = 98304;
constexpr int L_DSA_SEL = 131072;
constexpr int L_DSA_CNT = 131072 + 8192;
__device__ __forceinline__ unsigned ord_of(float s) { const unsigned u = __float_as_uint(s); return (u & 0x80000000u) ? ~u : (u | 0x80000000u); }
__device__ __forceinline__ unsigned img_off(unsigned row, unsigned ch) { return 256u * row + 16u * (ch ^ (((row & 3) << 2) | ((row >> 2) & 3))); }

template <int PASS>
__device__ __forceinline__ void dsa_score_pass(const Ctx& c, int ntile, const f16x8 (&qf)[9], const float (&sg)[8], unsigned myb1,
                                               LAS u32* hist, LAS u32* bm, LAS u64* cand, LAS u32* cnts) {
    const _Float16* KI = (const _Float16*)(c.ws + T_KI);
    const int lane = c.lane, q = lane & 15, g = lane >> 4;
    for (int kt = c.wave; kt < ntile; kt += NWAVES) {
        const f16x8 kf = *(const f16x8*)(KI + (size_t)(kt * 16 + q) * 32 + 8 * g);
        f32x4 acc = __builtin_amdgcn_mfma_f32_16x16x32_f16(kf, qf[8], (f32x4){0.f, 0.f, 0.f, 0.f}, 0, 0, 0);
#pragma unroll
        for (int hh = 0; hh < 8; ++hh) {
            const f32x4 x = __builtin_amdgcn_mfma_f32_16x16x32_f16(kf, qf[hh], (f32x4){0.f, 0.f, 0.f, 0.f}, 0, 0, 0);
#pragma unroll
            for (int r = 0; r < 4; ++r) acc[r] = __builtin_fmaf(__builtin_fabsf(x[r]), sg[hh], acc[r]);
        }
#pragma unroll
        for (int r = 0; r < 4; ++r) {
            const float sc = acc[r] + 0.0f; const unsigned od = ord_of(sc), bin = od >> 21; const int key = kt * 16 + 4 * g + r;
            if (PASS == 1) { lds_addu(hist + q * 1024 + (bin >> 1), (bin & 1) ? 0x10000u : 1u); }
            else {
                if (bin > myb1) { lds_oru(bm + q * 512 + (key >> 5), 1u << (key & 31)); }
                else if (bin == myb1) { const unsigned pos = lds_addu(cnts + 16 + q, 1u); if (pos < DSA_CAP) cand[q * DSA_CAP + pos] = ((u64)od << 32) | (u64)(0xFFFFFFFFu - (unsigned)key); }
            }
        }
    }
}

__device__ __forceinline__ void dsa_unit(const Ctx& c, int qt) {
    const _Float16* QI = (const _Float16*)(c.ws + T_QI); const u32* SG = (const u32*)(c.ws + T_SG);
    const u16* CKV = (const u16*)(c.ws + T_CKV); const u16* QL = (const u16*)(c.ws + T_QL); u16* OD = (u16*)(c.ws + T_OD);
    LAS u32* hist = (LAS u32*)(c.lds + L_DSA_IMG); LAS u64* cand = (LAS u64*)(c.lds + L_DSA_IMG);
    LAS u16* sel = (LAS u16*)(c.lds + L_DSA_SEL); LAS u32* cnts = (LAS u32*)(c.lds + L_DSA_CNT); LAS u32* bm = (LAS u32*)(c.lds + L_DSA_BM);
    const int lane = c.lane, q = lane & 15, g = lane >> 4, tid = c.tid;
    const int chunk = qt >> 2, N = 64 * (chunk + 1);
    if (tid < 64) cnts[tid] = 0u;
    if (N > 256) {
        for (int i = tid; i < 16 * 1024; i += NTHR) hist[i] = 0u;
        for (int i = tid; i < 16 * 512; i += NTHR) bm[i] = 0u;
        f16x8 qf[9]; float sg[8];
        { const _Float16* qp = QI + (size_t)(qt * 16 + q) * 288 + 8 * g;
#pragma unroll
          for (int hh = 0; hh < 9; ++hh) qf[hh] = *(const f16x8*)(qp + hh * 32);
          const u32 sb = SG[qt * 16 + q];
#pragma unroll
          for (int hh = 0; hh < 8; ++hh) sg[hh] = ((sb >> hh) & 1u) ? -1.f : 1.f; }
        __syncthreads();
        dsa_score_pass<1>(c, N / 16, qf, sg, 0u, hist, bm, cand, cnts);
        __syncthreads();
        for (int qq = 2 * c.wave; qq < 2 * c.wave + 2; ++qq) {
            const LAS u32* hq = hist + qq * 1024; unsigned loc = 0;
#pragma unroll
            for (int i = 0; i < 16; ++i) { const unsigned w = hq[lane * 16 + i]; loc += (w & 0xffffu) + (w >> 16); }
            unsigned suf = loc;
#pragma unroll
            for (int o = 1; o < 64; o <<= 1) { const unsigned v = __shfl_down(suf, o); if (lane + o < 64) suf += v; }
            const u64 bal = __ballot(suf >= 256u);
            const int Ls = 63 - __builtin_clzll(bal);
            unsigned above = __shfl(suf, Ls) - __shfl(loc, Ls);
            int b1 = Ls * 32; unsigned cab = above;
            for (int i = 15; i >= 0; --i) { const unsigned w = hq[Ls * 16 + i]; const unsigned hi = w >> 16, lo = w & 0xffffu;
                if (cab + hi >= 256u) { b1 = Ls * 32 + 2 * i + 1; break; } cab += hi;
                if (cab + lo >= 256u) { b1 = Ls * 32 + 2 * i; break; } cab += lo; }
            if (lane == 0) { cnts[32 + qq] = (unsigned)b1; cnts[48 + qq] = 256u - cab; }
        }
        __syncthreads();
        const unsigned myb1 = cnts[32 + q];
        __syncthreads();
        dsa_score_pass<2>(c, N / 16, qf, sg, myb1, hist, bm, cand, cnts);
        __syncthreads();
        for (int qq = 2 * c.wave; qq < 2 * c.wave + 2; ++qq) {
            const unsigned C = min(cnts[16 + qq], (unsigned)DSA_CAP), need = cnts[48 + qq], b1 = cnts[32 + qq];
            u64 ck[DSA_CAP / 64];
#pragma unroll
            for (int i = 0; i < DSA_CAP / 64; ++i) { const unsigned idx = lane + 64 * i; ck[i] = idx < C ? cand[qq * DSA_CAP + idx] : 0ull; }
            u64 pre = ((u64)(b1 << 21) << 32) | 0xFFFFC000ull;
            for (int bit = 52; bit >= 0; --bit) {
                if (bit < 32 && bit > 13) continue;
                const u64 trial = pre | (1ull << bit); unsigned cnt = 0;
#pragma unroll
                for (int i = 0; i < DSA_CAP / 64; ++i) cnt += __builtin_popcountll(__ballot(ck[i] >= trial));
                if (cnt >= need) pre = trial;
            }
#pragma unroll
            for (int i = 0; i < DSA_CAP / 64; ++i) if (ck[i] >= pre && ck[i] != 0ull) { const unsigned key = 0xFFFFFFFFu - (unsigned)(ck[i] & 0xFFFFFFFFull); lds_oru(bm + qq * 512 + (key >> 5), 1u << (key & 31)); }
            asm volatile("s_waitcnt lgkmcnt(0)" ::: "memory");
            unsigned wv[8]; unsigned cntl = 0;
#pragma unroll
            for (int i = 0; i < 8; ++i) { wv[i] = bm[qq * 512 + lane * 8 + i]; cntl += __builtin_popcount(wv[i]); }
            unsigned inc = cntl;
#pragma unroll
            for (int o = 1; o < 64; o <<= 1) { const unsigned v = __shfl_up(inc, o); if (lane >= o) inc += v; }
            unsigned pos = inc - cntl;
#pragma unroll
            for (int i = 0; i < 8; ++i) { unsigned w = wv[i]; while (w) { const int b = __builtin_ctz(w); if (pos < 256) sel[qq * 256 + pos] = (u16)(lane * 256 + i * 32 + b); ++pos; w &= w - 1; } }
            if (lane == 63) cnts[qq] = inc;
        }
        __syncthreads();
    } else {
        for (int i = tid; i < 16 * 256; i += NTHR) sel[i] = (u16)((i & 255) < N ? (i & 255) : 0);
        if (tid < 16) cnts[tid] = (unsigned)N;
        __syncthreads();
    }
    LAS unsigned char* img = c.lds + L_DSA_IMG + c.wave * 16384;
    for (int qq = 2 * c.wave; qq < 2 * c.wave + 2; ++qq) {
        const int t = qt * 16 + qq; const int nsel = (int)min(cnts[qq], 256u); const int ntl = (nsel + 31) >> 5;
        bf16x8 bq[4];
#pragma unroll
        for (int s = 0; s < 4; ++s) { if (q < 4) bq[s] = *(const bf16x8*)(QL + (size_t)t * 512 + q * 128 + 32 * s + 8 * g); else bq[s] = (bf16x8){0, 0, 0, 0, 0, 0, 0, 0}; }
        float m = -INFINITY, lsum = 0.f; f32x4 o[8];
#pragma unroll
        for (int cb = 0; cb < 8; ++cb) o[cb] = (f32x4){0.f, 0.f, 0.f, 0.f};
        for (int tl = 0; tl < ntl; ++tl) {
            LAS unsigned char* im = img + (tl & 1) * 8192;
#pragma unroll
            for (int i = 0; i < 8; ++i) { const unsigned n = lane + 64 * i, row = n >> 4, chk = n & 15; const int si = tl * 32 + row; const unsigned key = si < nsel ? sel[qq * 256 + si] : 0u;
                *(LAS u32x4*)(im + img_off(row, chk)) = *(const u32x4*)(CKV + (size_t)key * 128 + chk * 8); }
            asm volatile("s_waitcnt vmcnt(0) lgkmcnt(0)" ::: "memory");
            f32x4 st[2];
#pragma unroll
            for (int rb = 0; rb < 2; ++rb) { st[rb] = (f32x4){0.f, 0.f, 0.f, 0.f}; const unsigned row = 8 * (q >> 2) + 4 * rb + (q & 3);
#pragma unroll
                for (int s = 0; s < 4; ++s) { const bf16x8 af = *(const LAS bf16x8*)(im + img_off(row, 4 * s + g)); st[rb] = __builtin_amdgcn_mfma_f32_16x16x32_bf16(af, bq[s], st[rb], 0, 0, 0); } }
            float x[8]; float mx = -INFINITY;
#pragma unroll
            for (int j = 0; j < 8; ++j) { x[j] = st[j >> 2][j & 3]; if (tl * 32 + 8 * g + j >= nsel) x[j] = -INFINITY; mx = fmaxf(mx, x[j]); }
            mx = fmaxf(mx, __shfl_xor(mx, 16)); mx = fmaxf(mx, __shfl_xor(mx, 32));
            const float mn = fmaxf(m, mx); const float al = __builtin_amdgcn_exp2f(m - mn); m = mn; float sm = 0.f;
#pragma unroll
            for (int j = 0; j < 8; ++j) { x[j] = __builtin_amdgcn_exp2f(x[j] - mn); sm += x[j]; }
            lsum = lsum * al + sm;
            u32x4 pw; pw.x = pk_bf16(x[0], x[1]); pw.y = pk_bf16(x[2], x[3]); pw.z = pk_bf16(x[4], x[5]); pw.w = pk_bf16(x[6], x[7]);
            const bf16x8 pa = __builtin_bit_cast(bf16x8, pw);
            float alr[4];
#pragma unroll
            for (int r = 0; r < 4; ++r) alr[r] = __builtin_bit_cast(float, __builtin_amdgcn_readlane(__builtin_bit_cast(int, al), r));
            const unsigned imb = (unsigned)(uintptr_t)im;
#pragma unroll
            for (int cb = 0; cb < 8; ++cb) {
                u32x2 lo, hi; const unsigned p = lane & 3, qd = (lane & 15) >> 2;
                const unsigned a0 = imb + img_off(8 * g + qd, 2 * cb + (p >> 1)) + 8 * (p & 1), a1 = imb + img_off(8 * g + 4 + qd, 2 * cb + (p >> 1)) + 8 * (p & 1);
                asm volatile("ds_read_b64_tr_b16 %0, %2\n\tds_read_b64_tr_b16 %1, %3\n\ts_waitcnt lgkmcnt(0)" : "=&v"(lo), "=&v"(hi) : "v"(a0), "v"(a1) : "memory");
                u32x4 bw; bw.x = lo.x; bw.y = lo.y; bw.z = hi.x; bw.w = hi.y;
                f32x4 oc = o[cb];
#pragma unroll
                for (int r = 0; r < 4; ++r) oc[r] *= alr[r];
                o[cb] = __builtin_amdgcn_mfma_f32_16x16x32_bf16(pa, __builtin_bit_cast(bf16x8, bw), oc, 0, 0, 0);
            }
        }
        lsum += __shfl_xor(lsum, 16); lsum += __shfl_xor(lsum, 32);
        float il[4];
#pragma unroll
        for (int r = 0; r < 4; ++r) il[r] = 1.0f / __builtin_bit_cast(float, __builtin_amdgcn_readlane(__builtin_bit_cast(int, lsum), r));
        if (g == 0) {
#pragma unroll
            for (int cb = 0; cb < 8; ++cb)
#pragma unroll
                for (int r = 0; r < 4; ++r) OD[(size_t)t * 512 + r * 128 + 16 * cb + q] = f2bf(o[cb][r] * il[r]);
        }
    }
    __syncthreads();
}

__device__ __forceinline__ void phase_route(const Ctx& c, CArgsP a) {
    const float* xr = (const float*)(c.ws + O_XR); const float* ssq = (const float*)(c.ws + O_SSQ);
    const float* rw = a->in[I_RTW]; const float* rb = a->in[I_RTB]; const float* gf = a->in[I_GFFN] + D;
    int* TOPE = (int*)(c.ws + M_TOPE); float* TOPG = (float*)(c.ws + M_TOPG); int* CNT = (int*)(c.ws + M_CNT);
    LAS int* lcnt = (LAS int*)(c.lds + 100000);
    for (int blk = c.bid; blk < S / 64; blk += c.G) {
        __syncthreads();
        if (c.tid < 8) lcnt[c.tid] = 0;
        __syncthreads();
        for (int i = 0; i < 8; ++i) {
            const int t = blk * 64 + c.wave * 8 + i; float acc[8];
#pragma unroll
            for (int e = 0; e < 8; ++e) acc[e] = 0.f;
            for (int k = c.lane; k < D; k += 64) { const float xv = xr[(size_t)t * D + k] * gf[k]; const f32x4 w0 = *(const f32x4*)(rw + (size_t)k * 8), w1 = *(const f32x4*)(rw + (size_t)k * 8 + 4);
#pragma unroll
                for (int e = 0; e < 4; ++e) { acc[e] += xv * w0[e]; acc[4 + e] += xv * w1[e]; } }
            const float rs = row_rstd(ssq, t);
#pragma unroll
            for (int e = 0; e < 8; ++e) acc[e] = wave_sum(acc[e]) * rs + rb[e];
            int e0 = 0; float v0 = acc[0];
#pragma unroll
            for (int e = 1; e < 8; ++e) if (acc[e] > v0) { v0 = acc[e]; e0 = e; }
            int e1 = -1; float v1 = -INFINITY;
#pragma unroll
            for (int e = 0; e < 8; ++e) if (e != e0 && acc[e] > v1) { v1 = acc[e]; e1 = e; }
            const float p1 = 1.0f / (1.0f + __expf(v0 - v1)), p0 = 1.0f - p1;
            if (c.lane == 0) { TOPE[t * 2] = e0; TOPE[t * 2 + 1] = e1; TOPG[t * 2] = p0; TOPG[t * 2 + 1] = p1; lds_addi(&lcnt[e0], 1); lds_addi(&lcnt[e1], 1); }
        }
        __syncthreads();
        if (c.tid < 8) CNT[blk * 8 + c.tid] = lcnt[c.tid];
    }
}
__device__ __forceinline__ void moe_tables(const Ctx& c, LAS int* ebase, LAS int* pexp) {
    const int* CNT = (const int*)(c.ws + M_CNT);
    LAS int* tot = ebase + 16;
    if (c.tid < 8) tot[c.tid] = 0;
    __syncthreads();
    { int s = 0; const int e = c.tid & 7; for (int b = c.tid >> 3; b < 256; b += 64) s += CNT[b * 8 + e]; lds_addi(&tot[e], s); }
    __syncthreads();
    if (c.tid == 0) { int b = 0; for (int e = 0; e < 8; ++e) { ebase[e] = b; const int np = (tot[e] + 255) >> 8; for (int p = 0; p < np; ++p) pexp[(b >> 8) + p] = e; b += np << 8; } ebase[8] = b; }
    __syncthreads();
}
__device__ __forceinline__ void phase_sort(const Ctx& c) {
    const int* CNT = (const int*)(c.ws + M_CNT); const int* TOPE = (const int*)(c.ws + M_TOPE); const float* TOPG = (const float*)(c.ws + M_TOPG);
    const u16* xb = (const u16*)(c.ws + O_XB); const float* ssq = (const float*)(c.ws + O_SSQ);
    u16* XS = (u16*)(c.ws + M_XS); float* RS = (float*)(c.ws + M_RS); float* RGt = (float*)(c.ws + M_RG); int* TOKROW = (int*)(c.ws + M_TOKROW);
    LAS int* ebase = (LAS int*)(c.lds + 100000); LAS int* pexp = ebase + 64; LAS int* boff = ebase + 256; LAS int* rows = ebase + 320;
    moe_tables(c, ebase, pexp);
    for (int blk = c.bid; blk < S / 64; blk += c.G) {
        __syncthreads();
        if (c.tid < 8) { int s = 0; for (int b = 0; b < blk; ++b) s += CNT[b * 8 + c.tid]; boff[c.tid] = ebase[c.tid] + s; }
        __syncthreads();
        if (c.tid < 8) { int pos = boff[c.tid]; for (int i = 0; i < 128; ++i) if (TOPE[blk * 128 + i] == c.tid) rows[i] = pos++; }
        __syncthreads();
        for (int i = c.wave; i < 128; i += NWAVES) {
            const int t = blk * 64 + (i >> 1), row = rows[i];
            const u32x4* sp = (const u32x4*)(xb + (size_t)t * D); u32x4* dp = (u32x4*)(XS + (size_t)row * D);
            dp[c.lane] = sp[c.lane]; dp[c.lane + 64] = sp[c.lane + 64];
            if (c.lane == 0) { RS[row] = row_rstd(ssq, t); RGt[row] = TOPG[blk * 128 + i]; TOKROW[blk * 128 + i] = row; }
        }
    }
}
__device__ __forceinline__ void phase_final(const Ctx& c, CArgsP a) {
    const float* xr = (const float*)(c.ws + O_XR); const u16* YS = (const u16*)(c.ws + M_XS); const int* TOKROW = (const int*)(c.ws + M_TOKROW); const float* gfin = a->in[I_GFINAL];
    for (int t = c.gw; t < S; t += c.ngw) {
        const int r0 = TOKROW[t * 2], r1 = TOKROW[t * 2 + 1];
        f32x4 v[4]; float s = 0.f;
#pragma unroll
        for (int j = 0; j < 4; ++j) { const int col = (c.lane + 64 * j) * 4; v[j] = *(const f32x4*)(xr + (size_t)t * D + col);
            const u32x2 y0 = *(const u32x2*)(YS + (size_t)r0 * D + col), y1 = *(const u32x2*)(YS + (size_t)r1 * D + col);
            v[j].x += bflo(y0.x) + bflo(y1.x); v[j].y += bfhi(y0.x) + bfhi(y1.x); v[j].z += bflo(y0.y) + bflo(y1.y); v[j].w += bfhi(y0.y) + bfhi(y1.y);
            s += (v[j].x * v[j].x + v[j].y * v[j].y) + (v[j].z * v[j].z + v[j].w * v[j].w); }
        const float rs = 1.0f / sqrtf(wave_sum(s) * (1.0f / D) + RMS_EPS);
#pragma unroll
        for (int j = 0; j < 4; ++j) { const int col = (c.lane + 64 * j) * 4; const f32x4 gv = *(const f32x4*)(gfin + col); *(f32x4*)(a->out + (size_t)t * D + col) = v[j] * rs * gv; }
    }
}

constexpr int NPHASE_IDS = 24;
extern __shared__ __attribute__((aligned(16))) unsigned char lds_raw[];
#define FRESH() Ctx c; CArgsP ap; { ap = (CArgsP)__builtin_amdgcn_kernarg_segment_ptr(); asm volatile("" : "+s"(ap)); \
        unsigned lb = (unsigned)(uintptr_t)(LAS unsigned char*)lds_raw; asm volatile("" : "+s"(lb)); c.lds = (LAS unsigned char*)(uintptr_t)lb; \
        c.ws = ap->ws; c.ctl = (u32*)(c.ws + O_CTL); int t_ = threadIdx.x; asm volatile("" : "+v"(t_)); \
        c.tid = t_; c.lane = t_ & 63; c.wave = __builtin_amdgcn_readfirstlane(t_ >> 6); c.G = gridDim.x; c.bid = blockIdx.x; c.gw = c.bid * NWAVES + c.wave; c.ngw = c.G * NWAVES; } \
        LAS unsigned char* lds = c.lds; (void)lds; (void)ap
#define IN(k) (lo <= (k) && (k) < hi)
#if MK_PER_PHASE
#define SEAM(k) do { } while (0)
#else
#define SEAM(k) do { if (IN(k) && IN((k) + 1)) xcd_barrier(bar); } while (0)
#endif
template <int l> __device__ __forceinline__ void layer_body(const int lo, const int hi, const XcdBarrier& bar) {
        const int pb = l ? 10 : 1;
        if (SITE(1) && IN(pb + 0)) { FRESH(); const float* ssq = (const float*)(c.ws + O_SSQ); const u16* xb = (const u16*)(c.ws + O_XB); (void)ssq; (void)xb;
            pg8::Gemm g{xb, (const u16*)(c.ws + O_W1) + (size_t)l * NW1 * D, D}; pg8::StaticOrder so; so.init(S, NW1, c.G, c.bid);
            EpiG1 e{ssq, (u16*)(c.ws + T_QKVF), (u16*)(c.ws + T_QL), (float*)(c.ws + T_T56), (u16*)(c.ws + T_PR)};
            pg8::gemm_phase(lds, g, so, e);
        }
        SEAM(pb + 0);
        if (SITE(2) && IN(pb + 1)) { FRESH(); phase_prep(c, ap, l); }
        SEAM(pb + 1);
        if (SITE(3) && IN(pb + 2)) { FRESH(); const float* ssq = (const float*)(c.ws + O_SSQ); const u16* xb = (const u16*)(c.ws + O_XB); (void)ssq; (void)xb;
            LAS float* PB = (LAS float*)(lds + 81920);
            { const float* FB = (const float*)(c.ws + T_FB); if (c.tid < 4) { float run = 0.f; for (int i = 0; i < 256; ++i) { PB[c.tid * 256 + i] = run; run += FB[c.tid * 256 + i]; } } }
            __syncthreads();
            for (int task = c.gw; task < 2048; task += c.ngw) r1_task(c, task, (LAS float*)(lds + c.wave * 10240));
            u32* qctr = c.ctl + CW_Q_FOX + 128 * l;
            for (;;) {
                unsigned u = 0; if (c.lane == 0) u = atomicAdd(qctr, 1u);
                u = __builtin_amdgcn_readfirstlane(u);
                if (u >= 2048u) break;
                fox_unit(c, (int)u, PB);
            }
        }
        SEAM(pb + 2);
        if (SITE(4) && IN(pb + 3)) { FRESH(); const float* ssq = (const float*)(c.ws + O_SSQ); const u16* xb = (const u16*)(c.ws + O_XB); (void)ssq; (void)xb;
            if (c.bid < 8) { for (int h = c.bid; h < 8; h += (c.G < 8 ? c.G : 8)) r2_head(c, h); }
            __syncthreads();
            u32* qctr = c.ctl + CW_Q_DSA + 128 * l; LAS u32* ub = (LAS u32*)(lds + L_DSA_CNT + 512);
            for (;;) {
                if (c.tid == 0) ub[0] = atomicAdd(qctr, 1u);
                __syncthreads();
                const unsigned u = ub[0];
                __syncthreads();
                if (u >= 1024u) break;
                dsa_unit(c, 1023 - (int)u);
            }
        }
        SEAM(pb + 3);
        if (SITE(5) && IN(pb + 4)) { FRESH(); for (int task = c.gw; task < 2048; task += c.ngw) r3_task(c, ap, l, task); }
        SEAM(pb + 4);
        if (SITE(6) && IN(pb + 5)) { FRESH(); const float* ssq = (const float*)(c.ws + O_SSQ); const u16* xb = (const u16*)(c.ws + O_XB); (void)ssq; (void)xb;
            if (l == 0) {
                LAS float* scr = (LAS float*)(lds + c.wave * 8704);
                int it0 = convert_seg<1>(ap->in[I_FWG], ap->in[I_FWU], ap->in[I_GFFN], (u16*)(c.ws + T_FFNW), D, FFD, 2 * FFD, 0, scr, c.gw, c.ngw, c.lane);
                (void)convert_seg<0>(ap->in[I_FWD], nullptr, nullptr, (u16*)(c.ws + T_FFNWD), FFD, D, 1024, it0, scr, c.gw, c.ngw, c.lane);
                __syncthreads();
            }
            const u16* wgt = (const u16*)(c.ws + O_WGT) + (size_t)l * 3072 * D; const u16* ow = (const u16*)(c.ws + O_OUTW + l * OUTW_L);
            u16* gt = (u16*)(c.ws + T_GT); float* mgf = (float*)(c.ws + T_MGF); const float* bg = ap->in[I_BGATE] + l * 3072;
            pg8::StaticOrder so; so.init(S, D, c.G, c.bid);
            { pg8::Gemm g{xb, wgt, D}; EpiGate e{ssq, bg, gt}; pg8::gemm_phase(lds, g, so, e); }
            { pg8::Gemm g{(const u16*)(c.ws + T_OF), ow, 256}; EpiProj<0> e{gt, mgf}; pg8::gemm_phase(lds, g, so, e); }
            { pg8::Gemm g{xb, wgt + (size_t)1024 * D, D}; EpiGate e{ssq, bg + 1024, gt}; pg8::gemm_phase(lds, g, so, e); }
            { pg8::Gemm g{(const u16*)(c.ws + T_OD), ow + 1024 * 256, 512}; EpiProj<1> e{gt, mgf}; pg8::gemm_phase(lds, g, so, e); }
            { pg8::Gemm g{xb, wgt + (size_t)2048 * D, D}; EpiGate e{ssq, bg + 2048, gt}; pg8::gemm_phase(lds, g, so, e); }
            { pg8::Gemm g{(const u16*)(c.ws + T_OR), ow + 1024 * 256 + 1024 * 512, 512}; EpiProj<2> e{gt, mgf}; pg8::gemm_phase(lds, g, so, e); }
        }
        SEAM(pb + 5);
        if (SITE(7) && IN(pb + 6)) { FRESH(); const float* ssq = (const float*)(c.ws + O_SSQ); const u16* xb = (const u16*)(c.ws + O_XB); (void)ssq; (void)xb;
            const u16* ow = (const u16*)(c.ws + O_OUTW + l * OUTW_L);
            pg8::Gemm g{(const u16*)(c.ws + T_GT), ow + 1024 * 256 + 2 * 1024 * 512, D}; pg8::StaticOrder so; so.init(S, D, c.G, c.bid);
            EpiResid e{(float*)(c.ws + O_XR), (u16*)(c.ws + O_XB), (float*)(c.ws + O_SSQ)};
            pg8::gemm_phase(lds, g, so, e);
        }
        SEAM(pb + 6);
        if (l == 0) {
            if (SITE(8) && IN(pb + 7)) { FRESH(); const float* ssq = (const float*)(c.ws + O_SSQ); const u16* xb = (const u16*)(c.ws + O_XB); (void)ssq; (void)xb;
                pg8::Gemm g{xb, (const u16*)(c.ws + T_FFNW), D}; pg8::StaticOrder so; so.init(S, 2 * FFD, c.G, c.bid);
                EpiSwiglu e{ssq, nullptr, (u16*)(c.ws + T_ACT), FFD, 0};
                pg8::gemm_phase(lds, g, so, e);
            }
            SEAM(pb + 7);
            if (SITE(9) && IN(pb + 8)) { FRESH(); const float* ssq = (const float*)(c.ws + O_SSQ); const u16* xb = (const u16*)(c.ws + O_XB); (void)ssq; (void)xb;
                pg8::Gemm g{(const u16*)(c.ws + T_ACT), (const u16*)(c.ws + T_FFNWD), FFD}; pg8::StaticOrder so; so.init(S, D, c.G, c.bid);
                EpiResid e{(float*)(c.ws + O_XR), (u16*)(c.ws + O_XB), (float*)(c.ws + O_SSQ)};
                pg8::gemm_phase(lds, g, so, e);
            }
            SEAM(pb + 8);
        } else {
            if (SITE(10) && IN(pb + 7)) { FRESH();
                phase_route(c, ap);
                __syncthreads();
                LAS float* scr = (LAS float*)(lds + c.wave * 8704); int it0 = 0;
                for (int e = 0; e < NEXP; ++e) {
                    it0 = convert_seg<1>(ap->in[I_MWG] + (size_t)e * D * FFE, ap->in[I_MWU] + (size_t)e * D * FFE, ap->in[I_GFFN] + D, (u16*)(c.ws + M_WGU) + (size_t)e * 2 * FFE * D, D, FFE, 2 * FFE, it0, scr, c.gw, c.ngw, c.lane);
                    it0 = convert_seg<0>(ap->in[I_MWD] + (size_t)e * FFE * D, nullptr, nullptr, (u16*)(c.ws + M_WD) + (size_t)e * D * FFE, FFE, D, 1024, it0, scr, c.gw, c.ngw, c.lane);
                }
            }
            SEAM(pb + 7);
            if (SITE(11) && IN(pb + 8)) { FRESH(); phase_sort(c); }
            SEAM(pb + 8);
            for (int half = 0; half < 2; ++half) {
                if (!(IN(pb + 9 + 2 * half) || IN(pb + 10 + 2 * half))) continue;
                FRESH();
                LAS int* ebase = (LAS int*)(lds + 135168); LAS int* pexp = ebase + 64;
                moe_tables(c, ebase, pexp);
                const int npanel = ebase[8] >> 8;
                const int ph = (npanel + 1) >> 1; const int p0 = half ? ph : 0, np = half ? npanel - ph : ph;
                if (SITE(12) && IN(pb + 9 + 2 * half)) {
                    pg8::Gemm g{(const u16*)(c.ws + M_XS), (const u16*)(c.ws + M_WGU), D};
                    pg8::MoeOrder mo{p0, np, 28, c.G, c.bid, 28, pexp};
                    EpiSwiglu e{nullptr, (const float*)(c.ws + M_RS), (u16*)(c.ws + M_ACT), FFE, p0 * 256};
                    pg8::gemm_phase(lds, g, mo, e);
                }
                SEAM(pb + 9 + 2 * half);
                if (SITE(13) && IN(pb + 10 + 2 * half)) {
                    pg8::Gemm g{(const u16*)(c.ws + M_ACT) - (size_t)p0 * 256 * FFE, (const u16*)(c.ws + M_WD), FFE};
                    pg8::MoeOrder mo{p0, np, 4, c.G, c.bid, 4, pexp};
                    EpiMoeDown e{(const float*)(c.ws + M_RG), (u16*)(c.ws + M_XS)};
                    pg8::gemm_phase(lds, g, mo, e);
                }
                SEAM(pb + 10 + 2 * half);
            }
            if (SITE(14) && IN(pb + 13)) { FRESH(); phase_final(c, ap); }
        }
    }

__global__ void __launch_bounds__(NTHR, 2) mk_fwd(Args a) {
    LAS unsigned char* lds0 = (LAS unsigned char*)lds_raw; u32* ctl0 = (u32*)(a.ws + O_CTL);
    volatile LAS unsigned* MISC = (volatile LAS unsigned*)(lds0 + LDS_MISC);
    if (threadIdx.x < 64) MISC[threadIdx.x] = 0u;
    __syncthreads();
    XcdBarrier bar; bar.bar = ctl0 + CW_BAR; bar.x = 0; bar.st = nullptr;
#if !MK_PER_PHASE
    bar = xcd_barrier_post(ctl0 + CW_BAR, MISC);
#endif
    const int lo = a.ph_lo, hi = a.ph_hi;
    if (SITE(0) && IN(0)) { FRESH(); phase_prologue(c, ap); }
    SEAM(0);
    layer_body<0>(lo, hi, bar);
    layer_body<1>(lo, hi, bar);
#undef IN
#undef SEAM
}

extern "C" void kernel_launch(void* const* d_in, const int* in_sizes, int n_in, void* d_out, int out_size, void* d_ws, size_t ws_size, hipStream_t stream) {
    static int grid = 0;
    if (grid == 0) {
        if (n_in != 37 || ws_size < WS_NEED) { fprintf(stderr, "kernel_launch: n_in %d ws %zu need %zu\n", n_in, ws_size, (size_t)WS_NEED); grid = -1; return; }
        int dev = 0, cus = 0, per_cu = 0;
        hipGetDevice(&dev); hipDeviceGetAttribute(&cus, hipDeviceAttributeMultiprocessorCount, dev);
        hipFuncSetAttribute((const void*)mk_fwd, hipFuncAttributeMaxDynamicSharedMemorySize, LDS_BYTES);
        hipOccupancyMaxActiveBlocksPerMultiprocessor(&per_cu, (const void*)mk_fwd, NTHR, LDS_BYTES);
        (void)hipGetLastError();
        grid = cus > 0 ? cus : 256;
        if (per_cu < 1) fprintf(stderr, "kernel_launch: occupancy query says %d\n", per_cu);
    }
    if (grid < 0) return;
    hipMemsetAsync((char*)d_ws + O_CTL, 0, CTL_BYTES, stream);
    Args a{};
    for (int i = 0; i < 37; ++i) a.in[i] = (const float*)d_in[i];
    a.out = (float*)d_out; a.ws = (unsigned char*)d_ws;
#if MK_PER_PHASE
    for (int i = 0; i < NPHASE_IDS; ++i) { a.ph_lo = i; a.ph_hi = i + 1; hipLaunchKernelGGL(mk_fwd, dim3(grid), dim3(NTHR), LDS_BYTES, stream, a); }
#else
    a.ph_lo = 0; a.ph_hi = NPHASE_IDS; hipLaunchKernelGGL(mk_fwd, dim3(grid), dim3(NTHR), LDS_BYTES, stream, a);
#endif
}
```

```cpp
#include <hip/hip_runtime.h>
#include <stdint.h>
#include <stdio.h>

#ifndef MK_PER_PHASE
#define MK_PER_PHASE 0
#endif

#ifndef PHMASK
#define PHMASK 0xFFFFFFu
#endif
#define SITE(k) (((PHMASK) >> (k)) & 1u)
#ifndef PROBE
#define PROBE 0
#endif
#ifndef DSA_REP
#define DSA_REP 0
#endif
#define PA0 17
#define PA1 19
#define PB0 4
#define PB1 5
#define PQ 100.0f
#define LAS __attribute__((address_space(3)))
typedef unsigned short u16;
typedef unsigned int u32;
typedef unsigned long long u64;
typedef short bf16x8 __attribute__((ext_vector_type(8)));
typedef _Float16 f16x8 __attribute__((ext_vector_type(8)));
typedef float f32x4 __attribute__((ext_vector_type(4)));
typedef float f32x2 __attribute__((ext_vector_type(2)));
typedef unsigned u32x4 __attribute__((ext_vector_type(4)));
typedef unsigned u32x2 __attribute__((ext_vector_type(2)));
typedef __bf16 bf16x2_t __attribute__((ext_vector_type(2)));

constexpr int S = 16384, D = 1024;
constexpr int DIN = 6316;
constexpr float RMS_EPS = 1e-6f;
constexpr float LOG2E = 1.4426950408889634f;
constexpr float C2 = 0.125f * LOG2E;
constexpr int NW1 = 3584;
constexpr int FFD = 2816, FFE = 3584, NEXP = 8;
constexpr int MOE_ROWS = 2 * S + NEXP * 256;
constexpr int NWAVES = 8, NTHR = 512;

constexpr size_t MB = 1u << 20;
constexpr size_t O_CTL = 0;
constexpr size_t CTL_BYTES = 2 * MB;
constexpr size_t O_XR = O_CTL + CTL_BYTES;
constexpr size_t O_SSQ = O_XR + (size_t)S * D * 4;
constexpr size_t O_XB = O_SSQ + (size_t)S * 16 * 4;
constexpr size_t O_M = O_XB + (size_t)S * D * 2;
constexpr size_t O_VFIRST = O_M;
constexpr size_t O_W1 = O_VFIRST + (size_t)S * 512 * 2;
constexpr size_t O_WGT = O_W1 + (size_t)2 * NW1 * D * 2;
constexpr size_t OUTW_L = (size_t)(256 + 512 + 512 + 1024) * 1024 * 2;
constexpr size_t O_OUTW = O_WGT + (size_t)2 * 3072 * D * 2;
constexpr size_t O_WL = O_OUTW + 2 * OUTW_L;
constexpr size_t WL_L = (size_t)512 * 320 * 2;
constexpr size_t O_T = O_WL + 2 * WL_L;
constexpr size_t T_QKVF = O_T;
constexpr size_t T_QL = T_QKVF + (size_t)S * 768 * 2;
constexpr size_t T_FL = T_QL + (size_t)S * 512 * 2;
constexpr size_t T_FB = T_FL + (size_t)4 * S * 4;
constexpr size_t T_QKM = T_FB + 4096;
constexpr size_t T_KIM = T_QKM + 8192;
constexpr size_t T_VT = T_KIM + 1024;
constexpr size_t T_CKV = T_VT + (size_t)256 * S * 2;
constexpr size_t T_QI = T_CKV + (size_t)S * 128 * 2;
constexpr size_t T_KI = T_QI + (size_t)S * 288 * 2;
constexpr size_t T_SG = T_KI + (size_t)S * 32 * 2;
constexpr size_t T_BC = T_SG + (size_t)S * 4;
constexpr size_t T_OF = T_BC + (size_t)S * 8 * 4;
constexpr size_t T_OD = T_OF + (size_t)S * 256 * 2;
constexpr size_t T_OR = T_OD + (size_t)S * 512 * 2;
constexpr size_t T_RW = T_OR + (size_t)S * 512 * 2;
constexpr size_t T_RKK = T_RW + (size_t)S * 512 * 4;
constexpr size_t T_RB = T_RKK + (size_t)S * 512 * 2;
constexpr size_t T_RK = T_RB + (size_t)S * 512 * 2;
constexpr size_t T_RR = T_RK + (size_t)S * 512 * 2;
constexpr size_t T_RV = T_RR + (size_t)S * 512 * 2;
constexpr size_t T_RG = T_RV + (size_t)S * 512 * 2;
constexpr size_t T_U1 = T_RG + (size_t)S * 512 * 2;
constexpr size_t T_T56 = T_U1;
constexpr size_t T_PR = T_T56 + (size_t)S * 512 * 4;
constexpr size_t T_YL = T_U1;
constexpr size_t T_RT = T_YL + (size_t)S * 512 * 4;
constexpr size_t T_PC = T_RT + (size_t)S * 512 * 2;
constexpr size_t T_UC = T_PC + (size_t)2048 * 4096 * 4;
constexpr size_t T_U1_END = T_UC + (size_t)2048 * 4096 * 4;
constexpr size_t T_GT = T_U1;
constexpr size_t T_MGF = T_GT + (size_t)S * D * 2;
static_assert(T_MGF + (size_t)S * D * 4 <= T_U1_END, "outproj overlay");
static_assert(T_PR + (size_t)S * 1792 * 2 <= T_U1_END, "g1 overlay");
constexpr size_t T_DSB = T_RW;
static_assert((size_t)256 * 16 * 16384 <= (size_t)S * 512 * (4 + 2 + 2 + 2 + 2), "dsa bin scratch");
constexpr size_t T_FFNW = T_RW;
constexpr size_t T_FFNWD = T_FFNW + (size_t)2 * FFD * D * 2;
static_assert(T_FFNWD + (size_t)D * FFD * 2 <= T_RKK, "ffn weights overlay");
constexpr size_t T_ACT = T_RKK;
static_assert(T_ACT + (size_t)S * FFD * 2 <= T_U1, "ffn act overlay");
constexpr size_t M_WGU = O_M;
constexpr size_t M_WD = M_WGU + (size_t)NEXP * 2 * FFE * D * 2;
constexpr size_t M_XS = M_WD + (size_t)NEXP * D * FFE * 2;
constexpr size_t M_ACT = M_XS + (size_t)MOE_ROWS * D * 2;
constexpr int MOE_HALF_ROWS = MOE_ROWS / 2 + 256;
constexpr int YS2_ROWS = 2304;
constexpr size_t M_YS2 = M_ACT + (size_t)32 * MB;
static_assert((size_t)YS2_ROWS * FFE * 2 <= (size_t)32 * MB && (size_t)32 * MB + (size_t)3 * YS2_ROWS * D * 2 <= (size_t)MOE_HALF_ROWS * FFE * 2, "ys2 overlay");
constexpr size_t M_RS = M_ACT + (size_t)MOE_HALF_ROWS * FFE * 2;
constexpr size_t M_RG = M_RS + (size_t)MOE_ROWS * 4;
constexpr size_t M_TOKROW = M_RG + (size_t)MOE_ROWS * 4;
constexpr size_t M_TOPE = M_TOKROW + (size_t)S * 2 * 4;
constexpr size_t M_TOPG = M_TOPE + (size_t)S * 2 * 4;
constexpr size_t M_CNT = M_TOPG + (size_t)S * 2 * 4;
constexpr size_t M_END = M_CNT + 256 * 8 * 4;
constexpr size_t WS_NEED = (T_U1_END > M_END ? T_U1_END : M_END);

constexpr int CW_BAR = 1024;
constexpr int CW_Q_FOX = 8192;
constexpr int CW_Q_DSA = 8192 + 64;
constexpr int CW_STAMP = 16384;

constexpr int LDS_MISC = 147456 - 256;
constexpr int LDS_BYTES = 147456;

__device__ __forceinline__ unsigned pk_bf16(float lo, float hi) { f32x2 v = {lo, hi}; bf16x2_t b = __builtin_convertvector(v, bf16x2_t); return __builtin_bit_cast(unsigned, b); }
__device__ __forceinline__ float bf2f(u16 b) { return __uint_as_float(((unsigned)b) << 16); }
__device__ __forceinline__ float bflo(unsigned w) { return __uint_as_float(w << 16); }
__device__ __forceinline__ float bfhi(unsigned w) { return __uint_as_float(w & 0xffff0000u); }
__device__ __forceinline__ u16 f2bf(float f) { return (u16)(pk_bf16(f, 0.f) & 0xffffu); }
__device__ __forceinline__ float wave_sum(float v) {
#pragma unroll
    for (int o = 1; o < 64; o <<= 1) v += __shfl_xor(v, o);
    return v;
}
__device__ __forceinline__ unsigned lds_addu(LAS unsigned* p, unsigned v) { return __hip_atomic_fetch_add(p, v, __ATOMIC_RELAXED, __HIP_MEMORY_SCOPE_WORKGROUP); }
__device__ __forceinline__ void lds_oru(LAS unsigned* p, unsigned v) { (void)__hip_atomic_fetch_or(p, v, __ATOMIC_RELAXED, __HIP_MEMORY_SCOPE_WORKGROUP); }
__device__ __forceinline__ int lds_addi(LAS int* p, int v) { return __hip_atomic_fetch_add(p, v, __ATOMIC_RELAXED, __HIP_MEMORY_SCOPE_WORKGROUP); }
__device__ __forceinline__ float sigmoidf_(float x) { return 1.0f / (1.0f + __expf(-x)); }
__device__ __forceinline__ float row_rstd(const float* ssq, int row) {
    const f32x4* p = (const f32x4*)(ssq + (size_t)row * 16);
    const f32x4 a = p[0], b = p[1], c = p[2], d = p[3];
    const float s = ((a.x + a.y) + (a.z + a.w)) + ((b.x + b.y) + (b.z + b.w)) + ((c.x + c.y) + (c.z + c.w)) + ((d.x + d.y) + (d.z + d.w));
    return 1.0f / sqrtf(s * (1.0f / D) + RMS_EPS);
}

#define XB_TMO      128
#define XB_XCNT(j)  (256  + 64 * (j))
#define XB_XSUB(j)  (1280 + 64 * (j))
#define XB_XGEN(j)  (2304 + 64 * (j))
#define XB_TOP      3328
#define XB_TOPGEN   3392
#define XCD_BAR_WORDS 3456
#define XB_SPIN_CAP (1u << 22)
__device__ __forceinline__ unsigned xb_ld(unsigned* p)              { return __hip_atomic_load(p, __ATOMIC_RELAXED, __HIP_MEMORY_SCOPE_AGENT); }
__device__ __forceinline__ unsigned xb_add(unsigned* p, unsigned v) { return __hip_atomic_fetch_add(p, v, __ATOMIC_RELAXED, __HIP_MEMORY_SCOPE_AGENT); }
__device__ __forceinline__ unsigned xb_xcc_id() { return (unsigned)__builtin_amdgcn_s_getreg((3 << 11) | 20) & 0xFu; }
#define XB_SPIN(cond, bar) do { unsigned _sp = 0; while (cond) { __builtin_amdgcn_s_sleep(1); \
    if ((++_sp & 255u) == 0u) { if (xb_ld(&(bar)[XB_TMO])) break; if (_sp > XB_SPIN_CAP) { atomicAdd(&(bar)[XB_TMO], 1u); break; } } } } while (0)
struct XcdBarrier { unsigned* bar; unsigned x; volatile LAS unsigned* st; };
__device__ __forceinline__ XcdBarrier xcd_barrier_post(unsigned* bar, volatile LAS unsigned* st) {
    XcdBarrier b; b.bar = bar; b.x = xb_xcc_id(); b.st = st;
    if (threadIdx.x == 0) (void)xb_add(&bar[XB_XCNT(b.x)], 1u);
    return b;
}
__device__ __forceinline__ void xcd_barrier_complete(unsigned* bar, unsigned x, unsigned& nloc, unsigned& nx) {
    const unsigned G = gridDim.x * gridDim.y * gridDim.z;
    unsigned sum, cnt, mine, sp = 0u;
    for (;;) {
        sum = 0u; cnt = 0u; mine = 0u;
#pragma unroll
        for (unsigned j = 0; j < 16; ++j) { const unsigned c = xb_ld(&bar[XB_XCNT(j)]); sum += c; cnt += (c > 0u) ? 1u : 0u; mine = (j == x) ? c : mine; }
        if (sum == G) break;
        __builtin_amdgcn_s_sleep(1);
        if ((++sp & 255u) == 0u) { if (xb_ld(&bar[XB_TMO])) break; if (sp > XB_SPIN_CAP) { atomicAdd(&bar[XB_TMO], 1u); break; } }
    }
    nloc = mine > 0u ? mine : 1u; nx = cnt > 0u ? cnt : 1u;
}
__device__ __forceinline__ void xcd_barrier(const XcdBarrier& b) {
    asm volatile("s_waitcnt vmcnt(0)" ::: "memory");
    __syncthreads();
    if (threadIdx.x == 0) {
        unsigned* bar = b.bar;
        __builtin_amdgcn_s_waitcnt(0);
        unsigned nloc = b.st[0], nx = b.st[1];
        if (nloc == 0u) { xcd_barrier_complete(bar, b.x, nloc, nx); b.st[0] = nloc; b.st[1] = nx; }
        const unsigned old = xb_add(&bar[XB_XSUB(b.x)], 1u);
        const unsigned gen = old / nloc;
        if (old + 1u == (gen + 1u) * nloc) {
            __builtin_amdgcn_fence(__ATOMIC_RELEASE, "agent");
            asm volatile("s_waitcnt vmcnt(0)" ::: "memory");
            const unsigned og = xb_add(&bar[XB_TOP], 1u);
            const unsigned tg = og / nx;
            if (og + 1u == (tg + 1u) * nx) xb_add(&bar[XB_TOPGEN], 1u);
            else XB_SPIN(xb_ld(&bar[XB_TOPGEN]) == tg, bar);
            __builtin_amdgcn_fence(__ATOMIC_ACQUIRE, "agent");
            xb_add(&bar[XB_XGEN(b.x)], 1u);
            asm volatile("s_waitcnt vmcnt(0)" ::: "memory");
        } else {
            XB_SPIN(xb_ld(&bar[XB_XGEN(b.x)]) == gen, bar);
            __builtin_amdgcn_fence(__ATOMIC_ACQUIRE, "agent");
            asm volatile("s_waitcnt vmcnt(0)" ::: "memory");
        }
    }
    __syncthreads();
}

namespace pg8 {
constexpr int BM = 256, BK = 64, HALF = 128, HTB = HALF * BK * 2, STAGE_BYTES = 8 * HTB, NXCD = 8, WGM = 8;
__host__ __device__ __forceinline__ int lds_byte(int r, int c) { const int st = (r >> 4) * 2 + (c >> 5), rr = r & 15, cc = c & 31, ob = rr * 64 + cc * 2; return st * 1024 + (ob ^ (((ob >> 9) & 1) << 5)); }
__host__ __device__ __forceinline__ void stage_rc(int b, int& R, int& C) { const int st = b / 1024, sb = b % 1024, swz = sb ^ (((sb >> 9) & 1) << 5); R = (st >> 1) * 16 + swz / 64; C = (st & 1) * 32 + (swz % 64) / 2; }
__host__ __device__ __forceinline__ int perm32(int rho) { const int n = rho >> 4, i = rho & 15; return 8 * (i >> 2) + 4 * n + (i & 3); }
struct Unit { int pm, pn, cn, ks; };
struct Gemm { const u16* A; const u16* Bt; int K; int ld; };
struct StaticOrder {
    int nM, nN, nwg, G, c;
    __device__ void init(int M, int N, int G_, int c_) { nM = M / BM; nN = N / BM; nwg = nM * nN; G = G_; c = c_; }
    __device__ bool next(int i, Unit& u) const {
        const long L = (long)i * G + c; if (L >= nwg) return false;
        int wgid = (int)L; { const int q = nwg / NXCD, r = nwg % NXCD, xcd = wgid % NXCD, off = wgid / NXCD; wgid = (xcd < r ? xcd * (q + 1) : r * (q + 1) + (xcd - r) * q) + off; }
        const int nig = WGM * nN, gid = wgid / nig, fm = gid * WGM, gsz = (nM - fm) < WGM ? (nM - fm) : WGM;
        u.pm = fm + ((wgid % nig) % gsz); u.pn = (wgid % nig) / gsz; u.cn = u.pn; u.ks = 0; return true;
    }
};
struct MoeOrder {
    int p0, np, ncol, G, c, browtiles; const LAS int* pexp; int nks;
    __device__ bool next(int i, Unit& u) const {
        const long L = (long)i * G + c; if (L >= (long)np * ncol * nks) return false;
        const int per = np * nks; const int cn = (int)(L / per), rem = (int)(L % per), p = p0 + rem / nks;
        u.pm = p; u.cn = cn; u.pn = pexp[p] * browtiles + cn; u.ks = rem % nks; return true;
    }
};

template <class Epi, class Sched>
__device__ __forceinline__ void gemm_phase(LAS unsigned char* lds, const Gemm g, const Sched& S_, const Epi& E) {
    int tid = threadIdx.x; asm volatile("" : "+v"(tid));
    const int wid = __builtin_amdgcn_readfirstlane(tid >> 6), lane = tid & 63, wr = wid >> 2, wc = wid & 3, fr = lane & 15, fq = lane >> 4;
    int K = g.K; asm volatile("" : "+s"(K));
    const int nt = K / BK;
    int ld = g.ld; asm volatile("" : "+s"(ld));
    unsigned voffA[2], voffB[2];
#pragma unroll
    for (int i = 0; i < 2; ++i) { int R, C; stage_rc(tid * 16 + i * 8192, R, C); const int Rb = Epi::PERM ? ((R & ~31) + perm32(R & 31)) : R;
        voffA[i] = (unsigned)(R * ld + C) * 2u; voffB[i] = (unsigned)(Rb * ld + C) * 2u; }
    const size_t kstep = (size_t)(BK * 2);
    const size_t hstep = (size_t)HALF * ld * 2;
    const size_t sstep = (size_t)K * 2;
    const size_t tstep = 2 * hstep;
    const unsigned ldsw = (unsigned)wid * 1024u;
    const int aoff = lds_byte(wr * 64 + fr, fq * 8), boff = lds_byte(wc * 32 + fr, fq * 8);
#define PG8_SA(b, h) (((b) * 2 + (h)) * HTB)
#define PG8_SB(b, h) ((4 + (b) * 2 + (h)) * HTB)
#define PG8_STAGE(bufoff, gbase, voff) do { _Pragma("unroll") for (int _i = 0; _i < 2; ++_i) \
        __builtin_amdgcn_global_load_lds((const unsigned*)((const char*)(gbase) + (voff)[_i]), (LAS unsigned*)(lds + (bufoff) + ldsw + _i * 8192), 16, 0, 0); } while (0)
#define PG8_LDA(dst, b, h) do { _Pragma("unroll") for (int m = 0; m < 4; ++m) _Pragma("unroll") for (int k = 0; k < 2; ++k) dst[m][k] = *(const LAS bf16x8*)(lds + PG8_SA(b, h) + aoff + m * 2048 + k * 1024); } while (0)
#define PG8_LDB(dst, b, h) do { _Pragma("unroll") for (int n = 0; n < 2; ++n) _Pragma("unroll") for (int k = 0; k < 2; ++k) dst[n][k] = *(const LAS bf16x8*)(lds + PG8_SB(b, h) + boff + n * 2048 + k * 1024); } while (0)
#define PG8_MMA(ai, bj, At, Bt) do { __builtin_amdgcn_s_setprio(1); _Pragma("unroll") for (int m = 0; m < 4; ++m) _Pragma("unroll") for (int n = 0; n < 2; ++n) _Pragma("unroll") for (int k = 0; k < 2; ++k) \
        acc[ai][bj][m][n] = __builtin_amdgcn_mfma_f32_16x16x32_bf16(Bt[n][k], At[m][k], acc[ai][bj][m][n], 0, 0, 0); __builtin_amdgcn_s_setprio(0); } while (0)
#define PG8_WAIT_V(n) asm volatile("s_waitcnt vmcnt(" #n ")" ::: "memory")
#define PG8_WAIT_L(n) asm volatile("s_waitcnt lgkmcnt(" #n ")" ::: "memory")
#define PG8_BAR __builtin_amdgcn_s_barrier()
#define PG8_SCHED __builtin_amdgcn_sched_barrier(0)
    Unit cur, nxt; int ui = 0;
    if (!S_.next(0, cur)) return;
    f32x4 acc[2][2][4][2];
#pragma unroll
    for (int a = 0; a < 2; ++a)
#pragma unroll
        for (int b = 0; b < 2; ++b)
#pragma unroll
            for (int m = 0; m < 4; ++m)
#pragma unroll
                for (int n = 0; n < 2; ++n) acc[a][b][m][n] = (f32x4){0.f, 0.f, 0.f, 0.f};
    bf16x8 At[4][2], B0[2][2], B1[2][2];
    const char* cA = (const char*)g.A + (size_t)cur.pm * tstep + (size_t)cur.ks * sstep; const char* cB = (const char*)g.Bt + (size_t)cur.pn * tstep + (size_t)cur.ks * sstep;
    PG8_STAGE(PG8_SB(0, 0), cB, voffB); PG8_STAGE(PG8_SB(0, 1), cB + hstep, voffB); PG8_STAGE(PG8_SA(0, 0), cA, voffA); PG8_STAGE(PG8_SA(0, 1), cA + hstep, voffA);
    if (wr == 1) PG8_BAR;
    PG8_WAIT_V(2); PG8_BAR;
    PG8_STAGE(PG8_SB(1, 0), cB + kstep, voffB); PG8_STAGE(PG8_SA(1, 0), cA + kstep, voffA); PG8_STAGE(PG8_SB(1, 1), cB + hstep + kstep, voffB);
    PG8_WAIT_V(6); PG8_BAR;
    for (;;) {
        const bool has_next = S_.next(ui + 1, nxt);
        const char* nA = has_next ? (const char*)g.A + (size_t)nxt.pm * tstep + (size_t)nxt.ks * sstep : cA; const char* nB = has_next ? (const char*)g.Bt + (size_t)nxt.pn * tstep + (size_t)nxt.ks * sstep : cB;
        for (int t = 0; t < nt; t += 2) {
            const bool last = (t == nt - 2);
            const char* a1 = cA + (size_t)(t + 1) * kstep;
            const char* a2 = last ? nA : cA + (size_t)(t + 2) * kstep; const char* b2 = last ? nB : cB + (size_t)(t + 2) * kstep;
            const char* a3 = a2 + kstep; const char* b3 = b2 + kstep;
            PG8_LDB(B0, 0, 0); PG8_LDB(B1, 0, 1); PG8_SCHED; PG8_LDA(At, 0, 0); PG8_STAGE(PG8_SA(1, 1), a1 + hstep, voffA);
            PG8_WAIT_V(8); PG8_WAIT_L(0); PG8_BAR; PG8_MMA(0, 0, At, B0); PG8_MMA(0, 1, At, B1); PG8_BAR; PG8_SCHED;
            PG8_LDA(At, 0, 1); PG8_STAGE(PG8_SB(0, 0), b2, voffB); PG8_STAGE(PG8_SB(0, 1), b2 + hstep, voffB); PG8_STAGE(PG8_SA(0, 0), a2, voffA);
            PG8_WAIT_V(8); PG8_WAIT_L(0); PG8_BAR; PG8_MMA(1, 0, At, B0); PG8_MMA(1, 1, At, B1); PG8_BAR; PG8_SCHED;
            PG8_LDB(B0, 1, 0); PG8_LDB(B1, 1, 1); PG8_SCHED; PG8_LDA(At, 1, 0); PG8_STAGE(PG8_SA(0, 1), a2 + hstep, voffA);
            PG8_WAIT_V(8); PG8_WAIT_L(0); PG8_BAR; PG8_MMA(0, 0, At, B0); PG8_MMA(0, 1, At, B1); PG8_BAR; PG8_SCHED;
            PG8_LDA(At, 1, 1); PG8_STAGE(PG8_SB(1, 0), b3, voffB); PG8_STAGE(PG8_SB(1, 1), b3 + hstep, voffB); PG8_STAGE(PG8_SA(1, 0), a3, voffA);
            PG8_WAIT_V(8); PG8_WAIT_L(0); PG8_BAR; PG8_MMA(1, 0, At, B0); PG8_MMA(1, 1, At, B1); PG8_BAR; PG8_SCHED;
        }
        if (wr == 0) PG8_BAR;
        { int fr2 = fr, fq2 = fq; asm volatile("" : "+v"(fr2), "+v"(fq2)); E(acc, cur, wr, wc, fr2, fq2); }
        if (!has_next) break;
#pragma unroll
        for (int a = 0; a < 2; ++a)
#pragma unroll
            for (int b = 0; b < 2; ++b)
#pragma unroll
                for (int m = 0; m < 4; ++m)
#pragma unroll
                    for (int n = 0; n < 2; ++n) acc[a][b][m][n] = (f32x4){0.f, 0.f, 0.f, 0.f};
        cur = nxt; cA = nA; cB = nB; ++ui;
        if (wr == 1) PG8_BAR;
    }
    PG8_WAIT_V(0);
    PG8_BAR;
#undef PG8_SA
#undef PG8_SB
#undef PG8_STAGE
#undef PG8_LDA
#undef PG8_LDB
#undef PG8_MMA
#undef PG8_WAIT_V
#undef PG8_WAIT_L
#undef PG8_BAR
#undef PG8_SCHED
}
}
using pg8::Unit;
typedef f32x4 AccT[2][2][4][2];

__device__ __forceinline__ void st_bf16x8(u16* p, f32x4 v0, f32x4 v1) { u32x4 w; w.x = pk_bf16(v0[0], v0[1]); w.y = pk_bf16(v0[2], v0[3]); w.z = pk_bf16(v1[0], v1[1]); w.w = pk_bf16(v1[2], v1[3]); *(u32x4*)p = w; }
__device__ __forceinline__ void ld_bf16x8(const u16* p, f32x4& v0, f32x4& v1) { const u32x4 w = *(const u32x4*)p; v0 = (f32x4){bflo(w.x), bfhi(w.x), bflo(w.y), bfhi(w.y)}; v1 = (f32x4){bflo(w.z), bfhi(w.z), bflo(w.w), bfhi(w.w)}; }

__device__ __forceinline__ void rstd8(const float* ssq, int row0, int fq, float (&rs)[8]) {
    f32x4 p[8];
#pragma unroll
    for (int i = 0; i < 8; ++i) p[i] = *(const f32x4*)(ssq + (size_t)(row0 + (i >> 2) * 128 + (i & 3) * 16) * 16 + 4 * fq);
#pragma unroll
    for (int i = 0; i < 8; ++i) { float s = (p[i].x + p[i].y) + (p[i].z + p[i].w); s += __shfl_xor(s, 16); s += __shfl_xor(s, 32); rs[i] = 1.0f / sqrtf(s * (1.0f / D) + RMS_EPS); }
}
struct EpiG1 {
    static constexpr bool PERM = true;
    const float* ssq; u16* qkvf; u16* ql; float* t56; u16* pr;
    __device__ __forceinline__ void operator()(const AccT& acc, const Unit& u, int wr, int wc, int fr, int fq) const {
        const int row0 = u.pm * 256 + wr * 64 + fr, cn = u.cn;
        u16* ob = nullptr; float* of = nullptr; int ld, cb;
        if (cn < 3) { ob = qkvf; ld = 768; cb = cn * 256; } else if (cn < 5) { ob = ql; ld = 512; cb = (cn - 3) * 256; }
        else if (cn < 7) { of = t56; ld = 512; cb = (cn - 5) * 256; } else { ob = pr; ld = 1792; cb = (cn - 7) * 256; }
        float rs8[8]; rstd8(ssq, row0, fq, rs8);
#pragma unroll
        for (int ai = 0; ai < 2; ++ai)
#pragma unroll
            for (int m = 0; m < 4; ++m) {
                const int row = row0 + ai * 128 + m * 16; const float rs = rs8[ai * 4 + m];
#pragma unroll
                for (int bj = 0; bj < 2; ++bj) {
                    const int col = cb + bj * 128 + wc * 32 + 8 * fq;
                    const f32x4 v0 = acc[ai][bj][m][0] * rs, v1 = acc[ai][bj][m][1] * rs;
                    if (of) { float* p = of + (size_t)row * ld + col; *(f32x4*)p = v0; *(f32x4*)(p + 4) = v1; }
                    else st_bf16x8(ob + (size_t)row * ld + col, v0, v1);
                }
            }
    }
};
struct EpiGate {
    static constexpr bool PERM = true;
    const float* ssq; const float* bias; u16* gt;
    __device__ __forceinline__ void operator()(const AccT& acc, const Unit& u, int wr, int wc, int fr, int fq) const {
        const int row0 = u.pm * 256 + wr * 64 + fr;
        float rs8[8]; rstd8(ssq, row0, fq, rs8);
        f32x4 bb[2][2];
#pragma unroll
        for (int bj = 0; bj < 2; ++bj) { const int col = u.cn * 256 + bj * 128 + wc * 32 + 8 * fq; bb[bj][0] = *(const f32x4*)(bias + col); bb[bj][1] = *(const f32x4*)(bias + col + 4); }
#pragma unroll
        for (int ai = 0; ai < 2; ++ai)
#pragma unroll
            for (int m = 0; m < 4; ++m) {
                const int row = row0 + ai * 128 + m * 16; const float rs = rs8[ai * 4 + m];
#pragma unroll
                for (int bj = 0; bj < 2; ++bj) {
                    const int col = u.cn * 256 + bj * 128 + wc * 32 + 8 * fq;
                    f32x4 v0 = acc[ai][bj][m][0] * rs + bb[bj][0], v1 = acc[ai][bj][m][1] * rs + bb[bj][1];
#pragma unroll
                    for (int j = 0; j < 4; ++j) { v0[j] = sigmoidf_(v0[j]); v1[j] = sigmoidf_(v1[j]); }
                    st_bf16x8(gt + (size_t)row * D + col, v0, v1);
                }
            }
    }
};
template <int MODE> struct EpiProj {
    static constexpr bool PERM = true;
    u16* gt; float* mgf;
    __device__ __forceinline__ void operator()(const AccT& acc, const Unit& u, int wr, int wc, int fr, int fq) const {
        const int row0 = u.pm * 256 + wr * 64 + fr;
#pragma unroll
        for (int ai = 0; ai < 2; ++ai)
#pragma unroll
            for (int m2 = 0; m2 < 4; m2 += 2) {
                u32x4 gw[2][2]; f32x4 mv[2][2][2];
#pragma unroll
                for (int mm = 0; mm < 2; ++mm)
#pragma unroll
                    for (int bj = 0; bj < 2; ++bj) { const size_t o = (size_t)(row0 + ai * 128 + (m2 + mm) * 16) * D + u.cn * 256 + bj * 128 + wc * 32 + 8 * fq;
                        gw[mm][bj] = *(const u32x4*)(gt + o); if (MODE >= 1) { mv[mm][bj][0] = *(const f32x4*)(mgf + o); mv[mm][bj][1] = *(const f32x4*)(mgf + o + 4); } }
#pragma unroll
                for (int mm = 0; mm < 2; ++mm)
#pragma unroll
                    for (int bj = 0; bj < 2; ++bj) { const int m = m2 + mm; const size_t o = (size_t)(row0 + ai * 128 + m * 16) * D + u.cn * 256 + bj * 128 + wc * 32 + 8 * fq;
                        const u32x4 w = gw[mm][bj]; const f32x4 g0 = (f32x4){bflo(w.x), bfhi(w.x), bflo(w.y), bfhi(w.y)}, g1 = (f32x4){bflo(w.z), bfhi(w.z), bflo(w.w), bfhi(w.w)};
                        f32x4 v0 = acc[ai][bj][m][0] * g0, v1 = acc[ai][bj][m][1] * g1;
                        if (MODE >= 1) { v0 += mv[mm][bj][0]; v1 += mv[mm][bj][1]; }
                        if (MODE <= 1) { *(f32x4*)(mgf + o) = v0; *(f32x4*)(mgf + o + 4) = v1; }
                        else st_bf16x8(gt + o, v0, v1); }
                asm volatile("" ::: "memory");
            }
    }
};
struct EpiResid {
    static constexpr bool PERM = true;
    float* xr; u16* xb; float* ssq;
    __device__ __forceinline__ void operator()(const AccT& acc, const Unit& u, int wr, int wc, int fr, int fq) const {
        const int row0 = u.pm * 256 + wr * 64 + fr;
#pragma unroll
        for (int ai = 0; ai < 2; ++ai)
#pragma unroll
            for (int m2 = 0; m2 < 4; m2 += 2) {
                f32x4 xv[2][2][2];
#pragma unroll
                for (int mm = 0; mm < 2; ++mm)
#pragma unroll
                    for (int bj = 0; bj < 2; ++bj) { const size_t o = (size_t)(row0 + ai * 128 + (m2 + mm) * 16) * D + u.cn * 256 + bj * 128 + wc * 32 + 8 * fq; xv[mm][bj][0] = *(const f32x4*)(xr + o); xv[mm][bj][1] = *(const f32x4*)(xr + o + 4); }
#pragma unroll
                for (int mm = 0; mm < 2; ++mm) { const int m = m2 + mm; const int row = row0 + ai * 128 + m * 16; float sq = 0.f;
#pragma unroll
                    for (int bj = 0; bj < 2; ++bj) { const size_t o = (size_t)row * D + u.cn * 256 + bj * 128 + wc * 32 + 8 * fq;
                        const f32x4 v0 = acc[ai][bj][m][0] + xv[mm][bj][0], v1 = acc[ai][bj][m][1] + xv[mm][bj][1];
                        *(f32x4*)(xr + o) = v0; *(f32x4*)(xr + o + 4) = v1;
                        st_bf16x8(xb + o, v0, v1);
                        sq += (v0[0] * v0[0] + v0[1] * v0[1]) + (v0[2] * v0[2] + v0[3] * v0[3]) + (v1[0] * v1[0] + v1[1] * v1[1]) + (v1[2] * v1[2] + v1[3] * v1[3]); }
                    sq += __shfl_xor(sq, 16); sq += __shfl_xor(sq, 32);
                    if (fq == 0) ssq[(size_t)row * 16 + u.cn * 4 + wc] = sq; }
                asm volatile("" ::: "memory");
            }
    }
};
struct EpiSwiglu {
    static constexpr bool PERM = true;
    const float* ssq; const float* rsrow; u16* act; int ld; int row_base;
    __device__ __forceinline__ void operator()(const AccT& acc, const Unit& u, int wr, int wc, int fr, int fq) const {
        const int row0 = u.pm * 256 + wr * 64 + fr;
        float rs8[8];
        if (rsrow) {
#pragma unroll
            for (int i = 0; i < 8; ++i) rs8[i] = rsrow[row0 + (i >> 2) * 128 + (i & 3) * 16];
        } else rstd8(ssq, row0, fq, rs8);
#pragma unroll
        for (int ai = 0; ai < 2; ++ai)
#pragma unroll
            for (int m = 0; m < 4; ++m) {
                const int row = row0 + ai * 128 + m * 16; const float rs = rs8[ai * 4 + m];
                f32x4 o[2];
#pragma unroll
                for (int n = 0; n < 2; ++n)
#pragma unroll
                    for (int j = 0; j < 4; ++j) { const float gv = acc[ai][0][m][n][j] * rs, uv = acc[ai][1][m][n][j] * rs; o[n][j] = gv * sigmoidf_(gv) * uv; }
                st_bf16x8(act + (size_t)(row - row_base) * ld + u.cn * 128 + wc * 32 + 8 * fq, o[0], o[1]);
            }
    }
};
struct EpiMoeDown {
    static constexpr bool PERM = true;
    const float* rg; u16* ys; u16* ys2;
    __device__ __forceinline__ void operator()(const AccT& acc, const Unit& u, int wr, int wc, int fr, int fq) const {
        const int row0 = u.pm * 256 + wr * 64 + fr;
        u16* const yb = (u.ks == 0) ? ys : ys2 + ((long)(u.ks - 1) * YS2_ROWS - 32768L) * (long)D;
        float g8[8];
#pragma unroll
        for (int i = 0; i < 8; ++i) g8[i] = rg[row0 + (i >> 2) * 128 + (i & 3) * 16];
#pragma unroll
        for (int ai = 0; ai < 2; ++ai)
#pragma unroll
            for (int m = 0; m < 4; ++m) {
                const int row = row0 + ai * 128 + m * 16; const float gsc = g8[ai * 4 + m];
#pragma unroll
                for (int bj = 0; bj < 2; ++bj) {
                    const int col = u.cn * 256 + bj * 128 + wc * 32 + 8 * fq;
                    st_bf16x8(yb + (size_t)row * D + col, acc[ai][bj][m][0] * gsc, acc[ai][bj][m][1] * gsc);
                }
            }
    }
};

struct Args {
    const float* in[37];
    float* out; unsigned char* ws;
    int ph_lo, ph_hi;
};
typedef const __attribute__((address_space(4))) Args* CArgsP;
enum { I_X = 0, I_WIN, I_BGATE, I_GMIX, I_FBIAS, I_KVNORM, I_WUK, I_WUV, I_MU, I_W0, I_WUP, I_A0, I_AUP, I_GUP, I_KK, I_KA, I_RK, I_LNG, I_LNB,
       I_VDOWN, I_VMU, I_VUP, I_VV0, I_PFOX, I_PDSA, I_PRWKV, I_WOUT, I_GFFN, I_FWG, I_FWU, I_FWD, I_RTW, I_RTB, I_MWG, I_MWU, I_MWD, I_GFINAL };

struct Seg { const float* src; const float* src2; const float* gk; const float* aux; u16* dst; int kind, K, ld, col0, nrows, row0, item0; float scale; };
constexpr int MAXSEG = 48;
__device__ __forceinline__ void seg_set(LAS Seg* s, int& n, int& items, int kind, const float* src, const float* src2, const float* gk, const float* aux, u16* dst, int K, int ld, int col0, int nrows, int row0, float scale) {
    LAS Seg& g = s[n]; g.src = src; g.src2 = src2; g.gk = gk; g.aux = aux; g.dst = dst; g.kind = kind; g.K = K; g.ld = ld; g.col0 = col0; g.nrows = nrows; g.row0 = row0; g.item0 = items; g.scale = scale;
    items += (K / ((kind == 2 || kind == 3) ? 16 : 64)) * ((nrows + 31) / 32); ++n;
}
struct SegR { const float* src; const float* gk; const float* aux; int kind, ld, col0, nrows; float scale; };
__device__ __forceinline__ float seg_val(const SegR& g, int k, int n) {
    if (n >= g.nrows) return 0.f;
    switch (g.kind) {
    case 0: { float v = g.src[(size_t)k * g.ld + g.col0 + n] * g.scale; if (g.gk) v *= g.gk[k]; return v; }
    case 5: { return k < 32 ? g.src[(size_t)k * g.ld + n] : 0.f; }
    case 2: { const int h = n >> 7, r = n & 127; float s = 0.f; const float* sp = g.src + (size_t)k * g.ld + g.col0 + h * 64; const float* ap = g.aux + (size_t)h * 64 * 128 + r;
#pragma unroll 8
              for (int d = 0; d < 64; ++d) s += sp[d] * ap[d * 128]; return s * g.scale * g.gk[k]; }
    case 3: { const int h = k >> 7, r = k & 127; float s = 0.f; const float* ap = g.aux + (size_t)(h * 128 + r) * 64; const float* sp = g.src + (size_t)(h * 64) * g.ld + n;
#pragma unroll 8
              for (int d = 0; d < 64; ++d) s += ap[d] * sp[(size_t)d * g.ld]; return s; }
    default: return 0.f;
    }
}
__device__ __forceinline__ void convert_items(const LAS Seg* segs, int s_lo, int s_hi, int nitems, LAS float* scr, int gw, int ngw, int lane) {
    for (int it = gw; it < nitems; it += ngw) {
        int si = s_lo;
        for (int j = s_lo + 1; j < s_hi; ++j) if (segs[j].item0 <= it) si = j;
        SegR g; g.src = segs[si].src; g.gk = segs[si].gk; g.aux = segs[si].aux; g.kind = segs[si].kind; g.ld = segs[si].ld; g.col0 = segs[si].col0; g.nrows = segs[si].nrows; g.scale = segs[si].scale;
        u16* const dst = segs[si].dst; const int K = segs[si].K, row0 = segs[si].row0;
        const bool fold = (g.kind == 2 || g.kind == 3); const int KT = fold ? 16 : 64;
        const int r = it - segs[si].item0, nnb = (g.nrows + 31) / 32, kb = r / nnb, nb = r % nnb, k0 = KT * kb, n0 = 32 * nb;
        if (fold) {
#pragma unroll 2
            for (int i = 0; i < 8; ++i) { const int kk = 2 * i + (lane >> 5); scr[kk * 33 + (lane & 31)] = seg_val(g, k0 + kk, n0 + (lane & 31)); }
            asm volatile("s_waitcnt lgkmcnt(0)" ::: "memory");
            { const int n = lane >> 1, cc = lane & 1; const LAS float* s = scr + (8 * cc) * 33 + n;
              u32x4 o; o.x = pk_bf16(s[0 * 33], s[1 * 33]); o.y = pk_bf16(s[2 * 33], s[3 * 33]); o.z = pk_bf16(s[4 * 33], s[5 * 33]); o.w = pk_bf16(s[6 * 33], s[7 * 33]);
              if (n0 + n < g.nrows) *(u32x4*)(dst + (size_t)(row0 + n0 + n) * K + k0 + 8 * cc) = o; }
        } else {
        if (g.kind == 0) {
            const int n = n0 + (lane & 31); const bool ok = n < g.nrows; const float* sp = g.src + (size_t)(k0 + (lane >> 5)) * g.ld + g.col0 + (ok ? n : 0);
            const float* gp = g.gk ? g.gk + k0 + (lane >> 5) : nullptr;
#pragma unroll 16
            for (int i = 0; i < 32; ++i) { float v = sp[(size_t)(2 * i) * g.ld] * g.scale; if (gp) v *= gp[2 * i]; scr[(2 * i + (lane >> 5)) * 33 + (lane & 31)] = ok ? v : 0.f; }
        } else {
#pragma unroll 4
        for (int i = 0; i < 32; ++i) { const int kk = 2 * i + (lane >> 5); scr[kk * 33 + (lane & 31)] = seg_val(g, k0 + kk, n0 + (lane & 31)); }
        }
        asm volatile("s_waitcnt lgkmcnt(0)" ::: "memory");
        const int c = lane & 7;
#pragma unroll
        for (int j = 0; j < 4; ++j) { const int n = (lane >> 3) + 8 * j; const LAS float* s = scr + (8 * c) * 33 + n;
            u32x4 o; o.x = pk_bf16(s[0 * 33], s[1 * 33]); o.y = pk_bf16(s[2 * 33], s[3 * 33]); o.z = pk_bf16(s[4 * 33], s[5 * 33]); o.w = pk_bf16(s[6 * 33], s[7 * 33]);
            if (n0 + n < g.nrows) *(u32x4*)(dst + (size_t)(row0 + n0 + n) * K + k0 + 8 * c) = o; }
        }
        asm volatile("s_waitcnt lgkmcnt(0)" ::: "memory");
    }
}

template <int KIND>
__device__ __forceinline__ int convert_seg(const float* src, const float* src2, const float* gk, u16* dst, int K, int ld, int nrows, int item0, LAS float* scr, int gw, int ngw, int lane) {
    const int nnb = nrows / 64, nit = (K / 64) * nnb;
    int first = item0 + ((gw - item0) % ngw + ngw) % ngw;
    for (int it = first; it < item0 + nit; it += ngw) {
        const int r = it - item0, kb = r / nnb, nb = r % nnb, k0 = 64 * kb, n0 = 64 * nb;
        const float* sp;
        if (KIND == 0) sp = src + n0 + lane; else { const int within = n0 & 255, which = within >> 7, j = (n0 >> 8) * 128 + (within & 127); sp = (which ? src2 : src) + j + lane; }
#pragma unroll 8
        for (int i = 0; i < 64; ++i) { float v = sp[(size_t)(k0 + i) * ld]; if (gk) v *= gk[k0 + i]; scr[i * 65 + lane] = v; }
        asm volatile("s_waitcnt lgkmcnt(0)" ::: "memory");
        const int c = lane & 7;
#pragma unroll
        for (int j = 0; j < 8; ++j) { const int n = (lane >> 3) + 8 * j; const LAS float* s = scr + (8 * c) * 65 + n;
            u32x4 o; o.x = pk_bf16(s[0 * 65], s[1 * 65]); o.y = pk_bf16(s[2 * 65], s[3 * 65]); o.z = pk_bf16(s[4 * 65], s[5 * 65]); o.w = pk_bf16(s[6 * 65], s[7 * 65]);
            *(u32x4*)(dst + (size_t)(n0 + n) * K + k0 + 8 * c) = o; }
        asm volatile("s_waitcnt lgkmcnt(0)" ::: "memory");
    }
    return item0 + nit;
}

struct Ctx {
    LAS unsigned char* lds; unsigned char* ws; u32* ctl;
    int tid, lane, wave, gw, ngw, G, bid;
};

__device__ __forceinline__ void phase_prologue(const Ctx& c, CArgsP a) {
    LAS Seg* segs = (LAS Seg*)(c.lds + 69632);
    LAS int* nfo = (LAS int*)(c.lds + 69632 + MAXSEG * sizeof(Seg));
    if (c.tid == 0) {
        int n = 0, items = 0;
        for (int l = 0; l < 2; ++l) {
            const float* win = a->in[I_WIN] + (size_t)l * D * DIN; const float* gm = a->in[I_GMIX] + l * D;
            u16* w1 = (u16*)(c.ws + O_W1) + (size_t)l * NW1 * D;
            seg_set(segs, n, items, 0, win, nullptr, gm, nullptr, w1, D, DIN, 0, 256, 0, C2);
            seg_set(segs, n, items, 0, win, nullptr, gm, nullptr, w1, D, DIN, 256, 512, 256, 1.f);
            seg_set(segs, n, items, 2, win, nullptr, gm, a->in[I_WUK] + (size_t)l * 4 * 64 * 128, w1, D, DIN, 772, 512, 768, C2);
            seg_set(segs, n, items, 0, win, nullptr, gm, nullptr, w1, D, DIN, 1156, 256, 1280, 1.f);
            seg_set(segs, n, items, 0, win, nullptr, gm, nullptr, w1, D, DIN, 1028, 128, 1536, 1.f);
            seg_set(segs, n, items, 0, win, nullptr, gm, nullptr, w1, D, DIN, 1412, 32, 1664, 1.f);
            seg_set(segs, n, items, 0, win, nullptr, gm, nullptr, w1, D, DIN, 1444, 8, 1696, 1.f);
            seg_set(segs, n, items, 0, win, nullptr, gm, nullptr, w1, D, DIN, 768, 4, 1704, 1.f);
            if (l == 1) seg_set(segs, n, items, 0, a->in[I_VDOWN], nullptr, gm, nullptr, w1, D, 32, 0, 32, 1708, 1.f);
            else seg_set(segs, n, items, 4, nullptr, nullptr, nullptr, nullptr, w1, D, 0, 0, 32, 1708, 1.f);
            seg_set(segs, n, items, 4, nullptr, nullptr, nullptr, nullptr, w1, D, 0, 0, 52, 1740, 1.f);
            seg_set(segs, n, items, 0, win, nullptr, gm, nullptr, w1, D, DIN, 1452, 1792, 1792, 1.f);
            seg_set(segs, n, items, 0, win, nullptr, gm, nullptr, (u16*)(c.ws + O_WGT) + (size_t)l * 3072 * D, D, DIN, 3244, 3072, 0, 1.f);
            u16* ow = (u16*)(c.ws + O_OUTW + l * OUTW_L);
            seg_set(segs, n, items, 0, a->in[I_PFOX] + (size_t)l * 256 * D, nullptr, nullptr, nullptr, ow, 256, D, 0, 1024, 0, 1.f);
            seg_set(segs, n, items, 3, a->in[I_PDSA] + (size_t)l * 256 * D, nullptr, nullptr, a->in[I_WUV] + (size_t)l * 4 * 128 * 64, ow + 1024 * 256, 512, D, 0, 1024, 0, 1.f);
            seg_set(segs, n, items, 0, a->in[I_PRWKV] + (size_t)l * 512 * D, nullptr, nullptr, nullptr, ow + 1024 * 256 + 1024 * 512, 512, D, 0, 1024, 0, 1.f);
            seg_set(segs, n, items, 0, a->in[I_WOUT] + (size_t)l * D * D, nullptr, nullptr, nullptr, ow + 1024 * 256 + 2 * 1024 * 512, D, D, 0, 1024, 0, 1.f);
            u16* wl = (u16*)(c.ws + O_WL + l * WL_L);
            seg_set(segs, n, items, 0, a->in[I_WUP] + (size_t)l * 64 * 512, nullptr, nullptr, nullptr, wl, 64, 512, 0, 512, 0, 1.f);
            seg_set(segs, n, items, 0, a->in[I_AUP] + (size_t)l * 64 * 512, nullptr, nullptr, nullptr, wl + 512 * 64, 64, 512, 0, 512, 0, 1.f);
            seg_set(segs, n, items, 0, a->in[I_GUP] + (size_t)l * 128 * 512, nullptr, nullptr, nullptr, wl + 2 * 512 * 64, 128, 512, 0, 512, 0, 1.f);
            if (l == 1) seg_set(segs, n, items, 5, a->in[I_VUP], nullptr, nullptr, nullptr, wl + 2 * 512 * 64 + 512 * 128, 64, 512, 0, 512, 0, 1.f);
        }
        nfo[0] = n; nfo[1] = items;
    }
    __syncthreads();
    convert_items(segs, 0, nfo[0], nfo[1], (LAS float*)(c.lds + c.wave * 8704), c.gw, c.ngw, c.lane);
    const float* x = a->in[I_X]; float* xr = (float*)(c.ws + O_XR); u16* xb = (u16*)(c.ws + O_XB); float* ssq = (float*)(c.ws + O_SSQ);
    for (int t = c.gw; t < S; t += c.ngw) {
        const f32x4* xp = (const f32x4*)(x + (size_t)t * D) + c.lane; float s = 0.f;
#pragma unroll
        for (int j = 0; j < 4; ++j) { const f32x4 v = xp[64 * j]; s += (v.x * v.x + v.y * v.y) + (v.z * v.z + v.w * v.w);
            ((f32x4*)(xr + (size_t)t * D))[c.lane + 64 * j] = v;
            u32x2 w; w.x = pk_bf16(v.x, v.y); w.y = pk_bf16(v.z, v.w); ((u32x2*)(xb + (size_t)t * D))[c.lane + 64 * j] = w; }
        s = wave_sum(s);
        if (c.lane < 16) ssq[(size_t)t * 16 + c.lane] = (c.lane == 0) ? s : 0.f;
    }
}

__device__ __forceinline__ float log_sigmoid_(float x) { return -(fmaxf(-x, 0.f) + log1pf(__expf(-fabsf(x)))); }
__device__ __forceinline__ void phase_prep(const Ctx& c, CArgsP a, int l) {
    const u16* qkvf = (const u16*)(c.ws + T_QKVF); const float* t56 = (const float*)(c.ws + T_T56); const u16* pr = (const u16*)(c.ws + T_PR);
    float* FL = (float*)(c.ws + T_FL); float* FB = (float*)(c.ws + T_FB); u16* VT = (u16*)(c.ws + T_VT); u16* CKV = (u16*)(c.ws + T_CKV);
    _Float16* QI = (_Float16*)(c.ws + T_QI); _Float16* KI = (_Float16*)(c.ws + T_KI); u32* SG = (u32*)(c.ws + T_SG); float* BC = (float*)(c.ws + T_BC);
    float* RW = (float*)(c.ws + T_RW); _Float16* RKK = (_Float16*)(c.ws + T_RKK); _Float16* RB = (_Float16*)(c.ws + T_RB);
    u16* RK = (u16*)(c.ws + T_RK); u16* RR = (u16*)(c.ws + T_RR); u16* RV = (u16*)(c.ws + T_RV); u16* RG = (u16*)(c.ws + T_RG); u16* VF = (u16*)(c.ws + O_VFIRST);
    const float* fbias = a->in[I_FBIAS] + l * 4; const float* kvn = a->in[I_KVNORM] + l * 128;
    const float* mu = a->in[I_MU] + l * 1792; const float* w0 = a->in[I_W0] + l * 512; const float* wup = a->in[I_WUP] + (size_t)l * 64 * 512;
    const float* a0 = a->in[I_A0] + l * 512; const float* aup = a->in[I_AUP] + (size_t)l * 64 * 512; const float* gup = a->in[I_GUP] + (size_t)l * 128 * 512;
    const float* kkw = a->in[I_KK] + l * 512; const float* kaw = a->in[I_KA] + l * 512; const float* rkw = a->in[I_RK] + l * 512;
    const float* vmu = a->in[I_VMU]; const float* vup = a->in[I_VUP]; const float* vv0 = a->in[I_VV0];
    LAS float* L_lf = (LAS float*)c.lds;
    LAS u16* L_vt = (LAS u16*)(c.lds + 1024);
    LAS u16* L_xl = (LAS u16*)(c.lds + 38912);
    constexpr int XLS = 328;
    const int tid = c.tid;
    LAS float* L_cst = (LAS float*)(c.lds + 81920);
    for (int idx = tid; idx < 9 * 512; idx += NTHR) { const int v = idx >> 9, j = idx & 511;
        const float* sp = v == 0 ? w0 : v == 1 ? a0 : v == 2 ? kkw : v == 3 ? kaw : v == 4 ? rkw : v == 5 ? vv0 : v == 6 ? mu : v == 7 ? mu + 512 : mu + 1024;
        L_cst[idx] = (v == 5 && l == 0) ? 0.f : sp[j]; }
    for (int blk = c.bid; blk < S / 64; blk += c.G) {
        const int t0 = blk * 64;
        __syncthreads();
        if (tid < 256) { const int tok = tid >> 2, h = tid & 3; L_lf[tok * 4 + h] = log_sigmoid_(t56[(size_t)(t0 + tok) * 512 + 256 + 172 - 4 + h] + fbias[h]) * LOG2E; }
        for (int idx = tid; idx < 64 * 32; idx += NTHR) { const int tok = idx >> 5, c8 = (idx & 31) * 8; const u32x4 w = *(const u32x4*)(qkvf + (size_t)(t0 + tok) * 768 + 512 + c8);
            LAS u16* d = L_vt + c8 * 72 + tok;
            d[0] = (u16)w.x; d[72] = (u16)(w.x >> 16); d[144] = (u16)w.y; d[216] = (u16)(w.y >> 16); d[288] = (u16)w.z; d[360] = (u16)(w.z >> 16); d[432] = (u16)w.w; d[504] = (u16)(w.w >> 16); }
        for (int idx = tid; idx < 64 * 32; idx += NTHR) {
            const int tok = idx >> 5, c8 = (idx & 31) * 8, t = t0 + tok; const int col = 1536 + c8;
            const u32x4 wc = *(const u32x4*)(pr + (size_t)t * 1792 + col); u32x4 wp = (u32x4){0u, 0u, 0u, 0u}; if (t > 0) wp = *(const u32x4*)(pr + (size_t)(t - 1) * 1792 + col);
            const f32x4 m0 = *(const f32x4*)(mu + col), m1 = *(const f32x4*)(mu + col + 4);
            float cur[8] = {bflo(wc.x), bfhi(wc.x), bflo(wc.y), bfhi(wc.y), bflo(wc.z), bfhi(wc.z), bflo(wc.w), bfhi(wc.w)};
            float prv[8] = {bflo(wp.x), bfhi(wp.x), bflo(wp.y), bfhi(wp.y), bflo(wp.z), bfhi(wp.z), bflo(wp.w), bfhi(wp.w)};
            float mm[8] = {m0.x, m0.y, m0.z, m0.w, m1.x, m1.y, m1.z, m1.w}; float ov[8];
#pragma unroll
            for (int e = 0; e < 8; ++e) { const float xs = cur[e] + (prv[e] - cur[e]) * mm[e]; ov[e] = c8 < 64 ? tanhf(xs) : (c8 < 128 ? xs : sigmoidf_(xs)); }
            u32x4 o; o.x = pk_bf16(ov[0], ov[1]); o.y = pk_bf16(ov[2], ov[3]); o.z = pk_bf16(ov[4], ov[5]); o.w = pk_bf16(ov[6], ov[7]);
            *(LAS u32x4*)(L_xl + tok * XLS + c8) = o;
        }
        for (int idx = tid; idx < 64 * 64; idx += NTHR) {
            const int tok = idx >> 6, i = idx & 63, t = t0 + tok; float xv = 0.f;
            if (l == 1 && i < 32) { const float cur = t56[(size_t)t * 512 + 256 + 172 + i]; const float prev = t > 0 ? t56[(size_t)(t - 1) * 512 + 256 + 172 + i] : 0.f; xv = cur + (prev - cur) * vmu[i]; }
            L_xl[tok * XLS + 256 + i] = f2bf(xv);
        }
        __syncthreads();
        if (tid < 4) { float run = 0.f; for (int i = 0; i < 64; ++i) { run += L_lf[i * 4 + tid]; FL[(size_t)tid * S + t0 + i] = run; } FB[tid * 256 + blk] = run; }
        for (int idx = tid; idx < 256 * 8; idx += NTHR) { const int cc = idx >> 3, t8 = (idx & 7) * 8; *(u32x4*)(VT + (size_t)cc * S + t0 + t8) = *(const LAS u32x4*)(L_vt + cc * 72 + t8); }
        {
            LAS unsigned* L_mx = (LAS unsigned*)(c.lds + 37888);
            if (tid < 9) L_mx[tid] = 0u;
            __syncthreads();
            const int tok = tid >> 3, sub = tid & 7; const u16* qp = qkvf + (size_t)(t0 + tok) * 768 + (sub >> 2) * 256 + (sub & 3) * 64; float ss = 0.f;
#pragma unroll
            for (int i = 0; i < 8; ++i) { const u32x4 w = *(const u32x4*)(qp + 8 * i); const float e0 = bflo(w.x), e1 = bfhi(w.x), e2 = bflo(w.y), e3 = bfhi(w.y), e4 = bflo(w.z), e5 = bfhi(w.z), e6 = bflo(w.w), e7 = bfhi(w.w);
                ss += (e0 * e0 + e1 * e1) + (e2 * e2 + e3 * e3) + (e4 * e4 + e5 * e5) + (e6 * e6 + e7 * e7); }
            (void)__hip_atomic_fetch_max(L_mx + sub, __float_as_uint(ss), __ATOMIC_RELAXED, __HIP_MEMORY_SCOPE_WORKGROUP);
            { const float* kp = t56 + (size_t)(t0 + tok) * 512 + 256 + 128 + sub * 4; float ks = (kp[0] * kp[0] + kp[1] * kp[1]) + (kp[2] * kp[2] + kp[3] * kp[3]);
              ks += __shfl_xor(ks, 1); ks += __shfl_xor(ks, 2); ks += __shfl_xor(ks, 4);
              if (sub == 0) (void)__hip_atomic_fetch_max(L_mx + 8, __float_as_uint(ks), __ATOMIC_RELAXED, __HIP_MEMORY_SCOPE_WORKGROUP); }
            __syncthreads();
            if (tid < 8) ((float*)(c.ws + T_QKM))[blk * 8 + tid] = __uint_as_float(L_mx[tid]);
            if (tid == 8) ((float*)(c.ws + T_KIM))[blk] = __uint_as_float(L_mx[8]);
        }
        {
            const int tok = tid >> 3, sub = tid & 7, t = t0 + tok; const float* tp = t56 + (size_t)t * 512;
            float cv[16]; float ss = 0.f;
#pragma unroll
            for (int i = 0; i < 16; ++i) { cv[i] = tp[256 + sub * 16 + i]; ss += cv[i] * cv[i]; }
            ss += __shfl_xor(ss, 1); ss += __shfl_xor(ss, 2); ss += __shfl_xor(ss, 4);
            const float rs = 1.0f / sqrtf(ss * (1.0f / 128.f) + RMS_EPS);
            { u32x4 o0, o1; const float* kn = kvn + sub * 16;
              o0.x = pk_bf16(cv[0] * rs * kn[0], cv[1] * rs * kn[1]); o0.y = pk_bf16(cv[2] * rs * kn[2], cv[3] * rs * kn[3]); o0.z = pk_bf16(cv[4] * rs * kn[4], cv[5] * rs * kn[5]); o0.w = pk_bf16(cv[6] * rs * kn[6], cv[7] * rs * kn[7]);
              o1.x = pk_bf16(cv[8] * rs * kn[8], cv[9] * rs * kn[9]); o1.y = pk_bf16(cv[10] * rs * kn[10], cv[11] * rs * kn[11]); o1.z = pk_bf16(cv[12] * rs * kn[12], cv[13] * rs * kn[13]); o1.w = pk_bf16(cv[14] * rs * kn[14], cv[15] * rs * kn[15]);
              *(u32x4*)(CKV + (size_t)t * 128 + sub * 16) = o0; *(u32x4*)(CKV + (size_t)t * 128 + sub * 16 + 8) = o1; }
            const float wv = tp[256 + 160 + sub]; const float sc = 0.5f * 0.0625f;
            const float aw = fabsf(wv) * sc, lw = wv * sc;
            unsigned bit = (wv < 0.f) ? (1u << sub) : 0u; bit |= __shfl_xor(bit, 1); bit |= __shfl_xor(bit, 2); bit |= __shfl_xor(bit, 4);
            if (sub == 0) SG[t] = bit;
            typedef _Float16 f16x4_t __attribute__((ext_vector_type(4)));
            f16x4_t linq = {0, 0, 0, 0};
#pragma unroll
            for (int d8 = 0; d8 < 4; ++d8) {
                const f32x4 q0 = *(const f32x4*)(tp + sub * 32 + d8 * 8), q1 = *(const f32x4*)(tp + sub * 32 + d8 * 8 + 4);
                const float qv[8] = {q0.x, q0.y, q0.z, q0.w, q1.x, q1.y, q1.z, q1.w};
                f16x8 hq;
#pragma unroll
                for (int e = 0; e < 8; ++e) { hq[e] = (_Float16)(qv[e] * aw);
                    float lv = qv[e] * lw; lv += __shfl_xor(lv, 1); lv += __shfl_xor(lv, 2); lv += __shfl_xor(lv, 4);
                    const int d = d8 * 8 + e; if ((d >> 2) == sub) linq[d & 3] = (_Float16)lv; }
                *(f16x8*)(QI + (size_t)t * 288 + sub * 32 + d8 * 8) = hq;
            }
            *(f16x4_t*)(QI + (size_t)t * 288 + 256 + sub * 4) = linq;
            { const f32x4 kq = *(const f32x4*)(tp + 256 + 128 + sub * 4); f16x4_t hk = {(_Float16)kq.x, (_Float16)kq.y, (_Float16)kq.z, (_Float16)kq.w}; *(f16x4_t*)(KI + (size_t)t * 32 + sub * 4) = hk; }
        }
        {
            const u16* wl = (const u16*)(c.ws + O_WL + l * WL_L);
            const int lane = c.lane, hh = c.wave;
            for (int mt = 0; mt < 4; ++mt) {
                int n = lane & 15, g = lane >> 4; asm volatile("" : "+v"(n), "+v"(g));
                f32x4 cw[4], ca[4], cg[4], cv[4];
#pragma unroll
                for (int nt = 0; nt < 4; ++nt) { cw[nt] = (f32x4){0.f, 0.f, 0.f, 0.f}; ca[nt] = cw[nt]; cg[nt] = cw[nt]; cv[nt] = cw[nt]; }
                const LAS u16* xrow = L_xl + (16 * mt + n) * XLS + 8 * g;
#pragma unroll
                for (int ks = 0; ks < 2; ++ks) {
                    const bf16x8 fw = *(const LAS bf16x8*)(xrow + 32 * ks), fa = *(const LAS bf16x8*)(xrow + 64 + 32 * ks);
#pragma unroll
                    for (int nt = 0; nt < 4; ++nt) { const int j = 64 * hh + 16 * nt + n;
                        cw[nt] = __builtin_amdgcn_mfma_f32_16x16x32_bf16(*(const bf16x8*)(wl + (size_t)j * 64 + 32 * ks + 8 * g), fw, cw[nt], 0, 0, 0);
                        ca[nt] = __builtin_amdgcn_mfma_f32_16x16x32_bf16(*(const bf16x8*)(wl + 512 * 64 + (size_t)j * 64 + 32 * ks + 8 * g), fa, ca[nt], 0, 0, 0); }
                }
#pragma unroll
                for (int ks = 0; ks < 4; ++ks) {
                    const bf16x8 fg = *(const LAS bf16x8*)(xrow + 128 + 32 * ks);
#pragma unroll
                    for (int nt = 0; nt < 4; ++nt) { const int j = 64 * hh + 16 * nt + n;
                        cg[nt] = __builtin_amdgcn_mfma_f32_16x16x32_bf16(*(const bf16x8*)(wl + 2 * 512 * 64 + (size_t)j * 128 + 32 * ks + 8 * g), fg, cg[nt], 0, 0, 0); }
                }
                if (l == 1) {
#pragma unroll
                    for (int ks = 0; ks < 2; ++ks) {
                        const bf16x8 fv = *(const LAS bf16x8*)(xrow + 256 + 32 * ks);
#pragma unroll
                        for (int nt = 0; nt < 4; ++nt) { const int j = 64 * hh + 16 * nt + n;
                            cv[nt] = __builtin_amdgcn_mfma_f32_16x16x32_bf16(*(const bf16x8*)(wl + 2 * 512 * 64 + 512 * 128 + (size_t)j * 64 + 32 * ks + 8 * g), fv, cv[nt], 0, 0, 0); }
                    }
                }
                const int t = t0 + 16 * mt + n;
                const u16* pc = pr + (size_t)t * 1792; const u16* pp = pc - 1792;
                float kkr_[16], av_[16]; float nn = 0.f, bc = 0.f;
#pragma unroll
                for (int nt = 0; nt < 4; ++nt) {
                    const int j = 64 * hh + 16 * nt + 4 * g; const size_t o = (size_t)t * 512 + j;
                    const u32x2 rcw = *(const u32x2*)(pc + j), kcw = *(const u32x2*)(pc + 512 + j), vcw = *(const u32x2*)(pc + 1024 + j);
                    u32x2 rpw = (u32x2){0u, 0u}, kpw = rpw, vpw = rpw; if (t > 0) { rpw = *(const u32x2*)(pp + j); kpw = *(const u32x2*)(pp + 512 + j); vpw = *(const u32x2*)(pp + 1024 + j); }
                    const f32x4 w04 = *(const LAS f32x4*)(L_cst + j), a04 = *(const LAS f32x4*)(L_cst + 512 + j), kk4 = *(const LAS f32x4*)(L_cst + 1024 + j), ka4 = *(const LAS f32x4*)(L_cst + 1536 + j), rk4 = *(const LAS f32x4*)(L_cst + 2048 + j),
                                v04 = *(const LAS f32x4*)(L_cst + 2560 + j), mr4 = *(const LAS f32x4*)(L_cst + 3072 + j), mk4 = *(const LAS f32x4*)(L_cst + 3584 + j), mv4 = *(const LAS f32x4*)(L_cst + 4096 + j);
                    const float rc[4] = {bflo(rcw.x), bfhi(rcw.x), bflo(rcw.y), bfhi(rcw.y)}, kc[4] = {bflo(kcw.x), bfhi(kcw.x), bflo(kcw.y), bfhi(kcw.y)}, vc[4] = {bflo(vcw.x), bfhi(vcw.x), bflo(vcw.y), bfhi(vcw.y)};
                    const float rp[4] = {bflo(rpw.x), bfhi(rpw.x), bflo(rpw.y), bfhi(rpw.y)}, kp[4] = {bflo(kpw.x), bfhi(kpw.x), bflo(kpw.y), bfhi(kpw.y)}, vp[4] = {bflo(vpw.x), bfhi(vpw.x), bflo(vpw.y), bfhi(vpw.y)};
                    u32x2 vfw = (u32x2){0u, 0u}; if (l == 1) vfw = *(const u32x2*)(VF + o);
                    const float vf4[4] = {bflo(vfw.x), bfhi(vfw.x), bflo(vfw.y), bfhi(vfw.y)};
                    float dec[4], k2[4], rv[4], vv[4];
#pragma unroll
                    for (int r = 0; r < 4; ++r) {
                        rv[r] = rc[r] + (rp[r] - rc[r]) * mr4[r]; const float k = kc[r] + (kp[r] - kc[r]) * mk4[r]; float v = vc[r] + (vp[r] - vc[r]) * mv4[r];
                        if (l == 1) v = v + (vf4[r] - v) * sigmoidf_(v04[r] + cv[nt][r]);
                        vv[r] = v;
                        const float wpre = w04[r] + cw[nt][r];
                        const float sp = fmaxf(-wpre, 0.f) + log1pf(__expf(-fabsf(wpre)));
                        dec[r] = __expf(-__expf(-sp - 0.5f));
                        const float av2 = sigmoidf_(a04[r] + ca[nt][r]);
                        const float kkr = k * kk4[r]; nn += kkr * kkr;
                        k2[r] = k * (1.0f + (av2 - 1.0f) * ka4[r]);
                        bc += rv[r] * k2[r] * rk4[r];
                        kkr_[4 * nt + r] = kkr; av_[4 * nt + r] = av2;
                    }
                    *(f32x4*)(RW + o) = (f32x4){dec[0], dec[1], dec[2], dec[3]};
                    { u32x2 w2; w2.x = pk_bf16(k2[0], k2[1]); w2.y = pk_bf16(k2[2], k2[3]); *(u32x2*)(RK + o) = w2; w2.x = pk_bf16(rv[0], rv[1]); w2.y = pk_bf16(rv[2], rv[3]); *(u32x2*)(RR + o) = w2;
                      w2.x = pk_bf16(vv[0], vv[1]); w2.y = pk_bf16(vv[2], vv[3]); *(u32x2*)(RV + o) = w2; if (l == 0) *(u32x2*)(VF + o) = w2;
                      w2.x = pk_bf16(cg[nt][0], cg[nt][1]); w2.y = pk_bf16(cg[nt][2], cg[nt][3]); *(u32x2*)(RG + o) = w2; }
                }
                nn += __shfl_xor(nn, 16); nn += __shfl_xor(nn, 32); bc += __shfl_xor(bc, 16); bc += __shfl_xor(bc, 32);
                const float inv = 1.0f / sqrtf(nn + 1e-12f);
                typedef _Float16 f16x4_t __attribute__((ext_vector_type(4)));
#pragma unroll
                for (int nt = 0; nt < 4; ++nt) { const size_t o = (size_t)t * 512 + 64 * hh + 16 * nt + 4 * g;
                    f16x4_t kq, bq;
#pragma unroll
                    for (int r = 0; r < 4; ++r) { const float kkn = kkr_[4 * nt + r] * inv; kq[r] = (_Float16)kkn; bq[r] = (_Float16)(kkn * av_[4 * nt + r]); }
                    *(f16x4_t*)(RKK + o) = kq; *(f16x4_t*)(RB + o) = bq; }
                if (g == 0) BC[(size_t)t * 8 + hh] = bc;
            }
        }
    }
}

__device__ __forceinline__ void fox_unit(const Ctx& c, int u, const LAS float* PB) {
    const u16* qkvf = (const u16*)(c.ws + T_QKVF); const u16* VT = (const u16*)(c.ws + T_VT); const float* FL = (const float*)(c.ws + T_FL); u16* OF = (u16*)(c.ws + T_OF);
    const int lane = c.lane, q = lane & 15, g = lane >> 4;
    const int qb = 511 - (u >> 2), h = u & 3, r0 = qb * 32;
    const u16* Qp = qkvf + (size_t)(r0 + q) * 768 + h * 64 + 8 * g;
    bf16x8 qA[2], qB[2];
    qA[0] = *(const bf16x8*)Qp; qA[1] = *(const bf16x8*)(Qp + 32); qB[0] = *(const bf16x8*)(Qp + 16 * 768); qB[1] = *(const bf16x8*)(Qp + 16 * 768 + 32);
    const float* FLh = FL + (size_t)h * S; const LAS float* PBh = PB + h * 256;
    const float FqA = FLh[r0 + q] + PBh[r0 >> 6], FqB = FLh[r0 + 16 + q] + PBh[r0 >> 6];
    float mA = -INFINITY, mB = -INFINITY, lA = 0.f, lB = 0.f;
    f32x4 oA[4], oB[4];
#pragma unroll
    for (int d = 0; d < 4; ++d) { oA[d] = (f32x4){0.f, 0.f, 0.f, 0.f}; oB[d] = (f32x4){0.f, 0.f, 0.f, 0.f}; }
    const int krow_off = 8 * (q >> 2) + (q & 3);
    const u16* Kbase = qkvf + 256 + h * 64 + 8 * g;
    const u16* Vbase = VT + (size_t)(h * 64 + q) * S + 8 * g;
    int kt0 = 0;
    float dmin;
    { const u16* kd = Kbase + (size_t)(r0 + q) * 768;
      const u32x4 a0 = __builtin_bit_cast(u32x4, qA[0]), a1 = __builtin_bit_cast(u32x4, qA[1]), b0 = __builtin_bit_cast(u32x4, qB[0]), b1 = __builtin_bit_cast(u32x4, qB[1]);
      const u32x4 k0_ = *(const u32x4*)kd, k1_ = *(const u32x4*)(kd + 32), k2_ = *(const u32x4*)(kd + 16 * 768), k3_ = *(const u32x4*)(kd + 16 * 768 + 32);
      float dA = 0.f, dB = 0.f;
#pragma unroll
      for (int w = 0; w < 4; ++w) { dA += bflo(a0[w]) * bflo(k0_[w]) + bfhi(a0[w]) * bfhi(k0_[w]) + bflo(a1[w]) * bflo(k1_[w]) + bfhi(a1[w]) * bfhi(k1_[w]);
                                    dB += bflo(b0[w]) * bflo(k2_[w]) + bfhi(b0[w]) * bfhi(k2_[w]) + bflo(b1[w]) * bflo(k3_[w]) + bfhi(b1[w]) * bfhi(k3_[w]); }
      dA += __shfl_xor(dA, 16); dA += __shfl_xor(dA, 32); dB += __shfl_xor(dB, 16); dB += __shfl_xor(dB, 32);
      float dm = fminf(dA, dB);
#pragma unroll
      for (int o = 1; o < 16; o <<= 1) dm = fminf(dm, __shfl_xor(dm, o));
      dmin = __builtin_amdgcn_readfirstlane(dm) - 0.5f; }
    { const float thr = __builtin_amdgcn_readfirstlane(FLh[r0] + PBh[r0 >> 6]) + PB[1024 + h] - dmin; const int bmax = r0 >> 6; int b = 0;
#pragma unroll
      for (int e = 0; e < 4; ++e) {
          const int bb = lane + 64 * e; const bool cnd = bb < bmax && PBh[bb + 1] > thr;
          const unsigned long long nb = ~__ballot(cnd); const int n = nb ? __builtin_ctzll(nb) : 64;
          if (b == 64 * e) b += n; }
      kt0 = 2 * b; }
    bf16x8 kf[2][2], vf[4]; f32x4 f0, f1;
#define FOX_LOAD(KT) do { const int k0_ = (KT) * 32; \
        _Pragma("unroll") for (int rb = 0; rb < 2; ++rb) { const u16* kp = Kbase + (size_t)(k0_ + krow_off + 4 * rb) * 768; kf[rb][0] = *(const bf16x8*)kp; kf[rb][1] = *(const bf16x8*)(kp + 32); } \
        _Pragma("unroll") for (int d = 0; d < 4; ++d) vf[d] = *(const bf16x8*)(Vbase + (size_t)(16 * d) * S + k0_); \
        f0 = *(const f32x4*)(FLh + k0_ + 8 * g); f1 = *(const f32x4*)(FLh + k0_ + 8 * g + 4); } while (0)
    FOX_LOAD(kt0);
    for (int kt = kt0; kt <= qb; ++kt) {
        const int k0 = kt * 32;
        const float pb = PBh[k0 >> 6];
        float fk[8] = {f0.x + pb, f0.y + pb, f0.z + pb, f0.w + pb, f1.x + pb, f1.y + pb, f1.z + pb, f1.w + pb};
        bf16x8 kc[2][2], vc[4];
#pragma unroll
        for (int rb = 0; rb < 2; ++rb) { kc[rb][0] = kf[rb][0]; kc[rb][1] = kf[rb][1]; }
#pragma unroll
        for (int d = 0; d < 4; ++d) vc[d] = vf[d];
        if (kt < qb) FOX_LOAD(kt + 1);
        f32x4 sA[2], sB[2];
#pragma unroll
        for (int rb = 0; rb < 2; ++rb) {
            sA[rb] = __builtin_amdgcn_mfma_f32_16x16x32_bf16(kc[rb][0], qA[0], (f32x4){0.f, 0.f, 0.f, 0.f}, 0, 0, 0);
            sA[rb] = __builtin_amdgcn_mfma_f32_16x16x32_bf16(kc[rb][1], qA[1], sA[rb], 0, 0, 0);
            sB[rb] = __builtin_amdgcn_mfma_f32_16x16x32_bf16(kc[rb][0], qB[0], (f32x4){0.f, 0.f, 0.f, 0.f}, 0, 0, 0);
            sB[rb] = __builtin_amdgcn_mfma_f32_16x16x32_bf16(kc[rb][1], qB[1], sB[rb], 0, 0, 0);
        }
        float xA[8], xB[8];
#pragma unroll
        for (int j = 0; j < 8; ++j) { xA[j] = sA[j >> 2][j & 3] + (FqA - fk[j]); xB[j] = sB[j >> 2][j & 3] + (FqB - fk[j]); }
        if (kt == qb) {
#pragma unroll
            for (int j = 0; j < 8; ++j) { const int key = 8 * g + j; if (key > q) xA[j] = -INFINITY; if (key > 16 + q) xB[j] = -INFINITY; }
        }
        float mxA = xA[0], mxB = xB[0];
#pragma unroll
        for (int j = 1; j < 8; ++j) { mxA = fmaxf(mxA, xA[j]); mxB = fmaxf(mxB, xB[j]); }
        mxA = fmaxf(mxA, __shfl_xor(mxA, 16)); mxA = fmaxf(mxA, __shfl_xor(mxA, 32));
        mxB = fmaxf(mxB, __shfl_xor(mxB, 16)); mxB = fmaxf(mxB, __shfl_xor(mxB, 32));
        const float mnA = fmaxf(mA, mxA), mnB = fmaxf(mB, mxB);
        const float alA = __builtin_amdgcn_exp2f(mA - mnA), alB = __builtin_amdgcn_exp2f(mB - mnB);
        mA = mnA; mB = mnB;
        float sumA = 0.f, sumB = 0.f;
#pragma unroll
        for (int j = 0; j < 8; ++j) { xA[j] = __builtin_amdgcn_exp2f(xA[j] - mnA); xB[j] = __builtin_amdgcn_exp2f(xB[j] - mnB); sumA += xA[j]; sumB += xB[j]; }
        lA = lA * alA + sumA; lB = lB * alB + sumB;
        u32x4 pwA, pwB;
        pwA.x = pk_bf16(xA[0], xA[1]); pwA.y = pk_bf16(xA[2], xA[3]); pwA.z = pk_bf16(xA[4], xA[5]); pwA.w = pk_bf16(xA[6], xA[7]);
        pwB.x = pk_bf16(xB[0], xB[1]); pwB.y = pk_bf16(xB[2], xB[3]); pwB.z = pk_bf16(xB[4], xB[5]); pwB.w = pk_bf16(xB[6], xB[7]);
        const bf16x8 pA = __builtin_bit_cast(bf16x8, pwA), pB = __builtin_bit_cast(bf16x8, pwB);
#pragma unroll
        for (int d = 0; d < 4; ++d) {
            oA[d] = __builtin_amdgcn_mfma_f32_16x16x32_bf16(vc[d], pA, oA[d] * alA, 0, 0, 0);
            oB[d] = __builtin_amdgcn_mfma_f32_16x16x32_bf16(vc[d], pB, oB[d] * alB, 0, 0, 0);
        }
    }
#undef FOX_LOAD
    lA += __shfl_xor(lA, 16); lA += __shfl_xor(lA, 32); lB += __shfl_xor(lB, 16); lB += __shfl_xor(lB, 32);
    const float iA = 1.0f / lA, iB = 1.0f / lB;
#pragma unroll
    for (int d = 0; d < 4; ++d) {
        u32x2 w; w.x = pk_bf16(oA[d][0] * iA, oA[d][1] * iA); w.y = pk_bf16(oA[d][2] * iA, oA[d][3] * iA);
        *(u32x2*)(OF + (size_t)(r0 + q) * 256 + h * 64 + 16 * d + 4 * g) = w;
        w.x = pk_bf16(oB[d][0] * iB, oB[d][1] * iB); w.y = pk_bf16(oB[d][2] * iB, oB[d][3] * iB);
        *(u32x2*)(OF + (size_t)(r0 + 16 + q) * 256 + h * 64 + 16 * d + 4 * g) = w;
    }
}

__device__ __forceinline__ float r1_gsum(float x) {
    auto a = __builtin_amdgcn_permlane32_swap(__float_as_uint(x), __float_as_uint(x), false, false);
    const float y = __uint_as_float(a[0]) + __uint_as_float(a[1]);
    auto b = __builtin_amdgcn_permlane16_swap(__float_as_uint(y), __float_as_uint(y), false, false);
    return __uint_as_float(b[0]) + __uint_as_float(b[1]);
}
__device__ __forceinline__ void r1_task(const Ctx& c, int task, LAS float* lw) {
    const float* RW = (const float*)(c.ws + T_RW); const _Float16* RKK = (const _Float16*)(c.ws + T_RKK); const _Float16* RB = (const _Float16*)(c.ws + T_RB);
    const u16* RK = (const u16*)(c.ws + T_RK); const u16* RR = (const u16*)(c.ws + T_RR); const u16* RV = (const u16*)(c.ws + T_RV);
    float* YL = (float*)(c.ws + T_YL); u16* RT = (u16*)(c.ws + T_RT); float* PC = (float*)(c.ws + T_PC); float* UC = (float*)(c.ws + T_UC);
    const int lane = c.lane, m = lane & 15, g = lane >> 4, h = task >> 8, ch = task & 255, t0 = ch * 64;
    float U[4][16], P[4][16];
#pragma unroll
    for (int mt = 0; mt < 4; ++mt)
#pragma unroll
        for (int cc = 0; cc < 16; ++cc) { U[mt][cc] = 0.f; P[mt][cc] = (16 * mt + m == 16 * g + cc) ? 1.f : 0.f; }
    for (int blk = 0; blk < 8; ++blk) {
        const int tb = t0 + blk * 8;
        {
            int l2 = lane; asm volatile("" : "+v"(l2)); const int ls = l2 >> 3, lj = (l2 & 7) * 8;
            const size_t o = (size_t)(tb + ls) * 512 + h * 64 + lj;
            const f32x4 w0 = *(const f32x4*)(RW + o), w1 = *(const f32x4*)(RW + o + 4);
            const f16x8 kk = *(const f16x8*)(RKK + o), bb = *(const f16x8*)(RB + o);
            const u32x4 kr = *(const u32x4*)(RK + o), rr = *(const u32x4*)(RR + o), vv = *(const u32x4*)(RV + o);
            LAS float* d = lw + ls * 384 + lj;
            *(LAS f32x4*)(d) = w0; *(LAS f32x4*)(d + 4) = w1;
            *(LAS f32x4*)(d + 64) = (f32x4){(float)kk[0], (float)kk[1], (float)kk[2], (float)kk[3]}; *(LAS f32x4*)(d + 68) = (f32x4){(float)kk[4], (float)kk[5], (float)kk[6], (float)kk[7]};
            *(LAS f32x4*)(d + 128) = (f32x4){(float)bb[0], (float)bb[1], (float)bb[2], (float)bb[3]}; *(LAS f32x4*)(d + 132) = (f32x4){(float)bb[4], (float)bb[5], (float)bb[6], (float)bb[7]};
            *(LAS f32x4*)(d + 192) = (f32x4){bflo(kr.x), bfhi(kr.x), bflo(kr.y), bfhi(kr.y)}; *(LAS f32x4*)(d + 196) = (f32x4){bflo(kr.z), bfhi(kr.z), bflo(kr.w), bfhi(kr.w)};
            *(LAS f32x4*)(d + 256) = (f32x4){bflo(rr.x), bfhi(rr.x), bflo(rr.y), bfhi(rr.y)}; *(LAS f32x4*)(d + 260) = (f32x4){bflo(rr.z), bfhi(rr.z), bflo(rr.w), bfhi(rr.w)};
            *(LAS f32x4*)(d + 320) = (f32x4){bflo(vv.x), bfhi(vv.x), bflo(vv.y), bfhi(vv.y)}; *(LAS f32x4*)(d + 324) = (f32x4){bflo(vv.z), bfhi(vv.z), bflo(vv.w), bfhi(vv.w)};
        }
        asm volatile("s_waitcnt lgkmcnt(0)" ::: "memory");
        for (int s = 0; s < 8; ++s) {
            const LAS float* b = lw + s * 384 + 16 * g; const int t = tb + s;
            float vv_[4], su[4], sp[4];
            {   float a[4] = {0.f, 0.f, 0.f, 0.f}, p[4] = {0.f, 0.f, 0.f, 0.f};
#pragma unroll
                for (int q4 = 0; q4 < 4; ++q4) { const f32x4 kk4 = *(const LAS f32x4*)(b + 64 + 4 * q4);
#pragma unroll
                    for (int mt = 0; mt < 4; ++mt)
#pragma unroll
                        for (int e = 0; e < 4; ++e) { a[mt] = fmaf(U[mt][4 * q4 + e], kk4[e], a[mt]); p[mt] = fmaf(P[mt][4 * q4 + e], kk4[e], p[mt]); } }
#pragma unroll
                for (int mt = 0; mt < 4; ++mt) { vv_[mt] = lw[s * 384 + 320 + 16 * mt + m]; su[mt] = -r1_gsum(a[mt]); sp[mt] = -r1_gsum(p[mt]); } }
            float y[4] = {0.f, 0.f, 0.f, 0.f}, rt[4] = {0.f, 0.f, 0.f, 0.f};
#pragma unroll
            for (int q4 = 0; q4 < 4; ++q4) {
                const f32x4 w4 = *(const LAS f32x4*)(b + 4 * q4), b4 = *(const LAS f32x4*)(b + 128 + 4 * q4), k4 = *(const LAS f32x4*)(b + 192 + 4 * q4), r4 = *(const LAS f32x4*)(b + 256 + 4 * q4);
#pragma unroll
                for (int mt = 0; mt < 4; ++mt)
#pragma unroll
                    for (int e = 0; e < 4; ++e) { const int cc = 4 * q4 + e;
                        float t1 = vv_[mt] * k4[e]; t1 = fmaf(su[mt], b4[e], t1); U[mt][cc] = fmaf(U[mt][cc], w4[e], t1);
                        P[mt][cc] = fmaf(P[mt][cc], w4[e], sp[mt] * b4[e]);
                        y[mt] = fmaf(U[mt][cc], r4[e], y[mt]); rt[mt] = fmaf(P[mt][cc], r4[e], rt[mt]); }
            }
            float yv = 0.f, rv = 0.f;
#pragma unroll
            for (int mt = 0; mt < 4; ++mt) { const float ys = r1_gsum(y[mt]), rs_ = r1_gsum(rt[mt]); if (g == mt) { yv = ys; rv = rs_; } }
            { int l3 = lane; asm volatile("" : "+v"(l3)); const size_t oo = (size_t)t * 512 + h * 64 + l3; YL[oo] = yv; RT[oo] = f2bf(rv); }
        }
    }
    int ln = lane; asm volatile("" : "+v"(ln));
    const int m2 = ln & 15, g2 = ln >> 4;
    u16* ph = (u16*)PC + (size_t)task * 8192;
    LAS u16* lt = (LAS u16*)lw;
#pragma unroll
    for (int mt = 0; mt < 4; ++mt) { const int kpos = 32 * (mt >> 1) + 8 * (m2 >> 2) + 4 * (mt & 1) + (m2 & 3);
#pragma unroll
        for (int cc = 0; cc < 16; ++cc) { const float pv = P[mt][cc]; const u16 hi = f2bf(pv); const u16 lo = f2bf(pv - bf2f(hi)); lt[(16 * g2 + cc) * 64 + kpos] = hi; lt[4096 + (16 * g2 + cc) * 64 + kpos] = lo; } }
    asm volatile("s_waitcnt lgkmcnt(0)" ::: "memory");
#pragma unroll
    for (int i = 0; i < 16; ++i) *(u32x4*)(ph + (size_t)(i * 64 + ln) * 8) = *(const LAS u32x4*)((LAS u16*)lw + (i * 64 + ln) * 8);
    asm volatile("s_waitcnt lgkmcnt(0)" ::: "memory");
#pragma unroll
    for (int mt = 0; mt < 4; ++mt) { float* uc = UC + ((size_t)task * 64 + 16 * mt + m2) * 64 + 16 * g2;
#pragma unroll
        for (int cc = 0; cc < 16; cc += 4) *(f32x4*)(uc + cc) = (f32x4){U[mt][cc], U[mt][cc + 1], U[mt][cc + 2], U[mt][cc + 3]}; }
}

constexpr int R2_SLOT = 20480;
__device__ __forceinline__ void r2_task(const Ctx& c, int h, int rgp) {
    const u16* PHL = (const u16*)(c.ws + T_PC); float* UC = (float*)(c.ws + T_UC);
    volatile LAS unsigned* full = (volatile LAS unsigned*)(c.lds + 7 * R2_SLOT);
    volatile LAS unsigned* freef = full + 8;
    if (c.tid < 16) full[c.tid] = 0u;
    __syncthreads();
    const int lane = c.lane, n = lane & 15, g = lane >> 4, i = 16 * rgp + n;
    if (c.wave == 0) {
        f32x4 s[4];
#pragma unroll
        for (int mt = 0; mt < 4; ++mt) s[mt] = (f32x4){0.f, 0.f, 0.f, 0.f};
        for (int ch = 0; ch < 256; ++ch) {
            const int slot = ch % 7; const LAS unsigned char* sb = c.lds + slot * R2_SLOT;
            { unsigned sp = 0; while (full[slot] != (unsigned)(ch + 1)) { __builtin_amdgcn_s_sleep(1); if (++sp > (1u << 22)) break; } }
            asm volatile("" ::: "memory");
            bf16x8 ah[4][2], al[4][2]; f32x4 u[4];
#pragma unroll
            for (int mt = 0; mt < 4; ++mt) { u[mt] = *(const LAS f32x4*)(sb + 16384 + (mt * 64 + lane) * 16);
#pragma unroll
                for (int ks = 0; ks < 2; ++ks) { ah[mt][ks] = *(const LAS bf16x8*)(sb + ((mt * 2 + ks) * 64 + lane) * 16); al[mt][ks] = *(const LAS bf16x8*)(sb + 8192 + ((mt * 2 + ks) * 64 + lane) * 16); } }
            float* up = UC + ((size_t)(h * 256 + ch) * 64 + i) * 64 + 4 * g;
#pragma unroll
            for (int mt = 0; mt < 4; ++mt) *(f32x4*)(up + 16 * mt) = s[mt];
            bf16x8 bh[2], bl[2];
#pragma unroll
            for (int ks = 0; ks < 2; ++ks) {
                u32x4 wh, wl; float hv[8], lv[8];
#pragma unroll
                for (int j = 0; j < 8; ++j) { const float v = s[2 * ks + (j >> 2)][j & 3]; hv[j] = bf2f(f2bf(v)); lv[j] = v - hv[j]; }
                wh.x = pk_bf16(hv[0], hv[1]); wh.y = pk_bf16(hv[2], hv[3]); wh.z = pk_bf16(hv[4], hv[5]); wh.w = pk_bf16(hv[6], hv[7]);
                wl.x = pk_bf16(lv[0], lv[1]); wl.y = pk_bf16(lv[2], lv[3]); wl.z = pk_bf16(lv[4], lv[5]); wl.w = pk_bf16(lv[6], lv[7]);
                bh[ks] = __builtin_bit_cast(bf16x8, wh); bl[ks] = __builtin_bit_cast(bf16x8, wl);
            }
            asm volatile("s_waitcnt lgkmcnt(0)" ::: "memory");
            if (lane == 0) freef[slot] = (unsigned)(ch + 1);
#pragma unroll
            for (int mt = 0; mt < 4; ++mt) {
                f32x4 acc = u[mt];
#pragma unroll
                for (int ks = 0; ks < 2; ++ks) {
                    acc = __builtin_amdgcn_mfma_f32_16x16x32_bf16(ah[mt][ks], bl[ks], acc, 0, 0, 0);
                    acc = __builtin_amdgcn_mfma_f32_16x16x32_bf16(al[mt][ks], bh[ks], acc, 0, 0, 0);
                    acc = __builtin_amdgcn_mfma_f32_16x16x32_bf16(ah[mt][ks], bh[ks], acc, 0, 0, 0);
                }
                s[mt] = acc;
            }
        }
    } else {
        for (int ch = c.wave - 1; ch < 256; ch += 7) {
            const int slot = ch % 7; LAS unsigned char* sb = c.lds + slot * R2_SLOT;
            const u16* ph = PHL + (size_t)(h * 256 + ch) * 8192; const float* up = UC + ((size_t)(h * 256 + ch) * 64 + i) * 64 + 4 * g;
            bf16x8 ah[4][2], al[4][2]; f32x4 u[4];
#pragma unroll
            for (int mt = 0; mt < 4; ++mt) { u[mt] = *(const f32x4*)(up + 16 * mt);
#pragma unroll
                for (int ks = 0; ks < 2; ++ks) { ah[mt][ks] = *(const bf16x8*)(ph + (16 * mt + n) * 64 + 32 * ks + 8 * g); al[mt][ks] = *(const bf16x8*)(ph + 4096 + (16 * mt + n) * 64 + 32 * ks + 8 * g); } }
            asm volatile("s_waitcnt vmcnt(0)" ::: "memory");
            if (ch >= 7) { unsigned sp = 0; while (freef[slot] != (unsigned)(ch - 6)) { __builtin_amdgcn_s_sleep(1); if (++sp > (1u << 22)) break; } }
            asm volatile("" ::: "memory");
#pragma unroll
            for (int mt = 0; mt < 4; ++mt) { *(LAS f32x4*)(sb + 16384 + (mt * 64 + lane) * 16) = u[mt];
#pragma unroll
                for (int ks = 0; ks < 2; ++ks) { *(LAS bf16x8*)(sb + ((mt * 2 + ks) * 64 + lane) * 16) = ah[mt][ks]; *(LAS bf16x8*)(sb + 8192 + ((mt * 2 + ks) * 64 + lane) * 16) = al[mt][ks]; } }
            asm volatile("s_waitcnt lgkmcnt(0)" ::: "memory");
            if (lane == 0) full[slot] = (unsigned)(ch + 1);
        }
    }
    __syncthreads();
}

__device__ __forceinline__ void r3_task(const Ctx& c, CArgsP a, int l, int task) {
    const float* YL = (const float*)(c.ws + T_YL); const u16* RT = (const u16*)(c.ws + T_RT); const float* S0 = (const float*)(c.ws + T_UC);
    const u16* RV = (const u16*)(c.ws + T_RV); const u16* RG = (const u16*)(c.ws + T_RG); const float* BC = (const float*)(c.ws + T_BC); u16* OR_ = (u16*)(c.ws + T_OR);
    const int lane = c.lane, n = lane & 15, g = lane >> 4, h = task >> 8, ch = task & 255, t0 = ch * 64;
    bf16x8 sh[4][2], sl[4][2];
#pragma unroll
    for (int it = 0; it < 4; ++it)
#pragma unroll
        for (int ks = 0; ks < 2; ++ks) { const float* sp = S0 + ((size_t)task * 64 + 16 * it + n) * 64 + 32 * ks + 8 * g; const f32x4 v0 = *(const f32x4*)sp, v1 = *(const f32x4*)(sp + 4);
            const float v[8] = {v0.x, v0.y, v0.z, v0.w, v1.x, v1.y, v1.z, v1.w}; float hv[8], lv[8];
#pragma unroll
            for (int e = 0; e < 8; ++e) { hv[e] = bf2f(f2bf(v[e])); lv[e] = v[e] - hv[e]; }
            u32x4 wh, wl; wh.x = pk_bf16(hv[0], hv[1]); wh.y = pk_bf16(hv[2], hv[3]); wh.z = pk_bf16(hv[4], hv[5]); wh.w = pk_bf16(hv[6], hv[7]);
            wl.x = pk_bf16(lv[0], lv[1]); wl.y = pk_bf16(lv[2], lv[3]); wl.z = pk_bf16(lv[4], lv[5]); wl.w = pk_bf16(lv[6], lv[7]);
            sh[it][ks] = __builtin_bit_cast(bf16x8, wh); sl[it][ks] = __builtin_bit_cast(bf16x8, wl); }
    const float* lng = a->in[I_LNG] + l * 512 + h * 64; const float* lnb = a->in[I_LNB] + l * 512 + h * 64;
#pragma unroll 1
    for (int tt = 0; tt < 4; ++tt) {
        int n2 = n, g2 = g; asm volatile("" : "+v"(n2), "+v"(g2));
        const int t = t0 + 16 * tt + n2; const size_t ob = (size_t)t * 512 + h * 64 + 4 * g2;
        const bf16x8 r0 = *(const bf16x8*)(RT + (size_t)t * 512 + h * 64 + 8 * g2), r1 = *(const bf16x8*)(RT + (size_t)t * 512 + h * 64 + 32 + 8 * g2);
        f32x4 y[4]; float s1 = 0.f;
#pragma unroll
        for (int it = 0; it < 4; ++it) { f32x4 acc = *(const f32x4*)(YL + ob + 16 * it);
            acc = __builtin_amdgcn_mfma_f32_16x16x32_bf16(sl[it][0], r0, acc, 0, 0, 0); acc = __builtin_amdgcn_mfma_f32_16x16x32_bf16(sl[it][1], r1, acc, 0, 0, 0);
            acc = __builtin_amdgcn_mfma_f32_16x16x32_bf16(sh[it][0], r0, acc, 0, 0, 0); acc = __builtin_amdgcn_mfma_f32_16x16x32_bf16(sh[it][1], r1, acc, 0, 0, 0);
            y[it] = acc; s1 += (acc[0] + acc[1]) + (acc[2] + acc[3]); }
        s1 += __shfl_xor(s1, 16); s1 += __shfl_xor(s1, 32);
        const float mean = s1 * (1.0f / 64.f); float s2 = 0.f;
#pragma unroll
        for (int it = 0; it < 4; ++it)
#pragma unroll
            for (int r = 0; r < 4; ++r) { const float d = y[it][r] - mean; y[it][r] = d; s2 += d * d; }
        s2 += __shfl_xor(s2, 16); s2 += __shfl_xor(s2, 32);
        const float rstd = 1.0f / sqrtf(s2 * (1.0f / 64.f) + 64e-5f); const float bcv = BC[(size_t)t * 8 + h];
#pragma unroll
        for (int it = 0; it < 4; ++it) { const size_t o = ob + 16 * it; const f32x4 g4 = *(const f32x4*)(lng + 16 * it + 4 * g2), b4 = *(const f32x4*)(lnb + 16 * it + 4 * g2);
            const u32x2 vw = *(const u32x2*)(RV + o), gw = *(const u32x2*)(RG + o);
            const float vv[4] = {bflo(vw.x), bfhi(vw.x), bflo(vw.y), bfhi(vw.y)}, gg[4] = {bflo(gw.x), bfhi(gw.x), bflo(gw.y), bfhi(gw.y)}; float ov[4];
#pragma unroll
            for (int r = 0; r < 4; ++r) ov[r] = (y[it][r] * rstd * g4[r] + b4[r] + bcv * vv[r]) * gg[r];
            u32x2 w2; w2.x = pk_bf16(ov[0], ov[1]); w2.y = pk_bf16(ov[2], ov[3]); *(u32x2*)(OR_ + o) = w2; }
    }
}

constexpr int DSA_CAP = 384;
constexpr int L_DSA_IMG = 0;
constexpr int L_DSA_FLAT = 0;
constexpr int L_DSA_CBM = 65536;
constexpr int L_DSA_CAND = 16384;
constexpr int L_DSA_BM = 98304;
constexpr int L_DSA_SEL = 131072;
constexpr int L_DSA_CNT = 131072 + 8192;
__device__ __forceinline__ unsigned ord_of(float s) { const unsigned u = __float_as_uint(s); return (u & 0x80000000u) ? ~u : (u | 0x80000000u); }
__device__ __forceinline__ unsigned img_off(unsigned row, unsigned ch) { return 256u * row + 16u * (ch ^ (((row & 3) << 2) | ((row >> 2) & 3))); }

__device__ __forceinline__ void dsa_score_pass(const Ctx& c, int ntile, const f16x8 (&qf)[9], const float (&sg)[8], float invw, float boff, LAS u32* hist, unsigned char* binrow) {
    const _Float16* KI = (const _Float16*)(c.ws + T_KI);
    int lane = c.lane; asm volatile("" : "+v"(lane));
    const int q = lane & 15, g = lane >> 4;
    const _Float16* kip = KI + (size_t)q * 32 + 8 * g;
    LAS u32* hq = hist + q * 1024; const int rot = 37 * q;
    unsigned* bout = (unsigned*)(binrow + (size_t)q * 16384 + 4 * g);
    const int ntw = (ntile - c.wave + NWAVES - 1) / NWAVES;
    f16x8 k0, k1, k2, k3;
#define DSA_KLOAD(IT) ((IT) < ntw ? *(const f16x8*)(kip + (size_t)(c.wave + NWAVES * (IT)) * 512) : (f16x8){0, 0, 0, 0, 0, 0, 0, 0})
#define DSA_TILE_BODY(KF, IT) do { if ((IT) < ntw) { const int kt = c.wave + NWAVES * (IT); \
        f32x4 xs[9]; \
        _Pragma("unroll") for (int hh = 0; hh < 9; ++hh) xs[hh] = __builtin_amdgcn_mfma_f32_16x16x32_f16(KF, qf[hh], (f32x4){0.f, 0.f, 0.f, 0.f}, 0, 0, 0); \
        KF = DSA_KLOAD((IT) + 4); \
        asm volatile("s_nop 15" : "+v"(xs[0]), "+v"(xs[1]), "+v"(xs[2]), "+v"(xs[3]), "+v"(xs[4]), "+v"(xs[5]), "+v"(xs[6]), "+v"(xs[7]), "+v"(xs[8]));     \
        f32x4 acc = xs[8]; \
        _Pragma("unroll") for (int hh = 0; hh < 8; ++hh) _Pragma("unroll") for (int r = 0; r < 4; ++r) asm volatile("v_fma_f32 %0, |%1|, %2, %0" : "+v"(acc[r]) : "v"(xs[hh][r]), "v"(sg[hh])); \
        unsigned packed = 0; \
        _Pragma("unroll") for (int r = 0; r < 4; ++r) { const float sc = acc[r] + 0.0f; \
            const int bin = min(max((int)__builtin_fmaf(sc, invw, boff), 0), 1023); \
            lds_addu(hq + ((bin + rot) & 1023), 1u); packed |= (unsigned)(bin >> 2) << (8 * r); } \
        bout[kt * 4] = packed; } } while (0)
#define DSA_TILE_BODY_U(KF, IT) do { const int kt = c.wave + NWAVES * (IT); \
        f32x4 xs[9]; \
        _Pragma("unroll") for (int hh = 0; hh < 9; ++hh) xs[hh] = __builtin_amdgcn_mfma_f32_16x16x32_f16(KF, qf[hh], (f32x4){0.f, 0.f, 0.f, 0.f}, 0, 0, 0); \
        KF = *(const f16x8*)(kip + (size_t)(kt + 4 * NWAVES) * 512); \
        asm volatile("s_nop 15" : "+v"(xs[0]), "+v"(xs[1]), "+v"(xs[2]), "+v"(xs[3]), "+v"(xs[4]), "+v"(xs[5]), "+v"(xs[6]), "+v"(xs[7]), "+v"(xs[8])); \
        f32x4 acc = xs[8]; \
        _Pragma("unroll") for (int hh = 0; hh < 8; ++hh) _Pragma("unroll") for (int r = 0; r < 4; ++r) asm volatile("v_fma_f32 %0, |%1|, %2, %0" : "+v"(acc[r]) : "v"(xs[hh][r]), "v"(sg[hh])); \
        unsigned packed = 0; \
        _Pragma("unroll") for (int r = 0; r < 4; ++r) { const float sc = acc[r] + 0.0f; \
            const int bin = min(max((int)__builtin_fmaf(sc, invw, boff), 0), 1023); \
            lds_addu(hq + ((bin + rot) & 1023), 1u); packed |= (unsigned)(bin >> 2) << (8 * r); } \
        bout[kt * 4] = packed; } while (0)
    k0 = DSA_KLOAD(0); k1 = DSA_KLOAD(1); k2 = DSA_KLOAD(2); k3 = DSA_KLOAD(3);
    int it = 0;
    for (; it + 8 <= ntw; it += 4) {
        DSA_TILE_BODY_U(k0, it); DSA_TILE_BODY_U(k1, it + 1); DSA_TILE_BODY_U(k2, it + 2); DSA_TILE_BODY_U(k3, it + 3);
    }
    for (; it < ntw; it += 4) {
        DSA_TILE_BODY(k0, it); DSA_TILE_BODY(k1, it + 1); DSA_TILE_BODY(k2, it + 2); DSA_TILE_BODY(k3, it + 3);
    }
#undef DSA_TILE_BODY_U
#undef DSA_TILE_BODY
#undef DSA_KLOAD
    asm volatile("s_waitcnt vmcnt(0)" ::: "memory");
}
typedef _Float16 h2_t __attribute__((ext_vector_type(2)));
__device__ __forceinline__ float dsa_score_one(const Ctx& c, int t, int key) {
    const _Float16* qp = (const _Float16*)(c.ws + T_QI) + (size_t)t * 288; const _Float16* kp = (const _Float16*)(c.ws + T_KI) + (size_t)key * 32;
    const u32 sb = ((const u32*)(c.ws + T_SG))[t];
    h2_t kv[16];
#pragma unroll
    for (int i = 0; i < 4; ++i) { const u32x4 w = *(const u32x4*)(kp + 8 * i); kv[4 * i] = __builtin_bit_cast(h2_t, w.x); kv[4 * i + 1] = __builtin_bit_cast(h2_t, w.y); kv[4 * i + 2] = __builtin_bit_cast(h2_t, w.z); kv[4 * i + 3] = __builtin_bit_cast(h2_t, w.w); }
    float sc = 0.f;
#pragma unroll
    for (int hh = 8; hh >= 0; --hh) {
        float x = 0.f;
#pragma unroll
        for (int i = 0; i < 4; ++i) { const u32x4 w = *(const u32x4*)(qp + hh * 32 + 8 * i);
            x = __builtin_amdgcn_fdot2(__builtin_bit_cast(h2_t, w.x), kv[4 * i], x, false); x = __builtin_amdgcn_fdot2(__builtin_bit_cast(h2_t, w.y), kv[4 * i + 1], x, false);
            x = __builtin_amdgcn_fdot2(__builtin_bit_cast(h2_t, w.z), kv[4 * i + 2], x, false); x = __builtin_amdgcn_fdot2(__builtin_bit_cast(h2_t, w.w), kv[4 * i + 3], x, false); }
        if (hh == 8) sc = x; else sc = __builtin_fmaf(__builtin_fabsf(x), ((sb >> hh) & 1u) ? -1.f : 1.f, sc);
    }
    return sc + 0.0f;
}
#if PROBE
#define DSTAMP(k) do { if (c.bid == 100 && c.tid == 0) { const u64 now_ = wall_clock64(); ((LAS u64*)(c.lds + L_DSA_CNT + 1024))[k] += now_ - dst_; dst_ = now_; } } while (0)
#else
#define DSTAMP(k) do { } while (0)
#endif
__device__ __forceinline__ void dsa_unit(const Ctx& c, int qt) {
#if PROBE
    u64 dst_ = wall_clock64();
#endif
    const _Float16* QI = (const _Float16*)(c.ws + T_QI); const u32* SG = (const u32*)(c.ws + T_SG);
    const u16* CKV = (const u16*)(c.ws + T_CKV); const u16* QL = (const u16*)(c.ws + T_QL); u16* OD = (u16*)(c.ws + T_OD);
    LAS u32* hist = (LAS u32*)(c.lds + L_DSA_IMG); LAS u64* cand = (LAS u64*)(c.lds + L_DSA_CAND);
    LAS u16* sel = (LAS u16*)(c.lds + L_DSA_SEL); LAS u32* cnts = (LAS u32*)(c.lds + L_DSA_CNT); LAS u32* bm = (LAS u32*)(c.lds + L_DSA_BM);
    int lane = c.lane; asm volatile("" : "+v"(lane)); const int q = lane & 15, g = lane >> 4; int tid = c.tid; asm volatile("" : "+v"(tid));
    const int chunk = qt >> 2, N = 64 * (chunk + 1);
    if (tid < 65) cnts[tid] = 0u;
    if (N > 256) {
        for (int i = tid; i < 16 * 1024; i += NTHR) hist[i] = 0u;
        { LAS u32* cbm0 = (LAS u32*)(c.lds + L_DSA_CBM); for (int i = tid; i < 2 * 16 * 512; i += NTHR) cbm0[i] = 0u; }
        f16x8 qf[9]; float sg[8];
        { const _Float16* qp = QI + (size_t)(qt * 16 + q) * 288 + 8 * g;
#pragma unroll
          for (int hh = 0; hh < 9; ++hh) qf[hh] = *(const f16x8*)(qp + hh * 32);
          const u32 sb = SG[qt * 16 + q];
#pragma unroll
          for (int hh = 0; hh < 8; ++hh) sg[hh] = ((sb >> hh) & 1u) ? -1.f : 1.f; }
        float invw, boff;
        { const _Float16* KIs = (const _Float16*)(c.ws + T_KI); const int ntile = N / 16; float s1 = 0.f, s2 = 0.f;
#pragma unroll
          for (int j = 0; j < 2; ++j) { const int kts = ((2 * c.wave + j) * ntile) >> 4;
              const f16x8 kf = *(const f16x8*)(KIs + (size_t)(kts * 16 + q) * 32 + 8 * g);
              f32x4 acc = __builtin_amdgcn_mfma_f32_16x16x32_f16(kf, qf[8], (f32x4){0.f, 0.f, 0.f, 0.f}, 0, 0, 0);
#pragma unroll
              for (int hh = 0; hh < 8; ++hh) { const f32x4 x = __builtin_amdgcn_mfma_f32_16x16x32_f16(kf, qf[hh], (f32x4){0.f, 0.f, 0.f, 0.f}, 0, 0, 0);
#pragma unroll
                  for (int r = 0; r < 4; ++r) acc[r] = __builtin_fmaf(__builtin_fabsf(x[r]), sg[hh], acc[r]); }
#pragma unroll
              for (int r = 0; r < 4; ++r) { s1 += acc[r]; s2 += acc[r] * acc[r]; } }
          s1 += __shfl_xor(s1, 16); s1 += __shfl_xor(s1, 32); s2 += __shfl_xor(s2, 16); s2 += __shfl_xor(s2, 32);
          LAS float* part = (LAS float*)(c.lds + L_DSA_CNT + 1536);
          if (g == 0) { part[(c.wave * 16 + q) * 2] = s1; part[(c.wave * 16 + q) * 2 + 1] = s2; }
          __syncthreads();
          float t1 = 0.f, t2 = 0.f;
#pragma unroll
          for (int w = 0; w < 8; ++w) { t1 += part[(w * 16 + q) * 2]; t2 += part[(w * 16 + q) * 2 + 1]; }
          const float mean = t1 * (1.0f / 256.f), var = fmaxf(t2 * (1.0f / 256.f) - mean * mean, 1e-30f);
          invw = 512.0f / (6.0f * sqrtf(var)); boff = 512.0f - mean * invw; }
        __syncthreads();
        unsigned char* binrow = c.ws + T_DSB + (size_t)c.bid * (16 * 16384);
        dsa_score_pass(c, N / 16, qf, sg, invw, boff, hist, binrow);
        __syncthreads();
        if (DSA_REP & 1) { for (int i = tid; i < 16 * 1024; i += NTHR) hist[i] = 0u; __syncthreads(); dsa_score_pass(c, N / 16, qf, sg, invw, boff, hist, binrow); __syncthreads(); }
        DSTAMP(0);
        for (int qq = 2 * c.wave; qq < 2 * c.wave + 2; ++qq) {
            int lane = c.lane; asm volatile("" : "+v"(lane));
            const LAS u32* hq = hist + qq * 1024; unsigned cs[4]; unsigned loc = 0;
#pragma unroll
            for (int i = 0; i < 4; ++i) { cs[i] = 0;
#pragma unroll
                for (int e = 0; e < 4; ++e) cs[i] += hq[(lane * 16 + 4 * i + e + 37 * qq) & 1023];
                loc += cs[i]; }
            unsigned suf = loc;
#pragma unroll
            for (int o = 1; o < 64; o <<= 1) { const unsigned v = __shfl_down(suf, o); if (lane + o < 64) suf += v; }
            const u64 bal = __ballot(suf >= 256u);
            const int Ls = 63 - __builtin_clzll(bal);
            if (lane == Ls) { unsigned cab = suf - loc; int b1 = Ls * 4;
                for (int i = 3; i >= 0; --i) { if (cab + cs[i] >= 256u) { b1 = Ls * 4 + i; break; } cab += cs[i]; }
                cnts[32 + qq] = (unsigned)b1; cnts[48 + qq] = 256u - cab; }
        }
        if (c.wave == 0) { __builtin_amdgcn_fence(__ATOMIC_ACQUIRE, "agent"); asm volatile("s_waitcnt vmcnt(0)" ::: "memory"); }
        __syncthreads();
        DSTAMP(1);
        { LAS u32* cbm = (LAS u32*)(c.lds + L_DSA_CBM); const int nch = N >> 4;
          const int tot = 16 * nch;
          for (int base = tid; base < tot; base += 4 * NTHR) {
              u32x4 wq[4]; int qqs[4], chs[4];
#pragma unroll
              for (int u = 0; u < 4; ++u) { const int idx = base + u * NTHR; const int qq = idx < tot ? idx / nch : 0; const int ch = idx < tot ? idx - qq * nch : 0; qqs[u] = qq; chs[u] = ch;
                  wq[u] = *(const u32x4*)(binrow + (size_t)qq * 16384 + ch * 16); }
#pragma unroll
              for (int u = 0; u < 4; ++u) { if (base + u * NTHR >= tot) break;
                  const int qq = qqs[u], ch = chs[u]; const unsigned cb1 = cnts[32 + qq];
#pragma unroll
                  for (int wi = 0; wi < 4; ++wi) { const unsigned w = wq[u][wi];
#pragma unroll
                      for (int bb = 0; bb < 4; ++bb) { const unsigned cb = (w >> (8 * bb)) & 0xffu;
                          if (cb >= cb1) { const int key = ch * 16 + wi * 4 + bb;
                              if (cb > cb1) lds_oru(bm + qq * 512 + (key >> 5), 1u << (key & 31));
                              else lds_oru(cbm + qq * 512 + (key >> 5), 1u << (key & 31)); } } }
              }
          }
        }
        __syncthreads();
        DSTAMP(2);
        for (int rep8_ = 0; rep8_ < ((DSA_REP & 8) ? 2 : 1); ++rep8_)
        for (int qq = 2 * c.wave; qq < 2 * c.wave + 2; ++qq) {
            int lane = c.lane; asm volatile("" : "+v"(lane));
            const unsigned need = cnts[48 + qq]; unsigned C;
            {
                const LAS u32* cbm = (const LAS u32*)(c.lds + L_DSA_CBM) + qq * 512; LAS u16* ck_ = (LAS u16*)(c.lds + L_DSA_FLAT) + qq * DSA_CAP;
                unsigned wv[8]; unsigned cntl = 0;
#pragma unroll
                for (int i = 0; i < 8; ++i) { wv[i] = cbm[lane * 8 + i]; cntl += __builtin_popcount(wv[i]); }
                unsigned inc = cntl;
#pragma unroll
                for (int o = 1; o < 64; o <<= 1) { const unsigned v = __shfl_up(inc, o); if (lane >= o) inc += v; }
                unsigned pos = inc - cntl;
#pragma unroll
                for (int i = 0; i < 8; ++i) { unsigned w = wv[i]; while (w) { const int b = __builtin_ctz(w); if (pos < (unsigned)DSA_CAP) ck_[pos] = (u16)(lane * 256 + i * 32 + b); ++pos; w &= w - 1; } }
                C = min((unsigned)__shfl(inc, 63), (unsigned)DSA_CAP);
                asm volatile("s_waitcnt lgkmcnt(0)" ::: "memory");
            }
            {
                const LAS u16* candk = (const LAS u16*)(c.lds + L_DSA_FLAT) + qq * DSA_CAP; const int n_ = lane & 15, g_ = lane >> 4;
                const _Float16* qp = QI + (size_t)(qt * 16 + qq) * 288 + 8 * g_; const _Float16* KIc = (const _Float16*)(c.ws + T_KI);
                f16x8 q2[9];
#pragma unroll
                for (int hh = 0; hh < 9; ++hh) q2[hh] = *(const f16x8*)(qp + hh * 32);
                const u32 sb2 = SG[qt * 16 + qq];
                for (unsigned base = 0; base < C; base += 64) {
                    f16x8 kfs[4];
#pragma unroll
                    for (int u = 0; u < 4; ++u) { const unsigned j = base + 16 * u + n_; const unsigned key = j < C ? candk[j] : 0u; kfs[u] = *(const f16x8*)(KIc + (size_t)key * 32 + 8 * g_); }
#pragma unroll
                    for (int u = 0; u < 4; ++u) { if (base + 16 * u >= C) break;
                        f32x4 acc = __builtin_amdgcn_mfma_f32_16x16x32_f16(kfs[u], q2[8], (f32x4){0.f, 0.f, 0.f, 0.f}, 0, 0, 0);
#pragma unroll
                        for (int hh = 0; hh < 8; ++hh) { const f32x4 x = __builtin_amdgcn_mfma_f32_16x16x32_f16(kfs[u], q2[hh], (f32x4){0.f, 0.f, 0.f, 0.f}, 0, 0, 0); const float sgn = ((sb2 >> hh) & 1u) ? -1.f : 1.f;
#pragma unroll
                            for (int r = 0; r < 4; ++r) acc[r] = __builtin_fmaf(__builtin_fabsf(x[r]), sgn, acc[r]); }
                        if (n_ == 0) {
#pragma unroll
                            for (int r = 0; r < 4; ++r) { const unsigned jj = base + 16 * u + 4 * g_ + r; if (jj < C) cand[qq * DSA_CAP + jj] = ((u64)ord_of(acc[r] + 0.0f) << 32) | (u64)(0xFFFFFFFFu - (unsigned)candk[jj]); }
                        }
                    }
                }
                asm volatile("s_waitcnt lgkmcnt(0)" ::: "memory");
            }
            if (C <= 64u) {
                const u64 mine = (unsigned)lane < C ? cand[qq * DSA_CAP + lane] : 0ull; unsigned rank = 0;
                const unsigned mlo = (unsigned)mine, mhi = (unsigned)(mine >> 32);
                for (unsigned j = 0; j < C; ++j) { const u64 o = ((u64)(unsigned)__builtin_amdgcn_readlane((int)mhi, (int)j) << 32) | (unsigned)__builtin_amdgcn_readlane((int)mlo, (int)j); rank += (o > mine) ? 1u : 0u; }
                if ((unsigned)lane < C && rank < need) { const unsigned key = 0xFFFFFFFFu - mlo; lds_oru(bm + qq * 512 + (key >> 5), 1u << (key & 31)); }
            } else {
            u64 ck[DSA_CAP / 64];
#pragma unroll
            for (int i = 0; i < DSA_CAP / 64; ++i) { const unsigned idx = lane + 64 * i; ck[i] = idx < C ? cand[qq * DSA_CAP + idx] : 0ull; }
            u64 pre = 0xFFFFC000ull;
            for (int bit = 63; bit >= 0; --bit) {
                if (bit < 32 && bit > 13) continue;
                const u64 trial = pre | (1ull << bit); unsigned cnt = 0;
#pragma unroll
                for (int i = 0; i < DSA_CAP / 64; ++i) cnt += __builtin_popcountll(__ballot(ck[i] >= trial));
                if (cnt >= need) pre = trial;
            }
#pragma unroll
            for (int i = 0; i < DSA_CAP / 64; ++i) if (ck[i] >= pre && ck[i] != 0ull) { const unsigned key = 0xFFFFFFFFu - (unsigned)(ck[i] & 0xFFFFFFFFull); lds_oru(bm + qq * 512 + (key >> 5), 1u << (key & 31)); }
            }
            asm volatile("s_waitcnt lgkmcnt(0)" ::: "memory");
            unsigned wv[8]; unsigned cntl = 0;
#pragma unroll
            for (int i = 0; i < 8; ++i) { wv[i] = bm[qq * 512 + lane * 8 + i]; cntl += __builtin_popcount(wv[i]); }
            unsigned inc = cntl;
#pragma unroll
            for (int o = 1; o < 64; o <<= 1) { const unsigned v = __shfl_up(inc, o); if (lane >= o) inc += v; }
            unsigned pos = inc - cntl;
#pragma unroll
            for (int i = 0; i < 8; ++i) { unsigned w = wv[i]; while (w) { const int b = __builtin_ctz(w); if (pos < 256) sel[qq * 256 + pos] = (u16)(lane * 256 + i * 32 + b); ++pos; w &= w - 1; } }
            if (lane == 63) cnts[qq] = inc;
        }
        __syncthreads();
    } else {
        for (int i = tid; i < 16 * 256; i += NTHR) sel[i] = (u16)((i & 255) < N ? (i & 255) : 0);
        if (tid < 16) cnts[tid] = (unsigned)N;
        __syncthreads();
    }
    DSTAMP(3);
    LAS unsigned char* img = c.lds + L_DSA_IMG + c.wave * 16384;
    for (int rep_ = 0; rep_ < ((DSA_REP & 4) ? 2 : 1); ++rep_)
    for (int qq = 2 * c.wave; qq < 2 * c.wave + 2; ++qq) {
        int lane = c.lane; asm volatile("" : "+v"(lane)); const int q = lane & 15, g = lane >> 4;
        const int t = qt * 16 + qq; const int nsel = (int)min(cnts[qq], 256u); const int ntl = (nsel + 31) >> 5;
        bf16x8 bq[4];
#pragma unroll
        for (int s = 0; s < 4; ++s) { if (q < 4) bq[s] = *(const bf16x8*)(QL + (size_t)t * 512 + q * 128 + 32 * s + 8 * g); else bq[s] = (bf16x8){0, 0, 0, 0, 0, 0, 0, 0}; }
        float m = -INFINITY, lsum = 0.f; f32x4 o[8];
#pragma unroll
        for (int cb = 0; cb < 8; ++cb) o[cb] = (f32x4){0.f, 0.f, 0.f, 0.f};
        u32x4 grA[8], grB[8];
        const int grow = lane >> 4, gchk = lane & 15;
#define DSA_GATHER(TL, GR) do { _Pragma("unroll") for (int i = 0; i < 8; ++i) { const int si = (TL) * 32 + grow + 4 * i; const unsigned key = si < nsel ? sel[qq * 256 + si] : 0u; \
            GR[i] = *(const u32x4*)(CKV + (size_t)key * 128 + gchk * 8); } } while (0)
#define DSA_TILE(TL, GR, IMOFF) do { \
            LAS unsigned char* im = img + (IMOFF); \
            _Pragma("unroll") for (int i = 0; i < 8; ++i) *(LAS u32x4*)(im + img_off(grow + 4 * i, gchk)) = GR[i]; \
            if ((TL) + 2 < ntl) DSA_GATHER((TL) + 2, GR); \
            f32x4 st[2]; \
            _Pragma("unroll") for (int rb = 0; rb < 2; ++rb) { st[rb] = (f32x4){0.f, 0.f, 0.f, 0.f}; const unsigned row = 8 * (q >> 2) + 4 * rb + (q & 3); \
                _Pragma("unroll") for (int s = 0; s < 4; ++s) { const bf16x8 af = *(const LAS bf16x8*)(im + img_off(row, 4 * s + g)); st[rb] = __builtin_amdgcn_mfma_f32_16x16x32_bf16(af, bq[s], st[rb], 0, 0, 0); } } \
            float x[8]; float mx = -INFINITY; \
            _Pragma("unroll") for (int j = 0; j < 8; ++j) { x[j] = st[j >> 2][j & 3]; if ((TL) * 32 + 8 * g + j >= nsel) x[j] = -INFINITY; mx = fmaxf(mx, x[j]); } \
            mx = fmaxf(mx, __shfl_xor(mx, 16)); mx = fmaxf(mx, __shfl_xor(mx, 32)); \
            const float mn = fmaxf(m, mx); const float al = __builtin_amdgcn_exp2f(m - mn); m = mn; float sm = 0.f; \
            _Pragma("unroll") for (int j = 0; j < 8; ++j) { x[j] = __builtin_amdgcn_exp2f(x[j] - mn); sm += x[j]; } \
            lsum = lsum * al + sm; \
            u32x4 pw; pw.x = pk_bf16(x[0], x[1]); pw.y = pk_bf16(x[2], x[3]); pw.z = pk_bf16(x[4], x[5]); pw.w = pk_bf16(x[6], x[7]); \
            const bf16x8 pa = __builtin_bit_cast(bf16x8, pw); \
            float alr[4]; \
            _Pragma("unroll") for (int r = 0; r < 4; ++r) alr[r] = __builtin_bit_cast(float, __builtin_amdgcn_readlane(__builtin_bit_cast(int, al), r)); \
            const unsigned p = lane & 3, qd = (lane & 15) >> 2; \
            _Pragma("unroll") for (int cb = 0; cb < 8; ++cb) { \
                const v4i16_t lo = __builtin_amdgcn_ds_read_tr16_b64_v4i16((LAS v4i16_t*)(im + img_off(8 * g + qd, 2 * cb + (p >> 1)) + 8 * (p & 1))); \
                const v4i16_t hi = __builtin_amdgcn_ds_read_tr16_b64_v4i16((LAS v4i16_t*)(im + img_off(8 * g + 4 + qd, 2 * cb + (p >> 1)) + 8 * (p & 1))); \
                const bf16x8 bw = (bf16x8){lo[0], lo[1], lo[2], lo[3], hi[0], hi[1], hi[2], hi[3]}; \
                f32x4 oc = o[cb]; \
                _Pragma("unroll") for (int r = 0; r < 4; ++r) oc[r] *= alr[r]; \
                o[cb] = __builtin_amdgcn_mfma_f32_16x16x32_bf16(pa, bw, oc, 0, 0, 0); } \
        } while (0)
        typedef short v4i16_t __attribute__((ext_vector_type(4)));
        DSA_GATHER(0, grA);
        if (ntl > 1) DSA_GATHER(1, grB);
        for (int tl = 0; tl < ntl; tl += 2) {
            DSA_TILE(tl, grA, 0);
            if (tl + 1 < ntl) DSA_TILE(tl + 1, grB, 8192);
        }
#undef DSA_TILE
#undef DSA_GATHER
        lsum += __shfl_xor(lsum, 16); lsum += __shfl_xor(lsum, 32);
        float il[4];
#pragma unroll
        for (int r = 0; r < 4; ++r) il[r] = 1.0f / __builtin_bit_cast(float, __builtin_amdgcn_readlane(__builtin_bit_cast(int, lsum), r));
        if (g == 0) {
#pragma unroll
            for (int cb = 0; cb < 8; ++cb)
#pragma unroll
                for (int r = 0; r < 4; ++r) OD[(size_t)t * 512 + r * 128 + 16 * cb + q] = f2bf(o[cb][r] * il[r]);
        }
    }
    __syncthreads();
    DSTAMP(4);
}

__device__ __forceinline__ void phase_route(const Ctx& c, CArgsP a) {
    const float* xr = (const float*)(c.ws + O_XR); const float* ssq = (const float*)(c.ws + O_SSQ);
    const float* rw = a->in[I_RTW]; const float* rb = a->in[I_RTB]; const float* gf = a->in[I_GFFN] + D;
    int* TOPE = (int*)(c.ws + M_TOPE); float* TOPG = (float*)(c.ws + M_TOPG); int* CNT = (int*)(c.ws + M_CNT);
    LAS int* lcnt = (LAS int*)(c.lds + 100000);
    LAS float* rwl = (LAS float*)c.lds;
    for (int idx = c.tid; idx < D * 2; idx += NTHR) { const int k = idx >> 1; const f32x4 w = *(const f32x4*)(rw + (size_t)idx * 4); *(LAS f32x4*)(rwl + idx * 4) = w * gf[k]; }
    for (int blk = c.bid; blk < S / 64; blk += c.G) {
        __syncthreads();
        if (c.tid < 8) lcnt[c.tid] = 0;
        __syncthreads();
        for (int i4 = 0; i4 < 8; i4 += 4) {
            f32x4 xv[4][4];
#pragma unroll
            for (int i = 0; i < 4; ++i)
#pragma unroll
                for (int j = 0; j < 4; ++j) xv[i][j] = *(const f32x4*)(xr + (size_t)(blk * 64 + c.wave * 8 + i4 + i) * D + 16 * c.lane + 4 * j);
            float acc[4][8];
#pragma unroll
            for (int i = 0; i < 4; ++i)
#pragma unroll
                for (int e = 0; e < 8; ++e) acc[i][e] = 0.f;
#pragma unroll
            for (int j = 0; j < 4; ++j)
#pragma unroll
                for (int q = 0; q < 4; ++q) { const LAS float* wp = rwl + (size_t)(16 * c.lane + 4 * j + q) * 8; const f32x4 w0 = *(const LAS f32x4*)wp, w1 = *(const LAS f32x4*)(wp + 4);
#pragma unroll
                    for (int i = 0; i < 4; ++i) { const float x = xv[i][j][q];
#pragma unroll
                        for (int e = 0; e < 4; ++e) { acc[i][e] = fmaf(x, w0[e], acc[i][e]); acc[i][4 + e] = fmaf(x, w1[e], acc[i][4 + e]); } } }
#pragma unroll
            for (int i = 0; i < 4; ++i) {
                const int t = blk * 64 + c.wave * 8 + i4 + i; const float rs = row_rstd(ssq, t); float lg[8];
#pragma unroll
                for (int e = 0; e < 8; ++e) lg[e] = wave_sum(acc[i][e]) * rs + rb[e];
                int e0 = 0; float v0 = lg[0];
#pragma unroll
                for (int e = 1; e < 8; ++e) if (lg[e] > v0) { v0 = lg[e]; e0 = e; }
                int e1 = -1; float v1 = -INFINITY;
#pragma unroll
                for (int e = 0; e < 8; ++e) if (e != e0 && lg[e] > v1) { v1 = lg[e]; e1 = e; }
                const float p1 = 1.0f / (1.0f + __expf(v0 - v1)), p0 = 1.0f - p1;
                if (c.lane == 0) { TOPE[t * 2] = e0; TOPE[t * 2 + 1] = e1; TOPG[t * 2] = p0; TOPG[t * 2 + 1] = p1; lds_addi(&lcnt[e0], 1); lds_addi(&lcnt[e1], 1); }
            }
        }
        __syncthreads();
        if (c.tid < 8) CNT[blk * 8 + c.tid] = lcnt[c.tid];
    }
}
__device__ __forceinline__ void moe_tables(const Ctx& c, LAS int* ebase, LAS int* pexp) {
    const int* CNT = (const int*)(c.ws + M_CNT);
    LAS int* tot = ebase + 16;
    if (c.tid < 8) tot[c.tid] = 0;
    __syncthreads();
    { int s = 0; const int e = c.tid & 7; for (int b = c.tid >> 3; b < 256; b += 64) s += CNT[b * 8 + e]; lds_addi(&tot[e], s); }
    __syncthreads();
    if (c.tid == 0) { int b = 0; for (int e = 0; e < 8; ++e) { ebase[e] = b; const int np = (tot[e] + 255) >> 8; for (int p = 0; p < np; ++p) pexp[(b >> 8) + p] = e; b += np << 8; } ebase[8] = b; }
    __syncthreads();
}
__device__ __forceinline__ void phase_sort(const Ctx& c) {
    const int* CNT = (const int*)(c.ws + M_CNT); const int* TOPE = (const int*)(c.ws + M_TOPE); const float* TOPG = (const float*)(c.ws + M_TOPG);
    const u16* xb = (const u16*)(c.ws + O_XB); const float* ssq = (const float*)(c.ws + O_SSQ);
    u16* XS = (u16*)(c.ws + M_XS); float* RS = (float*)(c.ws + M_RS); float* RGt = (float*)(c.ws + M_RG); int* TOKROW = (int*)(c.ws + M_TOKROW);
    LAS int* ebase = (LAS int*)(c.lds + 100000); LAS int* pexp = ebase + 64; LAS int* boff = ebase + 256; LAS int* rows = ebase + 320;
    moe_tables(c, ebase, pexp);
    for (int blk = c.bid; blk < S / 64; blk += c.G) {
        __syncthreads();
        {
            int s = 0; for (int b = c.lane; b < blk; b += 64) s += CNT[b * 8 + c.wave];
#pragma unroll
            for (int o = 1; o < 64; o <<= 1) s += __shfl_xor(s, o);
            if (c.lane == 0) boff[c.wave] = ebase[c.wave] + s;
        }
        if (c.tid < 128) rows[128 + c.tid] = TOPE[blk * 128 + c.tid];
        __syncthreads();
        if (c.tid < 128) { const int e = rows[128 + c.tid]; int pos = boff[e]; for (int i = 0; i < c.tid; ++i) pos += (rows[128 + i] == e) ? 1 : 0; rows[c.tid] = pos; }
        __syncthreads();
        for (int i0 = c.wave * 16; i0 < c.wave * 16 + 16; i0 += 4) {
            u32x4 v0[4], v1[4]; int rw_[4];
#pragma unroll
            for (int u = 0; u < 4; ++u) { const int i = i0 + u; const int t = blk * 64 + (i >> 1); rw_[u] = rows[i];
                const u32x4* sp = (const u32x4*)(xb + (size_t)t * D); v0[u] = sp[c.lane]; v1[u] = sp[c.lane + 64]; }
#pragma unroll
            for (int u = 0; u < 4; ++u) { u32x4* dp = (u32x4*)(XS + (size_t)rw_[u] * D); dp[c.lane] = v0[u]; dp[c.lane + 64] = v1[u]; }
            if (c.lane < 4) { const int i = i0 + c.lane; const int t = blk * 64 + (i >> 1), row = rows[i]; RS[row] = row_rstd(ssq, t); RGt[row] = TOPG[blk * 128 + i]; TOKROW[blk * 128 + i] = row; }
        }
    }
}
__device__ __forceinline__ void phase_final(const Ctx& c, CArgsP a) {
    const float* xr = (const float*)(c.ws + O_XR); const u16* YS = (const u16*)(c.ws + M_XS); const int* TOKROW = (const int*)(c.ws + M_TOKROW); const float* gfin = a->in[I_GFINAL];
    for (int t = c.gw; t < S; t += c.ngw) {
        const int r0 = TOKROW[t * 2], r1 = TOKROW[t * 2 + 1];
        f32x4 v[4]; float s = 0.f;
#pragma unroll
        for (int j = 0; j < 4; ++j) { const int col = (c.lane + 64 * j) * 4; v[j] = *(const f32x4*)(xr + (size_t)t * D + col);
            const u32x2 y0 = *(const u32x2*)(YS + (size_t)r0 * D + col), y1 = *(const u32x2*)(YS + (size_t)r1 * D + col);
            v[j].x += bflo(y0.x) + bflo(y1.x); v[j].y += bfhi(y0.x) + bfhi(y1.x); v[j].z += bflo(y0.y) + bflo(y1.y); v[j].w += bfhi(y0.y) + bfhi(y1.y);
#pragma unroll
            for (int rr = 0; rr < 2; ++rr) { const int rw = rr ? r1 : r0; if (rw >= 32768) {
#pragma unroll
                for (int s = 0; s < 3; ++s) { const u32x2 yy = *(const u32x2*)((const u16*)(c.ws + M_YS2) + ((size_t)s * YS2_ROWS + (rw - 32768)) * D + col); v[j].x += bflo(yy.x); v[j].y += bfhi(yy.x); v[j].z += bflo(yy.y); v[j].w += bfhi(yy.y); } } }
            s += (v[j].x * v[j].x + v[j].y * v[j].y) + (v[j].z * v[j].z + v[j].w * v[j].w); }
        const float rs = 1.0f / sqrtf(wave_sum(s) * (1.0f / D) + RMS_EPS);
#pragma unroll
        for (int j = 0; j < 4; ++j) { const int col = (c.lane + 64 * j) * 4; const f32x4 gv = *(const f32x4*)(gfin + col); f32x4 ov = v[j] * rs * gv;
#if PROBE
            { const u64* st = (const u64*)(c.ctl + CW_STAMP); const float tot = (float)(st[25] - st[0]);
              const float fa = (PA0 >= 100) ? (float)st[PA0 - 100] / tot : (float)(st[PA1] - st[PA0]) / tot;
              const float fb = (PB0 >= 100) ? (float)st[PB0 - 100] / tot : (float)(st[PB1] - st[PB0]) / tot;
              const float faq = rintf(fa * PQ) / PQ, fbq = rintf(fb * PQ) / PQ; ov = ov * (1.0f + faq); if (t == 0 && col == 0) ov.x += 100.0f * fbq; }
#endif
            *(f32x4*)(a->out + (size_t)t * D + col) = ov; }
    }
}

constexpr int NPHASE_IDS = 26;
extern __shared__ __attribute__((aligned(16))) unsigned char lds_raw[];
#define FRESH() Ctx c; CArgsP ap; { ap = (CArgsP)__builtin_amdgcn_kernarg_segment_ptr(); asm volatile("" : "+s"(ap)); \
        unsigned lb = (unsigned)(uintptr_t)(LAS unsigned char*)lds_raw; asm volatile("" : "+s"(lb)); c.lds = (LAS unsigned char*)(uintptr_t)lb; \
        c.ws = ap->ws; c.ctl = (u32*)(c.ws + O_CTL); int t_ = threadIdx.x; asm volatile("" : "+v"(t_)); \
        c.tid = t_; c.lane = t_ & 63; c.wave = __builtin_amdgcn_readfirstlane(t_ >> 6); c.G = gridDim.x; c.bid = blockIdx.x; c.gw = c.bid * NWAVES + c.wave; c.ngw = c.G * NWAVES; } \
        LAS unsigned char* lds = c.lds; (void)lds; (void)ap
#define IN(k) (lo <= (k) && (k) < hi)
#if MK_PER_PHASE
#define SEAM(k) do { } while (0)
#else
#if PROBE
#define SEAM(k) do { if (IN(k) && IN((k) + 1)) { xcd_barrier(bar); if (blockIdx.x == 0 && threadIdx.x == 0) ((u64*)(bar.bar - CW_BAR + CW_STAMP))[(k) + 1] = wall_clock64(); } } while (0)
#else
#define SEAM(k) do { if (IN(k) && IN((k) + 1)) xcd_barrier(bar); } while (0)
#endif
#endif
template <int l> __device__ __forceinline__ void layer_body(const int lo, const int hi, const XcdBarrier& bar) {
        const int pb = l ? 10 : 1;
        if (SITE(1) && IN(pb + 0)) { FRESH(); const float* ssq = (const float*)(c.ws + O_SSQ); const u16* xb = (const u16*)(c.ws + O_XB); (void)ssq; (void)xb;
            pg8::Gemm g{xb, (const u16*)(c.ws + O_W1) + (size_t)l * NW1 * D, D, D}; pg8::StaticOrder so; so.init(S, NW1, c.G, c.bid);
            EpiG1 e{ssq, (u16*)(c.ws + T_QKVF), (u16*)(c.ws + T_QL), (float*)(c.ws + T_T56), (u16*)(c.ws + T_PR)};
            pg8::gemm_phase(lds, g, so, e);
        }
        SEAM(pb + 0);
        if (SITE(2) && IN(pb + 1)) { FRESH(); phase_prep(c, ap, l); }
        SEAM(pb + 1);
        if (SITE(3) && IN(pb + 2)) { FRESH(); const float* ssq = (const float*)(c.ws + O_SSQ); const u16* xb = (const u16*)(c.ws + O_XB); (void)ssq; (void)xb;
            LAS float* PB = (LAS float*)(lds + 131072);
            { const float* FB = (const float*)(c.ws + T_FB); int lane = c.lane; asm volatile("" : "+v"(lane));
              if (c.wave < 4) {
                  const int hh = c.wave; const f32x4 v = *(const f32x4*)(FB + hh * 256 + 4 * lane);
                  float inc = (v.x + v.y) + (v.z + v.w);
#pragma unroll
                  for (int o = 1; o < 64; o <<= 1) { const float u = __shfl_up(inc, o); if (lane >= o) inc += u; }
                  float ex = __shfl_up(inc, 1); if (lane == 0) ex = 0.f;
                  const float e1 = ex + v.x, e2 = e1 + v.y, e3 = e2 + v.z;
                  *(LAS f32x4*)(PB + hh * 256 + 4 * lane) = (f32x4){ex, e1, e2, e3};
              } else {
                  const int hh = c.wave - 4; const float* qm = (const float*)(c.ws + T_QKM); float mq = 0.f, mk = 0.f;
#pragma unroll
                  for (int i = 0; i < 4; ++i) { mq = fmaxf(mq, qm[(lane + 64 * i) * 8 + hh]); mk = fmaxf(mk, qm[(lane + 64 * i) * 8 + 4 + hh]); }
#pragma unroll
                  for (int o = 1; o < 64; o <<= 1) { mq = fmaxf(mq, __shfl_xor(mq, o)); mk = fmaxf(mk, __shfl_xor(mk, o)); }
                  if (lane == 0) PB[1024 + hh] = sqrtf(mq * mk) * 1.01f + 64.0f;
              } }
            __syncthreads();
            for (int rr1_ = 0; rr1_ < ((DSA_REP & 16) ? 2 : 1); ++rr1_)
            for (int task = c.gw; task < 2048; task += c.ngw) r1_task(c, task, (LAS float*)(lds + c.wave * 16384));
            for (int rf_ = 0; rf_ < ((DSA_REP & 32) ? 2 : 1); ++rf_) {
            u32* qctr = c.ctl + CW_Q_FOX + 128 * l + 32 * rf_;
            for (;;) {
                unsigned u = 0; if (c.lane == 0) u = atomicAdd(qctr, 1u);
                u = __builtin_amdgcn_readfirstlane(u);
                if (u >= 2048u) break;
                fox_unit(c, (int)u, PB);
            }
            }
        }
        SEAM(pb + 2);
        if (SITE(4) && IN(pb + 3)) { FRESH(); const float* ssq = (const float*)(c.ws + O_SSQ); const u16* xb = (const u16*)(c.ws + O_XB); (void)ssq; (void)xb;
#if PROBE
            if (c.tid < 8) ((LAS u64*)(lds + L_DSA_CNT + 1024))[c.tid] = 0ull;
#endif
            if (c.bid < 32) { for (int rt_ = c.bid; rt_ < 32; rt_ += (c.G < 32 ? c.G : 32)) r2_task(c, rt_ >> 2, rt_ & 3); }
            __syncthreads();
#if PROBE
            if (l == 0 && c.bid == 0 && c.tid == 0) ((u64*)(c.ctl + CW_STAMP))[24] = wall_clock64();
#endif
            if (c.tid < 64) { const float* kim = (const float*)(c.ws + T_KIM); float mk = fmaxf(fmaxf(kim[c.tid], kim[c.tid + 64]), fmaxf(kim[c.tid + 128], kim[c.tid + 192]));
#pragma unroll
                for (int o = 1; o < 64; o <<= 1) mk = fmaxf(mk, __shfl_xor(mk, o));
                if (c.tid == 0) ((LAS float*)(lds + L_DSA_CNT + 768))[0] = sqrtf(mk) * 1.02f; }
            __syncthreads();
            u32* qctr = c.ctl + CW_Q_DSA + 128 * l; LAS u32* ub = (LAS u32*)(lds + L_DSA_CNT + 512);
            for (;;) {
                if (c.tid == 0) ub[0] = atomicAdd(qctr, 1u);
                __syncthreads();
                const unsigned u = ub[0];
                __syncthreads();
                if (u >= 1024u) break;
                dsa_unit(c, 1023 - (int)u);
            }
#if PROBE
            if (l == 0 && c.bid == 100 && c.tid == 0) { u64* st = (u64*)(c.ctl + CW_STAMP); st[25] = wall_clock64(); for (int k = 0; k < 5; ++k) st[26 + k] = ((LAS u64*)(lds + L_DSA_CNT + 1024))[k]; }
#endif
        }
        SEAM(pb + 3);
        if (SITE(5) && IN(pb + 4)) { FRESH(); for (int task = c.gw; task < 2048; task += c.ngw) r3_task(c, ap, l, task); }
        SEAM(pb + 4);
        if (SITE(6) && IN(pb + 5)) { FRESH(); const float* ssq = (const float*)(c.ws + O_SSQ); const u16* xb = (const u16*)(c.ws + O_XB); (void)ssq; (void)xb;
            if (l == 0) {
                LAS float* scr = (LAS float*)(lds + c.wave * 16640);
                int it0 = convert_seg<1>(ap->in[I_FWG], ap->in[I_FWU], ap->in[I_GFFN], (u16*)(c.ws + T_FFNW), D, FFD, 2 * FFD, 0, scr, c.gw, c.ngw, c.lane);
                (void)convert_seg<0>(ap->in[I_FWD], nullptr, nullptr, (u16*)(c.ws + T_FFNWD), FFD, D, 1024, it0, scr, c.gw, c.ngw, c.lane);
                __syncthreads();
            }
            const u16* wgt = (const u16*)(c.ws + O_WGT) + (size_t)l * 3072 * D; const u16* ow = (const u16*)(c.ws + O_OUTW + l * OUTW_L);
            u16* gt = (u16*)(c.ws + T_GT); float* mgf = (float*)(c.ws + T_MGF); const float* bg = ap->in[I_BGATE] + l * 3072;
            pg8::StaticOrder so; so.init(S, D, c.G, c.bid);
            { pg8::Gemm g{xb, wgt, D, D}; EpiGate e{ssq, bg, gt}; pg8::gemm_phase(lds, g, so, e); }
            { pg8::Gemm g{(const u16*)(c.ws + T_OF), ow, 256, 256}; EpiProj<0> e{gt, mgf}; pg8::gemm_phase(lds, g, so, e); }
            { pg8::Gemm g{xb, wgt + (size_t)1024 * D, D, D}; EpiGate e{ssq, bg + 1024, gt}; pg8::gemm_phase(lds, g, so, e); }
            { pg8::Gemm g{(const u16*)(c.ws + T_OD), ow + 1024 * 256, 512, 512}; EpiProj<1> e{gt, mgf}; pg8::gemm_phase(lds, g, so, e); }
            { pg8::Gemm g{xb, wgt + (size_t)2048 * D, D, D}; EpiGate e{ssq, bg + 2048, gt}; pg8::gemm_phase(lds, g, so, e); }
            { pg8::Gemm g{(const u16*)(c.ws + T_OR), ow + 1024 * 256 + 1024 * 512, 512, 512}; EpiProj<2> e{gt, mgf}; pg8::gemm_phase(lds, g, so, e); }
        }
        SEAM(pb + 5);
        if (SITE(7) && IN(pb + 6)) { FRESH(); const float* ssq = (const float*)(c.ws + O_SSQ); const u16* xb = (const u16*)(c.ws + O_XB); (void)ssq; (void)xb;
            const u16* ow = (const u16*)(c.ws + O_OUTW + l * OUTW_L);
            pg8::Gemm g{(const u16*)(c.ws + T_GT), ow + 1024 * 256 + 2 * 1024 * 512, D, D}; pg8::StaticOrder so; so.init(S, D, c.G, c.bid);
            EpiResid e{(float*)(c.ws + O_XR), (u16*)(c.ws + O_XB), (float*)(c.ws + O_SSQ)};
            pg8::gemm_phase(lds, g, so, e);
        }
        SEAM(pb + 6);
        if (l == 0) {
            if (SITE(8) && IN(pb + 7)) { FRESH(); const float* ssq = (const float*)(c.ws + O_SSQ); const u16* xb = (const u16*)(c.ws + O_XB); (void)ssq; (void)xb;
                pg8::Gemm g{xb, (const u16*)(c.ws + T_FFNW), D, D}; pg8::StaticOrder so; so.init(S, 2 * FFD, c.G, c.bid);
                EpiSwiglu e{ssq, nullptr, (u16*)(c.ws + T_ACT), FFD, 0};
                pg8::gemm_phase(lds, g, so, e);
            }
            SEAM(pb + 7);
            if (SITE(9) && IN(pb + 8)) { FRESH(); const float* ssq = (const float*)(c.ws + O_SSQ); const u16* xb = (const u16*)(c.ws + O_XB); (void)ssq; (void)xb;
                pg8::Gemm g{(const u16*)(c.ws + T_ACT), (const u16*)(c.ws + T_FFNWD), FFD, FFD}; pg8::StaticOrder so; so.init(S, D, c.G, c.bid);
                EpiResid e{(float*)(c.ws + O_XR), (u16*)(c.ws + O_XB), (float*)(c.ws + O_SSQ)};
                pg8::gemm_phase(lds, g, so, e);
            }
            SEAM(pb + 8);
        } else {
            if (SITE(10) && IN(pb + 7)) { FRESH();
                for (int rq_ = 0; rq_ < ((DSA_REP & 64) ? 2 : 1); ++rq_) phase_route(c, ap);
                __syncthreads();
                LAS float* scr = (LAS float*)(lds + c.wave * 16640); int it0 = 0;
                for (int e = 0; e < NEXP; ++e) {
                    it0 = convert_seg<1>(ap->in[I_MWG] + (size_t)e * D * FFE, ap->in[I_MWU] + (size_t)e * D * FFE, ap->in[I_GFFN] + D, (u16*)(c.ws + M_WGU) + (size_t)e * 2 * FFE * D, D, FFE, 2 * FFE, it0, scr, c.gw, c.ngw, c.lane);
                    it0 = convert_seg<0>(ap->in[I_MWD] + (size_t)e * FFE * D, nullptr, nullptr, (u16*)(c.ws + M_WD) + (size_t)e * D * FFE, FFE, D, 1024, it0, scr, c.gw, c.ngw, c.lane);
                }
            }
            SEAM(pb + 7);
            if (SITE(11) && IN(pb + 8)) { FRESH(); for (int rq_ = 0; rq_ < ((DSA_REP & 128) ? 2 : 1); ++rq_) { phase_sort(c); __syncthreads(); } }
            SEAM(pb + 8);
            for (int half = 0; half < 3; ++half) {
                if (!(IN(pb + 9 + 2 * half) || IN(pb + 10 + 2 * half))) continue;
                FRESH();
                LAS int* ebase = (LAS int*)(lds + 135168); LAS int* pexp = ebase + 64;
                moe_tables(c, ebase, pexp);
                const int npanel = ebase[8] >> 8;
                const int p0 = min(64 * half, npanel), np = ((half == 2) ? npanel : min(64 * (half + 1), npanel)) - p0;
                if (SITE(12) && IN(pb + 9 + 2 * half)) {
                    pg8::Gemm g{(const u16*)(c.ws + M_XS), (const u16*)(c.ws + M_WGU), D, D};
                    pg8::MoeOrder mo{p0, np, 28, c.G, c.bid, 28, pexp, 1};
                    EpiSwiglu e{nullptr, (const float*)(c.ws + M_RS), (u16*)(c.ws + M_ACT), FFE, p0 * 256};
                    pg8::gemm_phase(lds, g, mo, e);
                }
                SEAM(pb + 9 + 2 * half);
                if (SITE(13) && IN(pb + 10 + 2 * half)) {
                    const int nks = (half == 2) ? 4 : 1;
                    pg8::Gemm g{(const u16*)(c.ws + M_ACT) - (size_t)p0 * 256 * FFE, (const u16*)(c.ws + M_WD), FFE / nks, FFE};
                    pg8::MoeOrder mo{p0, np, 4, c.G, c.bid, 4, pexp, nks};
                    EpiMoeDown e{(const float*)(c.ws + M_RG), (u16*)(c.ws + M_XS), (u16*)(c.ws + M_YS2)};
                    pg8::gemm_phase(lds, g, mo, e);
                }
                SEAM(pb + 10 + 2 * half);
            }
#if PROBE
            xcd_barrier(bar);
#endif
            if (SITE(14) && IN(pb + 15)) { FRESH(); phase_final(c, ap); }
        }
    }

__global__ void __launch_bounds__(NTHR, 2) mk_fwd(Args a) {
    LAS unsigned char* lds0 = (LAS unsigned char*)lds_raw; u32* ctl0 = (u32*)(a.ws + O_CTL);
    volatile LAS unsigned* MISC = (volatile LAS unsigned*)(lds0 + LDS_MISC);
    if (threadIdx.x < 64) MISC[threadIdx.x] = 0u;
    __syncthreads();
    XcdBarrier bar; bar.bar = ctl0 + CW_BAR; bar.x = 0; bar.st = nullptr;
#if !MK_PER_PHASE
    bar = xcd_barrier_post(ctl0 + CW_BAR, MISC);
#endif
    const int lo = a.ph_lo, hi = a.ph_hi;
#if PROBE
    if (blockIdx.x == 0 && threadIdx.x == 0) ((u64*)(ctl0 + CW_STAMP))[0] = wall_clock64();
#endif
    if (SITE(0) && IN(0)) { FRESH(); phase_prologue(c, ap); }
    SEAM(0);
    layer_body<0>(lo, hi, bar);
    layer_body<1>(lo, hi, bar);
#undef IN
#undef SEAM
}

extern "C" void kernel_launch(void* const* d_in, const int* in_sizes, int n_in, void* d_out, int out_size, void* d_ws, size_t ws_size, hipStream_t stream) {
    static int grid = 0;
    if (grid == 0) {
        if (n_in != 37 || ws_size < WS_NEED) { fprintf(stderr, "kernel_launch: n_in %d ws %zu need %zu\n", n_in, ws_size, (size_t)WS_NEED); grid = -1; return; }
        int dev = 0, cus = 0, per_cu = 0;
        hipGetDevice(&dev); hipDeviceGetAttribute(&cus, hipDeviceAttributeMultiprocessorCount, dev);
        hipFuncSetAttribute((const void*)mk_fwd, hipFuncAttributeMaxDynamicSharedMemorySize, LDS_BYTES);
        hipOccupancyMaxActiveBlocksPerMultiprocessor(&per_cu, (const void*)mk_fwd, NTHR, LDS_BYTES);
        (void)hipGetLastError();
        grid = cus > 0 ? cus : 256;
        if (per_cu < 1) fprintf(stderr, "kernel_launch: occupancy query says %d\n", per_cu);
    }
    if (grid < 0) return;
    hipMemsetAsync((char*)d_ws + O_CTL, 0, 131072, stream);
    Args a{};
    for (int i = 0; i < 37; ++i) a.in[i] = (const float*)d_in[i];
    a.out = (float*)d_out; a.ws = (unsigned char*)d_ws;
#if MK_PER_PHASE
    for (int i = 0; i < NPHASE_IDS; ++i) { a.ph_lo = i; a.ph_hi = i + 1; hipLaunchKernelGGL(mk_fwd, dim3(grid), dim3(NTHR), LDS_BYTES, stream, a); }
#else
    a.ph_lo = 0; a.ph_hi = NPHASE_IDS; hipLaunchKernelGGL(mk_fwd, dim3(grid), dim3(NTHR), LDS_BYTES, stream, a);
#endif
}
```

```cpp
#include <hip/hip_runtime.h>
#include <stdint.h>
#include <stdio.h>

#ifndef MK_PER_PHASE
#define MK_PER_PHASE 0
#endif

#ifndef PHMASK
#define PHMASK 0xFFFFFFu
#endif
#define SITE(k) (((PHMASK) >> (k)) & 1u)
#ifndef PROBE
#define PROBE 0
#endif
#ifndef DSA_REP
#define DSA_REP 0
#endif
#define PA0 17
#define PA1 19
#define PB0 4
#define PB1 5
#define PQ 100.0f
#define LAS __attribute__((address_space(3)))
typedef unsigned short u16;
typedef unsigned int u32;
typedef unsigned long long u64;
typedef short bf16x8 __attribute__((ext_vector_type(8)));
typedef _Float16 f16x8 __attribute__((ext_vector_type(8)));
typedef float f32x4 __attribute__((ext_vector_type(4)));
typedef float f32x2 __attribute__((ext_vector_type(2)));
typedef unsigned u32x4 __attribute__((ext_vector_type(4)));
typedef unsigned u32x2 __attribute__((ext_vector_type(2)));
typedef __bf16 bf16x2_t __attribute__((ext_vector_type(2)));

constexpr int S = 16384, D = 1024;
constexpr int DIN = 6316;
constexpr float RMS_EPS = 1e-6f;
constexpr float LOG2E = 1.4426950408889634f;
constexpr float C2 = 0.125f * LOG2E;
constexpr int NW1 = 3584;
constexpr int FFD = 2816, FFE = 3584, NEXP = 8;
constexpr int MOE_ROWS = 2 * S + NEXP * 256;
constexpr int NWAVES = 8, NTHR = 512;

constexpr size_t MB = 1u << 20;
constexpr size_t O_CTL = 0;
constexpr size_t CTL_BYTES = 2 * MB;
constexpr size_t O_XR = O_CTL + CTL_BYTES;
constexpr size_t O_SSQ = O_XR + (size_t)S * D * 4;
constexpr size_t O_XB = O_SSQ + (size_t)S * 16 * 4;
constexpr size_t O_M = O_XB + (size_t)S * D * 2;
constexpr size_t O_VFIRST = O_M;
constexpr size_t O_W1 = O_VFIRST + (size_t)S * 512 * 2;
constexpr size_t O_WGT = O_W1 + (size_t)2 * NW1 * D * 2;
constexpr size_t OUTW_L = (size_t)(256 + 512 + 512 + 1024) * 1024 * 2;
constexpr size_t O_OUTW = O_WGT + (size_t)2 * 3072 * D * 2;
constexpr size_t O_WL = O_OUTW + 2 * OUTW_L;
constexpr size_t WL_L = (size_t)512 * 320 * 2;
constexpr size_t O_T = O_WL + 2 * WL_L;
constexpr size_t T_QKVF = O_T;
constexpr size_t T_QL = T_QKVF + (size_t)S * 768 * 2;
constexpr size_t T_FL = T_QL + (size_t)S * 512 * 2;
constexpr size_t T_FB = T_FL + (size_t)4 * S * 4;
constexpr size_t T_QKM = T_FB + 4096;
constexpr size_t T_KIM = T_QKM + 8192;
constexpr size_t T_VT = T_KIM + 1024;
constexpr size_t T_CKV = T_VT + (size_t)256 * S * 2;
constexpr size_t T_QI = T_CKV + (size_t)S * 128 * 2;
constexpr size_t T_KI = T_QI + (size_t)S * 288 * 2;
constexpr size_t T_SG = T_KI + (size_t)S * 32 * 2;
constexpr size_t T_BC = T_SG + (size_t)S * 4;
constexpr size_t T_OF = T_BC + (size_t)S * 8 * 4;
constexpr size_t T_OD = T_OF + (size_t)S * 256 * 2;
constexpr size_t T_OR = T_OD + (size_t)S * 512 * 2;
constexpr size_t T_RW = T_OR + (size_t)S * 512 * 2;
constexpr size_t T_RKK = T_RW + (size_t)S * 512 * 4;
constexpr size_t T_RB = T_RKK + (size_t)S * 512 * 2;
constexpr size_t T_RK = T_RB + (size_t)S * 512 * 2;
constexpr size_t T_RR = T_RK + (size_t)S * 512 * 2;
constexpr size_t T_RV = T_RR + (size_t)S * 512 * 2;
constexpr size_t T_RG = T_RV + (size_t)S * 512 * 2;
constexpr size_t T_U1 = T_RG + (size_t)S * 512 * 2;
constexpr size_t T_T56 = T_U1;
constexpr size_t T_PR = T_T56 + (size_t)S * 512 * 4;
constexpr size_t T_YL = T_U1;
constexpr size_t T_RT = T_YL + (size_t)S * 512 * 4;
constexpr size_t T_PC = T_RT + (size_t)S * 512 * 2;
constexpr size_t T_UC = T_PC + (size_t)2048 * 4096 * 4;
constexpr size_t T_U1_END = T_UC + (size_t)2048 * 4096 * 4;
constexpr size_t T_GT = T_U1;
constexpr size_t T_MGF = T_GT + (size_t)S * D * 2;
static_assert(T_MGF + (size_t)S * D * 4 <= T_U1_END, "outproj overlay");
static_assert(T_PR + (size_t)S * 1792 * 2 <= T_U1_END, "g1 overlay");
constexpr size_t T_DSB = T_RW;
static_assert((size_t)256 * 16 * 16384 <= (size_t)S * 512 * (4 + 2 + 2 + 2 + 2), "dsa bin scratch");
constexpr size_t T_FFNW = T_RW;
constexpr size_t T_FFNWD = T_FFNW + (size_t)2 * FFD * D * 2;
static_assert(T_FFNWD + (size_t)D * FFD * 2 <= T_RKK, "ffn weights overlay");
constexpr size_t T_ACT = T_RKK;
static_assert(T_ACT + (size_t)S * FFD * 2 <= T_U1, "ffn act overlay");
constexpr size_t M_WGU = O_M;
constexpr size_t M_WD = M_WGU + (size_t)NEXP * 2 * FFE * D * 2;
constexpr size_t M_XS = M_WD + (size_t)NEXP * D * FFE * 2;
constexpr size_t M_ACT = M_XS + (size_t)MOE_ROWS * D * 2;
constexpr int MOE_HALF_ROWS = MOE_ROWS / 2 + 256;
constexpr int YS2_ROWS = 2304;
constexpr size_t M_YS2 = M_ACT + (size_t)32 * MB;
static_assert((size_t)YS2_ROWS * FFE * 2 <= (size_t)32 * MB && (size_t)32 * MB + (size_t)3 * YS2_ROWS * D * 2 <= (size_t)MOE_HALF_ROWS * FFE * 2, "ys2 overlay");
constexpr size_t M_RS = M_ACT + (size_t)MOE_HALF_ROWS * FFE * 2;
constexpr size_t M_RG = M_RS + (size_t)MOE_ROWS * 4;
constexpr size_t M_TOKROW = M_RG + (size_t)MOE_ROWS * 4;
constexpr size_t M_TOPE = M_TOKROW + (size_t)S * 2 * 4;
constexpr size_t M_TOPG = M_TOPE + (size_t)S * 2 * 4;
constexpr size_t M_CNT = M_TOPG + (size_t)S * 2 * 4;
constexpr size_t M_END = M_CNT + 256 * 8 * 4;
constexpr size_t WS_NEED = (T_U1_END > M_END ? T_U1_END : M_END);

constexpr int CW_BAR = 1024;
constexpr int CW_Q_FOX = 8192;
constexpr int CW_Q_DSA = 8192 + 64;
constexpr int CW_STAMP = 16384;

constexpr int LDS_MISC = 147456 - 256;
constexpr int LDS_BYTES = 147456;

__device__ __forceinline__ unsigned pk_bf16(float lo, float hi) { f32x2 v = {lo, hi}; bf16x2_t b = __builtin_convertvector(v, bf16x2_t); return __builtin_bit_cast(unsigned, b); }
__device__ __forceinline__ float bf2f(u16 b) { return __uint_as_float(((unsigned)b) << 16); }
__device__ __forceinline__ float bflo(unsigned w) { return __uint_as_float(w << 16); }
__device__ __forceinline__ float bfhi(unsigned w) { return __uint_as_float(w & 0xffff0000u); }
__device__ __forceinline__ u16 f2bf(float f) { return (u16)(pk_bf16(f, 0.f) & 0xffffu); }
__device__ __forceinline__ float wave_sum(float v) {
#pragma unroll
    for (int o = 1; o < 64; o <<= 1) v += __shfl_xor(v, o);
    return v;
}
__device__ __forceinline__ unsigned lds_addu(LAS unsigned* p, unsigned v) { return __hip_atomic_fetch_add(p, v, __ATOMIC_RELAXED, __HIP_MEMORY_SCOPE_WORKGROUP); }
__device__ __forceinline__ void lds_oru(LAS unsigned* p, unsigned v) { (void)__hip_atomic_fetch_or(p, v, __ATOMIC_RELAXED, __HIP_MEMORY_SCOPE_WORKGROUP); }
__device__ __forceinline__ int lds_addi(LAS int* p, int v) { return __hip_atomic_fetch_add(p, v, __ATOMIC_RELAXED, __HIP_MEMORY_SCOPE_WORKGROUP); }
__device__ __forceinline__ float sigmoidf_(float x) { return 1.0f / (1.0f + __expf(-x)); }
__device__ __forceinline__ float row_rstd(const float* ssq, int row) {
    const f32x4* p = (const f32x4*)(ssq + (size_t)row * 16);
    const f32x4 a = p[0], b = p[1], c = p[2], d = p[3];
    const float s = ((a.x + a.y) + (a.z + a.w)) + ((b.x + b.y) + (b.z + b.w)) + ((c.x + c.y) + (c.z + c.w)) + ((d.x + d.y) + (d.z + d.w));
    return 1.0f / sqrtf(s * (1.0f / D) + RMS_EPS);
}

#define XB_TMO      128
#define XB_XCNT(j)  (256  + 64 * (j))
#define XB_XSUB(j)  (1280 + 64 * (j))
#define XB_XGEN(j)  (2304 + 64 * (j))
#define XB_TOP      3328
#define XB_TOPGEN   3392
#define XCD_BAR_WORDS 3456
#define XB_SPIN_CAP (1u << 22)
__device__ __forceinline__ unsigned xb_ld(unsigned* p)              { return __hip_atomic_load(p, __ATOMIC_RELAXED, __HIP_MEMORY_SCOPE_AGENT); }
__device__ __forceinline__ unsigned xb_add(unsigned* p, unsigned v) { return __hip_atomic_fetch_add(p, v, __ATOMIC_RELAXED, __HIP_MEMORY_SCOPE_AGENT); }
__device__ __forceinline__ unsigned xb_xcc_id() { return (unsigned)__builtin_amdgcn_s_getreg((3 << 11) | 20) & 0xFu; }
#define XB_SPIN(cond, bar) do { unsigned _sp = 0; while (cond) { __builtin_amdgcn_s_sleep(1); \
    if ((++_sp & 255u) == 0u) { if (xb_ld(&(bar)[XB_TMO])) break; if (_sp > XB_SPIN_CAP) { atomicAdd(&(bar)[XB_TMO], 1u); break; } } } } while (0)
struct XcdBarrier { unsigned* bar; unsigned x; volatile LAS unsigned* st; };
__device__ __forceinline__ XcdBarrier xcd_barrier_post(unsigned* bar, volatile LAS unsigned* st) {
    XcdBarrier b; b.bar = bar; b.x = xb_xcc_id(); b.st = st;
    if (threadIdx.x == 0) (void)xb_add(&bar[XB_XCNT(b.x)], 1u);
    return b;
}
__device__ __forceinline__ void xcd_barrier_complete(unsigned* bar, unsigned x, unsigned& nloc, unsigned& nx) {
    const unsigned G = gridDim.x * gridDim.y * gridDim.z;
    unsigned sum, cnt, mine, sp = 0u;
    for (;;) {
        sum = 0u; cnt = 0u; mine = 0u;
#pragma unroll
        for (unsigned j = 0; j < 16; ++j) { const unsigned c = xb_ld(&bar[XB_XCNT(j)]); sum += c; cnt += (c > 0u) ? 1u : 0u; mine = (j == x) ? c : mine; }
        if (sum == G) break;
        __builtin_amdgcn_s_sleep(1);
        if ((++sp & 255u) == 0u) { if (xb_ld(&bar[XB_TMO])) break; if (sp > XB_SPIN_CAP) { atomicAdd(&bar[XB_TMO], 1u); break; } }
    }
    nloc = mine > 0u ? mine : 1u; nx = cnt > 0u ? cnt : 1u;
}
__device__ __forceinline__ void xcd_barrier(const XcdBarrier& b) {
    asm volatile("s_waitcnt vmcnt(0)" ::: "memory");
    __syncthreads();
    if (threadIdx.x == 0) {
        unsigned* bar = b.bar;
        __builtin_amdgcn_s_waitcnt(0);
        unsigned nloc = b.st[0], nx = b.st[1];
        if (nloc == 0u) { xcd_barrier_complete(bar, b.x, nloc, nx); b.st[0] = nloc; b.st[1] = nx; }
        const unsigned old = xb_add(&bar[XB_XSUB(b.x)], 1u);
        const unsigned gen = old / nloc;
        if (old + 1u == (gen + 1u) * nloc) {
            __builtin_amdgcn_fence(__ATOMIC_RELEASE, "agent");
            asm volatile("s_waitcnt vmcnt(0)" ::: "memory");
            const unsigned og = xb_add(&bar[XB_TOP], 1u);
            const unsigned tg = og / nx;
            if (og + 1u == (tg + 1u) * nx) xb_add(&bar[XB_TOPGEN], 1u);
            else XB_SPIN(xb_ld(&bar[XB_TOPGEN]) == tg, bar);
            __builtin_amdgcn_fence(__ATOMIC_ACQUIRE, "agent");
            xb_add(&bar[XB_XGEN(b.x)], 1u);
            asm volatile("s_waitcnt vmcnt(0)" ::: "memory");
        } else {
            XB_SPIN(xb_ld(&bar[XB_XGEN(b.x)]) == gen, bar);
            __builtin_amdgcn_fence(__ATOMIC_ACQUIRE, "agent");
            asm volatile("s_waitcnt vmcnt(0)" ::: "memory");
        }
    }
    __syncthreads();
}

namespace pg8 {
constexpr int BM = 256, BK = 64, HALF = 128, HTB = HALF * BK * 2, STAGE_BYTES = 8 * HTB, NXCD = 8, WGM = 8;
__host__ __device__ __forceinline__ int lds_byte(int r, int c) { const int st = (r >> 4) * 2 + (c >> 5), rr = r & 15, cc = c & 31, ob = rr * 64 + cc * 2; return st * 1024 + (ob ^ (((ob >> 9) & 1) << 5)); }
__host__ __device__ __forceinline__ void stage_rc(int b, int& R, int& C) { const int st = b / 1024, sb = b % 1024, swz = sb ^ (((sb >> 9) & 1) << 5); R = (st >> 1) * 16 + swz / 64; C = (st & 1) * 32 + (swz % 64) / 2; }
__host__ __device__ __forceinline__ int perm32(int rho) { const int n = rho >> 4, i = rho & 15; return 8 * (i >> 2) + 4 * n + (i & 3); }
struct Unit { int pm, pn, cn, ks; };
struct Gemm { const u16* A; const u16* Bt; int K; int ld; };
struct StaticOrder {
    int nM, nN, nwg, G, c;
    __device__ void init(int M, int N, int G_, int c_) { nM = M / BM; nN = N / BM; nwg = nM * nN; G = G_; c = c_; }
    __device__ bool next(int i, Unit& u) const {
        const long L = (long)i * G + c; if (L >= nwg) return false;
        int wgid = (int)L; { const int q = nwg / NXCD, r = nwg % NXCD, xcd = wgid % NXCD, off = wgid / NXCD; wgid = (xcd < r ? xcd * (q + 1) : r * (q + 1) + (xcd - r) * q) + off; }
        const int nig = WGM * nN, gid = wgid / nig, fm = gid * WGM, gsz = (nM - fm) < WGM ? (nM - fm) : WGM;
        u.pm = fm + ((wgid % nig) % gsz); u.pn = (wgid % nig) / gsz; u.cn = u.pn; u.ks = 0; return true;
    }
};
struct MoeOrder {
    int p0, np, ncol, G, c, browtiles; const LAS int* pexp; int nks;
    __device__ bool next(int i, Unit& u) const {
        const long L = (long)i * G + c; if (L >= (long)np * ncol * nks) return false;
        const int per = np * nks; const int cn = (int)(L / per), rem = (int)(L % per), p = p0 + rem / nks;
        u.pm = p; u.cn = cn; u.pn = pexp[p] * browtiles + cn; u.ks = rem % nks; return true;
    }
};

template <class Epi, class Sched>
__device__ __forceinline__ void gemm_phase(LAS unsigned char* lds, const Gemm g, const Sched& S_, const Epi& E) {
    int tid = threadIdx.x; asm volatile("" : "+v"(tid));
    const int wid = __builtin_amdgcn_readfirstlane(tid >> 6), lane = tid & 63, wr = wid >> 2, wc = wid & 3, fr = lane & 15, fq = lane >> 4;
    int K = g.K; asm volatile("" : "+s"(K));
    const int nt = K / BK;
    int ld = g.ld; asm volatile("" : "+s"(ld));
    unsigned voffA[2], voffB[2];
#pragma unroll
    for (int i = 0; i < 2; ++i) { int R, C; stage_rc(tid * 16 + i * 8192, R, C); const int Rb = Epi::PERM ? ((R & ~31) + perm32(R & 31)) : R;
        voffA[i] = (unsigned)(R * ld + C) * 2u; voffB[i] = (unsigned)(Rb * ld + C) * 2u; }
    const size_t kstep = (size_t)(BK * 2);
    const size_t hstep = (size_t)HALF * ld * 2;
    const size_t sstep = (size_t)K * 2;
    const size_t tstep = 2 * hstep;
    const unsigned ldsw = (unsigned)wid * 1024u;
    const int aoff = lds_byte(wr * 64 + fr, fq * 8), boff = lds_byte(wc * 32 + fr, fq * 8);
#define PG8_SA(b, h) (((b) * 2 + (h)) * HTB)
#define PG8_SB(b, h) ((4 + (b) * 2 + (h)) * HTB)
#define PG8_STAGE(bufoff, gbase, voff) do { _Pragma("unroll") for (int _i = 0; _i < 2; ++_i) \
        __builtin_amdgcn_global_load_lds((const unsigned*)((const char*)(gbase) + (voff)[_i]), (LAS unsigned*)(lds + (bufoff) + ldsw + _i * 8192), 16, 0, 0); } while (0)
#define PG8_LDA(dst, b, h) do { _Pragma("unroll") for (int m = 0; m < 4; ++m) _Pragma("unroll") for (int k = 0; k < 2; ++k) dst[m][k] = *(const LAS bf16x8*)(lds + PG8_SA(b, h) + aoff + m * 2048 + k * 1024); } while (0)
#define PG8_LDB(dst, b, h) do { _Pragma("unroll") for (int n = 0; n < 2; ++n) _Pragma("unroll") for (int k = 0; k < 2; ++k) dst[n][k] = *(const LAS bf16x8*)(lds + PG8_SB(b, h) + boff + n * 2048 + k * 1024); } while (0)
#define PG8_MMA(ai, bj, At, Bt) do { __builtin_amdgcn_s_setprio(1); _Pragma("unroll") for (int m = 0; m < 4; ++m) _Pragma("unroll") for (int n = 0; n < 2; ++n) _Pragma("unroll") for (int k = 0; k < 2; ++k) \
        acc[ai][bj][m][n] = __builtin_amdgcn_mfma_f32_16x16x32_bf16(Bt[n][k], At[m][k], acc[ai][bj][m][n], 0, 0, 0); __builtin_amdgcn_s_setprio(0); } while (0)
#define PG8_WAIT_V(n) asm volatile("s_waitcnt vmcnt(" #n ")" ::: "memory")
#define PG8_WAIT_L(n) asm volatile("s_waitcnt lgkmcnt(" #n ")" ::: "memory")
#define PG8_BAR __builtin_amdgcn_s_barrier()
#define PG8_SCHED __builtin_amdgcn_sched_barrier(0)
    Unit cur, nxt; int ui = 0;
    if (!S_.next(0, cur)) return;
    f32x4 acc[2][2][4][2];
#pragma unroll
    for (int a = 0; a < 2; ++a)
#pragma unroll
        for (int b = 0; b < 2; ++b)
#pragma unroll
            for (int m = 0; m < 4; ++m)
#pragma unroll
                for (int n = 0; n < 2; ++n) acc[a][b][m][n] = (f32x4){0.f, 0.f, 0.f, 0.f};
    bf16x8 At[4][2], B0[2][2], B1[2][2];
    const char* cA = (const char*)g.A + (size_t)cur.pm * tstep + (size_t)cur.ks * sstep; const char* cB = (const char*)g.Bt + (size_t)cur.pn * tstep + (size_t)cur.ks * sstep;
    PG8_STAGE(PG8_SB(0, 0), cB, voffB); PG8_STAGE(PG8_SB(0, 1), cB + hstep, voffB); PG8_STAGE(PG8_SA(0, 0), cA, voffA); PG8_STAGE(PG8_SA(0, 1), cA + hstep, voffA);
    if (wr == 1) PG8_BAR;
    PG8_WAIT_V(2); PG8_BAR;
    PG8_STAGE(PG8_SB(1, 0), cB + kstep, voffB); PG8_STAGE(PG8_SA(1, 0), cA + kstep, voffA); PG8_STAGE(PG8_SB(1, 1), cB + hstep + kstep, voffB);
    PG8_WAIT_V(6); PG8_BAR;
    for (;;) {
        const bool has_next = S_.next(ui + 1, nxt);
        const char* nA = has_next ? (const char*)g.A + (size_t)nxt.pm * tstep + (size_t)nxt.ks * sstep : cA; const char* nB = has_next ? (const char*)g.Bt + (size_t)nxt.pn * tstep + (size_t)nxt.ks * sstep : cB;
        for (int t = 0; t < nt; t += 2) {
            const bool last = (t == nt - 2);
            const char* a1 = cA + (size_t)(t + 1) * kstep;
            const char* a2 = last ? nA : cA + (size_t)(t + 2) * kstep; const char* b2 = last ? nB : cB + (size_t)(t + 2) * kstep;
            const char* a3 = a2 + kstep; const char* b3 = b2 + kstep;
            PG8_LDB(B0, 0, 0); PG8_LDB(B1, 0, 1); PG8_SCHED; PG8_LDA(At, 0, 0); PG8_STAGE(PG8_SA(1, 1), a1 + hstep, voffA);
            PG8_WAIT_V(8); PG8_WAIT_L(0); PG8_BAR; PG8_MMA(0, 0, At, B0); PG8_MMA(0, 1, At, B1); PG8_BAR; PG8_SCHED;
            PG8_LDA(At, 0, 1); PG8_STAGE(PG8_SB(0, 0), b2, voffB); PG8_STAGE(PG8_SB(0, 1), b2 + hstep, voffB); PG8_STAGE(PG8_SA(0, 0), a2, voffA);
            PG8_WAIT_V(8); PG8_WAIT_L(0); PG8_BAR; PG8_MMA(1, 0, At, B0); PG8_MMA(1, 1, At, B1); PG8_BAR; PG8_SCHED;
            PG8_LDB(B0, 1, 0); PG8_LDB(B1, 1, 1); PG8_SCHED; PG8_LDA(At, 1, 0); PG8_STAGE(PG8_SA(0, 1), a2 + hstep, voffA);
            PG8_WAIT_V(8); PG8_WAIT_L(0); PG8_BAR; PG8_MMA(0, 0, At, B0); PG8_MMA(0, 1, At, B1); PG8_BAR; PG8_SCHED;
            PG8_LDA(At, 1, 1); PG8_STAGE(PG8_SB(1, 0), b3, voffB); PG8_STAGE(PG8_SB(1, 1), b3 + hstep, voffB); PG8_STAGE(PG8_SA(1, 0), a3, voffA);
            PG8_WAIT_V(8); PG8_WAIT_L(0); PG8_BAR; PG8_MMA(1, 0, At, B0); PG8_MMA(1, 1, At, B1); PG8_BAR; PG8_SCHED;
        }
        if (wr == 0) PG8_BAR;
        { int fr2 = fr, fq2 = fq; asm volatile("" : "+v"(fr2), "+v"(fq2)); E(acc, cur, wr, wc, fr2, fq2); }
        if (!has_next) break;
#pragma unroll
        for (int a = 0; a < 2; ++a)
#pragma unroll
            for (int b = 0; b < 2; ++b)
#pragma unroll
                for (int m = 0; m < 4; ++m)
#pragma unroll
                    for (int n = 0; n < 2; ++n) acc[a][b][m][n] = (f32x4){0.f, 0.f, 0.f, 0.f};
        cur = nxt; cA = nA; cB = nB; ++ui;
        if (wr == 1) PG8_BAR;
    }
    PG8_WAIT_V(0);
    PG8_BAR;
#undef PG8_SA
#undef PG8_SB
#undef PG8_STAGE
#undef PG8_LDA
#undef PG8_LDB
#undef PG8_MMA
#undef PG8_WAIT_V
#undef PG8_WAIT_L
#undef PG8_BAR
#undef PG8_SCHED
}
}
using pg8::Unit;
typedef f32x4 AccT[2][2][4][2];

__device__ __forceinline__ void st_bf16x8(u16* p, f32x4 v0, f32x4 v1) { u32x4 w; w.x = pk_bf16(v0[0], v0[1]); w.y = pk_bf16(v0[2], v0[3]); w.z = pk_bf16(v1[0], v1[1]); w.w = pk_bf16(v1[2], v1[3]); *(u32x4*)p = w; }
__device__ __forceinline__ void ld_bf16x8(const u16* p, f32x4& v0, f32x4& v1) { const u32x4 w = *(const u32x4*)p; v0 = (f32x4){bflo(w.x), bfhi(w.x), bflo(w.y), bfhi(w.y)}; v1 = (f32x4){bflo(w.z), bfhi(w.z), bflo(w.w), bfhi(w.w)}; }

__device__ __forceinline__ void rstd8(const float* ssq, int row0, int fq, float (&rs)[8]) {
    f32x4 p[8];
#pragma unroll
    for (int i = 0; i < 8; ++i) p[i] = *(const f32x4*)(ssq + (size_t)(row0 + (i >> 2) * 128 + (i & 3) * 16) * 16 + 4 * fq);
#pragma unroll
    for (int i = 0; i < 8; ++i) { float s = (p[i].x + p[i].y) + (p[i].z + p[i].w); s += __shfl_xor(s, 16); s += __shfl_xor(s, 32); rs[i] = 1.0f / sqrtf(s * (1.0f / D) + RMS_EPS); }
}
struct EpiG1 {
    static constexpr bool PERM = true;
    const float* ssq; u16* qkvf; u16* ql; float* t56; u16* pr;
    __device__ __forceinline__ void operator()(const AccT& acc, const Unit& u, int wr, int wc, int fr, int fq) const {
        const int row0 = u.pm * 256 + wr * 64 + fr, cn = u.cn;
        u16* ob = nullptr; float* of = nullptr; int ld, cb;
        if (cn < 3) { ob = qkvf; ld = 768; cb = cn * 256; } else if (cn < 5) { ob = ql; ld = 512; cb = (cn - 3) * 256; }
        else if (cn < 7) { of = t56; ld = 512; cb = (cn - 5) * 256; } else { ob = pr; ld = 1792; cb = (cn - 7) * 256; }
        float rs8[8]; rstd8(ssq, row0, fq, rs8);
#pragma unroll
        for (int ai = 0; ai < 2; ++ai)
#pragma unroll
            for (int m = 0; m < 4; ++m) {
                const int row = row0 + ai * 128 + m * 16; const float rs = rs8[ai * 4 + m];
#pragma unroll
                for (int bj = 0; bj < 2; ++bj) {
                    const int col = cb + bj * 128 + wc * 32 + 8 * fq;
                    const f32x4 v0 = acc[ai][bj][m][0] * rs, v1 = acc[ai][bj][m][1] * rs;
                    if (of) { float* p = of + (size_t)row * ld + col; *(f32x4*)p = v0; *(f32x4*)(p + 4) = v1; }
                    else st_bf16x8(ob + (size_t)row * ld + col, v0, v1);
                }
            }
    }
};
struct EpiGate {
    static constexpr bool PERM = true;
    const float* ssq; const float* bias; u16* gt;
    __device__ __forceinline__ void operator()(const AccT& acc, const Unit& u, int wr, int wc, int fr, int fq) const {
        const int row0 = u.pm * 256 + wr * 64 + fr;
        float rs8[8]; rstd8(ssq, row0, fq, rs8);
        f32x4 bb[2][2];
#pragma unroll
        for (int bj = 0; bj < 2; ++bj) { const int col = u.cn * 256 + bj * 128 + wc * 32 + 8 * fq; bb[bj][0] = *(const f32x4*)(bias + col); bb[bj][1] = *(const f32x4*)(bias + col + 4); }
#pragma unroll
        for (int ai = 0; ai < 2; ++ai)
#pragma unroll
            for (int m = 0; m < 4; ++m) {
                const int row = row0 + ai * 128 + m * 16; const float rs = rs8[ai * 4 + m];
#pragma unroll
                for (int bj = 0; bj < 2; ++bj) {
                    const int col = u.cn * 256 + bj * 128 + wc * 32 + 8 * fq;
                    f32x4 v0 = acc[ai][bj][m][0] * rs + bb[bj][0], v1 = acc[ai][bj][m][1] * rs + bb[bj][1];
#pragma unroll
                    for (int j = 0; j < 4; ++j) { v0[j] = sigmoidf_(v0[j]); v1[j] = sigmoidf_(v1[j]); }
                    st_bf16x8(gt + (size_t)row * D + col, v0, v1);
                }
            }
    }
};
template <int MODE> struct EpiProj {
    static constexpr bool PERM = true;
    u16* gt; float* mgf;
    __device__ __forceinline__ void operator()(const AccT& acc, const Unit& u, int wr, int wc, int fr, int fq) const {
        const int row0 = u.pm * 256 + wr * 64 + fr;
#pragma unroll
        for (int ai = 0; ai < 2; ++ai)
#pragma unroll
            for (int m2 = 0; m2 < 4; m2 += 2) {
                u32x4 gw[2][2]; f32x4 mv[2][2][2];
#pragma unroll
                for (int mm = 0; mm < 2; ++mm)
#pragma unroll
                    for (int bj = 0; bj < 2; ++bj) { const size_t o = (size_t)(row0 + ai * 128 + (m2 + mm) * 16) * D + u.cn * 256 + bj * 128 + wc * 32 + 8 * fq;
                        gw[mm][bj] = *(const u32x4*)(gt + o); if (MODE >= 1) { mv[mm][bj][0] = *(const f32x4*)(mgf + o); mv[mm][bj][1] = *(const f32x4*)(mgf + o + 4); } }
#pragma unroll
                for (int mm = 0; mm < 2; ++mm)
#pragma unroll
                    for (int bj = 0; bj < 2; ++bj) { const int m = m2 + mm; const size_t o = (size_t)(row0 + ai * 128 + m * 16) * D + u.cn * 256 + bj * 128 + wc * 32 + 8 * fq;
                        const u32x4 w = gw[mm][bj]; const f32x4 g0 = (f32x4){bflo(w.x), bfhi(w.x), bflo(w.y), bfhi(w.y)}, g1 = (f32x4){bflo(w.z), bfhi(w.z), bflo(w.w), bfhi(w.w)};
                        f32x4 v0 = acc[ai][bj][m][0] * g0, v1 = acc[ai][bj][m][1] * g1;
                        if (MODE >= 1) { v0 += mv[mm][bj][0]; v1 += mv[mm][bj][1]; }
                        if (MODE <= 1) { *(f32x4*)(mgf + o) = v0; *(f32x4*)(mgf + o + 4) = v1; }
                        else st_bf16x8(gt + o, v0, v1); }
                asm volatile("" ::: "memory");
            }
    }
};
struct EpiResid {
    static constexpr bool PERM = true;
    float* xr; u16* xb; float* ssq;
    __device__ __forceinline__ void operator()(const AccT& acc, const Unit& u, int wr, int wc, int fr, int fq) const {
        const int row0 = u.pm * 256 + wr * 64 + fr;
#pragma unroll
        for (int ai = 0; ai < 2; ++ai)
#pragma unroll
            for (int m2 = 0; m2 < 4; m2 += 2) {
                f32x4 xv[2][2][2];
#pragma unroll
                for (int mm = 0; mm < 2; ++mm)
#pragma unroll
                    for (int bj = 0; bj < 2; ++bj) { const size_t o = (size_t)(row0 + ai * 128 + (m2 + mm) * 16) * D + u.cn * 256 + bj * 128 + wc * 32 + 8 * fq; xv[mm][bj][0] = *(const f32x4*)(xr + o); xv[mm][bj][1] = *(const f32x4*)(xr + o + 4); }
#pragma unroll
                for (int mm = 0; mm < 2; ++mm) { const int m = m2 + mm; const int row = row0 + ai * 128 + m * 16; float sq = 0.f;
#pragma unroll
                    for (int bj = 0; bj < 2; ++bj) { const size_t o = (size_t)row * D + u.cn * 256 + bj * 128 + wc * 32 + 8 * fq;
                        const f32x4 v0 = acc[ai][bj][m][0] + xv[mm][bj][0], v1 = acc[ai][bj][m][1] + xv[mm][bj][1];
                        *(f32x4*)(xr + o) = v0; *(f32x4*)(xr + o + 4) = v1;
                        st_bf16x8(xb + o, v0, v1);
                        sq += (v0[0] * v0[0] + v0[1] * v0[1]) + (v0[2] * v0[2] + v0[3] * v0[3]) + (v1[0] * v1[0] + v1[1] * v1[1]) + (v1[2] * v1[2] + v1[3] * v1[3]); }
                    sq += __shfl_xor(sq, 16); sq += __shfl_xor(sq, 32);
                    if (fq == 0) ssq[(size_t)row * 16 + u.cn * 4 + wc] = sq; }
                asm volatile("" ::: "memory");
            }
    }
};
struct EpiSwiglu {
    static constexpr bool PERM = true;
    const float* ssq; const float* rsrow; u16* act; int ld; int row_base;
    __device__ __forceinline__ void operator()(const AccT& acc, const Unit& u, int wr, int wc, int fr, int fq) const {
        const int row0 = u.pm * 256 + wr * 64 + fr;
        float rs8[8];
        if (rsrow) {
#pragma unroll
            for (int i = 0; i < 8; ++i) rs8[i] = rsrow[row0 + (i >> 2) * 128 + (i & 3) * 16];
        } else rstd8(ssq, row0, fq, rs8);
#pragma unroll
        for (int ai = 0; ai < 2; ++ai)
#pragma unroll
            for (int m = 0; m < 4; ++m) {
                const int row = row0 + ai * 128 + m * 16; const float rs = rs8[ai * 4 + m];
                f32x4 o[2];
#pragma unroll
                for (int n = 0; n < 2; ++n)
#pragma unroll
                    for (int j = 0; j < 4; ++j) { const float gv = acc[ai][0][m][n][j] * rs, uv = acc[ai][1][m][n][j] * rs; o[n][j] = gv * sigmoidf_(gv) * uv; }
                st_bf16x8(act + (size_t)(row - row_base) * ld + u.cn * 128 + wc * 32 + 8 * fq, o[0], o[1]);
            }
    }
};
struct EpiMoeDown {
    static constexpr bool PERM = true;
    const float* rg; u16* ys; u16* ys2;
    __device__ __forceinline__ void operator()(const AccT& acc, const Unit& u, int wr, int wc, int fr, int fq) const {
        const int row0 = u.pm * 256 + wr * 64 + fr;
        u16* const yb = (u.ks == 0) ? ys : ys2 + ((long)(u.ks - 1) * YS2_ROWS - 32768L) * (long)D;
        float g8[8];
#pragma unroll
        for (int i = 0; i < 8; ++i) g8[i] = rg[row0 + (i >> 2) * 128 + (i & 3) * 16];
#pragma unroll
        for (int ai = 0; ai < 2; ++ai)
#pragma unroll
            for (int m = 0; m < 4; ++m) {
                const int row = row0 + ai * 128 + m * 16; const float gsc = g8[ai * 4 + m];
#pragma unroll
                for (int bj = 0; bj < 2; ++bj) {
                    const int col = u.cn * 256 + bj * 128 + wc * 32 + 8 * fq;
                    st_bf16x8(yb + (size_t)row * D + col, acc[ai][bj][m][0] * gsc, acc[ai][bj][m][1] * gsc);
                }
            }
    }
};

struct Args {
    const float* in[37];
    float* out; unsigned char* ws;
    int ph_lo, ph_hi;
};
typedef const __attribute__((address_space(4))) Args* CArgsP;
enum { I_X = 0, I_WIN, I_BGATE, I_GMIX, I_FBIAS, I_KVNORM, I_WUK, I_WUV, I_MU, I_W0, I_WUP, I_A0, I_AUP, I_GUP, I_KK, I_KA, I_RK, I_LNG, I_LNB,
       I_VDOWN, I_VMU, I_VUP, I_VV0, I_PFOX, I_PDSA, I_PRWKV, I_WOUT, I_GFFN, I_FWG, I_FWU, I_FWD, I_RTW, I_RTB, I_MWG, I_MWU, I_MWD, I_GFINAL };

struct Seg { const float* src; const float* src2; const float* gk; const float* aux; u16* dst; int kind, K, ld, col0, nrows, row0, item0; float scale; };
constexpr int MAXSEG = 48;
__device__ __forceinline__ void seg_set(LAS Seg* s, int& n, int& items, int kind, const float* src, const float* src2, const float* gk, const float* aux, u16* dst, int K, int ld, int col0, int nrows, int row0, float scale) {
    LAS Seg& g = s[n]; g.src = src; g.src2 = src2; g.gk = gk; g.aux = aux; g.dst = dst; g.kind = kind; g.K = K; g.ld = ld; g.col0 = col0; g.nrows = nrows; g.row0 = row0; g.item0 = items; g.scale = scale;
    items += (K / ((kind == 2 || kind == 3) ? 16 : 64)) * ((nrows + 31) / 32); ++n;
}
struct SegR { const float* src; const float* gk; const float* aux; int kind, ld, col0, nrows; float scale; };
__device__ __forceinline__ float seg_val(const SegR& g, int k, int n) {
    if (n >= g.nrows) return 0.f;
    switch (g.kind) {
    case 0: { float v = g.src[(size_t)k * g.ld + g.col0 + n] * g.scale; if (g.gk) v *= g.gk[k]; return v; }
    case 5: { return k < 32 ? g.src[(size_t)k * g.ld + n] : 0.f; }
    case 2: { const int h = n >> 7, r = n & 127; float s = 0.f; const float* sp = g.src + (size_t)k * g.ld + g.col0 + h * 64; const float* ap = g.aux + (size_t)h * 64 * 128 + r;
#pragma unroll 8
              for (int d = 0; d < 64; ++d) s += sp[d] * ap[d * 128]; return s * g.scale * g.gk[k]; }
    case 3: { const int h = k >> 7, r = k & 127; float s = 0.f; const float* ap = g.aux + (size_t)(h * 128 + r) * 64; const float* sp = g.src + (size_t)(h * 64) * g.ld + n;
#pragma unroll 8
              for (int d = 0; d < 64; ++d) s += ap[d] * sp[(size_t)d * g.ld]; return s; }
    default: return 0.f;
    }
}
__device__ __forceinline__ void convert_items(const LAS Seg* segs, int s_lo, int s_hi, int nitems, LAS float* scr, int gw, int ngw, int lane) {
    for (int it = gw; it < nitems; it += ngw) {
        int si = s_lo;
        for (int j = s_lo + 1; j < s_hi; ++j) if (segs[j].item0 <= it) si = j;
        SegR g; g.src = segs[si].src; g.gk = segs[si].gk; g.aux = segs[si].aux; g.kind = segs[si].kind; g.ld = segs[si].ld; g.col0 = segs[si].col0; g.nrows = segs[si].nrows; g.scale = segs[si].scale;
        u16* const dst = segs[si].dst; const int K = segs[si].K, row0 = segs[si].row0;
        const bool fold = (g.kind == 2 || g.kind == 3); const int KT = fold ? 16 : 64;
        const int r = it - segs[si].item0, nnb = (g.nrows + 31) / 32, kb = r / nnb, nb = r % nnb, k0 = KT * kb, n0 = 32 * nb;
        if (fold) {
#pragma unroll 2
            for (int i = 0; i < 8; ++i) { const int kk = 2 * i + (lane >> 5); scr[kk * 33 + (lane & 31)] = seg_val(g, k0 + kk, n0 + (lane & 31)); }
            asm volatile("s_waitcnt lgkmcnt(0)" ::: "memory");
            { const int n = lane >> 1, cc = lane & 1; const LAS float* s = scr + (8 * cc) * 33 + n;
              u32x4 o; o.x = pk_bf16(s[0 * 33], s[1 * 33]); o.y = pk_bf16(s[2 * 33], s[3 * 33]); o.z = pk_bf16(s[4 * 33], s[5 * 33]); o.w = pk_bf16(s[6 * 33], s[7 * 33]);
              if (n0 + n < g.nrows) *(u32x4*)(dst + (size_t)(row0 + n0 + n) * K + k0 + 8 * cc) = o; }
        } else {
        if (g.kind == 0) {
            const int n = n0 + (lane & 31); const bool ok = n < g.nrows; const float* sp = g.src + (size_t)(k0 + (lane >> 5)) * g.ld + g.col0 + (ok ? n : 0);
            const float* gp = g.gk ? g.gk + k0 + (lane >> 5) : nullptr;
#pragma unroll 16
            for (int i = 0; i < 32; ++i) { float v = sp[(size_t)(2 * i) * g.ld] * g.scale; if (gp) v *= gp[2 * i]; scr[(2 * i + (lane >> 5)) * 33 + (lane & 31)] = ok ? v : 0.f; }
        } else {
#pragma unroll 4
        for (int i = 0; i < 32; ++i) { const int kk = 2 * i + (lane >> 5); scr[kk * 33 + (lane & 31)] = seg_val(g, k0 + kk, n0 + (lane & 31)); }
        }
        asm volatile("s_waitcnt lgkmcnt(0)" ::: "memory");
        const int c = lane & 7;
#pragma unroll
        for (int j = 0; j < 4; ++j) { const int n = (lane >> 3) + 8 * j; const LAS float* s = scr + (8 * c) * 33 + n;
            u32x4 o; o.x = pk_bf16(s[0 * 33], s[1 * 33]); o.y = pk_bf16(s[2 * 33], s[3 * 33]); o.z = pk_bf16(s[4 * 33], s[5 * 33]); o.w = pk_bf16(s[6 * 33], s[7 * 33]);
            if (n0 + n < g.nrows) *(u32x4*)(dst + (size_t)(row0 + n0 + n) * K + k0 + 8 * c) = o; }
        }
        asm volatile("s_waitcnt lgkmcnt(0)" ::: "memory");
    }
}

template <int KIND>
__device__ __forceinline__ int convert_seg(const float* src, const float* src2, const float* gk, u16* dst, int K, int ld, int nrows, int item0, LAS float* scr, int gw, int ngw, int lane) {
    const int nnb = nrows / 64, nit = (K / 64) * nnb;
    int first = item0 + ((gw - item0) % ngw + ngw) % ngw;
    for (int it = first; it < item0 + nit; it += ngw) {
        const int r = it - item0, kb = r / nnb, nb = r % nnb, k0 = 64 * kb, n0 = 64 * nb;
        const float* sp;
        if (KIND == 0) sp = src + n0 + lane; else { const int within = n0 & 255, which = within >> 7, j = (n0 >> 8) * 128 + (within & 127); sp = (which ? src2 : src) + j + lane; }
#pragma unroll 8
        for (int i = 0; i < 64; ++i) { float v = sp[(size_t)(k0 + i) * ld]; if (gk) v *= gk[k0 + i]; scr[i * 65 + lane] = v; }
        asm volatile("s_waitcnt lgkmcnt(0)" ::: "memory");
        const int c = lane & 7;
#pragma unroll
        for (int j = 0; j < 8; ++j) { const int n = (lane >> 3) + 8 * j; const LAS float* s = scr + (8 * c) * 65 + n;
            u32x4 o; o.x = pk_bf16(s[0 * 65], s[1 * 65]); o.y = pk_bf16(s[2 * 65], s[3 * 65]); o.z = pk_bf16(s[4 * 65], s[5 * 65]); o.w = pk_bf16(s[6 * 65], s[7 * 65]);
            *(u32x4*)(dst + (size_t)(n0 + n) * K + k0 + 8 * c) = o; }
        asm volatile("s_waitcnt lgkmcnt(0)" ::: "memory");
    }
    return item0 + nit;
}

struct Ctx {
    LAS unsigned char* lds; unsigned char* ws; u32* ctl;
    int tid, lane, wave, gw, ngw, G, bid;
};

__device__ __forceinline__ void phase_prologue(const Ctx& c, CArgsP a) {
    LAS Seg* segs = (LAS Seg*)(c.lds + 69632);
    LAS int* nfo = (LAS int*)(c.lds + 69632 + MAXSEG * sizeof(Seg));
    if (c.tid == 0) {
        int n = 0, items = 0;
        for (int l = 0; l < 2; ++l) {
            const float* win = a->in[I_WIN] + (size_t)l * D * DIN; const float* gm = a->in[I_GMIX] + l * D;
            u16* w1 = (u16*)(c.ws + O_W1) + (size_t)l * NW1 * D;
            seg_set(segs, n, items, 0, win, nullptr, gm, nullptr, w1, D, DIN, 0, 256, 0, C2);
            seg_set(segs, n, items, 0, win, nullptr, gm, nullptr, w1, D, DIN, 256, 512, 256, 1.f);
            seg_set(segs, n, items, 2, win, nullptr, gm, a->in[I_WUK] + (size_t)l * 4 * 64 * 128, w1, D, DIN, 772, 512, 768, C2);
            seg_set(segs, n, items, 0, win, nullptr, gm, nullptr, w1, D, DIN, 1156, 256, 1280, 1.f);
            seg_set(segs, n, items, 0, win, nullptr, gm, nullptr, w1, D, DIN, 1028, 128, 1536, 1.f);
            seg_set(segs, n, items, 0, win, nullptr, gm, nullptr, w1, D, DIN, 1412, 32, 1664, 1.f);
            seg_set(segs, n, items, 0, win, nullptr, gm, nullptr, w1, D, DIN, 1444, 8, 1696, 1.f);
            seg_set(segs, n, items, 0, win, nullptr, gm, nullptr, w1, D, DIN, 768, 4, 1704, 1.f);
            if (l == 1) seg_set(segs, n, items, 0, a->in[I_VDOWN], nullptr, gm, nullptr, w1, D, 32, 0, 32, 1708, 1.f);
            else seg_set(segs, n, items, 4, nullptr, nullptr, nullptr, nullptr, w1, D, 0, 0, 32, 1708, 1.f);
            seg_set(segs, n, items, 4, nullptr, nullptr, nullptr, nullptr, w1, D, 0, 0, 52, 1740, 1.f);
            seg_set(segs, n, items, 0, win, nullptr, gm, nullptr, w1, D, DIN, 1452, 1792, 1792, 1.f);
            seg_set(segs, n, items, 0, win, nullptr, gm, nullptr, (u16*)(c.ws + O_WGT) + (size_t)l * 3072 * D, D, DIN, 3244, 3072, 0, 1.f);
            u16* ow = (u16*)(c.ws + O_OUTW + l * OUTW_L);
            seg_set(segs, n, items, 0, a->in[I_PFOX] + (size_t)l * 256 * D, nullptr, nullptr, nullptr, ow, 256, D, 0, 1024, 0, 1.f);
            seg_set(segs, n, items, 3, a->in[I_PDSA] + (size_t)l * 256 * D, nullptr, nullptr, a->in[I_WUV] + (size_t)l * 4 * 128 * 64, ow + 1024 * 256, 512, D, 0, 1024, 0, 1.f);
            seg_set(segs, n, items, 0, a->in[I_PRWKV] + (size_t)l * 512 * D, nullptr, nullptr, nullptr, ow + 1024 * 256 + 1024 * 512, 512, D, 0, 1024, 0, 1.f);
            seg_set(segs, n, items, 0, a->in[I_WOUT] + (size_t)l * D * D, nullptr, nullptr, nullptr, ow + 1024 * 256 + 2 * 1024 * 512, D, D, 0, 1024, 0, 1.f);
            u16* wl = (u16*)(c.ws + O_WL + l * WL_L);
            seg_set(segs, n, items, 0, a->in[I_WUP] + (size_t)l * 64 * 512, nullptr, nullptr, nullptr, wl, 64, 512, 0, 512, 0, 1.f);
            seg_set(segs, n, items, 0, a->in[I_AUP] + (size_t)l * 64 * 512, nullptr, nullptr, nullptr, wl + 512 * 64, 64, 512, 0, 512, 0, 1.f);
            seg_set(segs, n, items, 0, a->in[I_GUP] + (size_t)l * 128 * 512, nullptr, nullptr, nullptr, wl + 2 * 512 * 64, 128, 512, 0, 512, 0, 1.f);
            if (l == 1) seg_set(segs, n, items, 5, a->in[I_VUP], nullptr, nullptr, nullptr, wl + 2 * 512 * 64 + 512 * 128, 64, 512, 0, 512, 0, 1.f);
        }
        nfo[0] = n; nfo[1] = items;
    }
    __syncthreads();
    convert_items(segs, 0, nfo[0], nfo[1], (LAS float*)(c.lds + c.wave * 8704), c.gw, c.ngw, c.lane);
    const float* x = a->in[I_X]; float* xr = (float*)(c.ws + O_XR); u16* xb = (u16*)(c.ws + O_XB); float* ssq = (float*)(c.ws + O_SSQ);
    for (int t = c.gw; t < S; t += c.ngw) {
        const f32x4* xp = (const f32x4*)(x + (size_t)t * D) + c.lane; float s = 0.f;
#pragma unroll
        for (int j = 0; j < 4; ++j) { const f32x4 v = xp[64 * j]; s += (v.x * v.x + v.y * v.y) + (v.z * v.z + v.w * v.w);
            ((f32x4*)(xr + (size_t)t * D))[c.lane + 64 * j] = v;
            u32x2 w; w.x = pk_bf16(v.x, v.y); w.y = pk_bf16(v.z, v.w); ((u32x2*)(xb + (size_t)t * D))[c.lane + 64 * j] = w; }
        s = wave_sum(s);
        if (c.lane < 16) ssq[(size_t)t * 16 + c.lane] = (c.lane == 0) ? s : 0.f;
    }
}

__device__ __forceinline__ float log_sigmoid_(float x) { return -(fmaxf(-x, 0.f) + log1pf(__expf(-fabsf(x)))); }
__device__ __forceinline__ void phase_prep(const Ctx& c, CArgsP a, int l) {
    const u16* qkvf = (const u16*)(c.ws + T_QKVF); const float* t56 = (const float*)(c.ws + T_T56); const u16* pr = (const u16*)(c.ws + T_PR);
    float* FL = (float*)(c.ws + T_FL); float* FB = (float*)(c.ws + T_FB); u16* VT = (u16*)(c.ws + T_VT); u16* CKV = (u16*)(c.ws + T_CKV);
    _Float16* QI = (_Float16*)(c.ws + T_QI); _Float16* KI = (_Float16*)(c.ws + T_KI); u32* SG = (u32*)(c.ws + T_SG); float* BC = (float*)(c.ws + T_BC);
    float* RW = (float*)(c.ws + T_RW); _Float16* RKK = (_Float16*)(c.ws + T_RKK); _Float16* RB = (_Float16*)(c.ws + T_RB);
    u16* RK = (u16*)(c.ws + T_RK); u16* RR = (u16*)(c.ws + T_RR); u16* RV = (u16*)(c.ws + T_RV); u16* RG = (u16*)(c.ws + T_RG); u16* VF = (u16*)(c.ws + O_VFIRST);
    const float* fbias = a->in[I_FBIAS] + l * 4; const float* kvn = a->in[I_KVNORM] + l * 128;
    const float* mu = a->in[I_MU] + l * 1792; const float* w0 = a->in[I_W0] + l * 512; const float* wup = a->in[I_WUP] + (size_t)l * 64 * 512;
    const float* a0 = a->in[I_A0] + l * 512; const float* aup = a->in[I_AUP] + (size_t)l * 64 * 512; const float* gup = a->in[I_GUP] + (size_t)l * 128 * 512;
    const float* kkw = a->in[I_KK] + l * 512; const float* kaw = a->in[I_KA] + l * 512; const float* rkw = a->in[I_RK] + l * 512;
    const float* vmu = a->in[I_VMU]; const float* vup = a->in[I_VUP]; const float* vv0 = a->in[I_VV0];
    LAS float* L_lf = (LAS float*)c.lds;
    LAS u16* L_vt = (LAS u16*)(c.lds + 1024);
    LAS u16* L_xl = (LAS u16*)(c.lds + 38912);
    constexpr int XLS = 328;
    const int tid = c.tid;
    LAS float* L_cst = (LAS float*)(c.lds + 81920);
    for (int idx = tid; idx < 9 * 512; idx += NTHR) { const int v = idx >> 9, j = idx & 511;
        const float* sp = v == 0 ? w0 : v == 1 ? a0 : v == 2 ? kkw : v == 3 ? kaw : v == 4 ? rkw : v == 5 ? vv0 : v == 6 ? mu : v == 7 ? mu + 512 : mu + 1024;
        L_cst[idx] = (v == 5 && l == 0) ? 0.f : sp[j]; }
    for (int blk = c.bid; blk < S / 64; blk += c.G) {
        const int t0 = blk * 64;
        __syncthreads();
        if (tid < 256) { const int tok = tid >> 2, h = tid & 3; L_lf[tok * 4 + h] = log_sigmoid_(t56[(size_t)(t0 + tok) * 512 + 256 + 172 - 4 + h] + fbias[h]) * LOG2E; }
        for (int idx = tid; idx < 64 * 32; idx += NTHR) { const int tok = idx >> 5, c8 = (idx & 31) * 8; const u32x4 w = *(const u32x4*)(qkvf + (size_t)(t0 + tok) * 768 + 512 + c8);
            LAS u16* d = L_vt + c8 * 72 + tok;
            d[0] = (u16)w.x; d[72] = (u16)(w.x >> 16); d[144] = (u16)w.y; d[216] = (u16)(w.y >> 16); d[288] = (u16)w.z; d[360] = (u16)(w.z >> 16); d[432] = (u16)w.w; d[504] = (u16)(w.w >> 16); }
        for (int idx = tid; idx < 64 * 32; idx += NTHR) {
            const int tok = idx >> 5, c8 = (idx & 31) * 8, t = t0 + tok; const int col = 1536 + c8;
            const u32x4 wc = *(const u32x4*)(pr + (size_t)t * 1792 + col); u32x4 wp = (u32x4){0u, 0u, 0u, 0u}; if (t > 0) wp = *(const u32x4*)(pr + (size_t)(t - 1) * 1792 + col);
            const f32x4 m0 = *(const f32x4*)(mu + col), m1 = *(const f32x4*)(mu + col + 4);
            float cur[8] = {bflo(wc.x), bfhi(wc.x), bflo(wc.y), bfhi(wc.y), bflo(wc.z), bfhi(wc.z), bflo(wc.w), bfhi(wc.w)};
            float prv[8] = {bflo(wp.x), bfhi(wp.x), bflo(wp.y), bfhi(wp.y), bflo(wp.z), bfhi(wp.z), bflo(wp.w), bfhi(wp.w)};
            float mm[8] = {m0.x, m0.y, m0.z, m0.w, m1.x, m1.y, m1.z, m1.w}; float ov[8];
#pragma unroll
            for (int e = 0; e < 8; ++e) { const float xs = cur[e] + (prv[e] - cur[e]) * mm[e]; ov[e] = c8 < 64 ? tanhf(xs) : (c8 < 128 ? xs : sigmoidf_(xs)); }
            u32x4 o; o.x = pk_bf16(ov[0], ov[1]); o.y = pk_bf16(ov[2], ov[3]); o.z = pk_bf16(ov[4], ov[5]); o.w = pk_bf16(ov[6], ov[7]);
            *(LAS u32x4*)(L_xl + tok * XLS + c8) = o;
        }
        for (int idx = tid; idx < 64 * 64; idx += NTHR) {
            const int tok = idx >> 6, i = idx & 63, t = t0 + tok; float xv = 0.f;
            if (l == 1 && i < 32) { const float cur = t56[(size_t)t * 512 + 256 + 172 + i]; const float prev = t > 0 ? t56[(size_t)(t - 1) * 512 + 256 + 172 + i] : 0.f; xv = cur + (prev - cur) * vmu[i]; }
            L_xl[tok * XLS + 256 + i] = f2bf(xv);
        }
        __syncthreads();
        if (tid < 4) { float run = 0.f; for (int i = 0; i < 64; ++i) { run += L_lf[i * 4 + tid]; FL[(size_t)tid * S + t0 + i] = run; } FB[tid * 256 + blk] = run; }
        for (int idx = tid; idx < 256 * 8; idx += NTHR) { const int cc = idx >> 3, t8 = (idx & 7) * 8; *(u32x4*)(VT + (size_t)cc * S + t0 + t8) = *(const LAS u32x4*)(L_vt + cc * 72 + t8); }
        {
            LAS unsigned* L_mx = (LAS unsigned*)(c.lds + 37888);
            if (tid < 9) L_mx[tid] = 0u;
            __syncthreads();
            const int tok = tid >> 3, sub = tid & 7; const u16* qp = qkvf + (size_t)(t0 + tok) * 768 + (sub >> 2) * 256 + (sub & 3) * 64; float ss = 0.f;
#pragma unroll
            for (int i = 0; i < 8; ++i) { const u32x4 w = *(const u32x4*)(qp + 8 * i); const float e0 = bflo(w.x), e1 = bfhi(w.x), e2 = bflo(w.y), e3 = bfhi(w.y), e4 = bflo(w.z), e5 = bfhi(w.z), e6 = bflo(w.w), e7 = bfhi(w.w);
                ss += (e0 * e0 + e1 * e1) + (e2 * e2 + e3 * e3) + (e4 * e4 + e5 * e5) + (e6 * e6 + e7 * e7); }
            (void)__hip_atomic_fetch_max(L_mx + sub, __float_as_uint(ss), __ATOMIC_RELAXED, __HIP_MEMORY_SCOPE_WORKGROUP);
            { const float* kp = t56 + (size_t)(t0 + tok) * 512 + 256 + 128 + sub * 4; float ks = (kp[0] * kp[0] + kp[1] * kp[1]) + (kp[2] * kp[2] + kp[3] * kp[3]);
              ks += __shfl_xor(ks, 1); ks += __shfl_xor(ks, 2); ks += __shfl_xor(ks, 4);
              if (sub == 0) (void)__hip_atomic_fetch_max(L_mx + 8, __float_as_uint(ks), __ATOMIC_RELAXED, __HIP_MEMORY_SCOPE_WORKGROUP); }
            __syncthreads();
            if (tid < 8) ((float*)(c.ws + T_QKM))[blk * 8 + tid] = __uint_as_float(L_mx[tid]);
            if (tid == 8) ((float*)(c.ws + T_KIM))[blk] = __uint_as_float(L_mx[8]);
        }
        {
            const int tok = tid >> 3, sub = tid & 7, t = t0 + tok; const float* tp = t56 + (size_t)t * 512;
            float cv[16]; float ss = 0.f;
#pragma unroll
            for (int i = 0; i < 16; ++i) { cv[i] = tp[256 + sub * 16 + i]; ss += cv[i] * cv[i]; }
            ss += __shfl_xor(ss, 1); ss += __shfl_xor(ss, 2); ss += __shfl_xor(ss, 4);
            const float rs = 1.0f / sqrtf(ss * (1.0f / 128.f) + RMS_EPS);
            { u32x4 o0, o1; const float* kn = kvn + sub * 16;
              o0.x = pk_bf16(cv[0] * rs * kn[0], cv[1] * rs * kn[1]); o0.y = pk_bf16(cv[2] * rs * kn[2], cv[3] * rs * kn[3]); o0.z = pk_bf16(cv[4] * rs * kn[4], cv[5] * rs * kn[5]); o0.w = pk_bf16(cv[6] * rs * kn[6], cv[7] * rs * kn[7]);
              o1.x = pk_bf16(cv[8] * rs * kn[8], cv[9] * rs * kn[9]); o1.y = pk_bf16(cv[10] * rs * kn[10], cv[11] * rs * kn[11]); o1.z = pk_bf16(cv[12] * rs * kn[12], cv[13] * rs * kn[13]); o1.w = pk_bf16(cv[14] * rs * kn[14], cv[15] * rs * kn[15]);
              *(u32x4*)(CKV + (size_t)t * 128 + sub * 16) = o0; *(u32x4*)(CKV + (size_t)t * 128 + sub * 16 + 8) = o1; }
            const float wv = tp[256 + 160 + sub]; const float sc = 0.5f * 0.0625f;
            const float aw = fabsf(wv) * sc, lw = wv * sc;
            unsigned bit = (wv < 0.f) ? (1u << sub) : 0u; bit |= __shfl_xor(bit, 1); bit |= __shfl_xor(bit, 2); bit |= __shfl_xor(bit, 4);
            if (sub == 0) SG[t] = bit;
            typedef _Float16 f16x4_t __attribute__((ext_vector_type(4)));
            f16x4_t linq = {0, 0, 0, 0};
#pragma unroll
            for (int d8 = 0; d8 < 4; ++d8) {
                const f32x4 q0 = *(const f32x4*)(tp + sub * 32 + d8 * 8), q1 = *(const f32x4*)(tp + sub * 32 + d8 * 8 + 4);
                const float qv[8] = {q0.x, q0.y, q0.z, q0.w, q1.x, q1.y, q1.z, q1.w};
                f16x8 hq;
#pragma unroll
                for (int e = 0; e < 8; ++e) { hq[e] = (_Float16)(qv[e] * aw);
                    float lv = qv[e] * lw; lv += __shfl_xor(lv, 1); lv += __shfl_xor(lv, 2); lv += __shfl_xor(lv, 4);
                    const int d = d8 * 8 + e; if ((d >> 2) == sub) linq[d & 3] = (_Float16)lv; }
                *(f16x8*)(QI + (size_t)t * 288 + sub * 32 + d8 * 8) = hq;
            }
            *(f16x4_t*)(QI + (size_t)t * 288 + 256 + sub * 4) = linq;
            { const f32x4 kq = *(const f32x4*)(tp + 256 + 128 + sub * 4); f16x4_t hk = {(_Float16)kq.x, (_Float16)kq.y, (_Float16)kq.z, (_Float16)kq.w}; *(f16x4_t*)(KI + (size_t)t * 32 + sub * 4) = hk; }
        }
        {
            const u16* wl = (const u16*)(c.ws + O_WL + l * WL_L);
            const int lane = c.lane, hh = c.wave;
            for (int mt = 0; mt < 4; ++mt) {
                int n = lane & 15, g = lane >> 4; asm volatile("" : "+v"(n), "+v"(g));
                f32x4 cw[4], ca[4], cg[4], cv[4];
#pragma unroll
                for (int nt = 0; nt < 4; ++nt) { cw[nt] = (f32x4){0.f, 0.f, 0.f, 0.f}; ca[nt] = cw[nt]; cg[nt] = cw[nt]; cv[nt] = cw[nt]; }
                const LAS u16* xrow = L_xl + (16 * mt + n) * XLS + 8 * g;
#pragma unroll
                for (int ks = 0; ks < 2; ++ks) {
                    const bf16x8 fw = *(const LAS bf16x8*)(xrow + 32 * ks), fa = *(const LAS bf16x8*)(xrow + 64 + 32 * ks);
#pragma unroll
                    for (int nt = 0; nt < 4; ++nt) { const int j = 64 * hh + 16 * nt + n;
                        cw[nt] = __builtin_amdgcn_mfma_f32_16x16x32_bf16(*(const bf16x8*)(wl + (size_t)j * 64 + 32 * ks + 8 * g), fw, cw[nt], 0, 0, 0);
                        ca[nt] = __builtin_amdgcn_mfma_f32_16x16x32_bf16(*(const bf16x8*)(wl + 512 * 64 + (size_t)j * 64 + 32 * ks + 8 * g), fa, ca[nt], 0, 0, 0); }
                }
#pragma unroll
                for (int ks = 0; ks < 4; ++ks) {
                    const bf16x8 fg = *(const LAS bf16x8*)(xrow + 128 + 32 * ks);
#pragma unroll
                    for (int nt = 0; nt < 4; ++nt) { const int j = 64 * hh + 16 * nt + n;
                        cg[nt] = __builtin_amdgcn_mfma_f32_16x16x32_bf16(*(const bf16x8*)(wl + 2 * 512 * 64 + (size_t)j * 128 + 32 * ks + 8 * g), fg, cg[nt], 0, 0, 0); }
                }
                if (l == 1) {
#pragma unroll
                    for (int ks = 0; ks < 2; ++ks) {
                        const bf16x8 fv = *(const LAS bf16x8*)(xrow + 256 + 32 * ks);
#pragma unroll
                        for (int nt = 0; nt < 4; ++nt) { const int j = 64 * hh + 16 * nt + n;
                            cv[nt] = __builtin_amdgcn_mfma_f32_16x16x32_bf16(*(const bf16x8*)(wl + 2 * 512 * 64 + 512 * 128 + (size_t)j * 64 + 32 * ks + 8 * g), fv, cv[nt], 0, 0, 0); }
                    }
                }
                const int t = t0 + 16 * mt + n;
                const u16* pc = pr + (size_t)t * 1792; const u16* pp = pc - 1792;
                float kkr_[16], av_[16]; float nn = 0.f, bc = 0.f;
#pragma unroll
                for (int nt = 0; nt < 4; ++nt) {
                    const int j = 64 * hh + 16 * nt + 4 * g; const size_t o = (size_t)t * 512 + j;
                    const u32x2 rcw = *(const u32x2*)(pc + j), kcw = *(const u32x2*)(pc + 512 + j), vcw = *(const u32x2*)(pc + 1024 + j);
                    u32x2 rpw = (u32x2){0u, 0u}, kpw = rpw, vpw = rpw; if (t > 0) { rpw = *(const u32x2*)(pp + j); kpw = *(const u32x2*)(pp + 512 + j); vpw = *(const u32x2*)(pp + 1024 + j); }
                    const f32x4 w04 = *(const LAS f32x4*)(L_cst + j), a04 = *(const LAS f32x4*)(L_cst + 512 + j), kk4 = *(const LAS f32x4*)(L_cst + 1024 + j), ka4 = *(const LAS f32x4*)(L_cst + 1536 + j), rk4 = *(const LAS f32x4*)(L_cst + 2048 + j),
                                v04 = *(const LAS f32x4*)(L_cst + 2560 + j), mr4 = *(const LAS f32x4*)(L_cst + 3072 + j), mk4 = *(const LAS f32x4*)(L_cst + 3584 + j), mv4 = *(const LAS f32x4*)(L_cst + 4096 + j);
                    const float rc[4] = {bflo(rcw.x), bfhi(rcw.x), bflo(rcw.y), bfhi(rcw.y)}, kc[4] = {bflo(kcw.x), bfhi(kcw.x), bflo(kcw.y), bfhi(kcw.y)}, vc[4] = {bflo(vcw.x), bfhi(vcw.x), bflo(vcw.y), bfhi(vcw.y)};
                    const float rp[4] = {bflo(rpw.x), bfhi(rpw.x), bflo(rpw.y), bfhi(rpw.y)}, kp[4] = {bflo(kpw.x), bfhi(kpw.x), bflo(kpw.y), bfhi(kpw.y)}, vp[4] = {bflo(vpw.x), bfhi(vpw.x), bflo(vpw.y), bfhi(vpw.y)};
                    u32x2 vfw = (u32x2){0u, 0u}; if (l == 1) vfw = *(const u32x2*)(VF + o);
                    const float vf4[4] = {bflo(vfw.x), bfhi(vfw.x), bflo(vfw.y), bfhi(vfw.y)};
                    float dec[4], k2[4], rv[4], vv[4];
#pragma unroll
                    for (int r = 0; r < 4; ++r) {
                        rv[r] = rc[r] + (rp[r] - rc[r]) * mr4[r]; const float k = kc[r] + (kp[r] - kc[r]) * mk4[r]; float v = vc[r] + (vp[r] - vc[r]) * mv4[r];
                        if (l == 1) v = v + (vf4[r] - v) * sigmoidf_(v04[r] + cv[nt][r]);
                        vv[r] = v;
                        const float wpre = w04[r] + cw[nt][r];
                        const float sp = fmaxf(-wpre, 0.f) + log1pf(__expf(-fabsf(wpre)));
                        dec[r] = __expf(-__expf(-sp - 0.5f));
                        const float av2 = sigmoidf_(a04[r] + ca[nt][r]);
                        const float kkr = k * kk4[r]; nn += kkr * kkr;
                        k2[r] = k * (1.0f + (av2 - 1.0f) * ka4[r]);
                        bc += rv[r] * k2[r] * rk4[r];
                        kkr_[4 * nt + r] = kkr; av_[4 * nt + r] = av2;
                    }
                    *(f32x4*)(RW + o) = (f32x4){dec[0], dec[1], dec[2], dec[3]};
                    { u32x2 w2; w2.x = pk_bf16(k2[0], k2[1]); w2.y = pk_bf16(k2[2], k2[3]); *(u32x2*)(RK + o) = w2; w2.x = pk_bf16(rv[0], rv[1]); w2.y = pk_bf16(rv[2], rv[3]); *(u32x2*)(RR + o) = w2;
                      w2.x = pk_bf16(vv[0], vv[1]); w2.y = pk_bf16(vv[2], vv[3]); *(u32x2*)(RV + o) = w2; if (l == 0) *(u32x2*)(VF + o) = w2;
                      w2.x = pk_bf16(cg[nt][0], cg[nt][1]); w2.y = pk_bf16(cg[nt][2], cg[nt][3]); *(u32x2*)(RG + o) = w2; }
                }
                nn += __shfl_xor(nn, 16); nn += __shfl_xor(nn, 32); bc += __shfl_xor(bc, 16); bc += __shfl_xor(bc, 32);
                const float inv = 1.0f / sqrtf(nn + 1e-12f);
                typedef _Float16 f16x4_t __attribute__((ext_vector_type(4)));
#pragma unroll
                for (int nt = 0; nt < 4; ++nt) { const size_t o = (size_t)t * 512 + 64 * hh + 16 * nt + 4 * g;
                    f16x4_t kq, bq;
#pragma unroll
                    for (int r = 0; r < 4; ++r) { const float kkn = kkr_[4 * nt + r] * inv; kq[r] = (_Float16)kkn; bq[r] = (_Float16)(kkn * av_[4 * nt + r]); }
                    *(f16x4_t*)(RKK + o) = kq; *(f16x4_t*)(RB + o) = bq; }
                if (g == 0) BC[(size_t)t * 8 + hh] = bc;
            }
        }
    }
}

__device__ __forceinline__ void fox_unit(const Ctx& c, int u, const LAS float* PB) {
    const u16* qkvf = (const u16*)(c.ws + T_QKVF); const u16* VT = (const u16*)(c.ws + T_VT); const float* FL = (const float*)(c.ws + T_FL); u16* OF = (u16*)(c.ws + T_OF);
    const int lane = c.lane, q = lane & 15, g = lane >> 4;
    const int qb = 511 - (u >> 2), h = u & 3, r0 = qb * 32;
    const u16* Qp = qkvf + (size_t)(r0 + q) * 768 + h * 64 + 8 * g;
    bf16x8 qA[2], qB[2];
    qA[0] = *(const bf16x8*)Qp; qA[1] = *(const bf16x8*)(Qp + 32); qB[0] = *(const bf16x8*)(Qp + 16 * 768); qB[1] = *(const bf16x8*)(Qp + 16 * 768 + 32);
    const float* FLh = FL + (size_t)h * S; const LAS float* PBh = PB + h * 256;
    const float FqA = FLh[r0 + q] + PBh[r0 >> 6], FqB = FLh[r0 + 16 + q] + PBh[r0 >> 6];
    float mA = -INFINITY, mB = -INFINITY, lA = 0.f, lB = 0.f;
    f32x4 oA[4], oB[4];
#pragma unroll
    for (int d = 0; d < 4; ++d) { oA[d] = (f32x4){0.f, 0.f, 0.f, 0.f}; oB[d] = (f32x4){0.f, 0.f, 0.f, 0.f}; }
    const int krow_off = 8 * (q >> 2) + (q & 3);
    const u16* Kbase = qkvf + 256 + h * 64 + 8 * g;
    const u16* Vbase = VT + (size_t)(h * 64 + q) * S + 8 * g;
    int kt0 = 0;
    float dmin;
    { const u16* kd = Kbase + (size_t)(r0 + q) * 768;
      const u32x4 a0 = __builtin_bit_cast(u32x4, qA[0]), a1 = __builtin_bit_cast(u32x4, qA[1]), b0 = __builtin_bit_cast(u32x4, qB[0]), b1 = __builtin_bit_cast(u32x4, qB[1]);
      const u32x4 k0_ = *(const u32x4*)kd, k1_ = *(const u32x4*)(kd + 32), k2_ = *(const u32x4*)(kd + 16 * 768), k3_ = *(const u32x4*)(kd + 16 * 768 + 32);
      float dA = 0.f, dB = 0.f;
#pragma unroll
      for (int w = 0; w < 4; ++w) { dA += bflo(a0[w]) * bflo(k0_[w]) + bfhi(a0[w]) * bfhi(k0_[w]) + bflo(a1[w]) * bflo(k1_[w]) + bfhi(a1[w]) * bfhi(k1_[w]);
                                    dB += bflo(b0[w]) * bflo(k2_[w]) + bfhi(b0[w]) * bfhi(k2_[w]) + bflo(b1[w]) * bflo(k3_[w]) + bfhi(b1[w]) * bfhi(k3_[w]); }
      dA += __shfl_xor(dA, 16); dA += __shfl_xor(dA, 32); dB += __shfl_xor(dB, 16); dB += __shfl_xor(dB, 32);
      float dm = fminf(dA, dB);
#pragma unroll
      for (int o = 1; o < 16; o <<= 1) dm = fminf(dm, __shfl_xor(dm, o));
      dmin = __builtin_amdgcn_readfirstlane(dm) - 0.5f; }
    { const float thr = __builtin_amdgcn_readfirstlane(FLh[r0] + PBh[r0 >> 6]) + PB[1024 + h] - dmin; const int bmax = r0 >> 6; int b = 0;
#pragma unroll
      for (int e = 0; e < 4; ++e) {
          const int bb = lane + 64 * e; const bool cnd = bb < bmax && PBh[bb + 1] > thr;
          const unsigned long long nb = ~__ballot(cnd); const int n = nb ? __builtin_ctzll(nb) : 64;
          if (b == 64 * e) b += n; }
      kt0 = 2 * b; }
    bf16x8 kf[2][2], vf[4]; f32x4 f0, f1;
#define FOX_LOAD(KT) do { const int k0_ = (KT) * 32; \
        _Pragma("unroll") for (int rb = 0; rb < 2; ++rb) { const u16* kp = Kbase + (size_t)(k0_ + krow_off + 4 * rb) * 768; kf[rb][0] = *(const bf16x8*)kp; kf[rb][1] = *(const bf16x8*)(kp + 32); } \
        _Pragma("unroll") for (int d = 0; d < 4; ++d) vf[d] = *(const bf16x8*)(Vbase + (size_t)(16 * d) * S + k0_); \
        f0 = *(const f32x4*)(FLh + k0_ + 8 * g); f1 = *(const f32x4*)(FLh + k0_ + 8 * g + 4); } while (0)
    FOX_LOAD(kt0);
    for (int kt = kt0; kt <= qb; ++kt) {
        const int k0 = kt * 32;
        const float pb = PBh[k0 >> 6];
        float fk[8] = {f0.x + pb, f0.y + pb, f0.z + pb, f0.w + pb, f1.x + pb, f1.y + pb, f1.z + pb, f1.w + pb};
        bf16x8 kc[2][2], vc[4];
#pragma unroll
        for (int rb = 0; rb < 2; ++rb) { kc[rb][0] = kf[rb][0]; kc[rb][1] = kf[rb][1]; }
#pragma unroll
        for (int d = 0; d < 4; ++d) vc[d] = vf[d];
        if (kt < qb) FOX_LOAD(kt + 1);
        f32x4 sA[2], sB[2];
#pragma unroll
        for (int rb = 0; rb < 2; ++rb) {
            sA[rb] = __builtin_amdgcn_mfma_f32_16x16x32_bf16(kc[rb][0], qA[0], (f32x4){0.f, 0.f, 0.f, 0.f}, 0, 0, 0);
            sA[rb] = __builtin_amdgcn_mfma_f32_16x16x32_bf16(kc[rb][1], qA[1], sA[rb], 0, 0, 0);
            sB[rb] = __builtin_amdgcn_mfma_f32_16x16x32_bf16(kc[rb][0], qB[0], (f32x4){0.f, 0.f, 0.f, 0.f}, 0, 0, 0);
            sB[rb] = __builtin_amdgcn_mfma_f32_16x16x32_bf16(kc[rb][1], qB[1], sB[rb], 0, 0, 0);
        }
        float xA[8], xB[8];
#pragma unroll
        for (int j = 0; j < 8; ++j) { xA[j] = sA[j >> 2][j & 3] + (FqA - fk[j]); xB[j] = sB[j >> 2][j & 3] + (FqB - fk[j]); }
        if (kt == qb) {
#pragma unroll
            for (int j = 0; j < 8; ++j) { const int key = 8 * g + j; if (key > q) xA[j] = -INFINITY; if (key > 16 + q) xB[j] = -INFINITY; }
        }
        float mxA = xA[0], mxB = xB[0];
#pragma unroll
        for (int j = 1; j < 8; ++j) { mxA = fmaxf(mxA, xA[j]); mxB = fmaxf(mxB, xB[j]); }
        mxA = fmaxf(mxA, __shfl_xor(mxA, 16)); mxA = fmaxf(mxA, __shfl_xor(mxA, 32));
        mxB = fmaxf(mxB, __shfl_xor(mxB, 16)); mxB = fmaxf(mxB, __shfl_xor(mxB, 32));
        const float mnA = fmaxf(mA, mxA), mnB = fmaxf(mB, mxB);
        const float alA = __builtin_amdgcn_exp2f(mA - mnA), alB = __builtin_amdgcn_exp2f(mB - mnB);
        mA = mnA; mB = mnB;
        float sumA = 0.f, sumB = 0.f;
#pragma unroll
        for (int j = 0; j < 8; ++j) { xA[j] = __builtin_amdgcn_exp2f(xA[j] - mnA); xB[j] = __builtin_amdgcn_exp2f(xB[j] - mnB); sumA += xA[j]; sumB += xB[j]; }
        lA = lA * alA + sumA; lB = lB * alB + sumB;
        u32x4 pwA, pwB;
        pwA.x = pk_bf16(xA[0], xA[1]); pwA.y = pk_bf16(xA[2], xA[3]); pwA.z = pk_bf16(xA[4], xA[5]); pwA.w = pk_bf16(xA[6], xA[7]);
        pwB.x = pk_bf16(xB[0], xB[1]); pwB.y = pk_bf16(xB[2], xB[3]); pwB.z = pk_bf16(xB[4], xB[5]); pwB.w = pk_bf16(xB[6], xB[7]);
        const bf16x8 pA = __builtin_bit_cast(bf16x8, pwA), pB = __builtin_bit_cast(bf16x8, pwB);
#pragma unroll
        for (int d = 0; d < 4; ++d) {
            oA[d] = __builtin_amdgcn_mfma_f32_16x16x32_bf16(vc[d], pA, oA[d] * alA, 0, 0, 0);
            oB[d] = __builtin_amdgcn_mfma_f32_16x16x32_bf16(vc[d], pB, oB[d] * alB, 0, 0, 0);
        }
    }
#undef FOX_LOAD
    lA += __shfl_xor(lA, 16); lA += __shfl_xor(lA, 32); lB += __shfl_xor(lB, 16); lB += __shfl_xor(lB, 32);
    const float iA = 1.0f / lA, iB = 1.0f / lB;
#pragma unroll
    for (int d = 0; d < 4; ++d) {
        u32x2 w; w.x = pk_bf16(oA[d][0] * iA, oA[d][1] * iA); w.y = pk_bf16(oA[d][2] * iA, oA[d][3] * iA);
        *(u32x2*)(OF + (size_t)(r0 + q) * 256 + h * 64 + 16 * d + 4 * g) = w;
        w.x = pk_bf16(oB[d][0] * iB, oB[d][1] * iB); w.y = pk_bf16(oB[d][2] * iB, oB[d][3] * iB);
        *(u32x2*)(OF + (size_t)(r0 + 16 + q) * 256 + h * 64 + 16 * d + 4 * g) = w;
    }
}

__device__ __forceinline__ float r1_gsum(float x) {
    auto a = __builtin_amdgcn_permlane32_swap(__float_as_uint(x), __float_as_uint(x), false, false);
    const float y = __uint_as_float(a[0]) + __uint_as_float(a[1]);
    auto b = __builtin_amdgcn_permlane16_swap(__float_as_uint(y), __float_as_uint(y), false, false);
    return __uint_as_float(b[0]) + __uint_as_float(b[1]);
}
__device__ __forceinline__ void r1_task(const Ctx& c, int task, LAS float* lw) {
    const float* RW = (const float*)(c.ws + T_RW); const _Float16* RKK = (const _Float16*)(c.ws + T_RKK); const _Float16* RB = (const _Float16*)(c.ws + T_RB);
    const u16* RK = (const u16*)(c.ws + T_RK); const u16* RR = (const u16*)(c.ws + T_RR); const u16* RV = (const u16*)(c.ws + T_RV);
    float* YL = (float*)(c.ws + T_YL); u16* RT = (u16*)(c.ws + T_RT); float* PC = (float*)(c.ws + T_PC); float* UC = (float*)(c.ws + T_UC);
    const int lane = c.lane, m = lane & 15, g = lane >> 4, h = task >> 8, ch = task & 255, t0 = ch * 64;
    float U[4][16], P[4][16];
#pragma unroll
    for (int mt = 0; mt < 4; ++mt)
#pragma unroll
        for (int cc = 0; cc < 16; ++cc) { U[mt][cc] = 0.f; P[mt][cc] = (16 * mt + m == 16 * g + cc) ? 1.f : 0.f; }
    for (int blk = 0; blk < 8; ++blk) {
        const int tb = t0 + blk * 8;
        {
            int l2 = lane; asm volatile("" : "+v"(l2)); const int ls = l2 >> 3, lj = (l2 & 7) * 8;
            const size_t o = (size_t)(tb + ls) * 512 + h * 64 + lj;
            const f32x4 w0 = *(const f32x4*)(RW + o), w1 = *(const f32x4*)(RW + o + 4);
            const f16x8 kk = *(const f16x8*)(RKK + o), bb = *(const f16x8*)(RB + o);
            const u32x4 kr = *(const u32x4*)(RK + o), rr = *(const u32x4*)(RR + o), vv = *(const u32x4*)(RV + o);
            LAS float* d = lw + ls * 384 + lj;
            *(LAS f32x4*)(d) = w0; *(LAS f32x4*)(d + 4) = w1;
            *(LAS f32x4*)(d + 64) = (f32x4){(float)kk[0], (float)kk[1], (float)kk[2], (float)kk[3]}; *(LAS f32x4*)(d + 68) = (f32x4){(float)kk[4], (float)kk[5], (float)kk[6], (float)kk[7]};
            *(LAS f32x4*)(d + 128) = (f32x4){(float)bb[0], (float)bb[1], (float)bb[2], (float)bb[3]}; *(LAS f32x4*)(d + 132) = (f32x4){(float)bb[4], (float)bb[5], (float)bb[6], (float)bb[7]};
            *(LAS f32x4*)(d + 192) = (f32x4){bflo(kr.x), bfhi(kr.x), bflo(kr.y), bfhi(kr.y)}; *(LAS f32x4*)(d + 196) = (f32x4){bflo(kr.z), bfhi(kr.z), bflo(kr.w), bfhi(kr.w)};
            *(LAS f32x4*)(d + 256) = (f32x4){bflo(rr.x), bfhi(rr.x), bflo(rr.y), bfhi(rr.y)}; *(LAS f32x4*)(d + 260) = (f32x4){bflo(rr.z), bfhi(rr.z), bflo(rr.w), bfhi(rr.w)};
            *(LAS f32x4*)(d + 320) = (f32x4){bflo(vv.x), bfhi(vv.x), bflo(vv.y), bfhi(vv.y)}; *(LAS f32x4*)(d + 324) = (f32x4){bflo(vv.z), bfhi(vv.z), bflo(vv.w), bfhi(vv.w)};
        }
        asm volatile("s_waitcnt lgkmcnt(0)" ::: "memory");
        for (int s = 0; s < 8; ++s) {
            const LAS float* b = lw + s * 384 + 16 * g; const int t = tb + s;
            float vv_[4], su[4], sp[4];
            {   float a[4] = {0.f, 0.f, 0.f, 0.f}, p[4] = {0.f, 0.f, 0.f, 0.f};
#pragma unroll
                for (int q4 = 0; q4 < 4; ++q4) { const f32x4 kk4 = *(const LAS f32x4*)(b + 64 + 4 * q4);
#pragma unroll
                    for (int mt = 0; mt < 4; ++mt)
#pragma unroll
                        for (int e = 0; e < 4; ++e) { a[mt] = fmaf(U[mt][4 * q4 + e], kk4[e], a[mt]); p[mt] = fmaf(P[mt][4 * q4 + e], kk4[e], p[mt]); } }
#pragma unroll
                for (int mt = 0; mt < 4; ++mt) { vv_[mt] = lw[s * 384 + 320 + 16 * mt + m]; su[mt] = -r1_gsum(a[mt]); sp[mt] = -r1_gsum(p[mt]); } }
            float y[4] = {0.f, 0.f, 0.f, 0.f}, rt[4] = {0.f, 0.f, 0.f, 0.f};
#pragma unroll
            for (int q4 = 0; q4 < 4; ++q4) {
                const f32x4 w4 = *(const LAS f32x4*)(b + 4 * q4), b4 = *(const LAS f32x4*)(b + 128 + 4 * q4), k4 = *(const LAS f32x4*)(b + 192 + 4 * q4), r4 = *(const LAS f32x4*)(b + 256 + 4 * q4);
#pragma unroll
                for (int mt = 0; mt < 4; ++mt)
#pragma unroll
                    for (int e = 0; e < 4; ++e) { const int cc = 4 * q4 + e;
                        float t1 = vv_[mt] * k4[e]; t1 = fmaf(su[mt], b4[e], t1); U[mt][cc] = fmaf(U[mt][cc], w4[e], t1);
                        P[mt][cc] = fmaf(P[mt][cc], w4[e], sp[mt] * b4[e]);
                        y[mt] = fmaf(U[mt][cc], r4[e], y[mt]); rt[mt] = fmaf(P[mt][cc], r4[e], rt[mt]); }
            }
            float yv = 0.f, rv = 0.f;
#pragma unroll
            for (int mt = 0; mt < 4; ++mt) { const float ys = r1_gsum(y[mt]), rs_ = r1_gsum(rt[mt]); if (g == mt) { yv = ys; rv = rs_; } }
            { int l3 = lane; asm volatile("" : "+v"(l3)); const size_t oo = (size_t)t * 512 + h * 64 + l3; YL[oo] = yv; RT[oo] = f2bf(rv); }
        }
    }
    int ln = lane; asm volatile("" : "+v"(ln));
    const int m2 = ln & 15, g2 = ln >> 4;
    u16* ph = (u16*)PC + (size_t)task * 8192;
    LAS u16* lt = (LAS u16*)lw;
#pragma unroll
    for (int mt = 0; mt < 4; ++mt) { const int kpos = 32 * (mt >> 1) + 8 * (m2 >> 2) + 4 * (mt & 1) + (m2 & 3);
#pragma unroll
        for (int cc = 0; cc < 16; ++cc) { const float pv = P[mt][cc]; const u16 hi = f2bf(pv); const u16 lo = f2bf(pv - bf2f(hi)); lt[(16 * g2 + cc) * 64 + kpos] = hi; lt[4096 + (16 * g2 + cc) * 64 + kpos] = lo; } }
    asm volatile("s_waitcnt lgkmcnt(0)" ::: "memory");
#pragma unroll
    for (int i = 0; i < 16; ++i) *(u32x4*)(ph + (size_t)(i * 64 + ln) * 8) = *(const LAS u32x4*)((LAS u16*)lw + (i * 64 + ln) * 8);
    asm volatile("s_waitcnt lgkmcnt(0)" ::: "memory");
#pragma unroll
    for (int mt = 0; mt < 4; ++mt) { float* uc = UC + ((size_t)task * 64 + 16 * mt + m2) * 64 + 16 * g2;
#pragma unroll
        for (int cc = 0; cc < 16; cc += 4) *(f32x4*)(uc + cc) = (f32x4){U[mt][cc], U[mt][cc + 1], U[mt][cc + 2], U[mt][cc + 3]}; }
}

constexpr int R2_SLOT = 20480;
__device__ __forceinline__ void r2_task(const Ctx& c, int h, int rgp) {
    const u16* PHL = (const u16*)(c.ws + T_PC); float* UC = (float*)(c.ws + T_UC);
    volatile LAS unsigned* full = (volatile LAS unsigned*)(c.lds + 7 * R2_SLOT);
    volatile LAS unsigned* freef = full + 8;
    if (c.tid < 16) full[c.tid] = 0u;
    __syncthreads();
    const int lane = c.lane, n = lane & 15, g = lane >> 4, i = 16 * rgp + n;
    if (c.wave == 0) {
        f32x4 s[4];
#pragma unroll
        for (int mt = 0; mt < 4; ++mt) s[mt] = (f32x4){0.f, 0.f, 0.f, 0.f};
        for (int ch = 0; ch < 256; ++ch) {
            const int slot = ch % 7; const LAS unsigned char* sb = c.lds + slot * R2_SLOT;
            { unsigned sp = 0; while (full[slot] != (unsigned)(ch + 1)) { __builtin_amdgcn_s_sleep(1); if (++sp > (1u << 22)) break; } }
            asm volatile("" ::: "memory");
            bf16x8 ah[4][2], al[4][2]; f32x4 u[4];
#pragma unroll
            for (int mt = 0; mt < 4; ++mt) { u[mt] = *(const LAS f32x4*)(sb + 16384 + (mt * 64 + lane) * 16);
#pragma unroll
                for (int ks = 0; ks < 2; ++ks) { ah[mt][ks] = *(const LAS bf16x8*)(sb + ((mt * 2 + ks) * 64 + lane) * 16); al[mt][ks] = *(const LAS bf16x8*)(sb + 8192 + ((mt * 2 + ks) * 64 + lane) * 16); } }
            float* up = UC + ((size_t)(h * 256 + ch) * 64 + i) * 64 + 4 * g;
#pragma unroll
            for (int mt = 0; mt < 4; ++mt) *(f32x4*)(up + 16 * mt) = s[mt];
            bf16x8 bh[2], bl[2];
#pragma unroll
            for (int ks = 0; ks < 2; ++ks) {
                u32x4 wh, wl; float hv[8], lv[8];
#pragma unroll
                for (int j = 0; j < 8; ++j) { const float v = s[2 * ks + (j >> 2)][j & 3]; hv[j] = bf2f(f2bf(v)); lv[j] = v - hv[j]; }
                wh.x = pk_bf16(hv[0], hv[1]); wh.y = pk_bf16(hv[2], hv[3]); wh.z = pk_bf16(hv[4], hv[5]); wh.w = pk_bf16(hv[6], hv[7]);
                wl.x = pk_bf16(lv[0], lv[1]); wl.y = pk_bf16(lv[2], lv[3]); wl.z = pk_bf16(lv[4], lv[5]); wl.w = pk_bf16(lv[6], lv[7]);
                bh[ks] = __builtin_bit_cast(bf16x8, wh); bl[ks] = __builtin_bit_cast(bf16x8, wl);
            }
            asm volatile("s_waitcnt lgkmcnt(0)" ::: "memory");
            if (lane == 0) freef[slot] = (unsigned)(ch + 1);
#pragma unroll
            for (int mt = 0; mt < 4; ++mt) {
                f32x4 acc = u[mt];
#pragma unroll
                for (int ks = 0; ks < 2; ++ks) {
                    acc = __builtin_amdgcn_mfma_f32_16x16x32_bf16(ah[mt][ks], bl[ks], acc, 0, 0, 0);
                    acc = __builtin_amdgcn_mfma_f32_16x16x32_bf16(al[mt][ks], bh[ks], acc, 0, 0, 0);
                    acc = __builtin_amdgcn_mfma_f32_16x16x32_bf16(ah[mt][ks], bh[ks], acc, 0, 0, 0);
                }
                s[mt] = acc;
            }
        }
    } else {
        for (int ch = c.wave - 1; ch < 256; ch += 7) {
            const int slot = ch % 7; LAS unsigned char* sb = c.lds + slot * R2_SLOT;
            const u16* ph = PHL + (size_t)(h * 256 + ch) * 8192; const float* up = UC + ((size_t)(h * 256 + ch) * 64 + i) * 64 + 4 * g;
            bf16x8 ah[4][2], al[4][2]; f32x4 u[4];
#pragma unroll
            for (int mt = 0; mt < 4; ++mt) { u[mt] = *(const f32x4*)(up + 16 * mt);
#pragma unroll
                for (int ks = 0; ks < 2; ++ks) { ah[mt][ks] = *(const bf16x8*)(ph + (16 * mt + n) * 64 + 32 * ks + 8 * g); al[mt][ks] = *(const bf16x8*)(ph + 4096 + (16 * mt + n) * 64 + 32 * ks + 8 * g); } }
            asm volatile("s_waitcnt vmcnt(0)" ::: "memory");
            if (ch >= 7) { unsigned sp = 0; while (freef[slot] != (unsigned)(ch - 6)) { __builtin_amdgcn_s_sleep(1); if (++sp > (1u << 22)) break; } }
            asm volatile("" ::: "memory");
#pragma unroll
            for (int mt = 0; mt < 4; ++mt) { *(LAS f32x4*)(sb + 16384 + (mt * 64 + lane) * 16) = u[mt];
#pragma unroll
                for (int ks = 0; ks < 2; ++ks) { *(LAS bf16x8*)(sb + ((mt * 2 + ks) * 64 + lane) * 16) = ah[mt][ks]; *(LAS bf16x8*)(sb + 8192 + ((mt * 2 + ks) * 64 + lane) * 16) = al[mt][ks]; } }
            asm volatile("s_waitcnt lgkmcnt(0)" ::: "memory");
            if (lane == 0) full[slot] = (unsigned)(ch + 1);
        }
    }
    __syncthreads();
}

__device__ __forceinline__ void r3_task(const Ctx& c, CArgsP a, int l, int task) {
    const float* YL = (const float*)(c.ws + T_YL); const u16* RT = (const u16*)(c.ws + T_RT); const float* S0 = (const float*)(c.ws + T_UC);
    const u16* RV = (const u16*)(c.ws + T_RV); const u16* RG = (const u16*)(c.ws + T_RG); const float* BC = (const float*)(c.ws + T_BC); u16* OR_ = (u16*)(c.ws + T_OR);
    const int lane = c.lane, n = lane & 15, g = lane >> 4, h = task >> 8, ch = task & 255, t0 = ch * 64;
    bf16x8 sh[4][2], sl[4][2];
#pragma unroll
    for (int it = 0; it < 4; ++it)
#pragma unroll
        for (int ks = 0; ks < 2; ++ks) { const float* sp = S0 + ((size_t)task * 64 + 16 * it + n) * 64 + 32 * ks + 8 * g; const f32x4 v0 = *(const f32x4*)sp, v1 = *(const f32x4*)(sp + 4);
            const float v[8] = {v0.x, v0.y, v0.z, v0.w, v1.x, v1.y, v1.z, v1.w}; float hv[8], lv[8];
#pragma unroll
            for (int e = 0; e < 8; ++e) { hv[e] = bf2f(f2bf(v[e])); lv[e] = v[e] - hv[e]; }
            u32x4 wh, wl; wh.x = pk_bf16(hv[0], hv[1]); wh.y = pk_bf16(hv[2], hv[3]); wh.z = pk_bf16(hv[4], hv[5]); wh.w = pk_bf16(hv[6], hv[7]);
            wl.x = pk_bf16(lv[0], lv[1]); wl.y = pk_bf16(lv[2], lv[3]); wl.z = pk_bf16(lv[4], lv[5]); wl.w = pk_bf16(lv[6], lv[7]);
            sh[it][ks] = __builtin_bit_cast(bf16x8, wh); sl[it][ks] = __builtin_bit_cast(bf16x8, wl); }
    const float* lng = a->in[I_LNG] + l * 512 + h * 64; const float* lnb = a->in[I_LNB] + l * 512 + h * 64;
#pragma unroll 1
    for (int tt = 0; tt < 4; ++tt) {
        int n2 = n, g2 = g; asm volatile("" : "+v"(n2), "+v"(g2));
        const int t = t0 + 16 * tt + n2; const size_t ob = (size_t)t * 512 + h * 64 + 4 * g2;
        const bf16x8 r0 = *(const bf16x8*)(RT + (size_t)t * 512 + h * 64 + 8 * g2), r1 = *(const bf16x8*)(RT + (size_t)t * 512 + h * 64 + 32 + 8 * g2);
        f32x4 y[4]; float s1 = 0.f;
#pragma unroll
        for (int it = 0; it < 4; ++it) { f32x4 acc = *(const f32x4*)(YL + ob + 16 * it);
            acc = __builtin_amdgcn_mfma_f32_16x16x32_bf16(sl[it][0], r0, acc, 0, 0, 0); acc = __builtin_amdgcn_mfma_f32_16x16x32_bf16(sl[it][1], r1, acc, 0, 0, 0);
            acc = __builtin_amdgcn_mfma_f32_16x16x32_bf16(sh[it][0], r0, acc, 0, 0, 0); acc = __builtin_amdgcn_mfma_f32_16x16x32_bf16(sh[it][1], r1, acc, 0, 0, 0);
            y[it] = acc; s1 += (acc[0] + acc[1]) + (acc[2] + acc[3]); }
        s1 += __shfl_xor(s1, 16); s1 += __shfl_xor(s1, 32);
        const float mean = s1 * (1.0f / 64.f); float s2 = 0.f;
#pragma unroll
        for (int it = 0; it < 4; ++it)
#pragma unroll
            for (int r = 0; r < 4; ++r) { const float d = y[it][r] - mean; y[it][r] = d; s2 += d * d; }
        s2 += __shfl_xor(s2, 16); s2 += __shfl_xor(s2, 32);
        const float rstd = 1.0f / sqrtf(s2 * (1.0f / 64.f) + 64e-5f); const float bcv = BC[(size_t)t * 8 + h];
#pragma unroll
        for (int it = 0; it < 4; ++it) { const size_t o = ob + 16 * it; const f32x4 g4 = *(const f32x4*)(lng + 16 * it + 4 * g2), b4 = *(const f32x4*)(lnb + 16 * it + 4 * g2);
            const u32x2 vw = *(const u32x2*)(RV + o), gw = *(const u32x2*)(RG + o);
            const float vv[4] = {bflo(vw.x), bfhi(vw.x), bflo(vw.y), bfhi(vw.y)}, gg[4] = {bflo(gw.x), bfhi(gw.x), bflo(gw.y), bfhi(gw.y)}; float ov[4];
#pragma unroll
            for (int r = 0; r < 4; ++r) ov[r] = (y[it][r] * rstd * g4[r] + b4[r] + bcv * vv[r]) * gg[r];
            u32x2 w2; w2.x = pk_bf16(ov[0], ov[1]); w2.y = pk_bf16(ov[2], ov[3]); *(u32x2*)(OR_ + o) = w2; }
    }
}

constexpr int DSA_CAP = 384;
constexpr int L_DSA_IMG = 0;
constexpr int L_DSA_FLAT = 0;
constexpr int L_DSA_CBM = 65536;
constexpr int L_DSA_CAND = 16384;
constexpr int L_DSA_BM = 98304;
constexpr int L_DSA_SEL = 131072;
constexpr int L_DSA_CNT = 131072 + 8192;
__device__ __forceinline__ unsigned ord_of(float s) { const unsigned u = __float_as_uint(s); return (u & 0x80000000u) ? ~u : (u | 0x80000000u); }
__device__ __forceinline__ unsigned img_off(unsigned row, unsigned ch) { return 256u * row + 16u * (ch ^ (((row & 3) << 2) | ((row >> 2) & 3))); }

__device__ __forceinline__ void dsa_score_pass(const Ctx& c, int ntile, const f16x8 (&qf)[9], const float (&sg)[8], float invw, float boff, LAS u32* hist, unsigned char* binrow) {
    const _Float16* KI = (const _Float16*)(c.ws + T_KI);
    int lane = c.lane; asm volatile("" : "+v"(lane));
    const int q = lane & 15, g = lane >> 4;
    const _Float16* kip = KI + (size_t)q * 32 + 8 * g;
    LAS u32* hq = hist + q * 1024; const int rot = 37 * q;
    unsigned* bout = (unsigned*)(binrow + (size_t)q * 16384 + 4 * g);
    const int ntw = (ntile - c.wave + NWAVES - 1) / NWAVES;
    f16x8 k0, k1, k2, k3;
#define DSA_KLOAD(IT) ((IT) < ntw ? *(const f16x8*)(kip + (size_t)(c.wave + NWAVES * (IT)) * 512) : (f16x8){0, 0, 0, 0, 0, 0, 0, 0})
#define DSA_TILE_BODY(KF, IT) do { if ((IT) < ntw) { const int kt = c.wave + NWAVES * (IT); \
        f32x4 xs[9]; \
        _Pragma("unroll") for (int hh = 0; hh < 9; ++hh) xs[hh] = __builtin_amdgcn_mfma_f32_16x16x32_f16(KF, qf[hh], (f32x4){0.f, 0.f, 0.f, 0.f}, 0, 0, 0); \
        KF = DSA_KLOAD((IT) + 4); \
        asm volatile("s_nop 15" : "+v"(xs[0]), "+v"(xs[1]), "+v"(xs[2]), "+v"(xs[3]), "+v"(xs[4]), "+v"(xs[5]), "+v"(xs[6]), "+v"(xs[7]), "+v"(xs[8]));     \
        f32x4 acc = xs[8]; \
        _Pragma("unroll") for (int hh = 0; hh < 8; ++hh) _Pragma("unroll") for (int r = 0; r < 4; ++r) asm volatile("v_fma_f32 %0, |%1|, %2, %0" : "+v"(acc[r]) : "v"(xs[hh][r]), "v"(sg[hh])); \
        unsigned packed = 0; \
        _Pragma("unroll") for (int r = 0; r < 4; ++r) { const float sc = acc[r] + 0.0f; \
            const int bin = min(max((int)__builtin_fmaf(sc, invw, boff), 0), 1023); \
            lds_addu(hq + ((bin + rot) & 1023), 1u); packed |= (unsigned)(bin >> 2) << (8 * r); } \
        bout[kt * 4] = packed; } } while (0)
#define DSA_TILE_BODY_U(KF, IT) do { const int kt = c.wave + NWAVES * (IT); \
        f32x4 xs[9]; \
        _Pragma("unroll") for (int hh = 0; hh < 9; ++hh) xs[hh] = __builtin_amdgcn_mfma_f32_16x16x32_f16(KF, qf[hh], (f32x4){0.f, 0.f, 0.f, 0.f}, 0, 0, 0); \
        KF = *(const f16x8*)(kip + (size_t)(kt + 4 * NWAVES) * 512); \
        asm volatile("s_nop 15" : "+v"(xs[0]), "+v"(xs[1]), "+v"(xs[2]), "+v"(xs[3]), "+v"(xs[4]), "+v"(xs[5]), "+v"(xs[6]), "+v"(xs[7]), "+v"(xs[8])); \
        f32x4 acc = xs[8]; \
        _Pragma("unroll") for (int hh = 0; hh < 8; ++hh) _Pragma("unroll") for (int r = 0; r < 4; ++r) asm volatile("v_fma_f32 %0, |%1|, %2, %0" : "+v"(acc[r]) : "v"(xs[hh][r]), "v"(sg[hh])); \
        unsigned packed = 0; \
        _Pragma("unroll") for (int r = 0; r < 4; ++r) { const float sc = acc[r] + 0.0f; \
            const int bin = min(max((int)__builtin_fmaf(sc, invw, boff), 0), 1023); \
            lds_addu(hq + ((bin + rot) & 1023), 1u); packed |= (unsigned)(bin >> 2) << (8 * r); } \
        bout[kt * 4] = packed; } while (0)
    k0 = DSA_KLOAD(0); k1 = DSA_KLOAD(1); k2 = DSA_KLOAD(2); k3 = DSA_KLOAD(3);
    int it = 0;
    for (; it + 8 <= ntw; it += 4) {
        DSA_TILE_BODY_U(k0, it); DSA_TILE_BODY_U(k1, it + 1); DSA_TILE_BODY_U(k2, it + 2); DSA_TILE_BODY_U(k3, it + 3);
    }
    for (; it < ntw; it += 4) {
        DSA_TILE_BODY(k0, it); DSA_TILE_BODY(k1, it + 1); DSA_TILE_BODY(k2, it + 2); DSA_TILE_BODY(k3, it + 3);
    }
#undef DSA_TILE_BODY_U
#undef DSA_TILE_BODY
#undef DSA_KLOAD
    asm volatile("s_waitcnt vmcnt(0)" ::: "memory");
}
typedef _Float16 h2_t __attribute__((ext_vector_type(2)));
__device__ __forceinline__ float dsa_score_one(const Ctx& c, int t, int key) {
    const _Float16* qp = (const _Float16*)(c.ws + T_QI) + (size_t)t * 288; const _Float16* kp = (const _Float16*)(c.ws + T_KI) + (size_t)key * 32;
    const u32 sb = ((const u32*)(c.ws + T_SG))[t];
    h2_t kv[16];
#pragma unroll
    for (int i = 0; i < 4; ++i) { const u32x4 w = *(const u32x4*)(kp + 8 * i); kv[4 * i] = __builtin_bit_cast(h2_t, w.x); kv[4 * i + 1] = __builtin_bit_cast(h2_t, w.y); kv[4 * i + 2] = __builtin_bit_cast(h2_t, w.z); kv[4 * i + 3] = __builtin_bit_cast(h2_t, w.w); }
    float sc = 0.f;
#pragma unroll
    for (int hh = 8; hh >= 0; --hh) {
        float x = 0.f;
#pragma unroll
        for (int i = 0; i < 4; ++i) { const u32x4 w = *(const u32x4*)(qp + hh * 32 + 8 * i);
            x = __builtin_amdgcn_fdot2(__builtin_bit_cast(h2_t, w.x), kv[4 * i], x, false); x = __builtin_amdgcn_fdot2(__builtin_bit_cast(h2_t, w.y), kv[4 * i + 1], x, false);
            x = __builtin_amdgcn_fdot2(__builtin_bit_cast(h2_t, w.z), kv[4 * i + 2], x, false); x = __builtin_amdgcn_fdot2(__builtin_bit_cast(h2_t, w.w), kv[4 * i + 3], x, false); }
        if (hh == 8) sc = x; else sc = __builtin_fmaf(__builtin_fabsf(x), ((sb >> hh) & 1u) ? -1.f : 1.f, sc);
    }
    return sc + 0.0f;
}
#if PROBE
#define DSTAMP(k) do { if (c.bid == 100 && c.tid == 0) { const u64 now_ = wall_clock64(); ((LAS u64*)(c.lds + L_DSA_CNT + 1024))[k] += now_ - dst_; dst_ = now_; } } while (0)
#else
#define DSTAMP(k) do { } while (0)
#endif
__device__ __forceinline__ void dsa_unit(const Ctx& c, int qt) {
#if PROBE
    u64 dst_ = wall_clock64();
#endif
    const _Float16* QI = (const _Float16*)(c.ws + T_QI); const u32* SG = (const u32*)(c.ws + T_SG);
    const u16* CKV = (const u16*)(c.ws + T_CKV); const u16* QL = (const u16*)(c.ws + T_QL); u16* OD = (u16*)(c.ws + T_OD);
    LAS u32* hist = (LAS u32*)(c.lds + L_DSA_IMG); LAS u64* cand = (LAS u64*)(c.lds + L_DSA_CAND);
    LAS u16* sel = (LAS u16*)(c.lds + L_DSA_SEL); LAS u32* cnts = (LAS u32*)(c.lds + L_DSA_CNT); LAS u32* bm = (LAS u32*)(c.lds + L_DSA_BM);
    int lane = c.lane; asm volatile("" : "+v"(lane)); const int q = lane & 15, g = lane >> 4; int tid = c.tid; asm volatile("" : "+v"(tid));
    const int chunk = qt >> 2, N = 64 * (chunk + 1);
    if (tid < 65) cnts[tid] = 0u;
    if (N > 256) {
        for (int i = tid; i < 16 * 1024; i += NTHR) hist[i] = 0u;
        { LAS u32* cbm0 = (LAS u32*)(c.lds + L_DSA_CBM); for (int i = tid; i < 2 * 16 * 512; i += NTHR) cbm0[i] = 0u; }
        f16x8 qf[9]; float sg[8];
        { const _Float16* qp = QI + (size_t)(qt * 16 + q) * 288 + 8 * g;
#pragma unroll
          for (int hh = 0; hh < 9; ++hh) qf[hh] = *(const f16x8*)(qp + hh * 32);
          const u32 sb = SG[qt * 16 + q];
#pragma unroll
          for (int hh = 0; hh < 8; ++hh) sg[hh] = ((sb >> hh) & 1u) ? -1.f : 1.f; }
        float invw, boff;
        { const _Float16* KIs = (const _Float16*)(c.ws + T_KI); const int ntile = N / 16; float s1 = 0.f, s2 = 0.f;
#pragma unroll
          for (int j = 0; j < 2; ++j) { const int kts = ((2 * c.wave + j) * ntile) >> 4;
              const f16x8 kf = *(const f16x8*)(KIs + (size_t)(kts * 16 + q) * 32 + 8 * g);
              f32x4 acc = __builtin_amdgcn_mfma_f32_16x16x32_f16(kf, qf[8], (f32x4){0.f, 0.f, 0.f, 0.f}, 0, 0, 0);
#pragma unroll
              for (int hh = 0; hh < 8; ++hh) { const f32x4 x = __builtin_amdgcn_mfma_f32_16x16x32_f16(kf, qf[hh], (f32x4){0.f, 0.f, 0.f, 0.f}, 0, 0, 0);
#pragma unroll
                  for (int r = 0; r < 4; ++r) acc[r] = __builtin_fmaf(__builtin_fabsf(x[r]), sg[hh], acc[r]); }
#pragma unroll
              for (int r = 0; r < 4; ++r) { s1 += acc[r]; s2 += acc[r] * acc[r]; } }
          s1 += __shfl_xor(s1, 16); s1 += __shfl_xor(s1, 32); s2 += __shfl_xor(s2, 16); s2 += __shfl_xor(s2, 32);
          LAS float* part = (LAS float*)(c.lds + L_DSA_CNT + 1536);
          if (g == 0) { part[(c.wave * 16 + q) * 2] = s1; part[(c.wave * 16 + q) * 2 + 1] = s2; }
          __syncthreads();
          float t1 = 0.f, t2 = 0.f;
#pragma unroll
          for (int w = 0; w < 8; ++w) { t1 += part[(w * 16 + q) * 2]; t2 += part[(w * 16 + q) * 2 + 1]; }
          const float mean = t1 * (1.0f / 256.f), var = fmaxf(t2 * (1.0f / 256.f) - mean * mean, 1e-30f);
          invw = 512.0f / (6.0f * sqrtf(var)); boff = 512.0f - mean * invw; }
        __syncthreads();
        unsigned char* binrow = c.ws + T_DSB + (size_t)c.bid * (16 * 16384);
        dsa_score_pass(c, N / 16, qf, sg, invw, boff, hist, binrow);
        __syncthreads();
        if (DSA_REP & 1) { for (int i = tid; i < 16 * 1024; i += NTHR) hist[i] = 0u; __syncthreads(); dsa_score_pass(c, N / 16, qf, sg, invw, boff, hist, binrow); __syncthreads(); }
        DSTAMP(0);
        for (int qq = 2 * c.wave; qq < 2 * c.wave + 2; ++qq) {
            int lane = c.lane; asm volatile("" : "+v"(lane));
            const LAS u32* hq = hist + qq * 1024; unsigned cs[4]; unsigned loc = 0;
#pragma unroll
            for (int i = 0; i < 4; ++i) { cs[i] = 0;
#pragma unroll
                for (int e = 0; e < 4; ++e) cs[i] += hq[(lane * 16 + 4 * i + e + 37 * qq) & 1023];
                loc += cs[i]; }
            unsigned suf = loc;
#pragma unroll
            for (int o = 1; o < 64; o <<= 1) { const unsigned v = __shfl_down(suf, o); if (lane + o < 64) suf += v; }
            const u64 bal = __ballot(suf >= 256u);
            const int Ls = 63 - __builtin_clzll(bal);
            if (lane == Ls) { unsigned cab = suf - loc; int b1 = Ls * 4;
                for (int i = 3; i >= 0; --i) { if (cab + cs[i] >= 256u) { b1 = Ls * 4 + i; break; } cab += cs[i]; }
                cnts[32 + qq] = (unsigned)b1; cnts[48 + qq] = 256u - cab; }
        }
        if (c.wave == 0) { __builtin_amdgcn_fence(__ATOMIC_ACQUIRE, "agent"); asm volatile("s_waitcnt vmcnt(0)" ::: "memory"); }
        __syncthreads();
        DSTAMP(1);
        { LAS u32* cbm = (LAS u32*)(c.lds + L_DSA_CBM); const int nch = N >> 4;
          const int tot = 16 * nch;
          for (int base = tid; base < tot; base += 4 * NTHR) {
              u32x4 wq[4]; int qqs[4], chs[4];
#pragma unroll
              for (int u = 0; u < 4; ++u) { const int idx = base + u * NTHR; const int qq = idx < tot ? idx / nch : 0; const int ch = idx < tot ? idx - qq * nch : 0; qqs[u] = qq; chs[u] = ch;
                  wq[u] = *(const u32x4*)(binrow + (size_t)qq * 16384 + ch * 16); }
#pragma unroll
              for (int u = 0; u < 4; ++u) { if (base + u * NTHR >= tot) break;
                  const int qq = qqs[u], ch = chs[u]; const unsigned cb1 = cnts[32 + qq];
#pragma unroll
                  for (int wi = 0; wi < 4; ++wi) { const unsigned w = wq[u][wi];
#pragma unroll
                      for (int bb = 0; bb < 4; ++bb) { const unsigned cb = (w >> (8 * bb)) & 0xffu;
                          if (cb >= cb1) { const int key = ch * 16 + wi * 4 + bb;
                              if (cb > cb1) lds_oru(bm + qq * 512 + (key >> 5), 1u << (key & 31));
                              else lds_oru(cbm + qq * 512 + (key >> 5), 1u << (key & 31)); } } }
              }
          }
        }
        __syncthreads();
        DSTAMP(2);
        for (int rep8_ = 0; rep8_ < ((DSA_REP & 8) ? 2 : 1); ++rep8_)
        for (int qq = 2 * c.wave; qq < 2 * c.wave + 2; ++qq) {
            int lane = c.lane; asm volatile("" : "+v"(lane));
            const unsigned need = cnts[48 + qq]; unsigned C;
            {
                const LAS u32* cbm = (const LAS u32*)(c.lds + L_DSA_CBM) + qq * 512; LAS u16* ck_ = (LAS u16*)(c.lds + L_DSA_FLAT) + qq * DSA_CAP;
                unsigned wv[8]; unsigned cntl = 0;
#pragma unroll
                for (int i = 0; i < 8; ++i) { wv[i] = cbm[lane * 8 + i]; cntl += __builtin_popcount(wv[i]); }
                unsigned inc = cntl;
#pragma unroll
                for (int o = 1; o < 64; o <<= 1) { const unsigned v = __shfl_up(inc, o); if (lane >= o) inc += v; }
                unsigned pos = inc - cntl;
#pragma unroll
                for (int i = 0; i < 8; ++i) { unsigned w = wv[i]; while (w) { const int b = __builtin_ctz(w); if (pos < (unsigned)DSA_CAP) ck_[pos] = (u16)(lane * 256 + i * 32 + b); ++pos; w &= w - 1; } }
                C = min((unsigned)__shfl(inc, 63), (unsigned)DSA_CAP);
                asm volatile("s_waitcnt lgkmcnt(0)" ::: "memory");
            }
            {
                const LAS u16* candk = (const LAS u16*)(c.lds + L_DSA_FLAT) + qq * DSA_CAP; const int n_ = lane & 15, g_ = lane >> 4;
                const _Float16* qp = QI + (size_t)(qt * 16 + qq) * 288 + 8 * g_; const _Float16* KIc = (const _Float16*)(c.ws + T_KI);
                f16x8 q2[9];
#pragma unroll
                for (int hh = 0; hh < 9; ++hh) q2[hh] = *(const f16x8*)(qp + hh * 32);
                const u32 sb2 = SG[qt * 16 + qq];
                for (unsigned base = 0; base < C; base += 64) {
                    f16x8 kfs[4];
#pragma unroll
                    for (int u = 0; u < 4; ++u) { const unsigned j = base + 16 * u + n_; const unsigned key = j < C ? candk[j] : 0u; kfs[u] = *(const f16x8*)(KIc + (size_t)key * 32 + 8 * g_); }
#pragma unroll
                    for (int u = 0; u < 4; ++u) { if (base + 16 * u >= C) break;
                        f32x4 acc = __builtin_amdgcn_mfma_f32_16x16x32_f16(kfs[u], q2[8], (f32x4){0.f, 0.f, 0.f, 0.f}, 0, 0, 0);
#pragma unroll
                        for (int hh = 0; hh < 8; ++hh) { const f32x4 x = __builtin_amdgcn_mfma_f32_16x16x32_f16(kfs[u], q2[hh], (f32x4){0.f, 0.f, 0.f, 0.f}, 0, 0, 0); const float sgn = ((sb2 >> hh) & 1u) ? -1.f : 1.f;
#pragma unroll
                            for (int r = 0; r < 4; ++r) acc[r] = __builtin_fmaf(__builtin_fabsf(x[r]), sgn, acc[r]); }
                        if (n_ == 0) {
#pragma unroll
                            for (int r = 0; r < 4; ++r) { const unsigned jj = base + 16 * u + 4 * g_ + r; if (jj < C) cand[qq * DSA_CAP + jj] = ((u64)ord_of(acc[r] + 0.0f) << 32) | (u64)(0xFFFFFFFFu - (unsigned)candk[jj]); }
                        }
                    }
                }
                asm volatile("s_waitcnt lgkmcnt(0)" ::: "memory");
            }
            if (C <= 64u) {
                const u64 mine = (unsigned)lane < C ? cand[qq * DSA_CAP + lane] : 0ull; unsigned rank = 0;
                const unsigned mlo = (unsigned)mine, mhi = (unsigned)(mine >> 32);
                for (unsigned j = 0; j < C; ++j) { const u64 o = ((u64)(unsigned)__builtin_amdgcn_readlane((int)mhi, (int)j) << 32) | (unsigned)__builtin_amdgcn_readlane((int)mlo, (int)j); rank += (o > mine) ? 1u : 0u; }
                if ((unsigned)lane < C && rank < need) { const unsigned key = 0xFFFFFFFFu - mlo; lds_oru(bm + qq * 512 + (key >> 5), 1u << (key & 31)); }
            } else {
            u64 ck[DSA_CAP / 64];
#pragma unroll
            for (int i = 0; i < DSA_CAP / 64; ++i) { const unsigned idx = lane + 64 * i; ck[i] = idx < C ? cand[qq * DSA_CAP + idx] : 0ull; }
            u64 pre = 0xFFFFC000ull;
            for (int bit = 63; bit >= 0; --bit) {
                if (bit < 32 && bit > 13) continue;
                const u64 trial = pre | (1ull << bit); unsigned cnt = 0;
#pragma unroll
                for (int i = 0; i < DSA_CAP / 64; ++i) cnt += __builtin_popcountll(__ballot(ck[i] >= trial));
                if (cnt >= need) pre = trial;
            }
#pragma unroll
            for (int i = 0; i < DSA_CAP / 64; ++i) if (ck[i] >= pre && ck[i] != 0ull) { const unsigned key = 0xFFFFFFFFu - (unsigned)(ck[i] & 0xFFFFFFFFull); lds_oru(bm + qq * 512 + (key >> 5), 1u << (key & 31)); }
            }
            asm volatile("s_waitcnt lgkmcnt(0)" ::: "memory");
            unsigned wv[8]; unsigned cntl = 0;
#pragma unroll
            for (int i = 0; i < 8; ++i) { wv[i] = bm[qq * 512 + lane * 8 + i]; cntl += __builtin_popcount(wv[i]); }
            unsigned inc = cntl;
#pragma unroll
            for (int o = 1; o < 64; o <<= 1) { const unsigned v = __shfl_up(inc, o); if (lane >= o) inc += v; }
            unsigned pos = inc - cntl;
#pragma unroll
            for (int i = 0; i < 8; ++i) { unsigned w = wv[i]; while (w) { const int b = __builtin_ctz(w); if (pos < 256) sel[qq * 256 + pos] = (u16)(lane * 256 + i * 32 + b); ++pos; w &= w - 1; } }
            if (lane == 63) cnts[qq] = inc;
        }
        __syncthreads();
    } else {
        for (int i = tid; i < 16 * 256; i += NTHR) sel[i] = (u16)((i & 255) < N ? (i & 255) : 0);
        if (tid < 16) cnts[tid] = (unsigned)N;
        __syncthreads();
    }
    DSTAMP(3);
    LAS unsigned char* img = c.lds + L_DSA_IMG + c.wave * 16384;
    for (int rep_ = 0; rep_ < ((DSA_REP & 4) ? 2 : 1); ++rep_)
    for (int qq = 2 * c.wave; qq < 2 * c.wave + 2; ++qq) {
        int lane = c.lane; asm volatile("" : "+v"(lane)); const int q = lane & 15, g = lane >> 4;
        const int t = qt * 16 + qq; const int nsel = (int)min(cnts[qq], 256u); const int ntl = (nsel + 31) >> 5;
        bf16x8 bq[4];
#pragma unroll
        for (int s = 0; s < 4; ++s) { if (q < 4) bq[s] = *(const bf16x8*)(QL + (size_t)t * 512 + q * 128 + 32 * s + 8 * g); else bq[s] = (bf16x8){0, 0, 0, 0, 0, 0, 0, 0}; }
        float m = -INFINITY, lsum = 0.f; f32x4 o[8];
#pragma unroll
        for (int cb = 0; cb < 8; ++cb) o[cb] = (f32x4){0.f, 0.f, 0.f, 0.f};
        u32x4 grA[8], grB[8];
        const int grow = lane >> 4, gchk = lane & 15;
#define DSA_GATHER(TL, GR) do { _Pragma("unroll") for (int i = 0; i < 8; ++i) { const int si = (TL) * 32 + grow + 4 * i; const unsigned key = si < nsel ? sel[qq * 256 + si] : 0u; \
            GR[i] = *(const u32x4*)(CKV + (size_t)key * 128 + gchk * 8); } } while (0)
#define DSA_TILE(TL, GR, IMOFF) do { \
            LAS unsigned char* im = img + (IMOFF); \
            _Pragma("unroll") for (int i = 0; i < 8; ++i) *(LAS u32x4*)(im + img_off(grow + 4 * i, gchk)) = GR[i]; \
            if ((TL) + 2 < ntl) DSA_GATHER((TL) + 2, GR); \
            f32x4 st[2]; \
            _Pragma("unroll") for (int rb = 0; rb < 2; ++rb) { st[rb] = (f32x4){0.f, 0.f, 0.f, 0.f}; const unsigned row = 8 * (q >> 2) + 4 * rb + (q & 3); \
                _Pragma("unroll") for (int s = 0; s < 4; ++s) { const bf16x8 af = *(const LAS bf16x8*)(im + img_off(row, 4 * s + g)); st[rb] = __builtin_amdgcn_mfma_f32_16x16x32_bf16(af, bq[s], st[rb], 0, 0, 0); } } \
            float x[8]; float mx = -INFINITY; \
            _Pragma("unroll") for (int j = 0; j < 8; ++j) { x[j] = st[j >> 2][j & 3]; if ((TL) * 32 + 8 * g + j >= nsel) x[j] = -INFINITY; mx = fmaxf(mx, x[j]); } \
            mx = fmaxf(mx, __shfl_xor(mx, 16)); mx = fmaxf(mx, __shfl_xor(mx, 32)); \
            const float mn = fmaxf(m, mx); const float al = __builtin_amdgcn_exp2f(m - mn); m = mn; float sm = 0.f; \
            _Pragma("unroll") for (int j = 0; j < 8; ++j) { x[j] = __builtin_amdgcn_exp2f(x[j] - mn); sm += x[j]; } \
            lsum = lsum * al + sm; \
            u32x4 pw; pw.x = pk_bf16(x[0], x[1]); pw.y = pk_bf16(x[2], x[3]); pw.z = pk_bf16(x[4], x[5]); pw.w = pk_bf16(x[6], x[7]); \
            const bf16x8 pa = __builtin_bit_cast(bf16x8, pw); \
            float alr[4]; \
            _Pragma("unroll") for (int r = 0; r < 4; ++r) alr[r] = __builtin_bit_cast(float, __builtin_amdgcn_readlane(__builtin_bit_cast(int, al), r)); \
            const unsigned p = lane & 3, qd = (lane & 15) >> 2; \
            _Pragma("unroll") for (int cb = 0; cb < 8; ++cb) { \
                const v4i16_t lo = __builtin_amdgcn_ds_read_tr16_b64_v4i16((LAS v4i16_t*)(im + img_off(8 * g + qd, 2 * cb + (p >> 1)) + 8 * (p & 1))); \
                const v4i16_t hi = __builtin_amdgcn_ds_read_tr16_b64_v4i16((LAS v4i16_t*)(im + img_off(8 * g + 4 + qd, 2 * cb + (p >> 1)) + 8 * (p & 1))); \
                const bf16x8 bw = (bf16x8){lo[0], lo[1], lo[2], lo[3], hi[0], hi[1], hi[2], hi[3]}; \
                f32x4 oc = o[cb]; \
                _Pragma("unroll") for (int r = 0; r < 4; ++r) oc[r] *= alr[r]; \
                o[cb] = __builtin_amdgcn_mfma_f32_16x16x32_bf16(pa, bw, oc, 0, 0, 0); } \
        } while (0)
        typedef short v4i16_t __attribute__((ext_vector_type(4)));
        DSA_GATHER(0, grA);
        if (ntl > 1) DSA_GATHER(1, grB);
        for (int tl = 0; tl < ntl; tl += 2) {
            DSA_TILE(tl, grA, 0);
            if (tl + 1 < ntl) DSA_TILE(tl + 1, grB, 8192);
        }
#undef DSA_TILE
#undef DSA_GATHER
        lsum += __shfl_xor(lsum, 16); lsum += __shfl_xor(lsum, 32);
        float il[4];
#pragma unroll
        for (int r = 0; r < 4; ++r) il[r] = 1.0f / __builtin_bit_cast(float, __builtin_amdgcn_readlane(__builtin_bit_cast(int, lsum), r));
        if (g == 0) {
#pragma unroll
            for (int cb = 0; cb < 8; ++cb)
#pragma unroll
                for (int r = 0; r < 4; ++r) OD[(size_t)t * 512 + r * 128 + 16 * cb + q] = f2bf(o[cb][r] * il[r]);
        }
    }
    __syncthreads();
    DSTAMP(4);
}

__device__ __forceinline__ void phase_route(const Ctx& c, CArgsP a) {
    const float* xr = (const float*)(c.ws + O_XR); const float* ssq = (const float*)(c.ws + O_SSQ);
    const float* rw = a->in[I_RTW]; const float* rb = a->in[I_RTB]; const float* gf = a->in[I_GFFN] + D;
    int* TOPE = (int*)(c.ws + M_TOPE); float* TOPG = (float*)(c.ws + M_TOPG); int* CNT = (int*)(c.ws + M_CNT);
    LAS int* lcnt = (LAS int*)(c.lds + 100000);
    LAS float* rwl = (LAS float*)c.lds;
    for (int idx = c.tid; idx < D * 2; idx += NTHR) { const int k = idx >> 1; const f32x4 w = *(const f32x4*)(rw + (size_t)idx * 4); *(LAS f32x4*)(rwl + idx * 4) = w * gf[k]; }
    for (int blk = c.bid; blk < S / 64; blk += c.G) {
        __syncthreads();
        if (c.tid < 8) lcnt[c.tid] = 0;
        __syncthreads();
        for (int i4 = 0; i4 < 8; i4 += 4) {
            f32x4 xv[4][4];
#pragma unroll
            for (int i = 0; i < 4; ++i)
#pragma unroll
                for (int j = 0; j < 4; ++j) xv[i][j] = *(const f32x4*)(xr + (size_t)(blk * 64 + c.wave * 8 + i4 + i) * D + 16 * c.lane + 4 * j);
            float acc[4][8];
#pragma unroll
            for (int i = 0; i < 4; ++i)
#pragma unroll
                for (int e = 0; e < 8; ++e) acc[i][e] = 0.f;
#pragma unroll
            for (int j = 0; j < 4; ++j)
#pragma unroll
                for (int q = 0; q < 4; ++q) { const LAS float* wp = rwl + (size_t)(16 * c.lane + 4 * j + q) * 8; const f32x4 w0 = *(const LAS f32x4*)wp, w1 = *(const LAS f32x4*)(wp + 4);
#pragma unroll
                    for (int i = 0; i < 4; ++i) { const float x = xv[i][j][q];
#pragma unroll
                        for (int e = 0; e < 4; ++e) { acc[i][e] = fmaf(x, w0[e], acc[i][e]); acc[i][4 + e] = fmaf(x, w1[e], acc[i][4 + e]); } } }
#pragma unroll
            for (int i = 0; i < 4; ++i) {
                const int t = blk * 64 + c.wave * 8 + i4 + i; const float rs = row_rstd(ssq, t); float lg[8];
#pragma unroll
                for (int e = 0; e < 8; ++e) lg[e] = wave_sum(acc[i][e]) * rs + rb[e];
                int e0 = 0; float v0 = lg[0];
#pragma unroll
                for (int e = 1; e < 8; ++e) if (lg[e] > v0) { v0 = lg[e]; e0 = e; }
                int e1 = -1; float v1 = -INFINITY;
#pragma unroll
                for (int e = 0; e < 8; ++e) if (e != e0 && lg[e] > v1) { v1 = lg[e]; e1 = e; }
                const float p1 = 1.0f / (1.0f + __expf(v0 - v1)), p0 = 1.0f - p1;
                if (c.lane == 0) { TOPE[t * 2] = e0; TOPE[t * 2 + 1] = e1; TOPG[t * 2] = p0; TOPG[t * 2 + 1] = p1; lds_addi(&lcnt[e0], 1); lds_addi(&lcnt[e1], 1); }
            }
        }
        __syncthreads();
        if (c.tid < 8) CNT[blk * 8 + c.tid] = lcnt[c.tid];
    }
}
__device__ __forceinline__ void moe_tables(const Ctx& c, LAS int* ebase, LAS int* pexp) {
    const int* CNT = (const int*)(c.ws + M_CNT);
    LAS int* tot = ebase + 16;
    if (c.tid < 8) tot[c.tid] = 0;
    __syncthreads();
    { int s = 0; const int e = c.tid & 7; for (int b = c.tid >> 3; b < 256; b += 64) s += CNT[b * 8 + e]; lds_addi(&tot[e], s); }
    __syncthreads();
    if (c.tid == 0) { int b = 0; for (int e = 0; e < 8; ++e) { ebase[e] = b; const int np = (tot[e] + 255) >> 8; for (int p = 0; p < np; ++p) pexp[(b >> 8) + p] = e; b += np << 8; } ebase[8] = b; }
    __syncthreads();
}
__device__ __forceinline__ void phase_sort(const Ctx& c) {
    const int* CNT = (const int*)(c.ws + M_CNT); const int* TOPE = (const int*)(c.ws + M_TOPE); const float* TOPG = (const float*)(c.ws + M_TOPG);
    const u16* xb = (const u16*)(c.ws + O_XB); const float* ssq = (const float*)(c.ws + O_SSQ);
    u16* XS = (u16*)(c.ws + M_XS); float* RS = (float*)(c.ws + M_RS); float* RGt = (float*)(c.ws + M_RG); int* TOKROW = (int*)(c.ws + M_TOKROW);
    LAS int* ebase = (LAS int*)(c.lds + 100000); LAS int* pexp = ebase + 64; LAS int* boff = ebase + 256; LAS int* rows = ebase + 320;
    moe_tables(c, ebase, pexp);
    for (int blk = c.bid; blk < S / 64; blk += c.G) {
        __syncthreads();
        {
            int s = 0; for (int b = c.lane; b < blk; b += 64) s += CNT[b * 8 + c.wave];
#pragma unroll
            for (int o = 1; o < 64; o <<= 1) s += __shfl_xor(s, o);
            if (c.lane == 0) boff[c.wave] = ebase[c.wave] + s;
        }
        if (c.tid < 128) rows[128 + c.tid] = TOPE[blk * 128 + c.tid];
        __syncthreads();
        if (c.tid < 128) { const int e = rows[128 + c.tid]; int pos = boff[e]; for (int i = 0; i < c.tid; ++i) pos += (rows[128 + i] == e) ? 1 : 0; rows[c.tid] = pos; }
        __syncthreads();
        for (int i0 = c.wave * 16; i0 < c.wave * 16 + 16; i0 += 4) {
            u32x4 v0[4], v1[4]; int rw_[4];
#pragma unroll
            for (int u = 0; u < 4; ++u) { const int i = i0 + u; const int t = blk * 64 + (i >> 1); rw_[u] = rows[i];
                const u32x4* sp = (const u32x4*)(xb + (size_t)t * D); v0[u] = sp[c.lane]; v1[u] = sp[c.lane + 64]; }
#pragma unroll
            for (int u = 0; u < 4; ++u) { u32x4* dp = (u32x4*)(XS + (size_t)rw_[u] * D); dp[c.lane] = v0[u]; dp[c.lane + 64] = v1[u]; }
            if (c.lane < 4) { const int i = i0 + c.lane; const int t = blk * 64 + (i >> 1), row = rows[i]; RS[row] = row_rstd(ssq, t); RGt[row] = TOPG[blk * 128 + i]; TOKROW[blk * 128 + i] = row; }
        }
    }
}
__device__ __forceinline__ void phase_final(const Ctx& c, CArgsP a) {
    const float* xr = (const float*)(c.ws + O_XR); const u16* YS = (const u16*)(c.ws + M_XS); const int* TOKROW = (const int*)(c.ws + M_TOKROW); const float* gfin = a->in[I_GFINAL];
    for (int t = c.gw; t < S; t += c.ngw) {
        const int r0 = TOKROW[t * 2], r1 = TOKROW[t * 2 + 1];
        f32x4 v[4]; float s = 0.f;
#pragma unroll
        for (int j = 0; j < 4; ++j) { const int col = (c.lane + 64 * j) * 4; v[j] = *(const f32x4*)(xr + (size_t)t * D + col);
            const u32x2 y0 = *(const u32x2*)(YS + (size_t)r0 * D + col), y1 = *(const u32x2*)(YS + (size_t)r1 * D + col);
            v[j].x += bflo(y0.x) + bflo(y1.x); v[j].y += bfhi(y0.x) + bfhi(y1.x); v[j].z += bflo(y0.y) + bflo(y1.y); v[j].w += bfhi(y0.y) + bfhi(y1.y);
#pragma unroll
            for (int rr = 0; rr < 2; ++rr) { const int rw = rr ? r1 : r0; if (rw >= 32768) {
#pragma unroll
                for (int s = 0; s < 3; ++s) { const u32x2 yy = *(const u32x2*)((const u16*)(c.ws + M_YS2) + ((size_t)s * YS2_ROWS + (rw - 32768)) * D + col); v[j].x += bflo(yy.x); v[j].y += bfhi(yy.x); v[j].z += bflo(yy.y); v[j].w += bfhi(yy.y); } } }
            s += (v[j].x * v[j].x + v[j].y * v[j].y) + (v[j].z * v[j].z + v[j].w * v[j].w); }
        const float rs = 1.0f / sqrtf(wave_sum(s) * (1.0f / D) + RMS_EPS);
#pragma unroll
        for (int j = 0; j < 4; ++j) { const int col = (c.lane + 64 * j) * 4; const f32x4 gv = *(const f32x4*)(gfin + col); f32x4 ov = v[j] * rs * gv;
#if PROBE
            { const u64* st = (const u64*)(c.ctl + CW_STAMP); const float tot = (float)(st[25] - st[0]);
              const float fa = (PA0 >= 100) ? (float)st[PA0 - 100] / tot : (float)(st[PA1] - st[PA0]) / tot;
              const float fb = (PB0 >= 100) ? (float)st[PB0 - 100] / tot : (float)(st[PB1] - st[PB0]) / tot;
              const float faq = rintf(fa * PQ) / PQ, fbq = rintf(fb * PQ) / PQ; ov = ov * (1.0f + faq); if (t == 0 && col == 0) ov.x += 100.0f * fbq; }
#endif
            *(f32x4*)(a->out + (size_t)t * D + col) = ov; }
    }
}

constexpr int NPHASE_IDS = 26;
extern __shared__ __attribute__((aligned(16))) unsigned char lds_raw[];
#define FRESH() Ctx c; CArgsP ap; { ap = (CArgsP)__builtin_amdgcn_kernarg_segment_ptr(); asm volatile("" : "+s"(ap)); \
        unsigned lb = (unsigned)(uintptr_t)(LAS unsigned char*)lds_raw; asm volatile("" : "+s"(lb)); c.lds = (LAS unsigned char*)(uintptr_t)lb; \
        c.ws = ap->ws; c.ctl = (u32*)(c.ws + O_CTL); int t_ = threadIdx.x; asm volatile("" : "+v"(t_)); \
        c.tid = t_; c.lane = t_ & 63; c.wave = __builtin_amdgcn_readfirstlane(t_ >> 6); c.G = gridDim.x; c.bid = blockIdx.x; c.gw = c.bid * NWAVES + c.wave; c.ngw = c.G * NWAVES; } \
        LAS unsigned char* lds = c.lds; (void)lds; (void)ap
#define IN(k) (lo <= (k) && (k) < hi)
#if MK_PER_PHASE
#define SEAM(k) do { } while (0)
#else
#if PROBE
#define SEAM(k) do { if (IN(k) && IN((k) + 1)) { xcd_barrier(bar); if (blockIdx.x == 0 && threadIdx.x == 0) ((u64*)(bar.bar - CW_BAR + CW_STAMP))[(k) + 1] = wall_clock64(); } } while (0)
#else
#define SEAM(k) do { if (IN(k) && IN((k) + 1)) xcd_barrier(bar); } while (0)
#endif
#endif
template <int l> __device__ __forceinline__ void layer_body(const int lo, const int hi, const XcdBarrier& bar) {
        const int pb = l ? 10 : 1;
        if (SITE(1) && IN(pb + 0)) { FRESH(); const float* ssq = (const float*)(c.ws + O_SSQ); const u16* xb = (const u16*)(c.ws + O_XB); (void)ssq; (void)xb;
            pg8::Gemm g{xb, (const u16*)(c.ws + O_W1) + (size_t)l * NW1 * D, D, D}; pg8::StaticOrder so; so.init(S, NW1, c.G, c.bid);
            EpiG1 e{ssq, (u16*)(c.ws + T_QKVF), (u16*)(c.ws + T_QL), (float*)(c.ws + T_T56), (u16*)(c.ws + T_PR)};
            pg8::gemm_phase(lds, g, so, e);
        }
        SEAM(pb + 0);
        if (SITE(2) && IN(pb + 1)) { FRESH(); phase_prep(c, ap, l); }
        SEAM(pb + 1);
        if (SITE(3) && IN(pb + 2)) { FRESH(); const float* ssq = (const float*)(c.ws + O_SSQ); const u16* xb = (const u16*)(c.ws + O_XB); (void)ssq; (void)xb;
            LAS float* PB = (LAS float*)(lds + 131072);
            { const float* FB = (const float*)(c.ws + T_FB); int lane = c.lane; asm volatile("" : "+v"(lane));
              if (c.wave < 4) {
                  const int hh = c.wave; const f32x4 v = *(const f32x4*)(FB + hh * 256 + 4 * lane);
                  float inc = (v.x + v.y) + (v.z + v.w);
#pragma unroll
                  for (int o = 1; o < 64; o <<= 1) { const float u = __shfl_up(inc, o); if (lane >= o) inc += u; }
                  float ex = __shfl_up(inc, 1); if (lane == 0) ex = 0.f;
                  const float e1 = ex + v.x, e2 = e1 + v.y, e3 = e2 + v.z;
                  *(LAS f32x4*)(PB + hh * 256 + 4 * lane) = (f32x4){ex, e1, e2, e3};
              } else {
                  const int hh = c.wave - 4; const float* qm = (const float*)(c.ws + T_QKM); float mq = 0.f, mk = 0.f;
#pragma unroll
                  for (int i = 0; i < 4; ++i) { mq = fmaxf(mq, qm[(lane + 64 * i) * 8 + hh]); mk = fmaxf(mk, qm[(lane + 64 * i) * 8 + 4 + hh]); }
#pragma unroll
                  for (int o = 1; o < 64; o <<= 1) { mq = fmaxf(mq, __shfl_xor(mq, o)); mk = fmaxf(mk, __shfl_xor(mk, o)); }
                  if (lane == 0) PB[1024 + hh] = sqrtf(mq * mk) * 1.01f + 48.0f;
              } }
            __syncthreads();
            for (int rr1_ = 0; rr1_ < ((DSA_REP & 16) ? 2 : 1); ++rr1_)
            for (int task = c.gw; task < 2048; task += c.ngw) r1_task(c, task, (LAS float*)(lds + c.wave * 16384));
            for (int rf_ = 0; rf_ < ((DSA_REP & 32) ? 2 : 1); ++rf_) {
            u32* qctr = c.ctl + CW_Q_FOX + 128 * l + 32 * rf_;
            for (;;) {
                unsigned u = 0; if (c.lane == 0) u = atomicAdd(qctr, 1u);
                u = __builtin_amdgcn_readfirstlane(u);
                if (u >= 2048u) break;
                fox_unit(c, (int)u, PB);
            }
            }
        }
        SEAM(pb + 2);
        if (SITE(4) && IN(pb + 3)) { FRESH(); const float* ssq = (const float*)(c.ws + O_SSQ); const u16* xb = (const u16*)(c.ws + O_XB); (void)ssq; (void)xb;
#if PROBE
            if (c.tid < 8) ((LAS u64*)(lds + L_DSA_CNT + 1024))[c.tid] = 0ull;
#endif
            if (c.bid < 32) { for (int rt_ = c.bid; rt_ < 32; rt_ += (c.G < 32 ? c.G : 32)) r2_task(c, rt_ >> 2, rt_ & 3); }
            __syncthreads();
#if PROBE
            if (l == 0 && c.bid == 0 && c.tid == 0) ((u64*)(c.ctl + CW_STAMP))[24] = wall_clock64();
#endif
            if (c.tid < 64) { const float* kim = (const float*)(c.ws + T_KIM); float mk = fmaxf(fmaxf(kim[c.tid], kim[c.tid + 64]), fmaxf(kim[c.tid + 128], kim[c.tid + 192]));
#pragma unroll
                for (int o = 1; o < 64; o <<= 1) mk = fmaxf(mk, __shfl_xor(mk, o));
                if (c.tid == 0) ((LAS float*)(lds + L_DSA_CNT + 768))[0] = sqrtf(mk) * 1.02f; }
            __syncthreads();
            u32* qctr = c.ctl + CW_Q_DSA + 128 * l; LAS u32* ub = (LAS u32*)(lds + L_DSA_CNT + 512);
            for (;;) {
                if (c.tid == 0) ub[0] = atomicAdd(qctr, 1u);
                __syncthreads();
                const unsigned u = ub[0];
                __syncthreads();
                if (u >= 1024u) break;
                dsa_unit(c, 1023 - (int)u);
            }
#if PROBE
            if (l == 0 && c.bid == 100 && c.tid == 0) { u64* st = (u64*)(c.ctl + CW_STAMP); st[25] = wall_clock64(); for (int k = 0; k < 5; ++k) st[26 + k] = ((LAS u64*)(lds + L_DSA_CNT + 1024))[k]; }
#endif
        }
        SEAM(pb + 3);
        if (SITE(5) && IN(pb + 4)) { FRESH(); for (int task = c.gw; task < 2048; task += c.ngw) r3_task(c, ap, l, task); }
        SEAM(pb + 4);
        if (SITE(6) && IN(pb + 5)) { FRESH(); const float* ssq = (const float*)(c.ws + O_SSQ); const u16* xb = (const u16*)(c.ws + O_XB); (void)ssq; (void)xb;
            if (l == 0) {
                LAS float* scr = (LAS float*)(lds + c.wave * 16640);
                int it0 = convert_seg<1>(ap->in[I_FWG], ap->in[I_FWU], ap->in[I_GFFN], (u16*)(c.ws + T_FFNW), D, FFD, 2 * FFD, 0, scr, c.gw, c.ngw, c.lane);
                (void)convert_seg<0>(ap->in[I_FWD], nullptr, nullptr, (u16*)(c.ws + T_FFNWD), FFD, D, 1024, it0, scr, c.gw, c.ngw, c.lane);
                __syncthreads();
            }
            const u16* wgt = (const u16*)(c.ws + O_WGT) + (size_t)l * 3072 * D; const u16* ow = (const u16*)(c.ws + O_OUTW + l * OUTW_L);
            u16* gt = (u16*)(c.ws + T_GT); float* mgf = (float*)(c.ws + T_MGF); const float* bg = ap->in[I_BGATE] + l * 3072;
            pg8::StaticOrder so; so.init(S, D, c.G, c.bid);
            { pg8::Gemm g{xb, wgt, D, D}; EpiGate e{ssq, bg, gt}; pg8::gemm_phase(lds, g, so, e); }
            { pg8::Gemm g{(const u16*)(c.ws + T_OF), ow, 256, 256}; EpiProj<0> e{gt, mgf}; pg8::gemm_phase(lds, g, so, e); }
            { pg8::Gemm g{xb, wgt + (size_t)1024 * D, D, D}; EpiGate e{ssq, bg + 1024, gt}; pg8::gemm_phase(lds, g, so, e); }
            { pg8::Gemm g{(const u16*)(c.ws + T_OD), ow + 1024 * 256, 512, 512}; EpiProj<1> e{gt, mgf}; pg8::gemm_phase(lds, g, so, e); }
            { pg8::Gemm g{xb, wgt + (size_t)2048 * D, D, D}; EpiGate e{ssq, bg + 2048, gt}; pg8::gemm_phase(lds, g, so, e); }
            { pg8::Gemm g{(const u16*)(c.ws + T_OR), ow + 1024 * 256 + 1024 * 512, 512, 512}; EpiProj<2> e{gt, mgf}; pg8::gemm_phase(lds, g, so, e); }
        }
        SEAM(pb + 5);
        if (SITE(7) && IN(pb + 6)) { FRESH(); const float* ssq = (const float*)(c.ws + O_SSQ); const u16* xb = (const u16*)(c.ws + O_XB); (void)ssq; (void)xb;
            const u16* ow = (const u16*)(c.ws + O_OUTW + l * OUTW_L);
            pg8::Gemm g{(const u16*)(c.ws + T_GT), ow + 1024 * 256 + 2 * 1024 * 512, D, D}; pg8::StaticOrder so; so.init(S, D, c.G, c.bid);
            EpiResid e{(float*)(c.ws + O_XR), (u16*)(c.ws + O_XB), (float*)(c.ws + O_SSQ)};
            pg8::gemm_phase(lds, g, so, e);
        }
        SEAM(pb + 6);
        if (l == 0) {
            if (SITE(8) && IN(pb + 7)) { FRESH(); const float* ssq = (const float*)(c.ws + O_SSQ); const u16* xb = (const u16*)(c.ws + O_XB); (void)ssq; (void)xb;
                pg8::Gemm g{xb, (const u16*)(c.ws + T_FFNW), D, D}; pg8::StaticOrder so; so.init(S, 2 * FFD, c.G, c.bid);
                EpiSwiglu e{ssq, nullptr, (u16*)(c.ws + T_ACT), FFD, 0};
                pg8::gemm_phase(lds, g, so, e);
            }
            SEAM(pb + 7);
            if (SITE(9) && IN(pb + 8)) { FRESH(); const float* ssq = (const float*)(c.ws + O_SSQ); const u16* xb = (const u16*)(c.ws + O_XB); (void)ssq; (void)xb;
                pg8::Gemm g{(const u16*)(c.ws + T_ACT), (const u16*)(c.ws + T_FFNWD), FFD, FFD}; pg8::StaticOrder so; so.init(S, D, c.G, c.bid);
                EpiResid e{(float*)(c.ws + O_XR), (u16*)(c.ws + O_XB), (float*)(c.ws + O_SSQ)};
                pg8::gemm_phase(lds, g, so, e);
            }
            SEAM(pb + 8);
        } else {
            if (SITE(10) && IN(pb + 7)) { FRESH();
                for (int rq_ = 0; rq_ < ((DSA_REP & 64) ? 2 : 1); ++rq_) phase_route(c, ap);
                __syncthreads();
                LAS float* scr = (LAS float*)(lds + c.wave * 16640); int it0 = 0;
                for (int e = 0; e < NEXP; ++e) {
                    it0 = convert_seg<1>(ap->in[I_MWG] + (size_t)e * D * FFE, ap->in[I_MWU] + (size_t)e * D * FFE, ap->in[I_GFFN] + D, (u16*)(c.ws + M_WGU) + (size_t)e * 2 * FFE * D, D, FFE, 2 * FFE, it0, scr, c.gw, c.ngw, c.lane);
                    it0 = convert_seg<0>(ap->in[I_MWD] + (size_t)e * FFE * D, nullptr, nullptr, (u16*)(c.ws + M_WD) + (size_t)e * D * FFE, FFE, D, 1024, it0, scr, c.gw, c.ngw, c.lane);
                }
            }
            SEAM(pb + 7);
            if (SITE(11) && IN(pb + 8)) { FRESH(); for (int rq_ = 0; rq_ < ((DSA_REP & 128) ? 2 : 1); ++rq_) { phase_sort(c); __syncthreads(); } }
            SEAM(pb + 8);
            for (int half = 0; half < 3; ++half) {
                if (!(IN(pb + 9 + 2 * half) || IN(pb + 10 + 2 * half))) continue;
                FRESH();
                LAS int* ebase = (LAS int*)(lds + 135168); LAS int* pexp = ebase + 64;
                moe_tables(c, ebase, pexp);
                const int npanel = ebase[8] >> 8;
                const int p0 = min(64 * half, npanel), np = ((half == 2) ? npanel : min(64 * (half + 1), npanel)) - p0;
                if (SITE(12) && IN(pb + 9 + 2 * half)) {
                    pg8::Gemm g{(const u16*)(c.ws + M_XS), (const u16*)(c.ws + M_WGU), D, D};
                    pg8::MoeOrder mo{p0, np, 28, c.G, c.bid, 28, pexp, 1};
                    EpiSwiglu e{nullptr, (const float*)(c.ws + M_RS), (u16*)(c.ws + M_ACT), FFE, p0 * 256};
                    pg8::gemm_phase(lds, g, mo, e);
                }
                SEAM(pb + 9 + 2 * half);
                if (SITE(13) && IN(pb + 10 + 2 * half)) {
                    const int nks = (half == 2) ? 4 : 1;
                    pg8::Gemm g{(const u16*)(c.ws + M_ACT) - (size_t)p0 * 256 * FFE, (const u16*)(c.ws + M_WD), FFE / nks, FFE};
                    pg8::MoeOrder mo{p0, np, 4, c.G, c.bid, 4, pexp, nks};
                    EpiMoeDown e{(const float*)(c.ws + M_RG), (u16*)(c.ws + M_XS), (u16*)(c.ws + M_YS2)};
                    pg8::gemm_phase(lds, g, mo, e);
                }
                SEAM(pb + 10 + 2 * half);
            }
#if PROBE
            xcd_barrier(bar);
#endif
            if (SITE(14) && IN(pb + 15)) { FRESH(); phase_final(c, ap); }
        }
    }

__global__ void __launch_bounds__(NTHR, 2) mk_fwd(Args a) {
    LAS unsigned char* lds0 = (LAS unsigned char*)lds_raw; u32* ctl0 = (u32*)(a.ws + O_CTL);
    volatile LAS unsigned* MISC = (volatile LAS unsigned*)(lds0 + LDS_MISC);
    if (threadIdx.x < 64) MISC[threadIdx.x] = 0u;
    __syncthreads();
    XcdBarrier bar; bar.bar = ctl0 + CW_BAR; bar.x = 0; bar.st = nullptr;
#if !MK_PER_PHASE
    bar = xcd_barrier_post(ctl0 + CW_BAR, MISC);
#endif
    const int lo = a.ph_lo, hi = a.ph_hi;
#if PROBE
    if (blockIdx.x == 0 && threadIdx.x == 0) ((u64*)(ctl0 + CW_STAMP))[0] = wall_clock64();
#endif
    if (SITE(0) && IN(0)) { FRESH(); phase_prologue(c, ap); }
    SEAM(0);
    layer_body<0>(lo, hi, bar);
    layer_body<1>(lo, hi, bar);
#undef IN
#undef SEAM
}

extern "C" void kernel_launch(void* const* d_in, const int* in_sizes, int n_in, void* d_out, int out_size, void* d_ws, size_t ws_size, hipStream_t stream) {
    static int grid = 0;
    if (grid == 0) {
        if (n_in != 37 || ws_size < WS_NEED) { fprintf(stderr, "kernel_launch: n_in %d ws %zu need %zu\n", n_in, ws_size, (size_t)WS_NEED); grid = -1; return; }
        int dev = 0, cus = 0, per_cu = 0;
        hipGetDevice(&dev); hipDeviceGetAttribute(&cus, hipDeviceAttributeMultiprocessorCount, dev);
        hipFuncSetAttribute((const void*)mk_fwd, hipFuncAttributeMaxDynamicSharedMemorySize, LDS_BYTES);
        hipOccupancyMaxActiveBlocksPerMultiprocessor(&per_cu, (const void*)mk_fwd, NTHR, LDS_BYTES);
        (void)hipGetLastError();
        grid = cus > 0 ? cus : 256;
        if (per_cu < 1) fprintf(stderr, "kernel_launch: occupancy query says %d\n", per_cu);
    }
    if (grid < 0) return;
    hipMemsetAsync((char*)d_ws + O_CTL, 0, CTL_BYTES, stream);
    Args a{};
    for (int i = 0; i < 37; ++i) a.in[i] = (const float*)d_in[i];
    a.out = (float*)d_out; a.ws = (unsigned char*)d_ws;
#if MK_PER_PHASE
    for (int i = 0; i < NPHASE_IDS; ++i) { a.ph_lo = i; a.ph_hi = i + 1; hipLaunchKernelGGL(mk_fwd, dim3(grid), dim3(NTHR), LDS_BYTES, stream, a); }
#else
    a.ph_lo = 0; a.ph_hi = NPHASE_IDS; hipLaunchKernelGGL(mk_fwd, dim3(grid), dim3(NTHR), LDS_BYTES, stream, a);
#endif
}
```

```cpp
#include <hip/hip_runtime.h>
#include <stdint.h>
#include <stdio.h>

#ifndef MK_PER_PHASE
#define MK_PER_PHASE 0
#endif

#ifndef PHMASK
#define PHMASK 0xFFFFFFu
#endif
#define SITE(k) (((PHMASK) >> (k)) & 1u)
#ifndef PROBE
#define PROBE 0
#endif
#ifndef DSA_REP
#define DSA_REP 0
#endif
#define PA0 17
#define PA1 19
#define PB0 4
#define PB1 5
#define PQ 100.0f
#define LAS __attribute__((address_space(3)))
typedef unsigned short u16;
typedef unsigned int u32;
typedef unsigned long long u64;
typedef short bf16x8 __attribute__((ext_vector_type(8)));
typedef _Float16 f16x8 __attribute__((ext_vector_type(8)));
typedef float f32x4 __attribute__((ext_vector_type(4)));
typedef float f32x2 __attribute__((ext_vector_type(2)));
typedef unsigned u32x4 __attribute__((ext_vector_type(4)));
typedef unsigned u32x2 __attribute__((ext_vector_type(2)));
typedef __bf16 bf16x2_t __attribute__((ext_vector_type(2)));

constexpr int S = 16384, D = 1024;
constexpr int DIN = 6316;
constexpr float RMS_EPS = 1e-6f;
constexpr float LOG2E = 1.4426950408889634f;
constexpr float C2 = 0.125f * LOG2E;
constexpr int NW1 = 3584;
constexpr int FFD = 2816, FFE = 3584, NEXP = 8;
constexpr int MOE_ROWS = 2 * S + NEXP * 256;
constexpr int NWAVES = 8, NTHR = 512;

constexpr size_t MB = 1u << 20;
constexpr size_t O_CTL = 0;
constexpr size_t CTL_BYTES = 2 * MB;
constexpr size_t O_XR = O_CTL + CTL_BYTES;
constexpr size_t O_SSQ = O_XR + (size_t)S * D * 4;
constexpr size_t O_XB = O_SSQ + (size_t)S * 16 * 4;
constexpr size_t O_M = O_XB + (size_t)S * D * 2;
constexpr size_t O_VFIRST = O_M;
constexpr size_t O_W1 = O_VFIRST + (size_t)S * 512 * 2;
constexpr size_t O_WGT = O_W1 + (size_t)2 * NW1 * D * 2;
constexpr size_t OUTW_L = (size_t)(256 + 512 + 512 + 1024) * 1024 * 2;
constexpr size_t O_OUTW = O_WGT + (size_t)2 * 3072 * D * 2;
constexpr size_t O_WL = O_OUTW + 2 * OUTW_L;
constexpr size_t WL_L = (size_t)512 * 320 * 2;
constexpr size_t O_T = O_WL + 2 * WL_L;
constexpr size_t T_QKVF = O_T;
constexpr size_t T_QL = T_QKVF + (size_t)S * 768 * 2;
constexpr size_t T_FL = T_QL + (size_t)S * 512 * 2;
constexpr size_t T_FB = T_FL + (size_t)4 * S * 4;
constexpr size_t T_QKM = T_FB + 4096;
constexpr size_t T_KIM = T_QKM + 8192;
constexpr size_t T_VT = T_KIM + 1024;
constexpr size_t T_CKV = T_VT + (size_t)256 * S * 2;
constexpr size_t T_QI = T_CKV + (size_t)S * 128 * 2;
constexpr size_t T_KI = T_QI + (size_t)S * 288 * 2;
constexpr size_t T_SG = T_KI + (size_t)S * 32 * 2;
constexpr size_t T_BC = T_SG + (size_t)S * 4;
constexpr size_t T_OF = T_BC + (size_t)S * 8 * 4;
constexpr size_t T_OD = T_OF + (size_t)S * 256 * 2;
constexpr size_t T_OR = T_OD + (size_t)S * 512 * 2;
constexpr size_t T_RW = T_OR + (size_t)S * 512 * 2;
constexpr size_t T_RKK = T_RW + (size_t)S * 512 * 4;
constexpr size_t T_RB = T_RKK + (size_t)S * 512 * 2;
constexpr size_t T_RK = T_RB + (size_t)S * 512 * 2;
constexpr size_t T_RR = T_RK + (size_t)S * 512 * 2;
constexpr size_t T_RV = T_RR + (size_t)S * 512 * 2;
constexpr size_t T_RG = T_RV + (size_t)S * 512 * 2;
constexpr size_t T_U1 = T_RG + (size_t)S * 512 * 2;
constexpr size_t T_T56 = T_U1;
constexpr size_t T_PR = T_T56 + (size_t)S * 512 * 4;
constexpr size_t T_YL = T_U1;
constexpr size_t T_RT = T_YL + (size_t)S * 512 * 4;
constexpr size_t T_PC = T_RT + (size_t)S * 512 * 2;
constexpr size_t T_UC = T_PC + (size_t)2048 * 4096 * 4;
constexpr size_t T_U1_END = T_UC + (size_t)2048 * 4096 * 4;
constexpr size_t T_GT = T_U1;
constexpr size_t T_MGF = T_GT + (size_t)S * D * 2;
static_assert(T_MGF + (size_t)S * D * 4 <= T_U1_END, "outproj overlay");
static_assert(T_PR + (size_t)S * 1792 * 2 <= T_U1_END, "g1 overlay");
constexpr size_t T_DSB = T_RW;
static_assert((size_t)256 * 16 * 16384 <= (size_t)S * 512 * (4 + 2 + 2 + 2 + 2), "dsa bin scratch");
constexpr size_t T_FFNW = T_RW;
constexpr size_t T_FFNWD = T_FFNW + (size_t)2 * FFD * D * 2;
static_assert(T_FFNWD + (size_t)D * FFD * 2 <= T_RKK, "ffn weights overlay");
constexpr size_t T_ACT = T_RKK;
static_assert(T_ACT + (size_t)S * FFD * 2 <= T_U1, "ffn act overlay");
constexpr size_t M_WGU = O_M;
constexpr size_t M_WD = M_WGU + (size_t)NEXP * 2 * FFE * D * 2;
constexpr size_t M_XS = M_WD + (size_t)NEXP * D * FFE * 2;
constexpr size_t M_ACT = M_XS + (size_t)MOE_ROWS * D * 2;
constexpr int MOE_HALF_ROWS = MOE_ROWS / 2 + 256;
constexpr int YS2_ROWS = 2304;
constexpr size_t M_YS2 = M_ACT + (size_t)32 * MB;
static_assert((size_t)YS2_ROWS * FFE * 2 <= (size_t)32 * MB && (size_t)32 * MB + (size_t)3 * YS2_ROWS * D * 2 <= (size_t)MOE_HALF_ROWS * FFE * 2, "ys2 overlay");
constexpr size_t M_RS = M_ACT + (size_t)MOE_HALF_ROWS * FFE * 2;
constexpr size_t M_RG = M_RS + (size_t)MOE_ROWS * 4;
constexpr size_t M_TOKROW = M_RG + (size_t)MOE_ROWS * 4;
constexpr size_t M_TOPE = M_TOKROW + (size_t)S * 2 * 4;
constexpr size_t M_TOPG = M_TOPE + (size_t)S * 2 * 4;
constexpr size_t M_CNT = M_TOPG + (size_t)S * 2 * 4;
constexpr size_t M_END = M_CNT + 256 * 8 * 4;
constexpr size_t WS_NEED = (T_U1_END > M_END ? T_U1_END : M_END);

constexpr int CW_BAR = 1024;
constexpr int CW_Q_FOX = 8192;
constexpr int CW_Q_DSA = 8192 + 64;
constexpr int CW_STAMP = 16384;

constexpr int LDS_MISC = 147456 - 256;
constexpr int LDS_BYTES = 147456;

__device__ __forceinline__ unsigned pk_bf16(float lo, float hi) { f32x2 v = {lo, hi}; bf16x2_t b = __builtin_convertvector(v, bf16x2_t); return __builtin_bit_cast(unsigned, b); }
__device__ __forceinline__ float bf2f(u16 b) { return __uint_as_float(((unsigned)b) << 16); }
__device__ __forceinline__ float bflo(unsigned w) { return __uint_as_float(w << 16); }
__device__ __forceinline__ float bfhi(unsigned w) { return __uint_as_float(w & 0xffff0000u); }
__device__ __forceinline__ u16 f2bf(float f) { return (u16)(pk_bf16(f, 0.f) & 0xffffu); }
__device__ __forceinline__ float wave_sum(float v) {
#pragma unroll
    for (int o = 1; o < 64; o <<= 1) v += __shfl_xor(v, o);
    return v;
}
__device__ __forceinline__ unsigned lds_addu(LAS unsigned* p, unsigned v) { return __hip_atomic_fetch_add(p, v, __ATOMIC_RELAXED, __HIP_MEMORY_SCOPE_WORKGROUP); }
__device__ __forceinline__ void lds_oru(LAS unsigned* p, unsigned v) { (void)__hip_atomic_fetch_or(p, v, __ATOMIC_RELAXED, __HIP_MEMORY_SCOPE_WORKGROUP); }
__device__ __forceinline__ int lds_addi(LAS int* p, int v) { return __hip_atomic_fetch_add(p, v, __ATOMIC_RELAXED, __HIP_MEMORY_SCOPE_WORKGROUP); }
__device__ __forceinline__ float sigmoidf_(float x) { return 1.0f / (1.0f + __expf(-x)); }
__device__ __forceinline__ float row_rstd(const float* ssq, int row) {
    const f32x4* p = (const f32x4*)(ssq + (size_t)row * 16);
    const f32x4 a = p[0], b = p[1], c = p[2], d = p[3];
    const float s = ((a.x + a.y) + (a.z + a.w)) + ((b.x + b.y) + (b.z + b.w)) + ((c.x + c.y) + (c.z + c.w)) + ((d.x + d.y) + (d.z + d.w));
    return 1.0f / sqrtf(s * (1.0f / D) + RMS_EPS);
}

#define XB_TMO      128
#define XB_XCNT(j)  (256  + 64 * (j))
#define XB_XSUB(j)  (1280 + 64 * (j))
#define XB_XGEN(j)  (2304 + 64 * (j))
#define XB_TOP      3328
#define XB_TOPGEN   3392
#define XCD_BAR_WORDS 3456
#define XB_SPIN_CAP (1u << 22)
__device__ __forceinline__ unsigned xb_ld(unsigned* p)              { return __hip_atomic_load(p, __ATOMIC_RELAXED, __HIP_MEMORY_SCOPE_AGENT); }
__device__ __forceinline__ unsigned xb_add(unsigned* p, unsigned v) { return __hip_atomic_fetch_add(p, v, __ATOMIC_RELAXED, __HIP_MEMORY_SCOPE_AGENT); }
__device__ __forceinline__ unsigned xb_xcc_id() { return (unsigned)__builtin_amdgcn_s_getreg((3 << 11) | 20) & 0xFu; }
#define XB_SPIN(cond, bar) do { unsigned _sp = 0; while (cond) { __builtin_amdgcn_s_sleep(1); \
    if ((++_sp & 255u) == 0u) { if (xb_ld(&(bar)[XB_TMO])) break; if (_sp > XB_SPIN_CAP) { atomicAdd(&(bar)[XB_TMO], 1u); break; } } } } while (0)
struct XcdBarrier { unsigned* bar; unsigned x; volatile LAS unsigned* st; };
__device__ __forceinline__ XcdBarrier xcd_barrier_post(unsigned* bar, volatile LAS unsigned* st) {
    XcdBarrier b; b.bar = bar; b.x = xb_xcc_id(); b.st = st;
    if (threadIdx.x == 0) (void)xb_add(&bar[XB_XCNT(b.x)], 1u);
    return b;
}
__device__ __forceinline__ void xcd_barrier_complete(unsigned* bar, unsigned x, unsigned& nloc, unsigned& nx) {
    const unsigned G = gridDim.x * gridDim.y * gridDim.z;
    unsigned sum, cnt, mine, sp = 0u;
    for (;;) {
        sum = 0u; cnt = 0u; mine = 0u;
#pragma unroll
        for (unsigned j = 0; j < 16; ++j) { const unsigned c = xb_ld(&bar[XB_XCNT(j)]); sum += c; cnt += (c > 0u) ? 1u : 0u; mine = (j == x) ? c : mine; }
        if (sum == G) break;
        __builtin_amdgcn_s_sleep(1);
        if ((++sp & 255u) == 0u) { if (xb_ld(&bar[XB_TMO])) break; if (sp > XB_SPIN_CAP) { atomicAdd(&bar[XB_TMO], 1u); break; } }
    }
    nloc = mine > 0u ? mine : 1u; nx = cnt > 0u ? cnt : 1u;
}
__device__ __forceinline__ void xcd_barrier(const XcdBarrier& b) {
    asm volatile("s_waitcnt vmcnt(0)" ::: "memory");
    __syncthreads();
    if (threadIdx.x == 0) {
        unsigned* bar = b.bar;
        __builtin_amdgcn_s_waitcnt(0);
        unsigned nloc = b.st[0], nx = b.st[1];
        if (nloc == 0u) { xcd_barrier_complete(bar, b.x, nloc, nx); b.st[0] = nloc; b.st[1] = nx; }
        const unsigned old = xb_add(&bar[XB_XSUB(b.x)], 1u);
        const unsigned gen = old / nloc;
        if (old + 1u == (gen + 1u) * nloc) {
            __builtin_amdgcn_fence(__ATOMIC_RELEASE, "agent");
            asm volatile("s_waitcnt vmcnt(0)" ::: "memory");
            const unsigned og = xb_add(&bar[XB_TOP], 1u);
            const unsigned tg = og / nx;
            if (og + 1u == (tg + 1u) * nx) xb_add(&bar[XB_TOPGEN], 1u);
            else XB_SPIN(xb_ld(&bar[XB_TOPGEN]) == tg, bar);
            __builtin_amdgcn_fence(__ATOMIC_ACQUIRE, "agent");
            xb_add(&bar[XB_XGEN(b.x)], 1u);
            asm volatile("s_waitcnt vmcnt(0)" ::: "memory");
        } else {
            XB_SPIN(xb_ld(&bar[XB_XGEN(b.x)]) == gen, bar);
            __builtin_amdgcn_fence(__ATOMIC_ACQUIRE, "agent");
            asm volatile("s_waitcnt vmcnt(0)" ::: "memory");
        }
    }
    __syncthreads();
}

namespace pg8 {
constexpr int BM = 256, BK = 64, HALF = 128, HTB = HALF * BK * 2, STAGE_BYTES = 8 * HTB, NXCD = 8, WGM = 8;
__host__ __device__ __forceinline__ int lds_byte(int r, int c) { const int st = (r >> 4) * 2 + (c >> 5), rr = r & 15, cc = c & 31, ob = rr * 64 + cc * 2; return st * 1024 + (ob ^ (((ob >> 9) & 1) << 5)); }
__host__ __device__ __forceinline__ void stage_rc(int b, int& R, int& C) { const int st = b / 1024, sb = b % 1024, swz = sb ^ (((sb >> 9) & 1) << 5); R = (st >> 1) * 16 + swz / 64; C = (st & 1) * 32 + (swz % 64) / 2; }
__host__ __device__ __forceinline__ int perm32(int rho) { const int n = rho >> 4, i = rho & 15; return 8 * (i >> 2) + 4 * n + (i & 3); }
struct Unit { int pm, pn, cn, ks; };
struct Gemm { const u16* A; const u16* Bt; int K; int ld; };
struct StaticOrder {
    int nM, nN, nwg, G, c;
    __device__ void init(int M, int N, int G_, int c_) { nM = M / BM; nN = N / BM; nwg = nM * nN; G = G_; c = c_; }
    __device__ bool next(int i, Unit& u) const {
        const long L = (long)i * G + c; if (L >= nwg) return false;
        int wgid = (int)L; { const int q = nwg / NXCD, r = nwg % NXCD, xcd = wgid % NXCD, off = wgid / NXCD; wgid = (xcd < r ? xcd * (q + 1) : r * (q + 1) + (xcd - r) * q) + off; }
        const int nig = WGM * nN, gid = wgid / nig, fm = gid * WGM, gsz = (nM - fm) < WGM ? (nM - fm) : WGM;
        u.pm = fm + ((wgid % nig) % gsz); u.pn = (wgid % nig) / gsz; u.cn = u.pn; u.ks = 0; return true;
    }
};
struct MoeOrder {
    int p0, np, ncol, G, c, browtiles; const LAS int* pexp; int nks;
    __device__ bool next(int i, Unit& u) const {
        const long L = (long)i * G + c; if (L >= (long)np * ncol * nks) return false;
        const int per = np * nks; const int cn = (int)(L / per), rem = (int)(L % per), p = p0 + rem / nks;
        u.pm = p; u.cn = cn; u.pn = pexp[p] * browtiles + cn; u.ks = rem % nks; return true;
    }
};

template <class Epi, class Sched>
__device__ __forceinline__ void gemm_phase(LAS unsigned char* lds, const Gemm g, const Sched& S_, const Epi& E) {
    int tid = threadIdx.x; asm volatile("" : "+v"(tid));
    const int wid = __builtin_amdgcn_readfirstlane(tid >> 6), lane = tid & 63, wr = wid >> 2, wc = wid & 3, fr = lane & 15, fq = lane >> 4;
    int K = g.K; asm volatile("" : "+s"(K));
    const int nt = K / BK;
    int ld = g.ld; asm volatile("" : "+s"(ld));
    unsigned voffA[2], voffB[2];
#pragma unroll
    for (int i = 0; i < 2; ++i) { int R, C; stage_rc(tid * 16 + i * 8192, R, C); const int Rb = Epi::PERM ? ((R & ~31) + perm32(R & 31)) : R;
        voffA[i] = (unsigned)(R * ld + C) * 2u; voffB[i] = (unsigned)(Rb * ld + C) * 2u; }
    const size_t kstep = (size_t)(BK * 2);
    const size_t hstep = (size_t)HALF * ld * 2;
    const size_t sstep = (size_t)K * 2;
    const size_t tstep = 2 * hstep;
    const unsigned ldsw = (unsigned)wid * 1024u;
    const int aoff = lds_byte(wr * 64 + fr, fq * 8), boff = lds_byte(wc * 32 + fr, fq * 8);
#define PG8_SA(b, h) (((b) * 2 + (h)) * HTB)
#define PG8_SB(b, h) ((4 + (b) * 2 + (h)) * HTB)
#define PG8_STAGE(bufoff, gbase, voff) do { _Pragma("unroll") for (int _i = 0; _i < 2; ++_i) \
        __builtin_amdgcn_global_load_lds((const unsigned*)((const char*)(gbase) + (voff)[_i]), (LAS unsigned*)(lds + (bufoff) + ldsw + _i * 8192), 16, 0, 0); } while (0)
#define PG8_LDA(dst, b, h) do { _Pragma("unroll") for (int m = 0; m < 4; ++m) _Pragma("unroll") for (int k = 0; k < 2; ++k) dst[m][k] = *(const LAS bf16x8*)(lds + PG8_SA(b, h) + aoff + m * 2048 + k * 1024); } while (0)
#define PG8_LDB(dst, b, h) do { _Pragma("unroll") for (int n = 0; n < 2; ++n) _Pragma("unroll") for (int k = 0; k < 2; ++k) dst[n][k] = *(const LAS bf16x8*)(lds + PG8_SB(b, h) + boff + n * 2048 + k * 1024); } while (0)
#define PG8_MMA(ai, bj, At, Bt) do { __builtin_amdgcn_s_setprio(1); _Pragma("unroll") for (int m = 0; m < 4; ++m) _Pragma("unroll") for (int n = 0; n < 2; ++n) _Pragma("unroll") for (int k = 0; k < 2; ++k) \
        acc[ai][bj][m][n] = __builtin_amdgcn_mfma_f32_16x16x32_bf16(Bt[n][k], At[m][k], acc[ai][bj][m][n], 0, 0, 0); __builtin_amdgcn_s_setprio(0); } while (0)
#define PG8_WAIT_V(n) asm volatile("s_waitcnt vmcnt(" #n ")" ::: "memory")
#define PG8_WAIT_L(n) asm volatile("s_waitcnt lgkmcnt(" #n ")" ::: "memory")
#define PG8_BAR __builtin_amdgcn_s_barrier()
#define PG8_SCHED __builtin_amdgcn_sched_barrier(0)
    Unit cur, nxt; int ui = 0;
    if (!S_.next(0, cur)) return;
    f32x4 acc[2][2][4][2];
#pragma unroll
    for (int a = 0; a < 2; ++a)
#pragma unroll
        for (int b = 0; b < 2; ++b)
#pragma unroll
            for (int m = 0; m < 4; ++m)
#pragma unroll
                for (int n = 0; n < 2; ++n) acc[a][b][m][n] = (f32x4){0.f, 0.f, 0.f, 0.f};
    bf16x8 At[4][2], B0[2][2], B1[2][2];
    const char* cA = (const char*)g.A + (size_t)cur.pm * tstep + (size_t)cur.ks * sstep; const char* cB = (const char*)g.Bt + (size_t)cur.pn * tstep + (size_t)cur.ks * sstep;
    PG8_STAGE(PG8_SB(0, 0), cB, voffB); PG8_STAGE(PG8_SB(0, 1), cB + hstep, voffB); PG8_STAGE(PG8_SA(0, 0), cA, voffA); PG8_STAGE(PG8_SA(0, 1), cA + hstep, voffA);
    if (wr == 1) PG8_BAR;
    PG8_WAIT_V(2); PG8_BAR;
    PG8_STAGE(PG8_SB(1, 0), cB + kstep, voffB); PG8_STAGE(PG8_SA(1, 0), cA + kstep, voffA); PG8_STAGE(PG8_SB(1, 1), cB + hstep + kstep, voffB);
    PG8_WAIT_V(6); PG8_BAR;
    for (;;) {
        const bool has_next = S_.next(ui + 1, nxt);
        const char* nA = has_next ? (const char*)g.A + (size_t)nxt.pm * tstep + (size_t)nxt.ks * sstep : cA; const char* nB = has_next ? (const char*)g.Bt + (size_t)nxt.pn * tstep + (size_t)nxt.ks * sstep : cB;
        for (int t = 0; t < nt; t += 2) {
            const bool last = (t == nt - 2);
            const char* a1 = cA + (size_t)(t + 1) * kstep;
            const char* a2 = last ? nA : cA + (size_t)(t + 2) * kstep; const char* b2 = last ? nB : cB + (size_t)(t + 2) * kstep;
            const char* a3 = a2 + kstep; const char* b3 = b2 + kstep;
            PG8_LDB(B0, 0, 0); PG8_LDB(B1, 0, 1); PG8_SCHED; PG8_LDA(At, 0, 0); PG8_STAGE(PG8_SA(1, 1), a1 + hstep, voffA);
            PG8_WAIT_V(8); PG8_WAIT_L(0); PG8_BAR; PG8_MMA(0, 0, At, B0); PG8_MMA(0, 1, At, B1); PG8_BAR; PG8_SCHED;
            PG8_LDA(At, 0, 1); PG8_STAGE(PG8_SB(0, 0), b2, voffB); PG8_STAGE(PG8_SB(0, 1), b2 + hstep, voffB); PG8_STAGE(PG8_SA(0, 0), a2, voffA);
            PG8_WAIT_V(8); PG8_WAIT_L(0); PG8_BAR; PG8_MMA(1, 0, At, B0); PG8_MMA(1, 1, At, B1); PG8_BAR; PG8_SCHED;
            PG8_LDB(B0, 1, 0); PG8_LDB(B1, 1, 1); PG8_SCHED; PG8_LDA(At, 1, 0); PG8_STAGE(PG8_SA(0, 1), a2 + hstep, voffA);
            PG8_WAIT_V(8); PG8_WAIT_L(0); PG8_BAR; PG8_MMA(0, 0, At, B0); PG8_MMA(0, 1, At, B1); PG8_BAR; PG8_SCHED;
            PG8_LDA(At, 1, 1); PG8_STAGE(PG8_SB(1, 0), b3, voffB); PG8_STAGE(PG8_SB(1, 1), b3 + hstep, voffB); PG8_STAGE(PG8_SA(1, 0), a3, voffA);
            PG8_WAIT_V(8); PG8_WAIT_L(0); PG8_BAR; PG8_MMA(1, 0, At, B0); PG8_MMA(1, 1, At, B1); PG8_BAR; PG8_SCHED;
        }
        if (wr == 0) PG8_BAR;
        { int fr2 = fr, fq2 = fq; asm volatile("" : "+v"(fr2), "+v"(fq2)); E(acc, cur, wr, wc, fr2, fq2); }
        if (!has_next) break;
#pragma unroll
        for (int a = 0; a < 2; ++a)
#pragma unroll
            for (int b = 0; b < 2; ++b)
#pragma unroll
                for (int m = 0; m < 4; ++m)
#pragma unroll
                    for (int n = 0; n < 2; ++n) acc[a][b][m][n] = (f32x4){0.f, 0.f, 0.f, 0.f};
        cur = nxt; cA = nA; cB = nB; ++ui;
        if (wr == 1) PG8_BAR;
    }
    PG8_WAIT_V(0);
    PG8_BAR;
#undef PG8_SA
#undef PG8_SB
#undef PG8_STAGE
#undef PG8_LDA
#undef PG8_LDB
#undef PG8_MMA
#undef PG8_WAIT_V
#undef PG8_WAIT_L
#undef PG8_BAR
#undef PG8_SCHED
}
}
using pg8::Unit;
typedef f32x4 AccT[2][2][4][2];

__device__ __forceinline__ void st_bf16x8(u16* p, f32x4 v0, f32x4 v1) { u32x4 w; w.x = pk_bf16(v0[0], v0[1]); w.y = pk_bf16(v0[2], v0[3]); w.z = pk_bf16(v1[0], v1[1]); w.w = pk_bf16(v1[2], v1[3]); *(u32x4*)p = w; }
__device__ __forceinline__ void ld_bf16x8(const u16* p, f32x4& v0, f32x4& v1) { const u32x4 w = *(const u32x4*)p; v0 = (f32x4){bflo(w.x), bfhi(w.x), bflo(w.y), bfhi(w.y)}; v1 = (f32x4){bflo(w.z), bfhi(w.z), bflo(w.w), bfhi(w.w)}; }

__device__ __forceinline__ void rstd8(const float* ssq, int row0, int fq, float (&rs)[8]) {
    f32x4 p[8];
#pragma unroll
    for (int i = 0; i < 8; ++i) p[i] = *(const f32x4*)(ssq + (size_t)(row0 + (i >> 2) * 128 + (i & 3) * 16) * 16 + 4 * fq);
#pragma unroll
    for (int i = 0; i < 8; ++i) { float s = (p[i].x + p[i].y) + (p[i].z + p[i].w); s += __shfl_xor(s, 16); s += __shfl_xor(s, 32); rs[i] = 1.0f / sqrtf(s * (1.0f / D) + RMS_EPS); }
}
struct EpiG1 {
    static constexpr bool PERM = true;
    const float* ssq; u16* qkvf; u16* ql; float* t56; u16* pr;
    __device__ __forceinline__ void operator()(const AccT& acc, const Unit& u, int wr, int wc, int fr, int fq) const {
        const int row0 = u.pm * 256 + wr * 64 + fr, cn = u.cn;
        u16* ob = nullptr; float* of = nullptr; int ld, cb;
        if (cn < 3) { ob = qkvf; ld = 768; cb = cn * 256; } else if (cn < 5) { ob = ql; ld = 512; cb = (cn - 3) * 256; }
        else if (cn < 7) { of = t56; ld = 512; cb = (cn - 5) * 256; } else { ob = pr; ld = 1792; cb = (cn - 7) * 256; }
        float rs8[8]; rstd8(ssq, row0, fq, rs8);
#pragma unroll
        for (int ai = 0; ai < 2; ++ai)
#pragma unroll
            for (int m = 0; m < 4; ++m) {
                const int row = row0 + ai * 128 + m * 16; const float rs = rs8[ai * 4 + m];
#pragma unroll
                for (int bj = 0; bj < 2; ++bj) {
                    const int col = cb + bj * 128 + wc * 32 + 8 * fq;
                    const f32x4 v0 = acc[ai][bj][m][0] * rs, v1 = acc[ai][bj][m][1] * rs;
                    if (of) { float* p = of + (size_t)row * ld + col; *(f32x4*)p = v0; *(f32x4*)(p + 4) = v1; }
                    else st_bf16x8(ob + (size_t)row * ld + col, v0, v1);
                }
            }
    }
};
struct EpiGate {
    static constexpr bool PERM = true;
    const float* ssq; const float* bias; u16* gt;
    __device__ __forceinline__ void operator()(const AccT& acc, const Unit& u, int wr, int wc, int fr, int fq) const {
        const int row0 = u.pm * 256 + wr * 64 + fr;
        float rs8[8]; rstd8(ssq, row0, fq, rs8);
        f32x4 bb[2][2];
#pragma unroll
        for (int bj = 0; bj < 2; ++bj) { const int col = u.cn * 256 + bj * 128 + wc * 32 + 8 * fq; bb[bj][0] = *(const f32x4*)(bias + col); bb[bj][1] = *(const f32x4*)(bias + col + 4); }
#pragma unroll
        for (int ai = 0; ai < 2; ++ai)
#pragma unroll
            for (int m = 0; m < 4; ++m) {
                const int row = row0 + ai * 128 + m * 16; const float rs = rs8[ai * 4 + m];
#pragma unroll
                for (int bj = 0; bj < 2; ++bj) {
                    const int col = u.cn * 256 + bj * 128 + wc * 32 + 8 * fq;
                    f32x4 v0 = acc[ai][bj][m][0] * rs + bb[bj][0], v1 = acc[ai][bj][m][1] * rs + bb[bj][1];
#pragma unroll
                    for (int j = 0; j < 4; ++j) { v0[j] = sigmoidf_(v0[j]); v1[j] = sigmoidf_(v1[j]); }
                    st_bf16x8(gt + (size_t)row * D + col, v0, v1);
                }
            }
    }
};
template <int MODE> struct EpiProj {
    static constexpr bool PERM = true;
    u16* gt; float* mgf;
    __device__ __forceinline__ void operator()(const AccT& acc, const Unit& u, int wr, int wc, int fr, int fq) const {
        const int row0 = u.pm * 256 + wr * 64 + fr;
#pragma unroll
        for (int ai = 0; ai < 2; ++ai)
#pragma unroll
            for (int m2 = 0; m2 < 4; m2 += 2) {
                u32x4 gw[2][2]; f32x4 mv[2][2][2];
#pragma unroll
                for (int mm = 0; mm < 2; ++mm)
#pragma unroll
                    for (int bj = 0; bj < 2; ++bj) { const size_t o = (size_t)(row0 + ai * 128 + (m2 + mm) * 16) * D + u.cn * 256 + bj * 128 + wc * 32 + 8 * fq;
                        gw[mm][bj] = *(const u32x4*)(gt + o); if (MODE >= 1) { mv[mm][bj][0] = *(const f32x4*)(mgf + o); mv[mm][bj][1] = *(const f32x4*)(mgf + o + 4); } }
#pragma unroll
                for (int mm = 0; mm < 2; ++mm)
#pragma unroll
                    for (int bj = 0; bj < 2; ++bj) { const int m = m2 + mm; const size_t o = (size_t)(row0 + ai * 128 + m * 16) * D + u.cn * 256 + bj * 128 + wc * 32 + 8 * fq;
                        const u32x4 w = gw[mm][bj]; const f32x4 g0 = (f32x4){bflo(w.x), bfhi(w.x), bflo(w.y), bfhi(w.y)}, g1 = (f32x4){bflo(w.z), bfhi(w.z), bflo(w.w), bfhi(w.w)};
                        f32x4 v0 = acc[ai][bj][m][0] * g0, v1 = acc[ai][bj][m][1] * g1;
                        if (MODE >= 1) { v0 += mv[mm][bj][0]; v1 += mv[mm][bj][1]; }
                        if (MODE <= 1) { *(f32x4*)(mgf + o) = v0; *(f32x4*)(mgf + o + 4) = v1; }
                        else st_bf16x8(gt + o, v0, v1); }
                asm volatile("" ::: "memory");
            }
    }
};
struct EpiResid {
    static constexpr bool PERM = true;
    float* xr; u16* xb; float* ssq;
    __device__ __forceinline__ void operator()(const AccT& acc, const Unit& u, int wr, int wc, int fr, int fq) const {
        const int row0 = u.pm * 256 + wr * 64 + fr;
#pragma unroll
        for (int ai = 0; ai < 2; ++ai)
#pragma unroll
            for (int m2 = 0; m2 < 4; m2 += 2) {
                f32x4 xv[2][2][2];
#pragma unroll
                for (int mm = 0; mm < 2; ++mm)
#pragma unroll
                    for (int bj = 0; bj < 2; ++bj) { const size_t o = (size_t)(row0 + ai * 128 + (m2 + mm) * 16) * D + u.cn * 256 + bj * 128 + wc * 32 + 8 * fq; xv[mm][bj][0] = *(const f32x4*)(xr + o); xv[mm][bj][1] = *(const f32x4*)(xr + o + 4); }
#pragma unroll
                for (int mm = 0; mm < 2; ++mm) { const int m = m2 + mm; const int row = row0 + ai * 128 + m * 16; float sq = 0.f;
#pragma unroll
                    for (int bj = 0; bj < 2; ++bj) { const size_t o = (size_t)row * D + u.cn * 256 + bj * 128 + wc * 32 + 8 * fq;
                        const f32x4 v0 = acc[ai][bj][m][0] + xv[mm][bj][0], v1 = acc[ai][bj][m][1] + xv[mm][bj][1];
                        *(f32x4*)(xr + o) = v0; *(f32x4*)(xr + o + 4) = v1;
                        st_bf16x8(xb + o, v0, v1);
                        sq += (v0[0] * v0[0] + v0[1] * v0[1]) + (v0[2] * v0[2] + v0[3] * v0[3]) + (v1[0] * v1[0] + v1[1] * v1[1]) + (v1[2] * v1[2] + v1[3] * v1[3]); }
                    sq += __shfl_xor(sq, 16); sq += __shfl_xor(sq, 32);
                    if (fq == 0) ssq[(size_t)row * 16 + u.cn * 4 + wc] = sq; }
                asm volatile("" ::: "memory");
            }
    }
};
struct EpiSwiglu {
    static constexpr bool PERM = true;
    const float* ssq; const float* rsrow; u16* act; int ld; int row_base;
    __device__ __forceinline__ void operator()(const AccT& acc, const Unit& u, int wr, int wc, int fr, int fq) const {
        const int row0 = u.pm * 256 + wr * 64 + fr;
        float rs8[8];
        if (rsrow) {
#pragma unroll
            for (int i = 0; i < 8; ++i) rs8[i] = rsrow[row0 + (i >> 2) * 128 + (i & 3) * 16];
        } else rstd8(ssq, row0, fq, rs8);
#pragma unroll
        for (int ai = 0; ai < 2; ++ai)
#pragma unroll
            for (int m = 0; m < 4; ++m) {
                const int row = row0 + ai * 128 + m * 16; const float rs = rs8[ai * 4 + m];
                f32x4 o[2];
#pragma unroll
                for (int n = 0; n < 2; ++n)
#pragma unroll
                    for (int j = 0; j < 4; ++j) { const float gv = acc[ai][0][m][n][j] * rs, uv = acc[ai][1][m][n][j] * rs; o[n][j] = gv * sigmoidf_(gv) * uv; }
                st_bf16x8(act + (size_t)(row - row_base) * ld + u.cn * 128 + wc * 32 + 8 * fq, o[0], o[1]);
            }
    }
};
struct EpiMoeDown {
    static constexpr bool PERM = true;
    const float* rg; u16* ys; u16* ys2;
    __device__ __forceinline__ void operator()(const AccT& acc, const Unit& u, int wr, int wc, int fr, int fq) const {
        const int row0 = u.pm * 256 + wr * 64 + fr;
        u16* const yb = (u.ks == 0) ? ys : ys2 + ((long)(u.ks - 1) * YS2_ROWS - 32768L) * (long)D;
        float g8[8];
#pragma unroll
        for (int i = 0; i < 8; ++i) g8[i] = rg[row0 + (i >> 2) * 128 + (i & 3) * 16];
#pragma unroll
        for (int ai = 0; ai < 2; ++ai)
#pragma unroll
            for (int m = 0; m < 4; ++m) {
                const int row = row0 + ai * 128 + m * 16; const float gsc = g8[ai * 4 + m];
#pragma unroll
                for (int bj = 0; bj < 2; ++bj) {
                    const int col = u.cn * 256 + bj * 128 + wc * 32 + 8 * fq;
                    st_bf16x8(yb + (size_t)row * D + col, acc[ai][bj][m][0] * gsc, acc[ai][bj][m][1] * gsc);
                }
            }
    }
};

struct Args {
    const float* in[37];
    float* out; unsigned char* ws;
    int ph_lo, ph_hi;
};
typedef const __attribute__((address_space(4))) Args* CArgsP;
enum { I_X = 0, I_WIN, I_BGATE, I_GMIX, I_FBIAS, I_KVNORM, I_WUK, I_WUV, I_MU, I_W0, I_WUP, I_A0, I_AUP, I_GUP, I_KK, I_KA, I_RK, I_LNG, I_LNB,
       I_VDOWN, I_VMU, I_VUP, I_VV0, I_PFOX, I_PDSA, I_PRWKV, I_WOUT, I_GFFN, I_FWG, I_FWU, I_FWD, I_RTW, I_RTB, I_MWG, I_MWU, I_MWD, I_GFINAL };

struct Seg { const float* src; const float* src2; const float* gk; const float* aux; u16* dst; int kind, K, ld, col0, nrows, row0, item0; float scale; };
constexpr int MAXSEG = 48;
__device__ __forceinline__ void seg_set(LAS Seg* s, int& n, int& items, int kind, const float* src, const float* src2, const float* gk, const float* aux, u16* dst, int K, int ld, int col0, int nrows, int row0, float scale) {
    LAS Seg& g = s[n]; g.src = src; g.src2 = src2; g.gk = gk; g.aux = aux; g.dst = dst; g.kind = kind; g.K = K; g.ld = ld; g.col0 = col0; g.nrows = nrows; g.row0 = row0; g.item0 = items; g.scale = scale;
    items += (K / ((kind == 2 || kind == 3) ? 16 : 64)) * ((nrows + 31) / 32); ++n;
}
struct SegR { const float* src; const float* gk; const float* aux; int kind, ld, col0, nrows; float scale; };
__device__ __forceinline__ float seg_val(const SegR& g, int k, int n) {
    if (n >= g.nrows) return 0.f;
    switch (g.kind) {
    case 0: { float v = g.src[(size_t)k * g.ld + g.col0 + n] * g.scale; if (g.gk) v *= g.gk[k]; return v; }
    case 5: { return k < 32 ? g.src[(size_t)k * g.ld + n] : 0.f; }
    case 2: { const int h = n >> 7, r = n & 127; float s = 0.f; const float* sp = g.src + (size_t)k * g.ld + g.col0 + h * 64; const float* ap = g.aux + (size_t)h * 64 * 128 + r;
#pragma unroll 8
              for (int d = 0; d < 64; ++d) s += sp[d] * ap[d * 128]; return s * g.scale * g.gk[k]; }
    case 3: { const int h = k >> 7, r = k & 127; float s = 0.f; const float* ap = g.aux + (size_t)(h * 128 + r) * 64; const float* sp = g.src + (size_t)(h * 64) * g.ld + n;
#pragma unroll 8
              for (int d = 0; d < 64; ++d) s += ap[d] * sp[(size_t)d * g.ld]; return s; }
    default: return 0.f;
    }
}
__device__ __forceinline__ void convert_items(const LAS Seg* segs, int s_lo, int s_hi, int nitems, LAS float* scr, int gw, int ngw, int lane) {
    for (int it = gw; it < nitems; it += ngw) {
        int si = s_lo;
        for (int j = s_lo + 1; j < s_hi; ++j) if (segs[j].item0 <= it) si = j;
        SegR g; g.src = segs[si].src; g.gk = segs[si].gk; g.aux = segs[si].aux; g.kind = segs[si].kind; g.ld = segs[si].ld; g.col0 = segs[si].col0; g.nrows = segs[si].nrows; g.scale = segs[si].scale;
        u16* const dst = segs[si].dst; const int K = segs[si].K, row0 = segs[si].row0;
        const bool fold = (g.kind == 2 || g.kind == 3); const int KT = fold ? 16 : 64;
        const int r = it - segs[si].item0, nnb = (g.nrows + 31) / 32, kb = r / nnb, nb = r % nnb, k0 = KT * kb, n0 = 32 * nb;
        if (fold) {
#pragma unroll 2
            for (int i = 0; i < 8; ++i) { const int kk = 2 * i + (lane >> 5); scr[kk * 33 + (lane & 31)] = seg_val(g, k0 + kk, n0 + (lane & 31)); }
            asm volatile("s_waitcnt lgkmcnt(0)" ::: "memory");
            { const int n = lane >> 1, cc = lane & 1; const LAS float* s = scr + (8 * cc) * 33 + n;
              u32x4 o; o.x = pk_bf16(s[0 * 33], s[1 * 33]); o.y = pk_bf16(s[2 * 33], s[3 * 33]); o.z = pk_bf16(s[4 * 33], s[5 * 33]); o.w = pk_bf16(s[6 * 33], s[7 * 33]);
              if (n0 + n < g.nrows) *(u32x4*)(dst + (size_t)(row0 + n0 + n) * K + k0 + 8 * cc) = o; }
        } else {
        if (g.kind == 0) {
            const int n = n0 + (lane & 31); const bool ok = n < g.nrows; const float* sp = g.src + (size_t)(k0 + (lane >> 5)) * g.ld + g.col0 + (ok ? n : 0);
            const float* gp = g.gk ? g.gk + k0 + (lane >> 5) : nullptr;
#pragma unroll 16
            for (int i = 0; i < 32; ++i) { float v = sp[(size_t)(2 * i) * g.ld] * g.scale; if (gp) v *= gp[2 * i]; scr[(2 * i + (lane >> 5)) * 33 + (lane & 31)] = ok ? v : 0.f; }
        } else {
#pragma unroll 4
        for (int i = 0; i < 32; ++i) { const int kk = 2 * i + (lane >> 5); scr[kk * 33 + (lane & 31)] = seg_val(g, k0 + kk, n0 + (lane & 31)); }
        }
        asm volatile("s_waitcnt lgkmcnt(0)" ::: "memory");
        const int c = lane & 7;
#pragma unroll
        for (int j = 0; j < 4; ++j) { const int n = (lane >> 3) + 8 * j; const LAS float* s = scr + (8 * c) * 33 + n;
            u32x4 o; o.x = pk_bf16(s[0 * 33], s[1 * 33]); o.y = pk_bf16(s[2 * 33], s[3 * 33]); o.z = pk_bf16(s[4 * 33], s[5 * 33]); o.w = pk_bf16(s[6 * 33], s[7 * 33]);
            if (n0 + n < g.nrows) *(u32x4*)(dst + (size_t)(row0 + n0 + n) * K + k0 + 8 * c) = o; }
        }
        asm volatile("s_waitcnt lgkmcnt(0)" ::: "memory");
    }
}

template <int KIND>
__device__ __forceinline__ int convert_seg(const float* src, const float* src2, const float* gk, u16* dst, int K, int ld, int nrows, int item0, LAS float* scr, int gw, int ngw, int lane) {
    const int nnb = nrows / 64, nit = (K / 64) * nnb;
    int first = item0 + ((gw - item0) % ngw + ngw) % ngw;
    for (int it = first; it < item0 + nit; it += ngw) {
        const int r = it - item0, kb = r / nnb, nb = r % nnb, k0 = 64 * kb, n0 = 64 * nb;
        const float* sp;
        if (KIND == 0) sp = src + n0 + lane; else { const int within = n0 & 255, which = within >> 7, j = (n0 >> 8) * 128 + (within & 127); sp = (which ? src2 : src) + j + lane; }
#pragma unroll 8
        for (int i = 0; i < 64; ++i) { float v = sp[(size_t)(k0 + i) * ld]; if (gk) v *= gk[k0 + i]; scr[i * 65 + lane] = v; }
        asm volatile("s_waitcnt lgkmcnt(0)" ::: "memory");
        const int c = lane & 7;
#pragma unroll
        for (int j = 0; j < 8; ++j) { const int n = (lane >> 3) + 8 * j; const LAS float* s = scr + (8 * c) * 65 + n;
            u32x4 o; o.x = pk_bf16(s[0 * 65], s[1 * 65]); o.y = pk_bf16(s[2 * 65], s[3 * 65]); o.z = pk_bf16(s[4 * 65], s[5 * 65]); o.w = pk_bf16(s[6 * 65], s[7 * 65]);
            *(u32x4*)(dst + (size_t)(n0 + n) * K + k0 + 8 * c) = o; }
        asm volatile("s_waitcnt lgkmcnt(0)" ::: "memory");
    }
    return item0 + nit;
}

struct Ctx {
    LAS unsigned char* lds; unsigned char* ws; u32* ctl;
    int tid, lane, wave, gw, ngw, G, bid;
};

__device__ __forceinline__ void phase_prologue(const Ctx& c, CArgsP a) {
    LAS Seg* segs = (LAS Seg*)(c.lds + 69632);
    LAS int* nfo = (LAS int*)(c.lds + 69632 + MAXSEG * sizeof(Seg));
    if (c.tid == 0) {
        int n = 0, items = 0;
        for (int l = 0; l < 2; ++l) {
            const float* win = a->in[I_WIN] + (size_t)l * D * DIN; const float* gm = a->in[I_GMIX] + l * D;
            u16* w1 = (u16*)(c.ws + O_W1) + (size_t)l * NW1 * D;
            seg_set(segs, n, items, 0, win, nullptr, gm, nullptr, w1, D, DIN, 0, 256, 0, C2);
            seg_set(segs, n, items, 0, win, nullptr, gm, nullptr, w1, D, DIN, 256, 512, 256, 1.f);
            seg_set(segs, n, items, 2, win, nullptr, gm, a->in[I_WUK] + (size_t)l * 4 * 64 * 128, w1, D, DIN, 772, 512, 768, C2);
            seg_set(segs, n, items, 0, win, nullptr, gm, nullptr, w1, D, DIN, 1156, 256, 1280, 1.f);
            seg_set(segs, n, items, 0, win, nullptr, gm, nullptr, w1, D, DIN, 1028, 128, 1536, 1.f);
            seg_set(segs, n, items, 0, win, nullptr, gm, nullptr, w1, D, DIN, 1412, 32, 1664, 1.f);
            seg_set(segs, n, items, 0, win, nullptr, gm, nullptr, w1, D, DIN, 1444, 8, 1696, 1.f);
            seg_set(segs, n, items, 0, win, nullptr, gm, nullptr, w1, D, DIN, 768, 4, 1704, 1.f);
            if (l == 1) seg_set(segs, n, items, 0, a->in[I_VDOWN], nullptr, gm, nullptr, w1, D, 32, 0, 32, 1708, 1.f);
            else seg_set(segs, n, items, 4, nullptr, nullptr, nullptr, nullptr, w1, D, 0, 0, 32, 1708, 1.f);
            seg_set(segs, n, items, 4, nullptr, nullptr, nullptr, nullptr, w1, D, 0, 0, 52, 1740, 1.f);
            seg_set(segs, n, items, 0, win, nullptr, gm, nullptr, w1, D, DIN, 1452, 1792, 1792, 1.f);
            seg_set(segs, n, items, 0, win, nullptr, gm, nullptr, (u16*)(c.ws + O_WGT) + (size_t)l * 3072 * D, D, DIN, 3244, 3072, 0, 1.f);
            u16* ow = (u16*)(c.ws + O_OUTW + l * OUTW_L);
            seg_set(segs, n, items, 0, a->in[I_PFOX] + (size_t)l * 256 * D, nullptr, nullptr, nullptr, ow, 256, D, 0, 1024, 0, 1.f);
            seg_set(segs, n, items, 3, a->in[I_PDSA] + (size_t)l * 256 * D, nullptr, nullptr, a->in[I_WUV] + (size_t)l * 4 * 128 * 64, ow + 1024 * 256, 512, D, 0, 1024, 0, 1.f);
            seg_set(segs, n, items, 0, a->in[I_PRWKV] + (size_t)l * 512 * D, nullptr, nullptr, nullptr, ow + 1024 * 256 + 1024 * 512, 512, D, 0, 1024, 0, 1.f);
            seg_set(segs, n, items, 0, a->in[I_WOUT] + (size_t)l * D * D, nullptr, nullptr, nullptr, ow + 1024 * 256 + 2 * 1024 * 512, D, D, 0, 1024, 0, 1.f);
            u16* wl = (u16*)(c.ws + O_WL + l * WL_L);
            seg_set(segs, n, items, 0, a->in[I_WUP] + (size_t)l * 64 * 512, nullptr, nullptr, nullptr, wl, 64, 512, 0, 512, 0, 1.f);
            seg_set(segs, n, items, 0, a->in[I_AUP] + (size_t)l * 64 * 512, nullptr, nullptr, nullptr, wl + 512 * 64, 64, 512, 0, 512, 0, 1.f);
            seg_set(segs, n, items, 0, a->in[I_GUP] + (size_t)l * 128 * 512, nullptr, nullptr, nullptr, wl + 2 * 512 * 64, 128, 512, 0, 512, 0, 1.f);
            if (l == 1) seg_set(segs, n, items, 5, a->in[I_VUP], nullptr, nullptr, nullptr, wl + 2 * 512 * 64 + 512 * 128, 64, 512, 0, 512, 0, 1.f);
        }
        nfo[0] = n; nfo[1] = items;
    }
    __syncthreads();
    convert_items(segs, 0, nfo[0], nfo[1], (LAS float*)(c.lds + c.wave * 8704), c.gw, c.ngw, c.lane);
    const float* x = a->in[I_X]; float* xr = (float*)(c.ws + O_XR); u16* xb = (u16*)(c.ws + O_XB); float* ssq = (float*)(c.ws + O_SSQ);
    for (int t = c.gw; t < S; t += c.ngw) {
        const f32x4* xp = (const f32x4*)(x + (size_t)t * D) + c.lane; float s = 0.f;
#pragma unroll
        for (int j = 0; j < 4; ++j) { const f32x4 v = xp[64 * j]; s += (v.x * v.x + v.y * v.y) + (v.z * v.z + v.w * v.w);
            ((f32x4*)(xr + (size_t)t * D))[c.lane + 64 * j] = v;
            u32x2 w; w.x = pk_bf16(v.x, v.y); w.y = pk_bf16(v.z, v.w); ((u32x2*)(xb + (size_t)t * D))[c.lane + 64 * j] = w; }
        s = wave_sum(s);
        if (c.lane < 16) ssq[(size_t)t * 16 + c.lane] = (c.lane == 0) ? s : 0.f;
    }
}

__device__ __forceinline__ float log_sigmoid_(float x) { return -(fmaxf(-x, 0.f) + log1pf(__expf(-fabsf(x)))); }
__device__ __forceinline__ void phase_prep(const Ctx& c, CArgsP a, int l) {
    const u16* qkvf = (const u16*)(c.ws + T_QKVF); const float* t56 = (const float*)(c.ws + T_T56); const u16* pr = (const u16*)(c.ws + T_PR);
    float* FL = (float*)(c.ws + T_FL); float* FB = (float*)(c.ws + T_FB); u16* VT = (u16*)(c.ws + T_VT); u16* CKV = (u16*)(c.ws + T_CKV);
    _Float16* QI = (_Float16*)(c.ws + T_QI); _Float16* KI = (_Float16*)(c.ws + T_KI); u32* SG = (u32*)(c.ws + T_SG); float* BC = (float*)(c.ws + T_BC);
    float* RW = (float*)(c.ws + T_RW); _Float16* RKK = (_Float16*)(c.ws + T_RKK); _Float16* RB = (_Float16*)(c.ws + T_RB);
    u16* RK = (u16*)(c.ws + T_RK); u16* RR = (u16*)(c.ws + T_RR); u16* RV = (u16*)(c.ws + T_RV); u16* RG = (u16*)(c.ws + T_RG); u16* VF = (u16*)(c.ws + O_VFIRST);
    const float* fbias = a->in[I_FBIAS] + l * 4; const float* kvn = a->in[I_KVNORM] + l * 128;
    const float* mu = a->in[I_MU] + l * 1792; const float* w0 = a->in[I_W0] + l * 512; const float* wup = a->in[I_WUP] + (size_t)l * 64 * 512;
    const float* a0 = a->in[I_A0] + l * 512; const float* aup = a->in[I_AUP] + (size_t)l * 64 * 512; const float* gup = a->in[I_GUP] + (size_t)l * 128 * 512;
    const float* kkw = a->in[I_KK] + l * 512; const float* kaw = a->in[I_KA] + l * 512; const float* rkw = a->in[I_RK] + l * 512;
    const float* vmu = a->in[I_VMU]; const float* vup = a->in[I_VUP]; const float* vv0 = a->in[I_VV0];
    LAS float* L_lf = (LAS float*)c.lds;
    LAS u16* L_vt = (LAS u16*)(c.lds + 1024);
    LAS u16* L_xl = (LAS u16*)(c.lds + 38912);
    constexpr int XLS = 328;
    const int tid = c.tid;
    LAS float* L_cst = (LAS float*)(c.lds + 81920);
    for (int idx = tid; idx < 9 * 512; idx += NTHR) { const int v = idx >> 9, j = idx & 511;
        const float* sp = v == 0 ? w0 : v == 1 ? a0 : v == 2 ? kkw : v == 3 ? kaw : v == 4 ? rkw : v == 5 ? vv0 : v == 6 ? mu : v == 7 ? mu + 512 : mu + 1024;
        L_cst[idx] = (v == 5 && l == 0) ? 0.f : sp[j]; }
    for (int blk = c.bid; blk < S / 64; blk += c.G) {
        const int t0 = blk * 64;
        __syncthreads();
        if (tid < 256) { const int tok = tid >> 2, h = tid & 3; L_lf[tok * 4 + h] = log_sigmoid_(t56[(size_t)(t0 + tok) * 512 + 256 + 172 - 4 + h] + fbias[h]) * LOG2E; }
        for (int idx = tid; idx < 64 * 32; idx += NTHR) { const int tok = idx >> 5, c8 = (idx & 31) * 8; const u32x4 w = *(const u32x4*)(qkvf + (size_t)(t0 + tok) * 768 + 512 + c8);
            LAS u16* d = L_vt + c8 * 72 + tok;
            d[0] = (u16)w.x; d[72] = (u16)(w.x >> 16); d[144] = (u16)w.y; d[216] = (u16)(w.y >> 16); d[288] = (u16)w.z; d[360] = (u16)(w.z >> 16); d[432] = (u16)w.w; d[504] = (u16)(w.w >> 16); }
        for (int idx = tid; idx < 64 * 32; idx += NTHR) {
            const int tok = idx >> 5, c8 = (idx & 31) * 8, t = t0 + tok; const int col = 1536 + c8;
            const u32x4 wc = *(const u32x4*)(pr + (size_t)t * 1792 + col); u32x4 wp = (u32x4){0u, 0u, 0u, 0u}; if (t > 0) wp = *(const u32x4*)(pr + (size_t)(t - 1) * 1792 + col);
            const f32x4 m0 = *(const f32x4*)(mu + col), m1 = *(const f32x4*)(mu + col + 4);
            float cur[8] = {bflo(wc.x), bfhi(wc.x), bflo(wc.y), bfhi(wc.y), bflo(wc.z), bfhi(wc.z), bflo(wc.w), bfhi(wc.w)};
            float prv[8] = {bflo(wp.x), bfhi(wp.x), bflo(wp.y), bfhi(wp.y), bflo(wp.z), bfhi(wp.z), bflo(wp.w), bfhi(wp.w)};
            float mm[8] = {m0.x, m0.y, m0.z, m0.w, m1.x, m1.y, m1.z, m1.w}; float ov[8];
#pragma unroll
            for (int e = 0; e < 8; ++e) { const float xs = cur[e] + (prv[e] - cur[e]) * mm[e]; ov[e] = c8 < 64 ? tanhf(xs) : (c8 < 128 ? xs : sigmoidf_(xs)); }
            u32x4 o; o.x = pk_bf16(ov[0], ov[1]); o.y = pk_bf16(ov[2], ov[3]); o.z = pk_bf16(ov[4], ov[5]); o.w = pk_bf16(ov[6], ov[7]);
            *(LAS u32x4*)(L_xl + tok * XLS + c8) = o;
        }
        for (int idx = tid; idx < 64 * 64; idx += NTHR) {
            const int tok = idx >> 6, i = idx & 63, t = t0 + tok; float xv = 0.f;
            if (l == 1 && i < 32) { const float cur = t56[(size_t)t * 512 + 256 + 172 + i]; const float prev = t > 0 ? t56[(size_t)(t - 1) * 512 + 256 + 172 + i] : 0.f; xv = cur + (prev - cur) * vmu[i]; }
            L_xl[tok * XLS + 256 + i] = f2bf(xv);
        }
        __syncthreads();
        if (tid < 4) { float run = 0.f; for (int i = 0; i < 64; ++i) { run += L_lf[i * 4 + tid]; FL[(size_t)tid * S + t0 + i] = run; } FB[tid * 256 + blk] = run; }
        for (int idx = tid; idx < 256 * 8; idx += NTHR) { const int cc = idx >> 3, t8 = (idx & 7) * 8; *(u32x4*)(VT + (size_t)cc * S + t0 + t8) = *(const LAS u32x4*)(L_vt + cc * 72 + t8); }
        {
            LAS unsigned* L_mx = (LAS unsigned*)(c.lds + 37888);
            if (tid < 9) L_mx[tid] = 0u;
            __syncthreads();
            const int tok = tid >> 3, sub = tid & 7; const u16* qp = qkvf + (size_t)(t0 + tok) * 768 + (sub >> 2) * 256 + (sub & 3) * 64; float ss = 0.f;
#pragma unroll
            for (int i = 0; i < 8; ++i) { const u32x4 w = *(const u32x4*)(qp + 8 * i); const float e0 = bflo(w.x), e1 = bfhi(w.x), e2 = bflo(w.y), e3 = bfhi(w.y), e4 = bflo(w.z), e5 = bfhi(w.z), e6 = bflo(w.w), e7 = bfhi(w.w);
                ss += (e0 * e0 + e1 * e1) + (e2 * e2 + e3 * e3) + (e4 * e4 + e5 * e5) + (e6 * e6 + e7 * e7); }
            (void)__hip_atomic_fetch_max(L_mx + sub, __float_as_uint(ss), __ATOMIC_RELAXED, __HIP_MEMORY_SCOPE_WORKGROUP);
            { const float* kp = t56 + (size_t)(t0 + tok) * 512 + 256 + 128 + sub * 4; float ks = (kp[0] * kp[0] + kp[1] * kp[1]) + (kp[2] * kp[2] + kp[3] * kp[3]);
              ks += __shfl_xor(ks, 1); ks += __shfl_xor(ks, 2); ks += __shfl_xor(ks, 4);
              if (sub == 0) (void)__hip_atomic_fetch_max(L_mx + 8, __float_as_uint(ks), __ATOMIC_RELAXED, __HIP_MEMORY_SCOPE_WORKGROUP); }
            __syncthreads();
            if (tid < 8) ((float*)(c.ws + T_QKM))[blk * 8 + tid] = __uint_as_float(L_mx[tid]);
            if (tid == 8) ((float*)(c.ws + T_KIM))[blk] = __uint_as_float(L_mx[8]);
        }
        {
            const int tok = tid >> 3, sub = tid & 7, t = t0 + tok; const float* tp = t56 + (size_t)t * 512;
            float cv[16]; float ss = 0.f;
#pragma unroll
            for (int i = 0; i < 16; ++i) { cv[i] = tp[256 + sub * 16 + i]; ss += cv[i] * cv[i]; }
            ss += __shfl_xor(ss, 1); ss += __shfl_xor(ss, 2); ss += __shfl_xor(ss, 4);
            const float rs = 1.0f / sqrtf(ss * (1.0f / 128.f) + RMS_EPS);
            { u32x4 o0, o1; const float* kn = kvn + sub * 16;
              o0.x = pk_bf16(cv[0] * rs * kn[0], cv[1] * rs * kn[1]); o0.y = pk_bf16(cv[2] * rs * kn[2], cv[3] * rs * kn[3]); o0.z = pk_bf16(cv[4] * rs * kn[4], cv[5] * rs * kn[5]); o0.w = pk_bf16(cv[6] * rs * kn[6], cv[7] * rs * kn[7]);
              o1.x = pk_bf16(cv[8] * rs * kn[8], cv[9] * rs * kn[9]); o1.y = pk_bf16(cv[10] * rs * kn[10], cv[11] * rs * kn[11]); o1.z = pk_bf16(cv[12] * rs * kn[12], cv[13] * rs * kn[13]); o1.w = pk_bf16(cv[14] * rs * kn[14], cv[15] * rs * kn[15]);
              *(u32x4*)(CKV + (size_t)t * 128 + sub * 16) = o0; *(u32x4*)(CKV + (size_t)t * 128 + sub * 16 + 8) = o1; }
            const float wv = tp[256 + 160 + sub]; const float sc = 0.5f * 0.0625f;
            const float aw = fabsf(wv) * sc, lw = wv * sc;
            unsigned bit = (wv < 0.f) ? (1u << sub) : 0u; bit |= __shfl_xor(bit, 1); bit |= __shfl_xor(bit, 2); bit |= __shfl_xor(bit, 4);
            if (sub == 0) SG[t] = bit;
            typedef _Float16 f16x4_t __attribute__((ext_vector_type(4)));
            f16x4_t linq = {0, 0, 0, 0};
#pragma unroll
            for (int d8 = 0; d8 < 4; ++d8) {
                const f32x4 q0 = *(const f32x4*)(tp + sub * 32 + d8 * 8), q1 = *(const f32x4*)(tp + sub * 32 + d8 * 8 + 4);
                const float qv[8] = {q0.x, q0.y, q0.z, q0.w, q1.x, q1.y, q1.z, q1.w};
                f16x8 hq;
#pragma unroll
                for (int e = 0; e < 8; ++e) { hq[e] = (_Float16)(qv[e] * aw);
                    float lv = qv[e] * lw; lv += __shfl_xor(lv, 1); lv += __shfl_xor(lv, 2); lv += __shfl_xor(lv, 4);
                    const int d = d8 * 8 + e; if ((d >> 2) == sub) linq[d & 3] = (_Float16)lv; }
                *(f16x8*)(QI + (size_t)t * 288 + sub * 32 + d8 * 8) = hq;
            }
            *(f16x4_t*)(QI + (size_t)t * 288 + 256 + sub * 4) = linq;
            { const f32x4 kq = *(const f32x4*)(tp + 256 + 128 + sub * 4); f16x4_t hk = {(_Float16)kq.x, (_Float16)kq.y, (_Float16)kq.z, (_Float16)kq.w}; *(f16x4_t*)(KI + (size_t)t * 32 + sub * 4) = hk; }
        }
        {
            const u16* wl = (const u16*)(c.ws + O_WL + l * WL_L);
            const int lane = c.lane, hh = c.wave;
            for (int mt = 0; mt < 4; ++mt) {
                int n = lane & 15, g = lane >> 4; asm volatile("" : "+v"(n), "+v"(g));
                f32x4 cw[4], ca[4], cg[4], cv[4];
#pragma unroll
                for (int nt = 0; nt < 4; ++nt) { cw[nt] = (f32x4){0.f, 0.f, 0.f, 0.f}; ca[nt] = cw[nt]; cg[nt] = cw[nt]; cv[nt] = cw[nt]; }
                const LAS u16* xrow = L_xl + (16 * mt + n) * XLS + 8 * g;
#pragma unroll
                for (int ks = 0; ks < 2; ++ks) {
                    const bf16x8 fw = *(const LAS bf16x8*)(xrow + 32 * ks), fa = *(const LAS bf16x8*)(xrow + 64 + 32 * ks);
#pragma unroll
                    for (int nt = 0; nt < 4; ++nt) { const int j = 64 * hh + 16 * nt + n;
                        cw[nt] = __builtin_amdgcn_mfma_f32_16x16x32_bf16(*(const bf16x8*)(wl + (size_t)j * 64 + 32 * ks + 8 * g), fw, cw[nt], 0, 0, 0);
                        ca[nt] = __builtin_amdgcn_mfma_f32_16x16x32_bf16(*(const bf16x8*)(wl + 512 * 64 + (size_t)j * 64 + 32 * ks + 8 * g), fa, ca[nt], 0, 0, 0); }
                }
#pragma unroll
                for (int ks = 0; ks < 4; ++ks) {
                    const bf16x8 fg = *(const LAS bf16x8*)(xrow + 128 + 32 * ks);
#pragma unroll
                    for (int nt = 0; nt < 4; ++nt) { const int j = 64 * hh + 16 * nt + n;
                        cg[nt] = __builtin_amdgcn_mfma_f32_16x16x32_bf16(*(const bf16x8*)(wl + 2 * 512 * 64 + (size_t)j * 128 + 32 * ks + 8 * g), fg, cg[nt], 0, 0, 0); }
                }
                if (l == 1) {
#pragma unroll
                    for (int ks = 0; ks < 2; ++ks) {
                        const bf16x8 fv = *(const LAS bf16x8*)(xrow + 256 + 32 * ks);
#pragma unroll
                        for (int nt = 0; nt < 4; ++nt) { const int j = 64 * hh + 16 * nt + n;
                            cv[nt] = __builtin_amdgcn_mfma_f32_16x16x32_bf16(*(const bf16x8*)(wl + 2 * 512 * 64 + 512 * 128 + (size_t)j * 64 + 32 * ks + 8 * g), fv, cv[nt], 0, 0, 0); }
                    }
                }
                const int t = t0 + 16 * mt + n;
                const u16* pc = pr + (size_t)t * 1792; const u16* pp = pc - 1792;
                float kkr_[16], av_[16]; float nn = 0.f, bc = 0.f;
#pragma unroll
                for (int nt = 0; nt < 4; ++nt) {
                    const int j = 64 * hh + 16 * nt + 4 * g; const size_t o = (size_t)t * 512 + j;
                    const u32x2 rcw = *(const u32x2*)(pc + j), kcw = *(const u32x2*)(pc + 512 + j), vcw = *(const u32x2*)(pc + 1024 + j);
                    u32x2 rpw = (u32x2){0u, 0u}, kpw = rpw, vpw = rpw; if (t > 0) { rpw = *(const u32x2*)(pp + j); kpw = *(const u32x2*)(pp + 512 + j); vpw = *(const u32x2*)(pp + 1024 + j); }
                    const f32x4 w04 = *(const LAS f32x4*)(L_cst + j), a04 = *(const LAS f32x4*)(L_cst + 512 + j), kk4 = *(const LAS f32x4*)(L_cst + 1024 + j), ka4 = *(const LAS f32x4*)(L_cst + 1536 + j), rk4 = *(const LAS f32x4*)(L_cst + 2048 + j),
                                v04 = *(const LAS f32x4*)(L_cst + 2560 + j), mr4 = *(const LAS f32x4*)(L_cst + 3072 + j), mk4 = *(const LAS f32x4*)(L_cst + 3584 + j), mv4 = *(const LAS f32x4*)(L_cst + 4096 + j);
                    const float rc[4] = {bflo(rcw.x), bfhi(rcw.x), bflo(rcw.y), bfhi(rcw.y)}, kc[4] = {bflo(kcw.x), bfhi(kcw.x), bflo(kcw.y), bfhi(kcw.y)}, vc[4] = {bflo(vcw.x), bfhi(vcw.x), bflo(vcw.y), bfhi(vcw.y)};
                    const float rp[4] = {bflo(rpw.x), bfhi(rpw.x), bflo(rpw.y), bfhi(rpw.y)}, kp[4] = {bflo(kpw.x), bfhi(kpw.x), bflo(kpw.y), bfhi(kpw.y)}, vp[4] = {bflo(vpw.x), bfhi(vpw.x), bflo(vpw.y), bfhi(vpw.y)};
                    u32x2 vfw = (u32x2){0u, 0u}; if (l == 1) vfw = *(const u32x2*)(VF + o);
                    const float vf4[4] = {bflo(vfw.x), bfhi(vfw.x), bflo(vfw.y), bfhi(vfw.y)};
                    float dec[4], k2[4], rv[4], vv[4];
#pragma unroll
                    for (int r = 0; r < 4; ++r) {
                        rv[r] = rc[r] + (rp[r] - rc[r]) * mr4[r]; const float k = kc[r] + (kp[r] - kc[r]) * mk4[r]; float v = vc[r] + (vp[r] - vc[r]) * mv4[r];
                        if (l == 1) v = v + (vf4[r] - v) * sigmoidf_(v04[r] + cv[nt][r]);
                        vv[r] = v;
                        const float wpre = w04[r] + cw[nt][r];
                        const float sp = fmaxf(-wpre, 0.f) + log1pf(__expf(-fabsf(wpre)));
                        dec[r] = __expf(-__expf(-sp - 0.5f));
                        const float av2 = sigmoidf_(a04[r] + ca[nt][r]);
                        const float kkr = k * kk4[r]; nn += kkr * kkr;
                        k2[r] = k * (1.0f + (av2 - 1.0f) * ka4[r]);
                        bc += rv[r] * k2[r] * rk4[r];
                        kkr_[4 * nt + r] = kkr; av_[4 * nt + r] = av2;
                    }
                    *(f32x4*)(RW + o) = (f32x4){dec[0], dec[1], dec[2], dec[3]};
                    { u32x2 w2; w2.x = pk_bf16(k2[0], k2[1]); w2.y = pk_bf16(k2[2], k2[3]); *(u32x2*)(RK + o) = w2; w2.x = pk_bf16(rv[0], rv[1]); w2.y = pk_bf16(rv[2], rv[3]); *(u32x2*)(RR + o) = w2;
                      w2.x = pk_bf16(vv[0], vv[1]); w2.y = pk_bf16(vv[2], vv[3]); *(u32x2*)(RV + o) = w2; if (l == 0) *(u32x2*)(VF + o) = w2;
                      w2.x = pk_bf16(cg[nt][0], cg[nt][1]); w2.y = pk_bf16(cg[nt][2], cg[nt][3]); *(u32x2*)(RG + o) = w2; }
                }
                nn += __shfl_xor(nn, 16); nn += __shfl_xor(nn, 32); bc += __shfl_xor(bc, 16); bc += __shfl_xor(bc, 32);
                const float inv = 1.0f / sqrtf(nn + 1e-12f);
                typedef _Float16 f16x4_t __attribute__((ext_vector_type(4)));
#pragma unroll
                for (int nt = 0; nt < 4; ++nt) { const size_t o = (size_t)t * 512 + 64 * hh + 16 * nt + 4 * g;
                    f16x4_t kq, bq;
#pragma unroll
                    for (int r = 0; r < 4; ++r) { const float kkn = kkr_[4 * nt + r] * inv; kq[r] = (_Float16)kkn; bq[r] = (_Float16)(kkn * av_[4 * nt + r]); }
                    *(f16x4_t*)(RKK + o) = kq; *(f16x4_t*)(RB + o) = bq; }
                if (g == 0) BC[(size_t)t * 8 + hh] = bc;
            }
        }
    }
}

__device__ __forceinline__ void fox_unit(const Ctx& c, int u, const LAS float* PB) {
    const u16* qkvf = (const u16*)(c.ws + T_QKVF); const u16* VT = (const u16*)(c.ws + T_VT); const float* FL = (const float*)(c.ws + T_FL); u16* OF = (u16*)(c.ws + T_OF);
    const int lane = c.lane, q = lane & 15, g = lane >> 4;
    const int qb = 511 - (u >> 2), h = u & 3, r0 = qb * 32;
    const u16* Qp = qkvf + (size_t)(r0 + q) * 768 + h * 64 + 8 * g;
    bf16x8 qA[2], qB[2];
    qA[0] = *(const bf16x8*)Qp; qA[1] = *(const bf16x8*)(Qp + 32); qB[0] = *(const bf16x8*)(Qp + 16 * 768); qB[1] = *(const bf16x8*)(Qp + 16 * 768 + 32);
    const float* FLh = FL + (size_t)h * S; const LAS float* PBh = PB + h * 256;
    const float FqA = FLh[r0 + q] + PBh[r0 >> 6], FqB = FLh[r0 + 16 + q] + PBh[r0 >> 6];
    float mA = -INFINITY, mB = -INFINITY, lA = 0.f, lB = 0.f;
    f32x4 oA[4], oB[4];
#pragma unroll
    for (int d = 0; d < 4; ++d) { oA[d] = (f32x4){0.f, 0.f, 0.f, 0.f}; oB[d] = (f32x4){0.f, 0.f, 0.f, 0.f}; }
    const int krow_off = 8 * (q >> 2) + (q & 3);
    const u16* Kbase = qkvf + 256 + h * 64 + 8 * g;
    const u16* Vbase = VT + (size_t)(h * 64 + q) * S + 8 * g;
    int kt0 = 0;
    float qn; float dmin;
    { const u16* kd = Kbase + (size_t)(r0 + q) * 768;
      const u32x4 a0 = __builtin_bit_cast(u32x4, qA[0]), a1 = __builtin_bit_cast(u32x4, qA[1]), b0 = __builtin_bit_cast(u32x4, qB[0]), b1 = __builtin_bit_cast(u32x4, qB[1]);
      const u32x4 k0_ = *(const u32x4*)kd, k1_ = *(const u32x4*)(kd + 32), k2_ = *(const u32x4*)(kd + 16 * 768), k3_ = *(const u32x4*)(kd + 16 * 768 + 32);
      float dA = 0.f, dB = 0.f, nA = 0.f, nB = 0.f;
#pragma unroll
      for (int w = 0; w < 4; ++w) { nA += bflo(a0[w]) * bflo(a0[w]) + bfhi(a0[w]) * bfhi(a0[w]) + bflo(a1[w]) * bflo(a1[w]) + bfhi(a1[w]) * bfhi(a1[w]);
                                    nB += bflo(b0[w]) * bflo(b0[w]) + bfhi(b0[w]) * bfhi(b0[w]) + bflo(b1[w]) * bflo(b1[w]) + bfhi(b1[w]) * bfhi(b1[w]); }
#pragma unroll
      for (int w = 0; w < 4; ++w) { dA += bflo(a0[w]) * bflo(k0_[w]) + bfhi(a0[w]) * bfhi(k0_[w]) + bflo(a1[w]) * bflo(k1_[w]) + bfhi(a1[w]) * bfhi(k1_[w]);
                                    dB += bflo(b0[w]) * bflo(k2_[w]) + bfhi(b0[w]) * bfhi(k2_[w]) + bflo(b1[w]) * bflo(k3_[w]) + bfhi(b1[w]) * bfhi(k3_[w]); }
      dA += __shfl_xor(dA, 16); dA += __shfl_xor(dA, 32); dB += __shfl_xor(dB, 16); dB += __shfl_xor(dB, 32);
      float dm = fminf(dA, dB);
#pragma unroll
      for (int o = 1; o < 16; o <<= 1) dm = fminf(dm, __shfl_xor(dm, o));
      nA += __shfl_xor(nA, 16); nA += __shfl_xor(nA, 32); nB += __shfl_xor(nB, 16); nB += __shfl_xor(nB, 32);
      float nm = fmaxf(nA, nB);
#pragma unroll
      for (int o = 1; o < 16; o <<= 1) nm = fmaxf(nm, __shfl_xor(nm, o));
      qn = sqrtf(__builtin_amdgcn_readfirstlane(nm)) * 1.001f;
      dmin = __builtin_amdgcn_readfirstlane(dm) - 0.5f; }
    { const float thr = __builtin_amdgcn_readfirstlane(FLh[r0] + PBh[r0 >> 6]) + (qn * PB[1024 + h] + 48.0f) - dmin; const int bmax = r0 >> 6; int b = 0;
#pragma unroll
      for (int e = 0; e < 4; ++e) {
          const int bb = lane + 64 * e; const bool cnd = bb < bmax && PBh[bb + 1] > thr;
          const unsigned long long nb = ~__ballot(cnd); const int n = nb ? __builtin_ctzll(nb) : 64;
          if (b == 64 * e) b += n; }
      kt0 = 2 * b; }
    bf16x8 kf[2][2], vf[4]; f32x4 f0, f1;
#define FOX_LOAD(KT) do { const int k0_ = (KT) * 32; \
        _Pragma("unroll") for (int rb = 0; rb < 2; ++rb) { const u16* kp = Kbase + (size_t)(k0_ + krow_off + 4 * rb) * 768; kf[rb][0] = *(const bf16x8*)kp; kf[rb][1] = *(const bf16x8*)(kp + 32); } \
        _Pragma("unroll") for (int d = 0; d < 4; ++d) vf[d] = *(const bf16x8*)(Vbase + (size_t)(16 * d) * S + k0_); \
        f0 = *(const f32x4*)(FLh + k0_ + 8 * g); f1 = *(const f32x4*)(FLh + k0_ + 8 * g + 4); } while (0)
    FOX_LOAD(kt0);
    for (int kt = kt0; kt <= qb; ++kt) {
        const int k0 = kt * 32;
        const float pb = PBh[k0 >> 6];
        float fk[8] = {f0.x + pb, f0.y + pb, f0.z + pb, f0.w + pb, f1.x + pb, f1.y + pb, f1.z + pb, f1.w + pb};
        bf16x8 kc[2][2], vc[4];
#pragma unroll
        for (int rb = 0; rb < 2; ++rb) { kc[rb][0] = kf[rb][0]; kc[rb][1] = kf[rb][1]; }
#pragma unroll
        for (int d = 0; d < 4; ++d) vc[d] = vf[d];
        if (kt < qb) FOX_LOAD(kt + 1);
        f32x4 sA[2], sB[2];
#pragma unroll
        for (int rb = 0; rb < 2; ++rb) {
            sA[rb] = __builtin_amdgcn_mfma_f32_16x16x32_bf16(kc[rb][0], qA[0], (f32x4){0.f, 0.f, 0.f, 0.f}, 0, 0, 0);
            sA[rb] = __builtin_amdgcn_mfma_f32_16x16x32_bf16(kc[rb][1], qA[1], sA[rb], 0, 0, 0);
            sB[rb] = __builtin_amdgcn_mfma_f32_16x16x32_bf16(kc[rb][0], qB[0], (f32x4){0.f, 0.f, 0.f, 0.f}, 0, 0, 0);
            sB[rb] = __builtin_amdgcn_mfma_f32_16x16x32_bf16(kc[rb][1], qB[1], sB[rb], 0, 0, 0);
        }
        float xA[8], xB[8];
#pragma unroll
        for (int j = 0; j < 8; ++j) { xA[j] = sA[j >> 2][j & 3] + (FqA - fk[j]); xB[j] = sB[j >> 2][j & 3] + (FqB - fk[j]); }
        if (kt == qb) {
#pragma unroll
            for (int j = 0; j < 8; ++j) { const int key = 8 * g + j; if (key > q) xA[j] = -INFINITY; if (key > 16 + q) xB[j] = -INFINITY; }
        }
        float mxA = xA[0], mxB = xB[0];
#pragma unroll
        for (int j = 1; j < 8; ++j) { mxA = fmaxf(mxA, xA[j]); mxB = fmaxf(mxB, xB[j]); }
        mxA = fmaxf(mxA, __shfl_xor(mxA, 16)); mxA = fmaxf(mxA, __shfl_xor(mxA, 32));
        mxB = fmaxf(mxB, __shfl_xor(mxB, 16)); mxB = fmaxf(mxB, __shfl_xor(mxB, 32));
        const float mnA = fmaxf(mA, mxA), mnB = fmaxf(mB, mxB);
        const float alA = __builtin_amdgcn_exp2f(mA - mnA), alB = __builtin_amdgcn_exp2f(mB - mnB);
        mA = mnA; mB = mnB;
        float sumA = 0.f, sumB = 0.f;
#pragma unroll
        for (int j = 0; j < 8; ++j) { xA[j] = __builtin_amdgcn_exp2f(xA[j] - mnA); xB[j] = __builtin_amdgcn_exp2f(xB[j] - mnB); sumA += xA[j]; sumB += xB[j]; }
        lA = lA * alA + sumA; lB = lB * alB + sumB;
        u32x4 pwA, pwB;
        pwA.x = pk_bf16(xA[0], xA[1]); pwA.y = pk_bf16(xA[2], xA[3]); pwA.z = pk_bf16(xA[4], xA[5]); pwA.w = pk_bf16(xA[6], xA[7]);
        pwB.x = pk_bf16(xB[0], xB[1]); pwB.y = pk_bf16(xB[2], xB[3]); pwB.z = pk_bf16(xB[4], xB[5]); pwB.w = pk_bf16(xB[6], xB[7]);
        const bf16x8 pA = __builtin_bit_cast(bf16x8, pwA), pB = __builtin_bit_cast(bf16x8, pwB);
#pragma unroll
        for (int d = 0; d < 4; ++d) {
            oA[d] = __builtin_amdgcn_mfma_f32_16x16x32_bf16(vc[d], pA, oA[d] * alA, 0, 0, 0);
            oB[d] = __builtin_amdgcn_mfma_f32_16x16x32_bf16(vc[d], pB, oB[d] * alB, 0, 0, 0);
        }
    }
#undef FOX_LOAD
    lA += __shfl_xor(lA, 16); lA += __shfl_xor(lA, 32); lB += __shfl_xor(lB, 16); lB += __shfl_xor(lB, 32);
    const float iA = 1.0f / lA, iB = 1.0f / lB;
#pragma unroll
    for (int d = 0; d < 4; ++d) {
        u32x2 w; w.x = pk_bf16(oA[d][0] * iA, oA[d][1] * iA); w.y = pk_bf16(oA[d][2] * iA, oA[d][3] * iA);
        *(u32x2*)(OF + (size_t)(r0 + q) * 256 + h * 64 + 16 * d + 4 * g) = w;
        w.x = pk_bf16(oB[d][0] * iB, oB[d][1] * iB); w.y = pk_bf16(oB[d][2] * iB, oB[d][3] * iB);
        *(u32x2*)(OF + (size_t)(r0 + 16 + q) * 256 + h * 64 + 16 * d + 4 * g) = w;
    }
}

__device__ __forceinline__ float r1_gsum(float x) {
    auto a = __builtin_amdgcn_permlane32_swap(__float_as_uint(x), __float_as_uint(x), false, false);
    const float y = __uint_as_float(a[0]) + __uint_as_float(a[1]);
    auto b = __builtin_amdgcn_permlane16_swap(__float_as_uint(y), __float_as_uint(y), false, false);
    return __uint_as_float(b[0]) + __uint_as_float(b[1]);
}
__device__ __forceinline__ void r1_task(const Ctx& c, int task, LAS float* lw) {
    const float* RW = (const float*)(c.ws + T_RW); const _Float16* RKK = (const _Float16*)(c.ws + T_RKK); const _Float16* RB = (const _Float16*)(c.ws + T_RB);
    const u16* RK = (const u16*)(c.ws + T_RK); const u16* RR = (const u16*)(c.ws + T_RR); const u16* RV = (const u16*)(c.ws + T_RV);
    float* YL = (float*)(c.ws + T_YL); u16* RT = (u16*)(c.ws + T_RT); float* PC = (float*)(c.ws + T_PC); float* UC = (float*)(c.ws + T_UC);
    const int lane = c.lane, m = lane & 15, g = lane >> 4, h = task >> 8, ch = task & 255, t0 = ch * 64;
    float U[4][16], P[4][16];
#pragma unroll
    for (int mt = 0; mt < 4; ++mt)
#pragma unroll
        for (int cc = 0; cc < 16; ++cc) { U[mt][cc] = 0.f; P[mt][cc] = (16 * mt + m == 16 * g + cc) ? 1.f : 0.f; }
    for (int blk = 0; blk < 8; ++blk) {
        const int tb = t0 + blk * 8;
        {
            int l2 = lane; asm volatile("" : "+v"(l2)); const int ls = l2 >> 3, lj = (l2 & 7) * 8;
            const size_t o = (size_t)(tb + ls) * 512 + h * 64 + lj;
            const f32x4 w0 = *(const f32x4*)(RW + o), w1 = *(const f32x4*)(RW + o + 4);
            const f16x8 kk = *(const f16x8*)(RKK + o), bb = *(const f16x8*)(RB + o);
            const u32x4 kr = *(const u32x4*)(RK + o), rr = *(const u32x4*)(RR + o), vv = *(const u32x4*)(RV + o);
            LAS float* d = lw + ls * 384 + lj;
            *(LAS f32x4*)(d) = w0; *(LAS f32x4*)(d + 4) = w1;
            *(LAS f32x4*)(d + 64) = (f32x4){(float)kk[0], (float)kk[1], (float)kk[2], (float)kk[3]}; *(LAS f32x4*)(d + 68) = (f32x4){(float)kk[4], (float)kk[5], (float)kk[6], (float)kk[7]};
            *(LAS f32x4*)(d + 128) = (f32x4){(float)bb[0], (float)bb[1], (float)bb[2], (float)bb[3]}; *(LAS f32x4*)(d + 132) = (f32x4){(float)bb[4], (float)bb[5], (float)bb[6], (float)bb[7]};
            *(LAS f32x4*)(d + 192) = (f32x4){bflo(kr.x), bfhi(kr.x), bflo(kr.y), bfhi(kr.y)}; *(LAS f32x4*)(d + 196) = (f32x4){bflo(kr.z), bfhi(kr.z), bflo(kr.w), bfhi(kr.w)};
            *(LAS f32x4*)(d + 256) = (f32x4){bflo(rr.x), bfhi(rr.x), bflo(rr.y), bfhi(rr.y)}; *(LAS f32x4*)(d + 260) = (f32x4){bflo(rr.z), bfhi(rr.z), bflo(rr.w), bfhi(rr.w)};
            *(LAS f32x4*)(d + 320) = (f32x4){bflo(vv.x), bfhi(vv.x), bflo(vv.y), bfhi(vv.y)}; *(LAS f32x4*)(d + 324) = (f32x4){bflo(vv.z), bfhi(vv.z), bflo(vv.w), bfhi(vv.w)};
        }
        asm volatile("s_waitcnt lgkmcnt(0)" ::: "memory");
        for (int s = 0; s < 8; ++s) {
            const LAS float* b = lw + s * 384 + 16 * g; const int t = tb + s;
            float vv_[4], su[4], sp[4];
            {   float a[4] = {0.f, 0.f, 0.f, 0.f}, p[4] = {0.f, 0.f, 0.f, 0.f};
#pragma unroll
                for (int q4 = 0; q4 < 4; ++q4) { const f32x4 kk4 = *(const LAS f32x4*)(b + 64 + 4 * q4);
#pragma unroll
                    for (int mt = 0; mt < 4; ++mt)
#pragma unroll
                        for (int e = 0; e < 4; ++e) { a[mt] = fmaf(U[mt][4 * q4 + e], kk4[e], a[mt]); p[mt] = fmaf(P[mt][4 * q4 + e], kk4[e], p[mt]); } }
#pragma unroll
                for (int mt = 0; mt < 4; ++mt) { vv_[mt] = lw[s * 384 + 320 + 16 * mt + m]; su[mt] = -r1_gsum(a[mt]); sp[mt] = -r1_gsum(p[mt]); } }
            float y[4] = {0.f, 0.f, 0.f, 0.f}, rt[4] = {0.f, 0.f, 0.f, 0.f};
#pragma unroll
            for (int q4 = 0; q4 < 4; ++q4) {
                const f32x4 w4 = *(const LAS f32x4*)(b + 4 * q4), b4 = *(const LAS f32x4*)(b + 128 + 4 * q4), k4 = *(const LAS f32x4*)(b + 192 + 4 * q4), r4 = *(const LAS f32x4*)(b + 256 + 4 * q4);
#pragma unroll
                for (int mt = 0; mt < 4; ++mt)
#pragma unroll
                    for (int e = 0; e < 4; ++e) { const int cc = 4 * q4 + e;
                        float t1 = vv_[mt] * k4[e]; t1 = fmaf(su[mt], b4[e], t1); U[mt][cc] = fmaf(U[mt][cc], w4[e], t1);
                        P[mt][cc] = fmaf(P[mt][cc], w4[e], sp[mt] * b4[e]);
                        y[mt] = fmaf(U[mt][cc], r4[e], y[mt]); rt[mt] = fmaf(P[mt][cc], r4[e], rt[mt]); }
            }
            float yv = 0.f, rv = 0.f;
#pragma unroll
            for (int mt = 0; mt < 4; ++mt) { const float ys = r1_gsum(y[mt]), rs_ = r1_gsum(rt[mt]); if (g == mt) { yv = ys; rv = rs_; } }
            { int l3 = lane; asm volatile("" : "+v"(l3)); const size_t oo = (size_t)t * 512 + h * 64 + l3; YL[oo] = yv; RT[oo] = f2bf(rv); }
        }
    }
    int ln = lane; asm volatile("" : "+v"(ln));
    const int m2 = ln & 15, g2 = ln >> 4;
    u16* ph = (u16*)PC + (size_t)task * 8192;
    LAS u16* lt = (LAS u16*)lw;
#pragma unroll
    for (int mt = 0; mt < 4; ++mt) { const int kpos = 32 * (mt >> 1) + 8 * (m2 >> 2) + 4 * (mt & 1) + (m2 & 3);
#pragma unroll
        for (int cc = 0; cc < 16; ++cc) { const float pv = P[mt][cc]; const u16 hi = f2bf(pv); const u16 lo = f2bf(pv - bf2f(hi)); lt[(16 * g2 + cc) * 64 + kpos] = hi; lt[4096 + (16 * g2 + cc) * 64 + kpos] = lo; } }
    asm volatile("s_waitcnt lgkmcnt(0)" ::: "memory");
#pragma unroll
    for (int i = 0; i < 16; ++i) *(u32x4*)(ph + (size_t)(i * 64 + ln) * 8) = *(const LAS u32x4*)((LAS u16*)lw + (i * 64 + ln) * 8);
    asm volatile("s_waitcnt lgkmcnt(0)" ::: "memory");
#pragma unroll
    for (int mt = 0; mt < 4; ++mt) { float* uc = UC + ((size_t)task * 64 + 16 * mt + m2) * 64 + 16 * g2;
#pragma unroll
        for (int cc = 0; cc < 16; cc += 4) *(f32x4*)(uc + cc) = (f32x4){U[mt][cc], U[mt][cc + 1], U[mt][cc + 2], U[mt][cc + 3]}; }
}

constexpr int R2_SLOT = 20480;
__device__ __forceinline__ void r2_task(const Ctx& c, int h, int rgp) {
    const u16* PHL = (const u16*)(c.ws + T_PC); float* UC = (float*)(c.ws + T_UC);
    volatile LAS unsigned* full = (volatile LAS unsigned*)(c.lds + 7 * R2_SLOT);
    volatile LAS unsigned* freef = full + 8;
    if (c.tid < 16) full[c.tid] = 0u;
    __syncthreads();
    const int lane = c.lane, n = lane & 15, g = lane >> 4, i = 16 * rgp + n;
    if (c.wave == 0) {
        f32x4 s[4];
#pragma unroll
        for (int mt = 0; mt < 4; ++mt) s[mt] = (f32x4){0.f, 0.f, 0.f, 0.f};
        for (int ch = 0; ch < 256; ++ch) {
            const int slot = ch % 7; const LAS unsigned char* sb = c.lds + slot * R2_SLOT;
            { unsigned sp = 0; while (full[slot] != (unsigned)(ch + 1)) { __builtin_amdgcn_s_sleep(1); if (++sp > (1u << 22)) break; } }
            asm volatile("" ::: "memory");
            bf16x8 ah[4][2], al[4][2]; f32x4 u[4];
#pragma unroll
            for (int mt = 0; mt < 4; ++mt) { u[mt] = *(const LAS f32x4*)(sb + 16384 + (mt * 64 + lane) * 16);
#pragma unroll
                for (int ks = 0; ks < 2; ++ks) { ah[mt][ks] = *(const LAS bf16x8*)(sb + ((mt * 2 + ks) * 64 + lane) * 16); al[mt][ks] = *(const LAS bf16x8*)(sb + 8192 + ((mt * 2 + ks) * 64 + lane) * 16); } }
            float* up = UC + ((size_t)(h * 256 + ch) * 64 + i) * 64 + 4 * g;
#pragma unroll
            for (int mt = 0; mt < 4; ++mt) *(f32x4*)(up + 16 * mt) = s[mt];
            bf16x8 bh[2], bl[2];
#pragma unroll
            for (int ks = 0; ks < 2; ++ks) {
                u32x4 wh, wl; float hv[8], lv[8];
#pragma unroll
                for (int j = 0; j < 8; ++j) { const float v = s[2 * ks + (j >> 2)][j & 3]; hv[j] = bf2f(f2bf(v)); lv[j] = v - hv[j]; }
                wh.x = pk_bf16(hv[0], hv[1]); wh.y = pk_bf16(hv[2], hv[3]); wh.z = pk_bf16(hv[4], hv[5]); wh.w = pk_bf16(hv[6], hv[7]);
                wl.x = pk_bf16(lv[0], lv[1]); wl.y = pk_bf16(lv[2], lv[3]); wl.z = pk_bf16(lv[4], lv[5]); wl.w = pk_bf16(lv[6], lv[7]);
                bh[ks] = __builtin_bit_cast(bf16x8, wh); bl[ks] = __builtin_bit_cast(bf16x8, wl);
            }
            asm volatile("s_waitcnt lgkmcnt(0)" ::: "memory");
            if (lane == 0) freef[slot] = (unsigned)(ch + 1);
#pragma unroll
            for (int mt = 0; mt < 4; ++mt) {
                f32x4 acc = u[mt];
#pragma unroll
                for (int ks = 0; ks < 2; ++ks) {
                    acc = __builtin_amdgcn_mfma_f32_16x16x32_bf16(ah[mt][ks], bl[ks], acc, 0, 0, 0);
                    acc = __builtin_amdgcn_mfma_f32_16x16x32_bf16(al[mt][ks], bh[ks], acc, 0, 0, 0);
                    acc = __builtin_amdgcn_mfma_f32_16x16x32_bf16(ah[mt][ks], bh[ks], acc, 0, 0, 0);
                }
                s[mt] = acc;
            }
        }
    } else {
        for (int ch = c.wave - 1; ch < 256; ch += 7) {
            const int slot = ch % 7; LAS unsigned char* sb = c.lds + slot * R2_SLOT;
            const u16* ph = PHL + (size_t)(h * 256 + ch) * 8192; const float* up = UC + ((size_t)(h * 256 + ch) * 64 + i) * 64 + 4 * g;
            bf16x8 ah[4][2], al[4][2]; f32x4 u[4];
#pragma unroll
            for (int mt = 0; mt < 4; ++mt) { u[mt] = *(const f32x4*)(up + 16 * mt);
#pragma unroll
                for (int ks = 0; ks < 2; ++ks) { ah[mt][ks] = *(const bf16x8*)(ph + (16 * mt + n) * 64 + 32 * ks + 8 * g); al[mt][ks] = *(const bf16x8*)(ph + 4096 + (16 * mt + n) * 64 + 32 * ks + 8 * g); } }
            asm volatile("s_waitcnt vmcnt(0)" ::: "memory");
            if (ch >= 7) { unsigned sp = 0; while (freef[slot] != (unsigned)(ch - 6)) { __builtin_amdgcn_s_sleep(1); if (++sp > (1u << 22)) break; } }
            asm volatile("" ::: "memory");
#pragma unroll
            for (int mt = 0; mt < 4; ++mt) { *(LAS f32x4*)(sb + 16384 + (mt * 64 + lane) * 16) = u[mt];
#pragma unroll
                for (int ks = 0; ks < 2; ++ks) { *(LAS bf16x8*)(sb + ((mt * 2 + ks) * 64 + lane) * 16) = ah[mt][ks]; *(LAS bf16x8*)(sb + 8192 + ((mt * 2 + ks) * 64 + lane) * 16) = al[mt][ks]; } }
            asm volatile("s_waitcnt lgkmcnt(0)" ::: "memory");
            if (lane == 0) full[slot] = (unsigned)(ch + 1);
        }
    }
    __syncthreads();
}

__device__ __forceinline__ void r3_task(const Ctx& c, CArgsP a, int l, int task) {
    const float* YL = (const float*)(c.ws + T_YL); const u16* RT = (const u16*)(c.ws + T_RT); const float* S0 = (const float*)(c.ws + T_UC);
    const u16* RV = (const u16*)(c.ws + T_RV); const u16* RG = (const u16*)(c.ws + T_RG); const float* BC = (const float*)(c.ws + T_BC); u16* OR_ = (u16*)(c.ws + T_OR);
    const int lane = c.lane, n = lane & 15, g = lane >> 4, h = task >> 8, ch = task & 255, t0 = ch * 64;
    bf16x8 sh[4][2], sl[4][2];
#pragma unroll
    for (int it = 0; it < 4; ++it)
#pragma unroll
        for (int ks = 0; ks < 2; ++ks) { const float* sp = S0 + ((size_t)task * 64 + 16 * it + n) * 64 + 32 * ks + 8 * g; const f32x4 v0 = *(const f32x4*)sp, v1 = *(const f32x4*)(sp + 4);
            const float v[8] = {v0.x, v0.y, v0.z, v0.w, v1.x, v1.y, v1.z, v1.w}; float hv[8], lv[8];
#pragma unroll
            for (int e = 0; e < 8; ++e) { hv[e] = bf2f(f2bf(v[e])); lv[e] = v[e] - hv[e]; }
            u32x4 wh, wl; wh.x = pk_bf16(hv[0], hv[1]); wh.y = pk_bf16(hv[2], hv[3]); wh.z = pk_bf16(hv[4], hv[5]); wh.w = pk_bf16(hv[6], hv[7]);
            wl.x = pk_bf16(lv[0], lv[1]); wl.y = pk_bf16(lv[2], lv[3]); wl.z = pk_bf16(lv[4], lv[5]); wl.w = pk_bf16(lv[6], lv[7]);
            sh[it][ks] = __builtin_bit_cast(bf16x8, wh); sl[it][ks] = __builtin_bit_cast(bf16x8, wl); }
    const float* lng = a->in[I_LNG] + l * 512 + h * 64; const float* lnb = a->in[I_LNB] + l * 512 + h * 64;
#pragma unroll 1
    for (int tt = 0; tt < 4; ++tt) {
        int n2 = n, g2 = g; asm volatile("" : "+v"(n2), "+v"(g2));
        const int t = t0 + 16 * tt + n2; const size_t ob = (size_t)t * 512 + h * 64 + 4 * g2;
        const bf16x8 r0 = *(const bf16x8*)(RT + (size_t)t * 512 + h * 64 + 8 * g2), r1 = *(const bf16x8*)(RT + (size_t)t * 512 + h * 64 + 32 + 8 * g2);
        f32x4 y[4]; float s1 = 0.f;
#pragma unroll
        for (int it = 0; it < 4; ++it) { f32x4 acc = *(const f32x4*)(YL + ob + 16 * it);
            acc = __builtin_amdgcn_mfma_f32_16x16x32_bf16(sl[it][0], r0, acc, 0, 0, 0); acc = __builtin_amdgcn_mfma_f32_16x16x32_bf16(sl[it][1], r1, acc, 0, 0, 0);
            acc = __builtin_amdgcn_mfma_f32_16x16x32_bf16(sh[it][0], r0, acc, 0, 0, 0); acc = __builtin_amdgcn_mfma_f32_16x16x32_bf16(sh[it][1], r1, acc, 0, 0, 0);
            y[it] = acc; s1 += (acc[0] + acc[1]) + (acc[2] + acc[3]); }
        s1 += __shfl_xor(s1, 16); s1 += __shfl_xor(s1, 32);
        const float mean = s1 * (1.0f / 64.f); float s2 = 0.f;
#pragma unroll
        for (int it = 0; it < 4; ++it)
#pragma unroll
            for (int r = 0; r < 4; ++r) { const float d = y[it][r] - mean; y[it][r] = d; s2 += d * d; }
        s2 += __shfl_xor(s2, 16); s2 += __shfl_xor(s2, 32);
        const float rstd = 1.0f / sqrtf(s2 * (1.0f / 64.f) + 64e-5f); const float bcv = BC[(size_t)t * 8 + h];
#pragma unroll
        for (int it = 0; it < 4; ++it) { const size_t o = ob + 16 * it; const f32x4 g4 = *(const f32x4*)(lng + 16 * it + 4 * g2), b4 = *(const f32x4*)(lnb + 16 * it + 4 * g2);
            const u32x2 vw = *(const u32x2*)(RV + o), gw = *(const u32x2*)(RG + o);
            const float vv[4] = {bflo(vw.x), bfhi(vw.x), bflo(vw.y), bfhi(vw.y)}, gg[4] = {bflo(gw.x), bfhi(gw.x), bflo(gw.y), bfhi(gw.y)}; float ov[4];
#pragma unroll
            for (int r = 0; r < 4; ++r) ov[r] = (y[it][r] * rstd * g4[r] + b4[r] + bcv * vv[r]) * gg[r];
            u32x2 w2; w2.x = pk_bf16(ov[0], ov[1]); w2.y = pk_bf16(ov[2], ov[3]); *(u32x2*)(OR_ + o) = w2; }
    }
}

constexpr int DSA_CAP = 384;
constexpr int L_DSA_IMG = 0;
constexpr int L_DSA_FLAT = 0;
constexpr int L_DSA_CBM = 65536;
constexpr int L_DSA_CAND = 16384;
constexpr int L_DSA_BM = 98304;
constexpr int L_DSA_SEL = 131072;
constexpr int L_DSA_CNT = 131072 + 8192;
__device__ __forceinline__ unsigned ord_of(float s) { const unsigned u = __float_as_uint(s); return (u & 0x80000000u) ? ~u : (u | 0x80000000u); }
__device__ __forceinline__ unsigned img_off(unsigned row, unsigned ch) { return 256u * row + 16u * (ch ^ (((row & 3) << 2) | ((row >> 2) & 3))); }

__device__ __forceinline__ void dsa_score_pass(const Ctx& c, int ntile, const f16x8 (&qf)[9], const float (&sg)[8], float invw, float boff, LAS u32* hist, unsigned char* binrow) {
    const _Float16* KI = (const _Float16*)(c.ws + T_KI);
    int lane = c.lane; asm volatile("" : "+v"(lane));
    const int q = lane & 15, g = lane >> 4;
    const _Float16* kip = KI + (size_t)q * 32 + 8 * g;
    LAS u32* hq = hist + q * 1024; const int rot = 37 * q;
    unsigned* bout = (unsigned*)(binrow + (size_t)q * 16384 + 4 * g);
    const int ntw = (ntile - c.wave + NWAVES - 1) / NWAVES;
    f16x8 k0, k1, k2, k3;
#define DSA_KLOAD(IT) ((IT) < ntw ? *(const f16x8*)(kip + (size_t)(c.wave + NWAVES * (IT)) * 512) : (f16x8){0, 0, 0, 0, 0, 0, 0, 0})
#define DSA_TILE_BODY(KF, IT) do { if ((IT) < ntw) { const int kt = c.wave + NWAVES * (IT); \
        f32x4 xs[9]; \
        _Pragma("unroll") for (int hh = 0; hh < 9; ++hh) xs[hh] = __builtin_amdgcn_mfma_f32_16x16x32_f16(KF, qf[hh], (f32x4){0.f, 0.f, 0.f, 0.f}, 0, 0, 0); \
        KF = DSA_KLOAD((IT) + 4); \
        asm volatile("s_nop 15" : "+v"(xs[0]), "+v"(xs[1]), "+v"(xs[2]), "+v"(xs[3]), "+v"(xs[4]), "+v"(xs[5]), "+v"(xs[6]), "+v"(xs[7]), "+v"(xs[8]));     \
        f32x4 acc = xs[8]; \
        _Pragma("unroll") for (int hh = 0; hh < 8; ++hh) _Pragma("unroll") for (int r = 0; r < 4; ++r) asm volatile("v_fma_f32 %0, |%1|, %2, %0" : "+v"(acc[r]) : "v"(xs[hh][r]), "v"(sg[hh])); \
        unsigned packed = 0; \
        _Pragma("unroll") for (int r = 0; r < 4; ++r) { const float sc = acc[r] + 0.0f; \
            const int bin = min(max((int)__builtin_fmaf(sc, invw, boff), 0), 1023); \
            lds_addu(hq + ((bin + rot) & 1023), 1u); packed |= (unsigned)(bin >> 2) << (8 * r); } \
        bout[kt * 4] = packed; } } while (0)
#define DSA_TILE_BODY_U(KF, IT) do { const int kt = c.wave + NWAVES * (IT); \
        f32x4 xs[9]; \
        _Pragma("unroll") for (int hh = 0; hh < 9; ++hh) xs[hh] = __builtin_amdgcn_mfma_f32_16x16x32_f16(KF, qf[hh], (f32x4){0.f, 0.f, 0.f, 0.f}, 0, 0, 0); \
        KF = *(const f16x8*)(kip + (size_t)(kt + 4 * NWAVES) * 512); \
        asm volatile("s_nop 15" : "+v"(xs[0]), "+v"(xs[1]), "+v"(xs[2]), "+v"(xs[3]), "+v"(xs[4]), "+v"(xs[5]), "+v"(xs[6]), "+v"(xs[7]), "+v"(xs[8])); \
        f32x4 acc = xs[8]; \
        _Pragma("unroll") for (int hh = 0; hh < 8; ++hh) _Pragma("unroll") for (int r = 0; r < 4; ++r) asm volatile("v_fma_f32 %0, |%1|, %2, %0" : "+v"(acc[r]) : "v"(xs[hh][r]), "v"(sg[hh])); \
        unsigned packed = 0; \
        _Pragma("unroll") for (int r = 0; r < 4; ++r) { const float sc = acc[r] + 0.0f; \
            const int bin = min(max((int)__builtin_fmaf(sc, invw, boff), 0), 1023); \
            lds_addu(hq + ((bin + rot) & 1023), 1u); packed |= (unsigned)(bin >> 2) << (8 * r); } \
        bout[kt * 4] = packed; } while (0)
    k0 = DSA_KLOAD(0); k1 = DSA_KLOAD(1); k2 = DSA_KLOAD(2); k3 = DSA_KLOAD(3);
    int it = 0;
    for (; it + 8 <= ntw; it += 4) {
        DSA_TILE_BODY_U(k0, it); DSA_TILE_BODY_U(k1, it + 1); DSA_TILE_BODY_U(k2, it + 2); DSA_TILE_BODY_U(k3, it + 3);
    }
    for (; it < ntw; it += 4) {
        DSA_TILE_BODY(k0, it); DSA_TILE_BODY(k1, it + 1); DSA_TILE_BODY(k2, it + 2); DSA_TILE_BODY(k3, it + 3);
    }
#undef DSA_TILE_BODY_U
#undef DSA_TILE_BODY
#undef DSA_KLOAD
    asm volatile("s_waitcnt vmcnt(0)" ::: "memory");
}
typedef _Float16 h2_t __attribute__((ext_vector_type(2)));
__device__ __forceinline__ float dsa_score_one(const Ctx& c, int t, int key) {
    const _Float16* qp = (const _Float16*)(c.ws + T_QI) + (size_t)t * 288; const _Float16* kp = (const _Float16*)(c.ws + T_KI) + (size_t)key * 32;
    const u32 sb = ((const u32*)(c.ws + T_SG))[t];
    h2_t kv[16];
#pragma unroll
    for (int i = 0; i < 4; ++i) { const u32x4 w = *(const u32x4*)(kp + 8 * i); kv[4 * i] = __builtin_bit_cast(h2_t, w.x); kv[4 * i + 1] = __builtin_bit_cast(h2_t, w.y); kv[4 * i + 2] = __builtin_bit_cast(h2_t, w.z); kv[4 * i + 3] = __builtin_bit_cast(h2_t, w.w); }
    float sc = 0.f;
#pragma unroll
    for (int hh = 8; hh >= 0; --hh) {
        float x = 0.f;
#pragma unroll
        for (int i = 0; i < 4; ++i) { const u32x4 w = *(const u32x4*)(qp + hh * 32 + 8 * i);
            x = __builtin_amdgcn_fdot2(__builtin_bit_cast(h2_t, w.x), kv[4 * i], x, false); x = __builtin_amdgcn_fdot2(__builtin_bit_cast(h2_t, w.y), kv[4 * i + 1], x, false);
            x = __builtin_amdgcn_fdot2(__builtin_bit_cast(h2_t, w.z), kv[4 * i + 2], x, false); x = __builtin_amdgcn_fdot2(__builtin_bit_cast(h2_t, w.w), kv[4 * i + 3], x, false); }
        if (hh == 8) sc = x; else sc = __builtin_fmaf(__builtin_fabsf(x), ((sb >> hh) & 1u) ? -1.f : 1.f, sc);
    }
    return sc + 0.0f;
}
#if PROBE
#define DSTAMP(k) do { if (c.bid == 100 && c.tid == 0) { const u64 now_ = wall_clock64(); ((LAS u64*)(c.lds + L_DSA_CNT + 1024))[k] += now_ - dst_; dst_ = now_; } } while (0)
#else
#define DSTAMP(k) do { } while (0)
#endif
__device__ __forceinline__ void dsa_unit(const Ctx& c, int qt) {
#if PROBE
    u64 dst_ = wall_clock64();
#endif
    const _Float16* QI = (const _Float16*)(c.ws + T_QI); const u32* SG = (const u32*)(c.ws + T_SG);
    const u16* CKV = (const u16*)(c.ws + T_CKV); const u16* QL = (const u16*)(c.ws + T_QL); u16* OD = (u16*)(c.ws + T_OD);
    LAS u32* hist = (LAS u32*)(c.lds + L_DSA_IMG); LAS u64* cand = (LAS u64*)(c.lds + L_DSA_CAND);
    LAS u16* sel = (LAS u16*)(c.lds + L_DSA_SEL); LAS u32* cnts = (LAS u32*)(c.lds + L_DSA_CNT); LAS u32* bm = (LAS u32*)(c.lds + L_DSA_BM);
    int lane = c.lane; asm volatile("" : "+v"(lane)); const int q = lane & 15, g = lane >> 4; int tid = c.tid; asm volatile("" : "+v"(tid));
    const int chunk = qt >> 2, N = 64 * (chunk + 1);
    if (tid < 65) cnts[tid] = 0u;
    if (N > 256) {
        for (int i = tid; i < 16 * 1024; i += NTHR) hist[i] = 0u;
        { LAS u32* cbm0 = (LAS u32*)(c.lds + L_DSA_CBM); for (int i = tid; i < 2 * 16 * 512; i += NTHR) cbm0[i] = 0u; }
        f16x8 qf[9]; float sg[8];
        { const _Float16* qp = QI + (size_t)(qt * 16 + q) * 288 + 8 * g;
#pragma unroll
          for (int hh = 0; hh < 9; ++hh) qf[hh] = *(const f16x8*)(qp + hh * 32);
          const u32 sb = SG[qt * 16 + q];
#pragma unroll
          for (int hh = 0; hh < 8; ++hh) sg[hh] = ((sb >> hh) & 1u) ? -1.f : 1.f; }
        float invw, boff;
        { const _Float16* KIs = (const _Float16*)(c.ws + T_KI); const int ntile = N / 16; float s1 = 0.f, s2 = 0.f;
#pragma unroll
          for (int j = 0; j < 2; ++j) { const int kts = ((2 * c.wave + j) * ntile) >> 4;
              const f16x8 kf = *(const f16x8*)(KIs + (size_t)(kts * 16 + q) * 32 + 8 * g);
              f32x4 acc = __builtin_amdgcn_mfma_f32_16x16x32_f16(kf, qf[8], (f32x4){0.f, 0.f, 0.f, 0.f}, 0, 0, 0);
#pragma unroll
              for (int hh = 0; hh < 8; ++hh) { const f32x4 x = __builtin_amdgcn_mfma_f32_16x16x32_f16(kf, qf[hh], (f32x4){0.f, 0.f, 0.f, 0.f}, 0, 0, 0);
#pragma unroll
                  for (int r = 0; r < 4; ++r) acc[r] = __builtin_fmaf(__builtin_fabsf(x[r]), sg[hh], acc[r]); }
#pragma unroll
              for (int r = 0; r < 4; ++r) { s1 += acc[r]; s2 += acc[r] * acc[r]; } }
          s1 += __shfl_xor(s1, 16); s1 += __shfl_xor(s1, 32); s2 += __shfl_xor(s2, 16); s2 += __shfl_xor(s2, 32);
          LAS float* part = (LAS float*)(c.lds + L_DSA_CNT + 1536);
          if (g == 0) { part[(c.wave * 16 + q) * 2] = s1; part[(c.wave * 16 + q) * 2 + 1] = s2; }
          __syncthreads();
          float t1 = 0.f, t2 = 0.f;
#pragma unroll
          for (int w = 0; w < 8; ++w) { t1 += part[(w * 16 + q) * 2]; t2 += part[(w * 16 + q) * 2 + 1]; }
          const float mean = t1 * (1.0f / 256.f), var = fmaxf(t2 * (1.0f / 256.f) - mean * mean, 1e-30f);
          invw = 512.0f / (6.0f * sqrtf(var)); boff = 512.0f - mean * invw; }
        __syncthreads();
        unsigned char* binrow = c.ws + T_DSB + (size_t)c.bid * (16 * 16384);
        dsa_score_pass(c, N / 16, qf, sg, invw, boff, hist, binrow);
        __syncthreads();
        if (DSA_REP & 1) { for (int i = tid; i < 16 * 1024; i += NTHR) hist[i] = 0u; __syncthreads(); dsa_score_pass(c, N / 16, qf, sg, invw, boff, hist, binrow); __syncthreads(); }
        DSTAMP(0);
        for (int qq = 2 * c.wave; qq < 2 * c.wave + 2; ++qq) {
            int lane = c.lane; asm volatile("" : "+v"(lane));
            const LAS u32* hq = hist + qq * 1024; unsigned cs[4]; unsigned loc = 0;
#pragma unroll
            for (int i = 0; i < 4; ++i) { cs[i] = 0;
#pragma unroll
                for (int e = 0; e < 4; ++e) cs[i] += hq[(lane * 16 + 4 * i + e + 37 * qq) & 1023];
                loc += cs[i]; }
            unsigned suf = loc;
#pragma unroll
            for (int o = 1; o < 64; o <<= 1) { const unsigned v = __shfl_down(suf, o); if (lane + o < 64) suf += v; }
            const u64 bal = __ballot(suf >= 256u);
            const int Ls = 63 - __builtin_clzll(bal);
            if (lane == Ls) { unsigned cab = suf - loc; int b1 = Ls * 4;
                for (int i = 3; i >= 0; --i) { if (cab + cs[i] >= 256u) { b1 = Ls * 4 + i; break; } cab += cs[i]; }
                cnts[32 + qq] = (unsigned)b1; cnts[48 + qq] = 256u - cab; }
        }
        if (c.wave == 0) { __builtin_amdgcn_fence(__ATOMIC_ACQUIRE, "agent"); asm volatile("s_waitcnt vmcnt(0)" ::: "memory"); }
        __syncthreads();
        DSTAMP(1);
        { LAS u32* cbm = (LAS u32*)(c.lds + L_DSA_CBM); const int nch = N >> 4;
          const int tot = 16 * nch;
          for (int base = tid; base < tot; base += 4 * NTHR) {
              u32x4 wq[4]; int qqs[4], chs[4];
#pragma unroll
              for (int u = 0; u < 4; ++u) { const int idx = base + u * NTHR; const int qq = idx < tot ? idx / nch : 0; const int ch = idx < tot ? idx - qq * nch : 0; qqs[u] = qq; chs[u] = ch;
                  wq[u] = *(const u32x4*)(binrow + (size_t)qq * 16384 + ch * 16); }
#pragma unroll
              for (int u = 0; u < 4; ++u) { if (base + u * NTHR >= tot) break;
                  const int qq = qqs[u], ch = chs[u]; const unsigned cb1 = cnts[32 + qq];
#pragma unroll
                  for (int wi = 0; wi < 4; ++wi) { const unsigned w = wq[u][wi];
#pragma unroll
                      for (int bb = 0; bb < 4; ++bb) { const unsigned cb = (w >> (8 * bb)) & 0xffu;
                          if (cb >= cb1) { const int key = ch * 16 + wi * 4 + bb;
                              if (cb > cb1) lds_oru(bm + qq * 512 + (key >> 5), 1u << (key & 31));
                              else lds_oru(cbm + qq * 512 + (key >> 5), 1u << (key & 31)); } } }
              }
          }
        }
        __syncthreads();
        DSTAMP(2);
        for (int rep8_ = 0; rep8_ < ((DSA_REP & 8) ? 2 : 1); ++rep8_)
        for (int qq = 2 * c.wave; qq < 2 * c.wave + 2; ++qq) {
            int lane = c.lane; asm volatile("" : "+v"(lane));
            const unsigned need = cnts[48 + qq]; unsigned C;
            {
                const LAS u32* cbm = (const LAS u32*)(c.lds + L_DSA_CBM) + qq * 512; LAS u16* ck_ = (LAS u16*)(c.lds + L_DSA_FLAT) + qq * DSA_CAP;
                unsigned wv[8]; unsigned cntl = 0;
#pragma unroll
                for (int i = 0; i < 8; ++i) { wv[i] = cbm[lane * 8 + i]; cntl += __builtin_popcount(wv[i]); }
                unsigned inc = cntl;
#pragma unroll
                for (int o = 1; o < 64; o <<= 1) { const unsigned v = __shfl_up(inc, o); if (lane >= o) inc += v; }
                unsigned pos = inc - cntl;
#pragma unroll
                for (int i = 0; i < 8; ++i) { unsigned w = wv[i]; while (w) { const int b = __builtin_ctz(w); if (pos < (unsigned)DSA_CAP) ck_[pos] = (u16)(lane * 256 + i * 32 + b); ++pos; w &= w - 1; } }
                C = min((unsigned)__shfl(inc, 63), (unsigned)DSA_CAP);
                asm volatile("s_waitcnt lgkmcnt(0)" ::: "memory");
            }
            {
                const LAS u16* candk = (const LAS u16*)(c.lds + L_DSA_FLAT) + qq * DSA_CAP; const int n_ = lane & 15, g_ = lane >> 4;
                const _Float16* qp = QI + (size_t)(qt * 16 + qq) * 288 + 8 * g_; const _Float16* KIc = (const _Float16*)(c.ws + T_KI);
                f16x8 q2[9];
#pragma unroll
                for (int hh = 0; hh < 9; ++hh) q2[hh] = *(const f16x8*)(qp + hh * 32);
                const u32 sb2 = SG[qt * 16 + qq];
                for (unsigned base = 0; base < C; base += 64) {
                    f16x8 kfs[4];
#pragma unroll
                    for (int u = 0; u < 4; ++u) { const unsigned j = base + 16 * u + n_; const unsigned key = j < C ? candk[j] : 0u; kfs[u] = *(const f16x8*)(KIc + (size_t)key * 32 + 8 * g_); }
#pragma unroll
                    for (int u = 0; u < 4; ++u) { if (base + 16 * u >= C) break;
                        f32x4 acc = __builtin_amdgcn_mfma_f32_16x16x32_f16(kfs[u], q2[8], (f32x4){0.f, 0.f, 0.f, 0.f}, 0, 0, 0);
#pragma unroll
                        for (int hh = 0; hh < 8; ++hh) { const f32x4 x = __builtin_amdgcn_mfma_f32_16x16x32_f16(kfs[u], q2[hh], (f32x4){0.f, 0.f, 0.f, 0.f}, 0, 0, 0); const float sgn = ((sb2 >> hh) & 1u) ? -1.f : 1.f;
#pragma unroll
                            for (int r = 0; r < 4; ++r) acc[r] = __builtin_fmaf(__builtin_fabsf(x[r]), sgn, acc[r]); }
                        if (n_ == 0) {
#pragma unroll
                            for (int r = 0; r < 4; ++r) { const unsigned jj = base + 16 * u + 4 * g_ + r; if (jj < C) cand[qq * DSA_CAP + jj] = ((u64)ord_of(acc[r] + 0.0f) << 32) | (u64)(0xFFFFFFFFu - (unsigned)candk[jj]); }
                        }
                    }
                }
                asm volatile("s_waitcnt lgkmcnt(0)" ::: "memory");
            }
            if (C <= 64u) {
                const u64 mine = (unsigned)lane < C ? cand[qq * DSA_CAP + lane] : 0ull; unsigned rank = 0;
                const unsigned mlo = (unsigned)mine, mhi = (unsigned)(mine >> 32);
                for (unsigned j = 0; j < C; ++j) { const u64 o = ((u64)(unsigned)__builtin_amdgcn_readlane((int)mhi, (int)j) << 32) | (unsigned)__builtin_amdgcn_readlane((int)mlo, (int)j); rank += (o > mine) ? 1u : 0u; }
                if ((unsigned)lane < C && rank < need) { const unsigned key = 0xFFFFFFFFu - mlo; lds_oru(bm + qq * 512 + (key >> 5), 1u << (key & 31)); }
            } else {
            u64 ck[DSA_CAP / 64];
#pragma unroll
            for (int i = 0; i < DSA_CAP / 64; ++i) { const unsigned idx = lane + 64 * i; ck[i] = idx < C ? cand[qq * DSA_CAP + idx] : 0ull; }
            u64 pre = 0xFFFFC000ull;
            for (int bit = 63; bit >= 0; --bit) {
                if (bit < 32 && bit > 13) continue;
                const u64 trial = pre | (1ull << bit); unsigned cnt = 0;
#pragma unroll
                for (int i = 0; i < DSA_CAP / 64; ++i) cnt += __builtin_popcountll(__ballot(ck[i] >= trial));
                if (cnt >= need) pre = trial;
            }
#pragma unroll
            for (int i = 0; i < DSA_CAP / 64; ++i) if (ck[i] >= pre && ck[i] != 0ull) { const unsigned key = 0xFFFFFFFFu - (unsigned)(ck[i] & 0xFFFFFFFFull); lds_oru(bm + qq * 512 + (key >> 5), 1u << (key & 31)); }
            }
            asm volatile("s_waitcnt lgkmcnt(0)" ::: "memory");
            unsigned wv[8]; unsigned cntl = 0;
#pragma unroll
            for (int i = 0; i < 8; ++i) { wv[i] = bm[qq * 512 + lane * 8 + i]; cntl += __builtin_popcount(wv[i]); }
            unsigned inc = cntl;
#pragma unroll
            for (int o = 1; o < 64; o <<= 1) { const unsigned v = __shfl_up(inc, o); if (lane >= o) inc += v; }
            unsigned pos = inc - cntl;
#pragma unroll
            for (int i = 0; i < 8; ++i) { unsigned w = wv[i]; while (w) { const int b = __builtin_ctz(w); if (pos < 256) sel[qq * 256 + pos] = (u16)(lane * 256 + i * 32 + b); ++pos; w &= w - 1; } }
            if (lane == 63) cnts[qq] = inc;
        }
        __syncthreads();
    } else {
        for (int i = tid; i < 16 * 256; i += NTHR) sel[i] = (u16)((i & 255) < N ? (i & 255) : 0);
        if (tid < 16) cnts[tid] = (unsigned)N;
        __syncthreads();
    }
    DSTAMP(3);
    LAS unsigned char* img = c.lds + L_DSA_IMG + c.wave * 16384;
    for (int rep_ = 0; rep_ < ((DSA_REP & 4) ? 2 : 1); ++rep_)
    for (int qq = 2 * c.wave; qq < 2 * c.wave + 2; ++qq) {
        int lane = c.lane; asm volatile("" : "+v"(lane)); const int q = lane & 15, g = lane >> 4;
        const int t = qt * 16 + qq; const int nsel = (int)min(cnts[qq], 256u); const int ntl = (nsel + 31) >> 5;
        bf16x8 bq[4];
#pragma unroll
        for (int s = 0; s < 4; ++s) { if (q < 4) bq[s] = *(const bf16x8*)(QL + (size_t)t * 512 + q * 128 + 32 * s + 8 * g); else bq[s] = (bf16x8){0, 0, 0, 0, 0, 0, 0, 0}; }
        float m = -INFINITY, lsum = 0.f; f32x4 o[8];
#pragma unroll
        for (int cb = 0; cb < 8; ++cb) o[cb] = (f32x4){0.f, 0.f, 0.f, 0.f};
        u32x4 grA[8], grB[8];
        const int grow = lane >> 4, gchk = lane & 15;
#define DSA_GATHER(TL, GR) do { _Pragma("unroll") for (int i = 0; i < 8; ++i) { const int si = (TL) * 32 + grow + 4 * i; const unsigned key = si < nsel ? sel[qq * 256 + si] : 0u; \
            GR[i] = *(const u32x4*)(CKV + (size_t)key * 128 + gchk * 8); } } while (0)
#define DSA_TILE(TL, GR, IMOFF) do { \
            LAS unsigned char* im = img + (IMOFF); \
            _Pragma("unroll") for (int i = 0; i < 8; ++i) *(LAS u32x4*)(im + img_off(grow + 4 * i, gchk)) = GR[i]; \
            if ((TL) + 2 < ntl) DSA_GATHER((TL) + 2, GR); \
            f32x4 st[2]; \
            _Pragma("unroll") for (int rb = 0; rb < 2; ++rb) { st[rb] = (f32x4){0.f, 0.f, 0.f, 0.f}; const unsigned row = 8 * (q >> 2) + 4 * rb + (q & 3); \
                _Pragma("unroll") for (int s = 0; s < 4; ++s) { const bf16x8 af = *(const LAS bf16x8*)(im + img_off(row, 4 * s + g)); st[rb] = __builtin_amdgcn_mfma_f32_16x16x32_bf16(af, bq[s], st[rb], 0, 0, 0); } } \
            float x[8]; float mx = -INFINITY; \
            _Pragma("unroll") for (int j = 0; j < 8; ++j) { x[j] = st[j >> 2][j & 3]; if ((TL) * 32 + 8 * g + j >= nsel) x[j] = -INFINITY; mx = fmaxf(mx, x[j]); } \
            mx = fmaxf(mx, __shfl_xor(mx, 16)); mx = fmaxf(mx, __shfl_xor(mx, 32)); \
            const float mn = fmaxf(m, mx); const float al = __builtin_amdgcn_exp2f(m - mn); m = mn; float sm = 0.f; \
            _Pragma("unroll") for (int j = 0; j < 8; ++j) { x[j] = __builtin_amdgcn_exp2f(x[j] - mn); sm += x[j]; } \
            lsum = lsum * al + sm; \
            u32x4 pw; pw.x = pk_bf16(x[0], x[1]); pw.y = pk_bf16(x[2], x[3]); pw.z = pk_bf16(x[4], x[5]); pw.w = pk_bf16(x[6], x[7]); \
            const bf16x8 pa = __builtin_bit_cast(bf16x8, pw); \
            float alr[4]; \
            _Pragma("unroll") for (int r = 0; r < 4; ++r) alr[r] = __builtin_bit_cast(float, __builtin_amdgcn_readlane(__builtin_bit_cast(int, al), r)); \
            const unsigned p = lane & 3, qd = (lane & 15) >> 2; \
            _Pragma("unroll") for (int cb = 0; cb < 8; ++cb) { \
                const v4i16_t lo = __builtin_amdgcn_ds_read_tr16_b64_v4i16((LAS v4i16_t*)(im + img_off(8 * g + qd, 2 * cb + (p >> 1)) + 8 * (p & 1))); \
                const v4i16_t hi = __builtin_amdgcn_ds_read_tr16_b64_v4i16((LAS v4i16_t*)(im + img_off(8 * g + 4 + qd, 2 * cb + (p >> 1)) + 8 * (p & 1))); \
                const bf16x8 bw = (bf16x8){lo[0], lo[1], lo[2], lo[3], hi[0], hi[1], hi[2], hi[3]}; \
                f32x4 oc = o[cb]; \
                _Pragma("unroll") for (int r = 0; r < 4; ++r) oc[r] *= alr[r]; \
                o[cb] = __builtin_amdgcn_mfma_f32_16x16x32_bf16(pa, bw, oc, 0, 0, 0); } \
        } while (0)
        typedef short v4i16_t __attribute__((ext_vector_type(4)));
        DSA_GATHER(0, grA);
        if (ntl > 1) DSA_GATHER(1, grB);
        for (int tl = 0; tl < ntl; tl += 2) {
            DSA_TILE(tl, grA, 0);
            if (tl + 1 < ntl) DSA_TILE(tl + 1, grB, 8192);
        }
#undef DSA_TILE
#undef DSA_GATHER
        lsum += __shfl_xor(lsum, 16); lsum += __shfl_xor(lsum, 32);
        float il[4];
#pragma unroll
        for (int r = 0; r < 4; ++r) il[r] = 1.0f / __builtin_bit_cast(float, __builtin_amdgcn_readlane(__builtin_bit_cast(int, lsum), r));
        if (g == 0) {
#pragma unroll
            for (int cb = 0; cb < 8; ++cb)
#pragma unroll
                for (int r = 0; r < 4; ++r) OD[(size_t)t * 512 + r * 128 + 16 * cb + q] = f2bf(o[cb][r] * il[r]);
        }
    }
    __syncthreads();
    DSTAMP(4);
}

__device__ __forceinline__ void phase_route(const Ctx& c, CArgsP a) {
    const float* xr = (const float*)(c.ws + O_XR); const float* ssq = (const float*)(c.ws + O_SSQ);
    const float* rw = a->in[I_RTW]; const float* rb = a->in[I_RTB]; const float* gf = a->in[I_GFFN] + D;
    int* TOPE = (int*)(c.ws + M_TOPE); float* TOPG = (float*)(c.ws + M_TOPG); int* CNT = (int*)(c.ws + M_CNT);
    LAS int* lcnt = (LAS int*)(c.lds + 100000);
    LAS float* rwl = (LAS float*)c.lds;
    for (int idx = c.tid; idx < D * 2; idx += NTHR) { const int k = idx >> 1; const f32x4 w = *(const f32x4*)(rw + (size_t)idx * 4); *(LAS f32x4*)(rwl + idx * 4) = w * gf[k]; }
    for (int blk = c.bid; blk < S / 64; blk += c.G) {
        __syncthreads();
        if (c.tid < 8) lcnt[c.tid] = 0;
        __syncthreads();
        for (int i4 = 0; i4 < 8; i4 += 4) {
            f32x4 xv[4][4];
#pragma unroll
            for (int i = 0; i < 4; ++i)
#pragma unroll
                for (int j = 0; j < 4; ++j) xv[i][j] = *(const f32x4*)(xr + (size_t)(blk * 64 + c.wave * 8 + i4 + i) * D + 16 * c.lane + 4 * j);
            float acc[4][8];
#pragma unroll
            for (int i = 0; i < 4; ++i)
#pragma unroll
                for (int e = 0; e < 8; ++e) acc[i][e] = 0.f;
#pragma unroll
            for (int j = 0; j < 4; ++j)
#pragma unroll
                for (int q = 0; q < 4; ++q) { const LAS float* wp = rwl + (size_t)(16 * c.lane + 4 * j + q) * 8; const f32x4 w0 = *(const LAS f32x4*)wp, w1 = *(const LAS f32x4*)(wp + 4);
#pragma unroll
                    for (int i = 0; i < 4; ++i) { const float x = xv[i][j][q];
#pragma unroll
                        for (int e = 0; e < 4; ++e) { acc[i][e] = fmaf(x, w0[e], acc[i][e]); acc[i][4 + e] = fmaf(x, w1[e], acc[i][4 + e]); } } }
#pragma unroll
            for (int i = 0; i < 4; ++i) {
                const int t = blk * 64 + c.wave * 8 + i4 + i; const float rs = row_rstd(ssq, t); float lg[8];
#pragma unroll
                for (int e = 0; e < 8; ++e) lg[e] = wave_sum(acc[i][e]) * rs + rb[e];
                int e0 = 0; float v0 = lg[0];
#pragma unroll
                for (int e = 1; e < 8; ++e) if (lg[e] > v0) { v0 = lg[e]; e0 = e; }
                int e1 = -1; float v1 = -INFINITY;
#pragma unroll
                for (int e = 0; e < 8; ++e) if (e != e0 && lg[e] > v1) { v1 = lg[e]; e1 = e; }
                const float p1 = 1.0f / (1.0f + __expf(v0 - v1)), p0 = 1.0f - p1;
                if (c.lane == 0) { TOPE[t * 2] = e0; TOPE[t * 2 + 1] = e1; TOPG[t * 2] = p0; TOPG[t * 2 + 1] = p1; lds_addi(&lcnt[e0], 1); lds_addi(&lcnt[e1], 1); }
            }
        }
        __syncthreads();
        if (c.tid < 8) CNT[blk * 8 + c.tid] = lcnt[c.tid];
    }
}
__device__ __forceinline__ void moe_tables(const Ctx& c, LAS int* ebase, LAS int* pexp) {
    const int* CNT = (const int*)(c.ws + M_CNT);
    LAS int* tot = ebase + 16;
    if (c.tid < 8) tot[c.tid] = 0;
    __syncthreads();
    { int s = 0; const int e = c.tid & 7; for (int b = c.tid >> 3; b < 256; b += 64) s += CNT[b * 8 + e]; lds_addi(&tot[e], s); }
    __syncthreads();
    if (c.tid == 0) { int b = 0; for (int e = 0; e < 8; ++e) { ebase[e] = b; const int np = (tot[e] + 255) >> 8; for (int p = 0; p < np; ++p) pexp[(b >> 8) + p] = e; b += np << 8; } ebase[8] = b; }
    __syncthreads();
}
__device__ __forceinline__ void phase_sort(const Ctx& c) {
    const int* CNT = (const int*)(c.ws + M_CNT); const int* TOPE = (const int*)(c.ws + M_TOPE); const float* TOPG = (const float*)(c.ws + M_TOPG);
    const u16* xb = (const u16*)(c.ws + O_XB); const float* ssq = (const float*)(c.ws + O_SSQ);
    u16* XS = (u16*)(c.ws + M_XS); float* RS = (float*)(c.ws + M_RS); float* RGt = (float*)(c.ws + M_RG); int* TOKROW = (int*)(c.ws + M_TOKROW);
    LAS int* ebase = (LAS int*)(c.lds + 100000); LAS int* pexp = ebase + 64; LAS int* boff = ebase + 256; LAS int* rows = ebase + 320;
    moe_tables(c, ebase, pexp);
    for (int blk = c.bid; blk < S / 64; blk += c.G) {
        __syncthreads();
        {
            int s = 0; for (int b = c.lane; b < blk; b += 64) s += CNT[b * 8 + c.wave];
#pragma unroll
            for (int o = 1; o < 64; o <<= 1) s += __shfl_xor(s, o);
            if (c.lane == 0) boff[c.wave] = ebase[c.wave] + s;
        }
        if (c.tid < 128) rows[128 + c.tid] = TOPE[blk * 128 + c.tid];
        __syncthreads();
        if (c.tid < 128) { const int e = rows[128 + c.tid]; int pos = boff[e]; for (int i = 0; i < c.tid; ++i) pos += (rows[128 + i] == e) ? 1 : 0; rows[c.tid] = pos; }
        __syncthreads();
        for (int i0 = c.wave * 16; i0 < c.wave * 16 + 16; i0 += 4) {
            u32x4 v0[4], v1[4]; int rw_[4];
#pragma unroll
            for (int u = 0; u < 4; ++u) { const int i = i0 + u; const int t = blk * 64 + (i >> 1); rw_[u] = rows[i];
                const u32x4* sp = (const u32x4*)(xb + (size_t)t * D); v0[u] = sp[c.lane]; v1[u] = sp[c.lane + 64]; }
#pragma unroll
            for (int u = 0; u < 4; ++u) { u32x4* dp = (u32x4*)(XS + (size_t)rw_[u] * D); dp[c.lane] = v0[u]; dp[c.lane + 64] = v1[u]; }
            if (c.lane < 4) { const int i = i0 + c.lane; const int t = blk * 64 + (i >> 1), row = rows[i]; RS[row] = row_rstd(ssq, t); RGt[row] = TOPG[blk * 128 + i]; TOKROW[blk * 128 + i] = row; }
        }
    }
}
__device__ __forceinline__ void phase_final(const Ctx& c, CArgsP a) {
    const float* xr = (const float*)(c.ws + O_XR); const u16* YS = (const u16*)(c.ws + M_XS); const int* TOKROW = (const int*)(c.ws + M_TOKROW); const float* gfin = a->in[I_GFINAL];
    for (int t = c.gw; t < S; t += c.ngw) {
        const int r0 = TOKROW[t * 2], r1 = TOKROW[t * 2 + 1];
        f32x4 v[4]; float s = 0.f;
#pragma unroll
        for (int j = 0; j < 4; ++j) { const int col = (c.lane + 64 * j) * 4; v[j] = *(const f32x4*)(xr + (size_t)t * D + col);
            const u32x2 y0 = *(const u32x2*)(YS + (size_t)r0 * D + col), y1 = *(const u32x2*)(YS + (size_t)r1 * D + col);
            v[j].x += bflo(y0.x) + bflo(y1.x); v[j].y += bfhi(y0.x) + bfhi(y1.x); v[j].z += bflo(y0.y) + bflo(y1.y); v[j].w += bfhi(y0.y) + bfhi(y1.y);
#pragma unroll
            for (int rr = 0; rr < 2; ++rr) { const int rw = rr ? r1 : r0; if (rw >= 32768) {
#pragma unroll
                for (int s = 0; s < 3; ++s) { const u32x2 yy = *(const u32x2*)((const u16*)(c.ws + M_YS2) + ((size_t)s * YS2_ROWS + (rw - 32768)) * D + col); v[j].x += bflo(yy.x); v[j].y += bfhi(yy.x); v[j].z += bflo(yy.y); v[j].w += bfhi(yy.y); } } }
            s += (v[j].x * v[j].x + v[j].y * v[j].y) + (v[j].z * v[j].z + v[j].w * v[j].w); }
        const float rs = 1.0f / sqrtf(wave_sum(s) * (1.0f / D) + RMS_EPS);
#pragma unroll
        for (int j = 0; j < 4; ++j) { const int col = (c.lane + 64 * j) * 4; const f32x4 gv = *(const f32x4*)(gfin + col); f32x4 ov = v[j] * rs * gv;
#if PROBE
            { const u64* st = (const u64*)(c.ctl + CW_STAMP); const float tot = (float)(st[25] - st[0]);
              const float fa = (PA0 >= 100) ? (float)st[PA0 - 100] / tot : (float)(st[PA1] - st[PA0]) / tot;
              const float fb = (PB0 >= 100) ? (float)st[PB0 - 100] / tot : (float)(st[PB1] - st[PB0]) / tot;
              const float faq = rintf(fa * PQ) / PQ, fbq = rintf(fb * PQ) / PQ; ov = ov * (1.0f + faq); if (t == 0 && col == 0) ov.x += 100.0f * fbq; }
#endif
            *(f32x4*)(a->out + (size_t)t * D + col) = ov; }
    }
}

constexpr int NPHASE_IDS = 26;
extern __shared__ __attribute__((aligned(16))) unsigned char lds_raw[];
#define FRESH() Ctx c; CArgsP ap; { ap = (CArgsP)__builtin_amdgcn_kernarg_segment_ptr(); asm volatile("" : "+s"(ap)); \
        unsigned lb = (unsigned)(uintptr_t)(LAS unsigned char*)lds_raw; asm volatile("" : "+s"(lb)); c.lds = (LAS unsigned char*)(uintptr_t)lb; \
        c.ws = ap->ws; c.ctl = (u32*)(c.ws + O_CTL); int t_ = threadIdx.x; asm volatile("" : "+v"(t_)); \
        c.tid = t_; c.lane = t_ & 63; c.wave = __builtin_amdgcn_readfirstlane(t_ >> 6); c.G = gridDim.x; c.bid = blockIdx.x; c.gw = c.bid * NWAVES + c.wave; c.ngw = c.G * NWAVES; } \
        LAS unsigned char* lds = c.lds; (void)lds; (void)ap
#define IN(k) (lo <= (k) && (k) < hi)
#if MK_PER_PHASE
#define SEAM(k) do { } while (0)
#else
#if PROBE
#define SEAM(k) do { if (IN(k) && IN((k) + 1)) { xcd_barrier(bar); if (blockIdx.x == 0 && threadIdx.x == 0) ((u64*)(bar.bar - CW_BAR + CW_STAMP))[(k) + 1] = wall_clock64(); } } while (0)
#else
#define SEAM(k) do { if (IN(k) && IN((k) + 1)) xcd_barrier(bar); } while (0)
#endif
#endif
template <int l> __device__ __forceinline__ void layer_body(const int lo, const int hi, const XcdBarrier& bar) {
        const int pb = l ? 10 : 1;
        if (SITE(1) && IN(pb + 0)) { FRESH(); const float* ssq = (const float*)(c.ws + O_SSQ); const u16* xb = (const u16*)(c.ws + O_XB); (void)ssq; (void)xb;
            pg8::Gemm g{xb, (const u16*)(c.ws + O_W1) + (size_t)l * NW1 * D, D, D}; pg8::StaticOrder so; so.init(S, NW1, c.G, c.bid);
            EpiG1 e{ssq, (u16*)(c.ws + T_QKVF), (u16*)(c.ws + T_QL), (float*)(c.ws + T_T56), (u16*)(c.ws + T_PR)};
            pg8::gemm_phase(lds, g, so, e);
        }
        SEAM(pb + 0);
        if (SITE(2) && IN(pb + 1)) { FRESH(); phase_prep(c, ap, l); }
        SEAM(pb + 1);
        if (SITE(3) && IN(pb + 2)) { FRESH(); const float* ssq = (const float*)(c.ws + O_SSQ); const u16* xb = (const u16*)(c.ws + O_XB); (void)ssq; (void)xb;
            LAS float* PB = (LAS float*)(lds + 131072);
            { const float* FB = (const float*)(c.ws + T_FB); int lane = c.lane; asm volatile("" : "+v"(lane));
              if (c.wave < 4) {
                  const int hh = c.wave; const f32x4 v = *(const f32x4*)(FB + hh * 256 + 4 * lane);
                  float inc = (v.x + v.y) + (v.z + v.w);
#pragma unroll
                  for (int o = 1; o < 64; o <<= 1) { const float u = __shfl_up(inc, o); if (lane >= o) inc += u; }
                  float ex = __shfl_up(inc, 1); if (lane == 0) ex = 0.f;
                  const float e1 = ex + v.x, e2 = e1 + v.y, e3 = e2 + v.z;
                  *(LAS f32x4*)(PB + hh * 256 + 4 * lane) = (f32x4){ex, e1, e2, e3};
              } else {
                  const int hh = c.wave - 4; const float* qm = (const float*)(c.ws + T_QKM); float mq = 0.f, mk = 0.f;
#pragma unroll
                  for (int i = 0; i < 4; ++i) { mq = fmaxf(mq, qm[(lane + 64 * i) * 8 + hh]); mk = fmaxf(mk, qm[(lane + 64 * i) * 8 + 4 + hh]); }
#pragma unroll
                  for (int o = 1; o < 64; o <<= 1) { mq = fmaxf(mq, __shfl_xor(mq, o)); mk = fmaxf(mk, __shfl_xor(mk, o)); }
                  if (lane == 0) { (void)mq; PB[1024 + hh] = sqrtf(mk) * 1.01f; }
              } }
            __syncthreads();
            for (int rr1_ = 0; rr1_ < ((DSA_REP & 16) ? 2 : 1); ++rr1_)
            for (int task = c.gw; task < 2048; task += c.ngw) r1_task(c, task, (LAS float*)(lds + c.wave * 16384));
            for (int rf_ = 0; rf_ < ((DSA_REP & 32) ? 2 : 1); ++rf_) {
            u32* qctr = c.ctl + CW_Q_FOX + 128 * l + 32 * rf_;
            for (;;) {
                unsigned u = 0; if (c.lane == 0) u = atomicAdd(qctr, 1u);
                u = __builtin_amdgcn_readfirstlane(u);
                if (u >= 2048u) break;
                fox_unit(c, (int)u, PB);
            }
            }
        }
        SEAM(pb + 2);
        if (SITE(4) && IN(pb + 3)) { FRESH(); const float* ssq = (const float*)(c.ws + O_SSQ); const u16* xb = (const u16*)(c.ws + O_XB); (void)ssq; (void)xb;
#if PROBE
            if (c.tid < 8) ((LAS u64*)(lds + L_DSA_CNT + 1024))[c.tid] = 0ull;
#endif
            if (c.bid < 32) { for (int rt_ = c.bid; rt_ < 32; rt_ += (c.G < 32 ? c.G : 32)) r2_task(c, rt_ >> 2, rt_ & 3); }
            __syncthreads();
#if PROBE
            if (l == 0 && c.bid == 0 && c.tid == 0) ((u64*)(c.ctl + CW_STAMP))[24] = wall_clock64();
#endif
            if (c.tid < 64) { const float* kim = (const float*)(c.ws + T_KIM); float mk = fmaxf(fmaxf(kim[c.tid], kim[c.tid + 64]), fmaxf(kim[c.tid + 128], kim[c.tid + 192]));
#pragma unroll
                for (int o = 1; o < 64; o <<= 1) mk = fmaxf(mk, __shfl_xor(mk, o));
                if (c.tid == 0) ((LAS float*)(lds + L_DSA_CNT + 768))[0] = sqrtf(mk) * 1.02f; }
            __syncthreads();
            u32* qctr = c.ctl + CW_Q_DSA + 128 * l; LAS u32* ub = (LAS u32*)(lds + L_DSA_CNT + 512);
            for (;;) {
                if (c.tid == 0) ub[0] = atomicAdd(qctr, 1u);
                __syncthreads();
                const unsigned u = ub[0];
                __syncthreads();
                if (u >= 1024u) break;
                dsa_unit(c, 1023 - (int)u);
            }
#if PROBE
            if (l == 0 && c.bid == 100 && c.tid == 0) { u64* st = (u64*)(c.ctl + CW_STAMP); st[25] = wall_clock64(); for (int k = 0; k < 5; ++k) st[26 + k] = ((LAS u64*)(lds + L_DSA_CNT + 1024))[k]; }
#endif
        }
        SEAM(pb + 3);
        if (SITE(5) && IN(pb + 4)) { FRESH(); for (int task = c.gw; task < 2048; task += c.ngw) r3_task(c, ap, l, task); }
        SEAM(pb + 4);
        if (SITE(6) && IN(pb + 5)) { FRESH(); const float* ssq = (const float*)(c.ws + O_SSQ); const u16* xb = (const u16*)(c.ws + O_XB); (void)ssq; (void)xb;
            if (l == 0) {
                LAS float* scr = (LAS float*)(lds + c.wave * 16640);
                int it0 = convert_seg<1>(ap->in[I_FWG], ap->in[I_FWU], ap->in[I_GFFN], (u16*)(c.ws + T_FFNW), D, FFD, 2 * FFD, 0, scr, c.gw, c.ngw, c.lane);
                (void)convert_seg<0>(ap->in[I_FWD], nullptr, nullptr, (u16*)(c.ws + T_FFNWD), FFD, D, 1024, it0, scr, c.gw, c.ngw, c.lane);
                __syncthreads();
            }
            const u16* wgt = (const u16*)(c.ws + O_WGT) + (size_t)l * 3072 * D; const u16* ow = (const u16*)(c.ws + O_OUTW + l * OUTW_L);
            u16* gt = (u16*)(c.ws + T_GT); float* mgf = (float*)(c.ws + T_MGF); const float* bg = ap->in[I_BGATE] + l * 3072;
            pg8::StaticOrder so; so.init(S, D, c.G, c.bid);
            { pg8::Gemm g{xb, wgt, D, D}; EpiGate e{ssq, bg, gt}; pg8::gemm_phase(lds, g, so, e); }
            { pg8::Gemm g{(const u16*)(c.ws + T_OF), ow, 256, 256}; EpiProj<0> e{gt, mgf}; pg8::gemm_phase(lds, g, so, e); }
            { pg8::Gemm g{xb, wgt + (size_t)1024 * D, D, D}; EpiGate e{ssq, bg + 1024, gt}; pg8::gemm_phase(lds, g, so, e); }
            { pg8::Gemm g{(const u16*)(c.ws + T_OD), ow + 1024 * 256, 512, 512}; EpiProj<1> e{gt, mgf}; pg8::gemm_phase(lds, g, so, e); }
            { pg8::Gemm g{xb, wgt + (size_t)2048 * D, D, D}; EpiGate e{ssq, bg + 2048, gt}; pg8::gemm_phase(lds, g, so, e); }
            { pg8::Gemm g{(const u16*)(c.ws + T_OR), ow + 1024 * 256 + 1024 * 512, 512, 512}; EpiProj<2> e{gt, mgf}; pg8::gemm_phase(lds, g, so, e); }
        }
        SEAM(pb + 5);
        if (SITE(7) && IN(pb + 6)) { FRESH(); const float* ssq = (const float*)(c.ws + O_SSQ); const u16* xb = (const u16*)(c.ws + O_XB); (void)ssq; (void)xb;
            const u16* ow = (const u16*)(c.ws + O_OUTW + l * OUTW_L);
            pg8::Gemm g{(const u16*)(c.ws + T_GT), ow + 1024 * 256 + 2 * 1024 * 512, D, D}; pg8::StaticOrder so; so.init(S, D, c.G, c.bid);
            EpiResid e{(float*)(c.ws + O_XR), (u16*)(c.ws + O_XB), (float*)(c.ws + O_SSQ)};
            pg8::gemm_phase(lds, g, so, e);
        }
        SEAM(pb + 6);
        if (l == 0) {
            if (SITE(8) && IN(pb + 7)) { FRESH(); const float* ssq = (const float*)(c.ws + O_SSQ); const u16* xb = (const u16*)(c.ws + O_XB); (void)ssq; (void)xb;
                pg8::Gemm g{xb, (const u16*)(c.ws + T_FFNW), D, D}; pg8::StaticOrder so; so.init(S, 2 * FFD, c.G, c.bid);
                EpiSwiglu e{ssq, nullptr, (u16*)(c.ws + T_ACT), FFD, 0};
                pg8::gemm_phase(lds, g, so, e);
            }
            SEAM(pb + 7);
            if (SITE(9) && IN(pb + 8)) { FRESH(); const float* ssq = (const float*)(c.ws + O_SSQ); const u16* xb = (const u16*)(c.ws + O_XB); (void)ssq; (void)xb;
                pg8::Gemm g{(const u16*)(c.ws + T_ACT), (const u16*)(c.ws + T_FFNWD), FFD, FFD}; pg8::StaticOrder so; so.init(S, D, c.G, c.bid);
                EpiResid e{(float*)(c.ws + O_XR), (u16*)(c.ws + O_XB), (float*)(c.ws + O_SSQ)};
                pg8::gemm_phase(lds, g, so, e);
            }
            SEAM(pb + 8);
        } else {
            if (SITE(10) && IN(pb + 7)) { FRESH();
                for (int rq_ = 0; rq_ < ((DSA_REP & 64) ? 2 : 1); ++rq_) phase_route(c, ap);
                __syncthreads();
                LAS float* scr = (LAS float*)(lds + c.wave * 16640); int it0 = 0;
                for (int e = 0; e < NEXP; ++e) {
                    it0 = convert_seg<1>(ap->in[I_MWG] + (size_t)e * D * FFE, ap->in[I_MWU] + (size_t)e * D * FFE, ap->in[I_GFFN] + D, (u16*)(c.ws + M_WGU) + (size_t)e * 2 * FFE * D, D, FFE, 2 * FFE, it0, scr, c.gw, c.ngw, c.lane);
                    it0 = convert_seg<0>(ap->in[I_MWD] + (size_t)e * FFE * D, nullptr, nullptr, (u16*)(c.ws + M_WD) + (size_t)e * D * FFE, FFE, D, 1024, it0, scr, c.gw, c.ngw, c.lane);
                }
            }
            SEAM(pb + 7);
            if (SITE(11) && IN(pb + 8)) { FRESH(); for (int rq_ = 0; rq_ < ((DSA_REP & 128) ? 2 : 1); ++rq_) { phase_sort(c); __syncthreads(); } }
            SEAM(pb + 8);
            for (int half = 0; half < 3; ++half) {
                if (!(IN(pb + 9 + 2 * half) || IN(pb + 10 + 2 * half))) continue;
                FRESH();
                LAS int* ebase = (LAS int*)(lds + 135168); LAS int* pexp = ebase + 64;
                moe_tables(c, ebase, pexp);
                const int npanel = ebase[8] >> 8;
                const int p0 = min(64 * half, npanel), np = ((half == 2) ? npanel : min(64 * (half + 1), npanel)) - p0;
                if (SITE(12) && IN(pb + 9 + 2 * half)) {
                    pg8::Gemm g{(const u16*)(c.ws + M_XS), (const u16*)(c.ws + M_WGU), D, D};
                    pg8::MoeOrder mo{p0, np, 28, c.G, c.bid, 28, pexp, 1};
                    EpiSwiglu e{nullptr, (const float*)(c.ws + M_RS), (u16*)(c.ws + M_ACT), FFE, p0 * 256};
                    pg8::gemm_phase(lds, g, mo, e);
                }
                SEAM(pb + 9 + 2 * half);
                if (SITE(13) && IN(pb + 10 + 2 * half)) {
                    const int nks = (half == 2) ? 4 : 1;
                    pg8::Gemm g{(const u16*)(c.ws + M_ACT) - (size_t)p0 * 256 * FFE, (const u16*)(c.ws + M_WD), FFE / nks, FFE};
                    pg8::MoeOrder mo{p0, np, 4, c.G, c.bid, 4, pexp, nks};
                    EpiMoeDown e{(const float*)(c.ws + M_RG), (u16*)(c.ws + M_XS), (u16*)(c.ws + M_YS2)};
                    pg8::gemm_phase(lds, g, mo, e);
                }
                SEAM(pb + 10 + 2 * half);
            }
#if PROBE
            xcd_barrier(bar);
#endif
            if (SITE(14) && IN(pb + 15)) { FRESH(); phase_final(c, ap); }
        }
    }

__global__ void __launch_bounds__(NTHR, 2) mk_fwd(Args a) {
    LAS unsigned char* lds0 = (LAS unsigned char*)lds_raw; u32* ctl0 = (u32*)(a.ws + O_CTL);
    volatile LAS unsigned* MISC = (volatile LAS unsigned*)(lds0 + LDS_MISC);
    if (threadIdx.x < 64) MISC[threadIdx.x] = 0u;
    __syncthreads();
    XcdBarrier bar; bar.bar = ctl0 + CW_BAR; bar.x = 0; bar.st = nullptr;
#if !MK_PER_PHASE
    bar = xcd_barrier_post(ctl0 + CW_BAR, MISC);
#endif
    const int lo = a.ph_lo, hi = a.ph_hi;
#if PROBE
    if (blockIdx.x == 0 && threadIdx.x == 0) ((u64*)(ctl0 + CW_STAMP))[0] = wall_clock64();
#endif
    if (SITE(0) && IN(0)) { FRESH(); phase_prologue(c, ap); }
    SEAM(0);
    layer_body<0>(lo, hi, bar);
    layer_body<1>(lo, hi, bar);
#undef IN
#undef SEAM
}

extern "C" void kernel_launch(void* const* d_in, const int* in_sizes, int n_in, void* d_out, int out_size, void* d_ws, size_t ws_size, hipStream_t stream) {
    static int grid = 0;
    if (grid == 0) {
        if (n_in != 37 || ws_size < WS_NEED) { fprintf(stderr, "kernel_launch: n_in %d ws %zu need %zu\n", n_in, ws_size, (size_t)WS_NEED); grid = -1; return; }
        int dev = 0, cus = 0, per_cu = 0;
        hipGetDevice(&dev); hipDeviceGetAttribute(&cus, hipDeviceAttributeMultiprocessorCount, dev);
        hipFuncSetAttribute((const void*)mk_fwd, hipFuncAttributeMaxDynamicSharedMemorySize, LDS_BYTES);
        hipOccupancyMaxActiveBlocksPerMultiprocessor(&per_cu, (const void*)mk_fwd, NTHR, LDS_BYTES);
        (void)hipGetLastError();
        grid = cus > 0 ? cus : 256;
        if (per_cu < 1) fprintf(stderr, "kernel_launch: occupancy query says %d\n", per_cu);
    }
    if (grid < 0) return;
    hipMemsetAsync((char*)d_ws + O_CTL, 0, CTL_BYTES, stream);
    Args a{};
    for (int i = 0; i < 37; ++i) a.in[i] = (const float*)d_in[i];
    a.out = (float*)d_out; a.ws = (unsigned char*)d_ws;
#if MK_PER_PHASE
    for (int i = 0; i < NPHASE_IDS; ++i) { a.ph_lo = i; a.ph_hi = i + 1; hipLaunchKernelGGL(mk_fwd, dim3(grid), dim3(NTHR), LDS_BYTES, stream, a); }
#else
    a.ph_lo = 0; a.ph_hi = NPHASE_IDS; hipLaunchKernelGGL(mk_fwd, dim3(grid), dim3(NTHR), LDS_BYTES, stream, a);
#endif
}
```

```cpp
#include <hip/hip_runtime.h>
#include <stdint.h>
#include <stdio.h>

#ifndef MK_PER_PHASE
#define MK_PER_PHASE 0
#endif

#ifndef PHMASK
#define PHMASK 0xFFFFFFu
#endif
#define SITE(k) (((PHMASK) >> (k)) & 1u)
#ifndef PROBE
#define PROBE 0
#endif
#ifndef DSA_REP
#define DSA_REP 0
#endif
#define PA0 17
#define PA1 19
#define PB0 4
#define PB1 5
#define PQ 100.0f
#define LAS __attribute__((address_space(3)))
typedef unsigned short u16;
typedef unsigned int u32;
typedef unsigned long long u64;
typedef short bf16x8 __attribute__((ext_vector_type(8)));
typedef _Float16 f16x8 __attribute__((ext_vector_type(8)));
typedef float f32x4 __attribute__((ext_vector_type(4)));
typedef float f32x2 __attribute__((ext_vector_type(2)));
typedef unsigned u32x4 __attribute__((ext_vector_type(4)));
typedef unsigned u32x2 __attribute__((ext_vector_type(2)));
typedef __bf16 bf16x2_t __attribute__((ext_vector_type(2)));

constexpr int S = 16384, D = 1024;
constexpr int DIN = 6316;
constexpr float RMS_EPS = 1e-6f;
constexpr float LOG2E = 1.4426950408889634f;
constexpr float C2 = 0.125f * LOG2E;
constexpr int NW1 = 3584;
constexpr int FFD = 2816, FFE = 3584, NEXP = 8;
constexpr int MOE_ROWS = 2 * S + NEXP * 256;
constexpr int NWAVES = 8, NTHR = 512;

constexpr size_t MB = 1u << 20;
constexpr size_t O_CTL = 0;
constexpr size_t CTL_BYTES = 2 * MB;
constexpr size_t O_XR = O_CTL + CTL_BYTES;
constexpr size_t O_SSQ = O_XR + (size_t)S * D * 4;
constexpr size_t O_XB = O_SSQ + (size_t)S * 16 * 4;
constexpr size_t O_M = O_XB + (size_t)S * D * 2;
constexpr size_t O_VFIRST = O_M;
constexpr size_t O_W1 = O_VFIRST + (size_t)S * 512 * 2;
constexpr size_t O_WGT = O_W1 + (size_t)2 * NW1 * D * 2;
constexpr size_t OUTW_L = (size_t)(256 + 512 + 512 + 1024) * 1024 * 2;
constexpr size_t O_OUTW = O_WGT + (size_t)2 * 3072 * D * 2;
constexpr size_t O_WL = O_OUTW + 2 * OUTW_L;
constexpr size_t WL_L = (size_t)512 * 320 * 2;
constexpr size_t O_T = O_WL + 2 * WL_L;
constexpr size_t T_QKVF = O_T;
constexpr size_t T_QL = T_QKVF + (size_t)S * 768 * 2;
constexpr size_t T_FL = T_QL + (size_t)S * 512 * 2;
constexpr size_t T_FB = T_FL + (size_t)4 * S * 4;
constexpr size_t T_QKM = T_FB + 4096;
constexpr size_t T_KIM = T_QKM + 8192;
constexpr size_t T_VT = T_KIM + 1024;
constexpr size_t T_CKV = T_VT + (size_t)256 * S * 2;
constexpr size_t T_QI = T_CKV + (size_t)S * 128 * 2;
constexpr size_t T_KI = T_QI + (size_t)S * 288 * 2;
constexpr size_t T_SG = T_KI + (size_t)S * 32 * 2;
constexpr size_t T_BC = T_SG + (size_t)S * 4;
constexpr size_t T_OF = T_BC + (size_t)S * 8 * 4;
constexpr size_t T_OD = T_OF + (size_t)S * 256 * 2;
constexpr size_t T_OR = T_OD + (size_t)S * 512 * 2;
constexpr size_t T_RW = T_OR + (size_t)S * 512 * 2;
constexpr size_t T_RKK = T_RW + (size_t)S * 512 * 4;
constexpr size_t T_RB = T_RKK + (size_t)S * 512 * 2;
constexpr size_t T_RK = T_RB + (size_t)S * 512 * 2;
constexpr size_t T_RR = T_RK + (size_t)S * 512 * 2;
constexpr size_t T_RV = T_RR + (size_t)S * 512 * 2;
constexpr size_t T_RG = T_RV + (size_t)S * 512 * 2;
constexpr size_t T_U1 = T_RG + (size_t)S * 512 * 2;
constexpr size_t T_T56 = T_U1;
constexpr size_t T_PR = T_T56 + (size_t)S * 512 * 4;
constexpr size_t T_YL = T_U1;
constexpr size_t T_RT = T_YL + (size_t)S * 512 * 4;
constexpr size_t T_PC = T_RT + (size_t)S * 512 * 2;
constexpr size_t T_UC = T_PC + (size_t)2048 * 4096 * 4;
constexpr size_t T_U1_END = T_UC + (size_t)2048 * 4096 * 4;
constexpr size_t T_GT = T_U1;
constexpr size_t T_MGF = T_GT + (size_t)S * D * 2;
static_assert(T_MGF + (size_t)S * D * 4 <= T_U1_END, "outproj overlay");
static_assert(T_PR + (size_t)S * 1792 * 2 <= T_U1_END, "g1 overlay");
constexpr size_t T_DSB = T_RW;
static_assert((size_t)256 * 16 * 16384 <= (size_t)S * 512 * (4 + 2 + 2 + 2 + 2), "dsa bin scratch");
constexpr size_t T_FFNW = T_RW;
constexpr size_t T_FFNWD = T_FFNW + (size_t)2 * FFD * D * 2;
static_assert(T_FFNWD + (size_t)D * FFD * 2 <= T_RKK, "ffn weights overlay");
constexpr size_t T_ACT = T_RKK;
static_assert(T_ACT + (size_t)S * FFD * 2 <= T_U1, "ffn act overlay");
constexpr size_t M_WGU = O_M;
constexpr size_t M_WD = M_WGU + (size_t)NEXP * 2 * FFE * D * 2;
constexpr size_t M_XS = M_WD + (size_t)NEXP * D * FFE * 2;
constexpr size_t M_ACT = M_XS + (size_t)MOE_ROWS * D * 2;
constexpr int MOE_HALF_ROWS = MOE_ROWS / 2 + 256;
constexpr int YS2_ROWS = 2304;
constexpr size_t M_YS2 = M_ACT + (size_t)32 * MB;
static_assert((size_t)YS2_ROWS * FFE * 2 <= (size_t)32 * MB && (size_t)32 * MB + (size_t)3 * YS2_ROWS * D * 2 <= (size_t)MOE_HALF_ROWS * FFE * 2, "ys2 overlay");
constexpr size_t M_RS = M_ACT + (size_t)MOE_HALF_ROWS * FFE * 2;
constexpr size_t M_RG = M_RS + (size_t)MOE_ROWS * 4;
constexpr size_t M_TOKROW = M_RG + (size_t)MOE_ROWS * 4;
constexpr size_t M_TOPE = M_TOKROW + (size_t)S * 2 * 4;
constexpr size_t M_TOPG = M_TOPE + (size_t)S * 2 * 4;
constexpr size_t M_CNT = M_TOPG + (size_t)S * 2 * 4;
constexpr size_t M_END = M_CNT + 256 * 8 * 4;
constexpr size_t WS_NEED = (T_U1_END > M_END ? T_U1_END : M_END);

constexpr int CW_BAR = 1024;
constexpr int CW_Q_FOX = 8192;
constexpr int CW_Q_DSA = 8192 + 64;
constexpr int CW_STAMP = 16384;

constexpr int LDS_MISC = 147456 - 256;
constexpr int LDS_BYTES = 147456;

__device__ __forceinline__ unsigned pk_bf16(float lo, float hi) { f32x2 v = {lo, hi}; bf16x2_t b = __builtin_convertvector(v, bf16x2_t); return __builtin_bit_cast(unsigned, b); }
__device__ __forceinline__ float bf2f(u16 b) { return __uint_as_float(((unsigned)b) << 16); }
__device__ __forceinline__ float bflo(unsigned w) { return __uint_as_float(w << 16); }
__device__ __forceinline__ float bfhi(unsigned w) { return __uint_as_float(w & 0xffff0000u); }
__device__ __forceinline__ u16 f2bf(float f) { return (u16)(pk_bf16(f, 0.f) & 0xffffu); }
__device__ __forceinline__ float wave_sum(float v) {
#pragma unroll
    for (int o = 1; o < 64; o <<= 1) v += __shfl_xor(v, o);
    return v;
}
__device__ __forceinline__ unsigned lds_addu(LAS unsigned* p, unsigned v) { return __hip_atomic_fetch_add(p, v, __ATOMIC_RELAXED, __HIP_MEMORY_SCOPE_WORKGROUP); }
__device__ __forceinline__ void lds_oru(LAS unsigned* p, unsigned v) { (void)__hip_atomic_fetch_or(p, v, __ATOMIC_RELAXED, __HIP_MEMORY_SCOPE_WORKGROUP); }
__device__ __forceinline__ int lds_addi(LAS int* p, int v) { return __hip_atomic_fetch_add(p, v, __ATOMIC_RELAXED, __HIP_MEMORY_SCOPE_WORKGROUP); }
__device__ __forceinline__ float sigmoidf_(float x) { return 1.0f / (1.0f + __expf(-x)); }
__device__ __forceinline__ float row_rstd(const float* ssq, int row) {
    const f32x4* p = (const f32x4*)(ssq + (size_t)row * 16);
    const f32x4 a = p[0], b = p[1], c = p[2], d = p[3];
    const float s = ((a.x + a.y) + (a.z + a.w)) + ((b.x + b.y) + (b.z + b.w)) + ((c.x + c.y) + (c.z + c.w)) + ((d.x + d.y) + (d.z + d.w));
    return 1.0f / sqrtf(s * (1.0f / D) + RMS_EPS);
}

#define XB_TMO      128
#define XB_XCNT(j)  (256  + 64 * (j))
#define XB_XSUB(j)  (1280 + 64 * (j))
#define XB_XGEN(j)  (2304 + 64 * (j))
#define XB_TOP      3328
#define XB_TOPGEN   3392
#define XCD_BAR_WORDS 3456
#define XB_SPIN_CAP (1u << 22)
__device__ __forceinline__ unsigned xb_ld(unsigned* p)              { return __hip_atomic_load(p, __ATOMIC_RELAXED, __HIP_MEMORY_SCOPE_AGENT); }
__device__ __forceinline__ unsigned xb_add(unsigned* p, unsigned v) { return __hip_atomic_fetch_add(p, v, __ATOMIC_RELAXED, __HIP_MEMORY_SCOPE_AGENT); }
__device__ __forceinline__ unsigned xb_xcc_id() { return (unsigned)__builtin_amdgcn_s_getreg((3 << 11) | 20) & 0xFu; }
#define XB_SPIN(cond, bar) do { unsigned _sp = 0; while (cond) { __builtin_amdgcn_s_sleep(1); \
    if ((++_sp & 255u) == 0u) { if (xb_ld(&(bar)[XB_TMO])) break; if (_sp > XB_SPIN_CAP) { atomicAdd(&(bar)[XB_TMO], 1u); break; } } } } while (0)
struct XcdBarrier { unsigned* bar; unsigned x; volatile LAS unsigned* st; };
__device__ __forceinline__ XcdBarrier xcd_barrier_post(unsigned* bar, volatile LAS unsigned* st) {
    XcdBarrier b; b.bar = bar; b.x = xb_xcc_id(); b.st = st;
    if (threadIdx.x == 0) (void)xb_add(&bar[XB_XCNT(b.x)], 1u);
    return b;
}
__device__ __forceinline__ void xcd_barrier_complete(unsigned* bar, unsigned x, unsigned& nloc, unsigned& nx) {
    const unsigned G = gridDim.x * gridDim.y * gridDim.z;
    unsigned sum, cnt, mine, sp = 0u;
    for (;;) {
        sum = 0u; cnt = 0u; mine = 0u;
#pragma unroll
        for (unsigned j = 0; j < 16; ++j) { const unsigned c = xb_ld(&bar[XB_XCNT(j)]); sum += c; cnt += (c > 0u) ? 1u : 0u; mine = (j == x) ? c : mine; }
        if (sum == G) break;
        __builtin_amdgcn_s_sleep(1);
        if ((++sp & 255u) == 0u) { if (xb_ld(&bar[XB_TMO])) break; if (sp > XB_SPIN_CAP) { atomicAdd(&bar[XB_TMO], 1u); break; } }
    }
    nloc = mine > 0u ? mine : 1u; nx = cnt > 0u ? cnt : 1u;
}
__device__ __forceinline__ void xcd_barrier(const XcdBarrier& b) {
    asm volatile("s_waitcnt vmcnt(0)" ::: "memory");
    __syncthreads();
    if (threadIdx.x == 0) {
        unsigned* bar = b.bar;
        __builtin_amdgcn_s_waitcnt(0);
        unsigned nloc = b.st[0], nx = b.st[1];
        if (nloc == 0u) { xcd_barrier_complete(bar, b.x, nloc, nx); b.st[0] = nloc; b.st[1] = nx; }
        const unsigned old = xb_add(&bar[XB_XSUB(b.x)], 1u);
        const unsigned gen = old / nloc;
        if (old + 1u == (gen + 1u) * nloc) {
            __builtin_amdgcn_fence(__ATOMIC_RELEASE, "agent");
            asm volatile("s_waitcnt vmcnt(0)" ::: "memory");
            const unsigned og = xb_add(&bar[XB_TOP], 1u);
            const unsigned tg = og / nx;
            if (og + 1u == (tg + 1u) * nx) xb_add(&bar[XB_TOPGEN], 1u);
            else XB_SPIN(xb_ld(&bar[XB_TOPGEN]) == tg, bar);
            __builtin_amdgcn_fence(__ATOMIC_ACQUIRE, "agent");
            xb_add(&bar[XB_XGEN(b.x)], 1u);
            asm volatile("s_waitcnt vmcnt(0)" ::: "memory");
        } else {
            XB_SPIN(xb_ld(&bar[XB_XGEN(b.x)]) == gen, bar);
            __builtin_amdgcn_fence(__ATOMIC_ACQUIRE, "agent");
            asm volatile("s_waitcnt vmcnt(0)" ::: "memory");
        }
    }
    __syncthreads();
}

namespace pg8 {
constexpr int BM = 256, BK = 64, HALF = 128, HTB = HALF * BK * 2, STAGE_BYTES = 8 * HTB, NXCD = 8, WGM = 8;
__host__ __device__ __forceinline__ int lds_byte(int r, int c) { const int st = (r >> 4) * 2 + (c >> 5), rr = r & 15, cc = c & 31, ob = rr * 64 + cc * 2; return st * 1024 + (ob ^ (((ob >> 9) & 1) << 5)); }
__host__ __device__ __forceinline__ void stage_rc(int b, int& R, int& C) { const int st = b / 1024, sb = b % 1024, swz = sb ^ (((sb >> 9) & 1) << 5); R = (st >> 1) * 16 + swz / 64; C = (st & 1) * 32 + (swz % 64) / 2; }
__host__ __device__ __forceinline__ int perm32(int rho) { const int n = rho >> 4, i = rho & 15; return 8 * (i >> 2) + 4 * n + (i & 3); }
struct Unit { int pm, pn, cn, ks; };
struct Gemm { const u16* A; const u16* Bt; int K; int ld; };
struct StaticOrder {
    int nM, nN, nwg, G, c;
    __device__ void init(int M, int N, int G_, int c_) { nM = M / BM; nN = N / BM; nwg = nM * nN; G = G_; c = c_; }
    __device__ bool next(int i, Unit& u) const {
        const long L = (long)i * G + c; if (L >= nwg) return false;
        int wgid = (int)L; { const int q = nwg / NXCD, r = nwg % NXCD, xcd = wgid % NXCD, off = wgid / NXCD; wgid = (xcd < r ? xcd * (q + 1) : r * (q + 1) + (xcd - r) * q) + off; }
        const int nig = WGM * nN, gid = wgid / nig, fm = gid * WGM, gsz = (nM - fm) < WGM ? (nM - fm) : WGM;
        u.pm = fm + ((wgid % nig) % gsz); u.pn = (wgid % nig) / gsz; u.cn = u.pn; u.ks = 0; return true;
    }
};
struct MoeOrder {
    int p0, np, ncol, G, c, browtiles; const LAS int* pexp; int nks;
    __device__ bool next(int i, Unit& u) const {
        const long L = (long)i * G + c; if (L >= (long)np * ncol * nks) return false;
        const int per = np * nks; const int cn = (int)(L / per), rem = (int)(L % per), p = p0 + rem / nks;
        u.pm = p; u.cn = cn; u.pn = pexp[p] * browtiles + cn; u.ks = rem % nks; return true;
    }
};

template <class Epi, class Sched>
__device__ __forceinline__ void gemm_phase(LAS unsigned char* lds, const Gemm g, const Sched& S_, const Epi& E) {
    int tid = threadIdx.x; asm volatile("" : "+v"(tid));
    const int wid = __builtin_amdgcn_readfirstlane(tid >> 6), lane = tid & 63, wr = wid >> 2, wc = wid & 3, fr = lane & 15, fq = lane >> 4;
    int K = g.K; asm volatile("" : "+s"(K));
    const int nt = K / BK;
    int ld = g.ld; asm volatile("" : "+s"(ld));
    unsigned voffA[2], voffB[2];
#pragma unroll
    for (int i = 0; i < 2; ++i) { int R, C; stage_rc(tid * 16 + i * 8192, R, C); const int Rb = Epi::PERM ? ((R & ~31) + perm32(R & 31)) : R;
        voffA[i] = (unsigned)(R * ld + C) * 2u; voffB[i] = (unsigned)(Rb * ld + C) * 2u; }
    const size_t kstep = (size_t)(BK * 2);
    const size_t hstep = (size_t)HALF * ld * 2;
    const size_t sstep = (size_t)K * 2;
    const size_t tstep = 2 * hstep;
    const unsigned ldsw = (unsigned)wid * 1024u;
    const int aoff = lds_byte(wr * 64 + fr, fq * 8), boff = lds_byte(wc * 32 + fr, fq * 8);
#define PG8_SA(b, h) (((b) * 2 + (h)) * HTB)
#define PG8_SB(b, h) ((4 + (b) * 2 + (h)) * HTB)
#define PG8_STAGE(bufoff, gbase, voff) do { _Pragma("unroll") for (int _i = 0; _i < 2; ++_i) \
        __builtin_amdgcn_global_load_lds((const unsigned*)((const char*)(gbase) + (voff)[_i]), (LAS unsigned*)(lds + (bufoff) + ldsw + _i * 8192), 16, 0, 0); } while (0)
#define PG8_LDA(dst, b, h) do { _Pragma("unroll") for (int m = 0; m < 4; ++m) _Pragma("unroll") for (int k = 0; k < 2; ++k) dst[m][k] = *(const LAS bf16x8*)(lds + PG8_SA(b, h) + aoff + m * 2048 + k * 1024); } while (0)
#define PG8_LDB(dst, b, h) do { _Pragma("unroll") for (int n = 0; n < 2; ++n) _Pragma("unroll") for (int k = 0; k < 2; ++k) dst[n][k] = *(const LAS bf16x8*)(lds + PG8_SB(b, h) + boff + n * 2048 + k * 1024); } while (0)
#define PG8_MMA(ai, bj, At, Bt) do { __builtin_amdgcn_s_setprio(1); _Pragma("unroll") for (int m = 0; m < 4; ++m) _Pragma("unroll") for (int n = 0; n < 2; ++n) _Pragma("unroll") for (int k = 0; k < 2; ++k) \
        acc[ai][bj][m][n] = __builtin_amdgcn_mfma_f32_16x16x32_bf16(Bt[n][k], At[m][k], acc[ai][bj][m][n], 0, 0, 0); __builtin_amdgcn_s_setprio(0); } while (0)
#define PG8_WAIT_V(n) asm volatile("s_waitcnt vmcnt(" #n ")" ::: "memory")
#define PG8_WAIT_L(n) asm volatile("s_waitcnt lgkmcnt(" #n ")" ::: "memory")
#define PG8_BAR __builtin_amdgcn_s_barrier()
#define PG8_SCHED __builtin_amdgcn_sched_barrier(0)
    Unit cur, nxt; int ui = 0;
    if (!S_.next(0, cur)) return;
    f32x4 acc[2][2][4][2];
#pragma unroll
    for (int a = 0; a < 2; ++a)
#pragma unroll
        for (int b = 0; b < 2; ++b)
#pragma unroll
            for (int m = 0; m < 4; ++m)
#pragma unroll
                for (int n = 0; n < 2; ++n) acc[a][b][m][n] = (f32x4){0.f, 0.f, 0.f, 0.f};
    bf16x8 At[4][2], B0[2][2], B1[2][2];
    const char* cA = (const char*)g.A + (size_t)cur.pm * tstep + (size_t)cur.ks * sstep; const char* cB = (const char*)g.Bt + (size_t)cur.pn * tstep + (size_t)cur.ks * sstep;
    PG8_STAGE(PG8_SB(0, 0), cB, voffB); PG8_STAGE(PG8_SB(0, 1), cB + hstep, voffB); PG8_STAGE(PG8_SA(0, 0), cA, voffA); PG8_STAGE(PG8_SA(0, 1), cA + hstep, voffA);
    if (wr == 1) PG8_BAR;
    PG8_WAIT_V(2); PG8_BAR;
    PG8_STAGE(PG8_SB(1, 0), cB + kstep, voffB); PG8_STAGE(PG8_SA(1, 0), cA + kstep, voffA); PG8_STAGE(PG8_SB(1, 1), cB + hstep + kstep, voffB);
    PG8_WAIT_V(6); PG8_BAR;
    for (;;) {
        const bool has_next = S_.next(ui + 1, nxt);
        const char* nA = has_next ? (const char*)g.A + (size_t)nxt.pm * tstep + (size_t)nxt.ks * sstep : cA; const char* nB = has_next ? (const char*)g.Bt + (size_t)nxt.pn * tstep + (size_t)nxt.ks * sstep : cB;
        for (int t = 0; t < nt; t += 2) {
            const bool last = (t == nt - 2);
            const char* a1 = cA + (size_t)(t + 1) * kstep;
            const char* a2 = last ? nA : cA + (size_t)(t + 2) * kstep; const char* b2 = last ? nB : cB + (size_t)(t + 2) * kstep;
            const char* a3 = a2 + kstep; const char* b3 = b2 + kstep;
            PG8_LDB(B0, 0, 0); PG8_LDB(B1, 0, 1); PG8_SCHED; PG8_LDA(At, 0, 0); PG8_STAGE(PG8_SA(1, 1), a1 + hstep, voffA);
            PG8_WAIT_V(8); PG8_WAIT_L(0); PG8_BAR; PG8_MMA(0, 0, At, B0); PG8_MMA(0, 1, At, B1); PG8_BAR; PG8_SCHED;
            PG8_LDA(At, 0, 1); PG8_STAGE(PG8_SB(0, 0), b2, voffB); PG8_STAGE(PG8_SB(0, 1), b2 + hstep, voffB); PG8_STAGE(PG8_SA(0, 0), a2, voffA);
            PG8_WAIT_V(8); PG8_WAIT_L(0); PG8_BAR; PG8_MMA(1, 0, At, B0); PG8_MMA(1, 1, At, B1); PG8_BAR; PG8_SCHED;
            PG8_LDB(B0, 1, 0); PG8_LDB(B1, 1, 1); PG8_SCHED; PG8_LDA(At, 1, 0); PG8_STAGE(PG8_SA(0, 1), a2 + hstep, voffA);
            PG8_WAIT_V(8); PG8_WAIT_L(0); PG8_BAR; PG8_MMA(0, 0, At, B0); PG8_MMA(0, 1, At, B1); PG8_BAR; PG8_SCHED;
            PG8_LDA(At, 1, 1); PG8_STAGE(PG8_SB(1, 0), b3, voffB); PG8_STAGE(PG8_SB(1, 1), b3 + hstep, voffB); PG8_STAGE(PG8_SA(1, 0), a3, voffA);
            PG8_WAIT_V(8); PG8_WAIT_L(0); PG8_BAR; PG8_MMA(1, 0, At, B0); PG8_MMA(1, 1, At, B1); PG8_BAR; PG8_SCHED;
        }
        if (wr == 0) PG8_BAR;
        { int fr2 = fr, fq2 = fq; asm volatile("" : "+v"(fr2), "+v"(fq2)); E(acc, cur, wr, wc, fr2, fq2); }
        if (!has_next) break;
#pragma unroll
        for (int a = 0; a < 2; ++a)
#pragma unroll
            for (int b = 0; b < 2; ++b)
#pragma unroll
                for (int m = 0; m < 4; ++m)
#pragma unroll
                    for (int n = 0; n < 2; ++n) acc[a][b][m][n] = (f32x4){0.f, 0.f, 0.f, 0.f};
        cur = nxt; cA = nA; cB = nB; ++ui;
        if (wr == 1) PG8_BAR;
    }
    PG8_WAIT_V(0);
    PG8_BAR;
#undef PG8_SA
#undef PG8_SB
#undef PG8_STAGE
#undef PG8_LDA
#undef PG8_LDB
#undef PG8_MMA
#undef PG8_WAIT_V
#undef PG8_WAIT_L
#undef PG8_BAR
#undef PG8_SCHED
}
}
using pg8::Unit;
typedef f32x4 AccT[2][2][4][2];

__device__ __forceinline__ void st_bf16x8(u16* p, f32x4 v0, f32x4 v1) { u32x4 w; w.x = pk_bf16(v0[0], v0[1]); w.y = pk_bf16(v0[2], v0[3]); w.z = pk_bf16(v1[0], v1[1]); w.w = pk_bf16(v1[2], v1[3]); *(u32x4*)p = w; }
__device__ __forceinline__ void ld_bf16x8(const u16* p, f32x4& v0, f32x4& v1) { const u32x4 w = *(const u32x4*)p; v0 = (f32x4){bflo(w.x), bfhi(w.x), bflo(w.y), bfhi(w.y)}; v1 = (f32x4){bflo(w.z), bfhi(w.z), bflo(w.w), bfhi(w.w)}; }

__device__ __forceinline__ void rstd8(const float* ssq, int row0, int fq, float (&rs)[8]) {
    f32x4 p[8];
#pragma unroll
    for (int i = 0; i < 8; ++i) p[i] = *(const f32x4*)(ssq + (size_t)(row0 + (i >> 2) * 128 + (i & 3) * 16) * 16 + 4 * fq);
#pragma unroll
    for (int i = 0; i < 8; ++i) { float s = (p[i].x + p[i].y) + (p[i].z + p[i].w); s += __shfl_xor(s, 16); s += __shfl_xor(s, 32); rs[i] = 1.0f / sqrtf(s * (1.0f / D) + RMS_EPS); }
}
struct EpiG1 {
    static constexpr bool PERM = true;
    const float* ssq; u16* qkvf; u16* ql; float* t56; u16* pr;
    __device__ __forceinline__ void operator()(const AccT& acc, const Unit& u, int wr, int wc, int fr, int fq) const {
        const int row0 = u.pm * 256 + wr * 64 + fr, cn = u.cn;
        u16* ob = nullptr; float* of = nullptr; int ld, cb;
        if (cn < 3) { ob = qkvf; ld = 768; cb = cn * 256; } else if (cn < 5) { ob = ql; ld = 512; cb = (cn - 3) * 256; }
        else if (cn < 7) { of = t56; ld = 512; cb = (cn - 5) * 256; } else { ob = pr; ld = 1792; cb = (cn - 7) * 256; }
        float rs8[8]; rstd8(ssq, row0, fq, rs8);
#pragma unroll
        for (int ai = 0; ai < 2; ++ai)
#pragma unroll
            for (int m = 0; m < 4; ++m) {
                const int row = row0 + ai * 128 + m * 16; const float rs = rs8[ai * 4 + m];
#pragma unroll
                for (int bj = 0; bj < 2; ++bj) {
                    const int col = cb + bj * 128 + wc * 32 + 8 * fq;
                    const f32x4 v0 = acc[ai][bj][m][0] * rs, v1 = acc[ai][bj][m][1] * rs;
                    if (of) { float* p = of + (size_t)row * ld + col; *(f32x4*)p = v0; *(f32x4*)(p + 4) = v1; }
                    else st_bf16x8(ob + (size_t)row * ld + col, v0, v1);
                }
            }
    }
};
struct EpiGate {
    static constexpr bool PERM = true;
    const float* ssq; const float* bias; u16* gt;
    __device__ __forceinline__ void operator()(const AccT& acc, const Unit& u, int wr, int wc, int fr, int fq) const {
        const int row0 = u.pm * 256 + wr * 64 + fr;
        float rs8[8]; rstd8(ssq, row0, fq, rs8);
        f32x4 bb[2][2];
#pragma unroll
        for (int bj = 0; bj < 2; ++bj) { const int col = u.cn * 256 + bj * 128 + wc * 32 + 8 * fq; bb[bj][0] = *(const f32x4*)(bias + col); bb[bj][1] = *(const f32x4*)(bias + col + 4); }
#pragma unroll
        for (int ai = 0; ai < 2; ++ai)
#pragma unroll
            for (int m = 0; m < 4; ++m) {
                const int row = row0 + ai * 128 + m * 16; const float rs = rs8[ai * 4 + m];
#pragma unroll
                for (int bj = 0; bj < 2; ++bj) {
                    const int col = u.cn * 256 + bj * 128 + wc * 32 + 8 * fq;
                    f32x4 v0 = acc[ai][bj][m][0] * rs + bb[bj][0], v1 = acc[ai][bj][m][1] * rs + bb[bj][1];
#pragma unroll
                    for (int j = 0; j < 4; ++j) { v0[j] = sigmoidf_(v0[j]); v1[j] = sigmoidf_(v1[j]); }
                    st_bf16x8(gt + (size_t)row * D + col, v0, v1);
                }
            }
    }
};
template <int MODE> struct EpiProj {
    static constexpr bool PERM = true;
    u16* gt; float* mgf;
    __device__ __forceinline__ void operator()(const AccT& acc, const Unit& u, int wr, int wc, int fr, int fq) const {
        const int row0 = u.pm * 256 + wr * 64 + fr;
#pragma unroll
        for (int ai = 0; ai < 2; ++ai)
#pragma unroll
            for (int m2 = 0; m2 < 4; m2 += 2) {
                u32x4 gw[2][2]; f32x4 mv[2][2][2];
#pragma unroll
                for (int mm = 0; mm < 2; ++mm)
#pragma unroll
                    for (int bj = 0; bj < 2; ++bj) { const size_t o = (size_t)(row0 + ai * 128 + (m2 + mm) * 16) * D + u.cn * 256 + bj * 128 + wc * 32 + 8 * fq;
                        gw[mm][bj] = *(const u32x4*)(gt + o); if (MODE >= 1) { mv[mm][bj][0] = *(const f32x4*)(mgf + o); mv[mm][bj][1] = *(const f32x4*)(mgf + o + 4); } }
#pragma unroll
                for (int mm = 0; mm < 2; ++mm)
#pragma unroll
                    for (int bj = 0; bj < 2; ++bj) { const int m = m2 + mm; const size_t o = (size_t)(row0 + ai * 128 + m * 16) * D + u.cn * 256 + bj * 128 + wc * 32 + 8 * fq;
                        const u32x4 w = gw[mm][bj]; const f32x4 g0 = (f32x4){bflo(w.x), bfhi(w.x), bflo(w.y), bfhi(w.y)}, g1 = (f32x4){bflo(w.z), bfhi(w.z), bflo(w.w), bfhi(w.w)};
                        f32x4 v0 = acc[ai][bj][m][0] * g0, v1 = acc[ai][bj][m][1] * g1;
                        if (MODE >= 1) { v0 += mv[mm][bj][0]; v1 += mv[mm][bj][1]; }
                        if (MODE <= 1) { *(f32x4*)(mgf + o) = v0; *(f32x4*)(mgf + o + 4) = v1; }
                        else st_bf16x8(gt + o, v0, v1); }
                asm volatile("" ::: "memory");
            }
    }
};
struct EpiResid {
    static constexpr bool PERM = true;
    float* xr; u16* xb; float* ssq;
    __device__ __forceinline__ void operator()(const AccT& acc, const Unit& u, int wr, int wc, int fr, int fq) const {
        const int row0 = u.pm * 256 + wr * 64 + fr;
#pragma unroll
        for (int ai = 0; ai < 2; ++ai)
#pragma unroll
            for (int m2 = 0; m2 < 4; m2 += 2) {
                f32x4 xv[2][2][2];
#pragma unroll
                for (int mm = 0; mm < 2; ++mm)
#pragma unroll
                    for (int bj = 0; bj < 2; ++bj) { const size_t o = (size_t)(row0 + ai * 128 + (m2 + mm) * 16) * D + u.cn * 256 + bj * 128 + wc * 32 + 8 * fq; xv[mm][bj][0] = *(const f32x4*)(xr + o); xv[mm][bj][1] = *(const f32x4*)(xr + o + 4); }
#pragma unroll
                for (int mm = 0; mm < 2; ++mm) { const int m = m2 + mm; const int row = row0 + ai * 128 + m * 16; float sq = 0.f;
#pragma unroll
                    for (int bj = 0; bj < 2; ++bj) { const size_t o = (size_t)row * D + u.cn * 256 + bj * 128 + wc * 32 + 8 * fq;
                        const f32x4 v0 = acc[ai][bj][m][0] + xv[mm][bj][0], v1 = acc[ai][bj][m][1] + xv[mm][bj][1];
                        *(f32x4*)(xr + o) = v0; *(f32x4*)(xr + o + 4) = v1;
                        st_bf16x8(xb + o, v0, v1);
                        sq += (v0[0] * v0[0] + v0[1] * v0[1]) + (v0[2] * v0[2] + v0[3] * v0[3]) + (v1[0] * v1[0] + v1[1] * v1[1]) + (v1[2] * v1[2] + v1[3] * v1[3]); }
                    sq += __shfl_xor(sq, 16); sq += __shfl_xor(sq, 32);
                    if (fq == 0) ssq[(size_t)row * 16 + u.cn * 4 + wc] = sq; }
                asm volatile("" ::: "memory");
            }
    }
};
struct EpiSwiglu {
    static constexpr bool PERM = true;
    const float* ssq; const float* rsrow; u16* act; int ld; int row_base;
    __device__ __forceinline__ void operator()(const AccT& acc, const Unit& u, int wr, int wc, int fr, int fq) const {
        const int row0 = u.pm * 256 + wr * 64 + fr;
        float rs8[8];
        if (rsrow) {
#pragma unroll
            for (int i = 0; i < 8; ++i) rs8[i] = rsrow[row0 + (i >> 2) * 128 + (i & 3) * 16];
        } else rstd8(ssq, row0, fq, rs8);
#pragma unroll
        for (int ai = 0; ai < 2; ++ai)
#pragma unroll
            for (int m = 0; m < 4; ++m) {
                const int row = row0 + ai * 128 + m * 16; const float rs = rs8[ai * 4 + m];
                f32x4 o[2];
#pragma unroll
                for (int n = 0; n < 2; ++n)
#pragma unroll
                    for (int j = 0; j < 4; ++j) { const float gv = acc[ai][0][m][n][j] * rs, uv = acc[ai][1][m][n][j] * rs; o[n][j] = gv * sigmoidf_(gv) * uv; }
                st_bf16x8(act + (size_t)(row - row_base) * ld + u.cn * 128 + wc * 32 + 8 * fq, o[0], o[1]);
            }
    }
};
struct EpiMoeDown {
    static constexpr bool PERM = true;
    const float* rg; u16* ys; u16* ys2;
    __device__ __forceinline__ void operator()(const AccT& acc, const Unit& u, int wr, int wc, int fr, int fq) const {
        const int row0 = u.pm * 256 + wr * 64 + fr;
        u16* const yb = (u.ks == 0) ? ys : ys2 + ((long)(u.ks - 1) * YS2_ROWS - 32768L) * (long)D;
        float g8[8];
#pragma unroll
        for (int i = 0; i < 8; ++i) g8[i] = rg[row0 + (i >> 2) * 128 + (i & 3) * 16];
#pragma unroll
        for (int ai = 0; ai < 2; ++ai)
#pragma unroll
            for (int m = 0; m < 4; ++m) {
                const int row = row0 + ai * 128 + m * 16; const float gsc = g8[ai * 4 + m];
#pragma unroll
                for (int bj = 0; bj < 2; ++bj) {
                    const int col = u.cn * 256 + bj * 128 + wc * 32 + 8 * fq;
                    st_bf16x8(yb + (size_t)row * D + col, acc[ai][bj][m][0] * gsc, acc[ai][bj][m][1] * gsc);
                }
            }
    }
};

struct Args {
    const float* in[37];
    float* out; unsigned char* ws;
    int ph_lo, ph_hi;
};
typedef const __attribute__((address_space(4))) Args* CArgsP;
enum { I_X = 0, I_WIN, I_BGATE, I_GMIX, I_FBIAS, I_KVNORM, I_WUK, I_WUV, I_MU, I_W0, I_WUP, I_A0, I_AUP, I_GUP, I_KK, I_KA, I_RK, I_LNG, I_LNB,
       I_VDOWN, I_VMU, I_VUP, I_VV0, I_PFOX, I_PDSA, I_PRWKV, I_WOUT, I_GFFN, I_FWG, I_FWU, I_FWD, I_RTW, I_RTB, I_MWG, I_MWU, I_MWD, I_GFINAL };

struct Seg { const float* src; const float* src2; const float* gk; const float* aux; u16* dst; int kind, K, ld, col0, nrows, row0, item0; float scale; };
constexpr int MAXSEG = 48;
__device__ __forceinline__ void seg_set(LAS Seg* s, int& n, int& items, int kind, const float* src, const float* src2, const float* gk, const float* aux, u16* dst, int K, int ld, int col0, int nrows, int row0, float scale) {
    LAS Seg& g = s[n]; g.src = src; g.src2 = src2; g.gk = gk; g.aux = aux; g.dst = dst; g.kind = kind; g.K = K; g.ld = ld; g.col0 = col0; g.nrows = nrows; g.row0 = row0; g.item0 = items; g.scale = scale;
    items += (K / ((kind == 2 || kind == 3) ? 16 : 64)) * ((nrows + 31) / 32); ++n;
}
struct SegR { const float* src; const float* gk; const float* aux; int kind, ld, col0, nrows; float scale; };
__device__ __forceinline__ float seg_val(const SegR& g, int k, int n) {
    if (n >= g.nrows) return 0.f;
    switch (g.kind) {
    case 0: { float v = g.src[(size_t)k * g.ld + g.col0 + n] * g.scale; if (g.gk) v *= g.gk[k]; return v; }
    case 5: { return k < 32 ? g.src[(size_t)k * g.ld + n] : 0.f; }
    case 2: { const int h = n >> 7, r = n & 127; float s = 0.f; const float* sp = g.src + (size_t)k * g.ld + g.col0 + h * 64; const float* ap = g.aux + (size_t)h * 64 * 128 + r;
#pragma unroll 8
              for (int d = 0; d < 64; ++d) s += sp[d] * ap[d * 128]; return s * g.scale * g.gk[k]; }
    case 3: { const int h = k >> 7, r = k & 127; float s = 0.f; const float* ap = g.aux + (size_t)(h * 128 + r) * 64; const float* sp = g.src + (size_t)(h * 64) * g.ld + n;
#pragma unroll 8
              for (int d = 0; d < 64; ++d) s += ap[d] * sp[(size_t)d * g.ld]; return s; }
    default: return 0.f;
    }
}
__device__ __forceinline__ void convert_items(const LAS Seg* segs, int s_lo, int s_hi, int nitems, LAS float* scr, int gw, int ngw, int lane) {
    for (int it = gw; it < nitems; it += ngw) {
        int si = s_lo;
        for (int j = s_lo + 1; j < s_hi; ++j) if (segs[j].item0 <= it) si = j;
        SegR g; g.src = segs[si].src; g.gk = segs[si].gk; g.aux = segs[si].aux; g.kind = segs[si].kind; g.ld = segs[si].ld; g.col0 = segs[si].col0; g.nrows = segs[si].nrows; g.scale = segs[si].scale;
        u16* const dst = segs[si].dst; const int K = segs[si].K, row0 = segs[si].row0;
        const bool fold = (g.kind == 2 || g.kind == 3); const int KT = fold ? 16 : 64;
        const int r = it - segs[si].item0, nnb = (g.nrows + 31) / 32, kb = r / nnb, nb = r % nnb, k0 = KT * kb, n0 = 32 * nb;
        if (fold) {
#pragma unroll 2
            for (int i = 0; i < 8; ++i) { const int kk = 2 * i + (lane >> 5); scr[kk * 33 + (lane & 31)] = seg_val(g, k0 + kk, n0 + (lane & 31)); }
            asm volatile("s_waitcnt lgkmcnt(0)" ::: "memory");
            { const int n = lane >> 1, cc = lane & 1; const LAS float* s = scr + (8 * cc) * 33 + n;
              u32x4 o; o.x = pk_bf16(s[0 * 33], s[1 * 33]); o.y = pk_bf16(s[2 * 33], s[3 * 33]); o.z = pk_bf16(s[4 * 33], s[5 * 33]); o.w = pk_bf16(s[6 * 33], s[7 * 33]);
              if (n0 + n < g.nrows) *(u32x4*)(dst + (size_t)(row0 + n0 + n) * K + k0 + 8 * cc) = o; }
        } else {
        if (g.kind == 0) {
            const int n = n0 + (lane & 31); const bool ok = n < g.nrows; const float* sp = g.src + (size_t)(k0 + (lane >> 5)) * g.ld + g.col0 + (ok ? n : 0);
            const float* gp = g.gk ? g.gk + k0 + (lane >> 5) : nullptr;
#pragma unroll 16
            for (int i = 0; i < 32; ++i) { float v = sp[(size_t)(2 * i) * g.ld] * g.scale; if (gp) v *= gp[2 * i]; scr[(2 * i + (lane >> 5)) * 33 + (lane & 31)] = ok ? v : 0.f; }
        } else {
#pragma unroll 4
        for (int i = 0; i < 32; ++i) { const int kk = 2 * i + (lane >> 5); scr[kk * 33 + (lane & 31)] = seg_val(g, k0 + kk, n0 + (lane & 31)); }
        }
        asm volatile("s_waitcnt lgkmcnt(0)" ::: "memory");
        const int c = lane & 7;
#pragma unroll
        for (int j = 0; j < 4; ++j) { const int n = (lane >> 3) + 8 * j; const LAS float* s = scr + (8 * c) * 33 + n;
            u32x4 o; o.x = pk_bf16(s[0 * 33], s[1 * 33]); o.y = pk_bf16(s[2 * 33], s[3 * 33]); o.z = pk_bf16(s[4 * 33], s[5 * 33]); o.w = pk_bf16(s[6 * 33], s[7 * 33]);
            if (n0 + n < g.nrows) *(u32x4*)(dst + (size_t)(row0 + n0 + n) * K + k0 + 8 * c) = o; }
        }
        asm volatile("s_waitcnt lgkmcnt(0)" ::: "memory");
    }
}

template <int KIND>
__device__ __forceinline__ int convert_seg(const float* src, const float* src2, const float* gk, u16* dst, int K, int ld, int nrows, int item0, LAS float* scr, int gw, int ngw, int lane) {
    const int nnb = nrows / 64, nit = (K / 64) * nnb;
    int first = item0 + ((gw - item0) % ngw + ngw) % ngw;
    for (int it = first; it < item0 + nit; it += ngw) {
        const int r = it - item0, kb = r / nnb, nb = r % nnb, k0 = 64 * kb, n0 = 64 * nb;
        const float* sp;
        if (KIND == 0) sp = src + n0 + lane; else { const int within = n0 & 255, which = within >> 7, j = (n0 >> 8) * 128 + (within & 127); sp = (which ? src2 : src) + j + lane; }
#pragma unroll 8
        for (int i = 0; i < 64; ++i) { float v = sp[(size_t)(k0 + i) * ld]; if (gk) v *= gk[k0 + i]; scr[i * 65 + lane] = v; }
        asm volatile("s_waitcnt lgkmcnt(0)" ::: "memory");
        const int c = lane & 7;
#pragma unroll
        for (int j = 0; j < 8; ++j) { const int n = (lane >> 3) + 8 * j; const LAS float* s = scr + (8 * c) * 65 + n;
            u32x4 o; o.x = pk_bf16(s[0 * 65], s[1 * 65]); o.y = pk_bf16(s[2 * 65], s[3 * 65]); o.z = pk_bf16(s[4 * 65], s[5 * 65]); o.w = pk_bf16(s[6 * 65], s[7 * 65]);
            *(u32x4*)(dst + (size_t)(n0 + n) * K + k0 + 8 * c) = o; }
        asm volatile("s_waitcnt lgkmcnt(0)" ::: "memory");
    }
    return item0 + nit;
}

struct Ctx {
    LAS unsigned char* lds; unsigned char* ws; u32* ctl;
    int tid, lane, wave, gw, ngw, G, bid;
};

__device__ __forceinline__ void phase_prologue(const Ctx& c, CArgsP a) {
    LAS Seg* segs = (LAS Seg*)(c.lds + 69632);
    LAS int* nfo = (LAS int*)(c.lds + 69632 + MAXSEG * sizeof(Seg));
    if (c.tid == 0) {
        int n = 0, items = 0;
        for (int l = 0; l < 2; ++l) {
            const float* win = a->in[I_WIN] + (size_t)l * D * DIN; const float* gm = a->in[I_GMIX] + l * D;
            u16* w1 = (u16*)(c.ws + O_W1) + (size_t)l * NW1 * D;
            seg_set(segs, n, items, 0, win, nullptr, gm, nullptr, w1, D, DIN, 0, 256, 0, C2);
            seg_set(segs, n, items, 0, win, nullptr, gm, nullptr, w1, D, DIN, 256, 512, 256, 1.f);
            seg_set(segs, n, items, 2, win, nullptr, gm, a->in[I_WUK] + (size_t)l * 4 * 64 * 128, w1, D, DIN, 772, 512, 768, C2);
            seg_set(segs, n, items, 0, win, nullptr, gm, nullptr, w1, D, DIN, 1156, 256, 1280, 1.f);
            seg_set(segs, n, items, 0, win, nullptr, gm, nullptr, w1, D, DIN, 1028, 128, 1536, 1.f);
            seg_set(segs, n, items, 0, win, nullptr, gm, nullptr, w1, D, DIN, 1412, 32, 1664, 1.f);
            seg_set(segs, n, items, 0, win, nullptr, gm, nullptr, w1, D, DIN, 1444, 8, 1696, 1.f);
            seg_set(segs, n, items, 0, win, nullptr, gm, nullptr, w1, D, DIN, 768, 4, 1704, 1.f);
            if (l == 1) seg_set(segs, n, items, 0, a->in[I_VDOWN], nullptr, gm, nullptr, w1, D, 32, 0, 32, 1708, 1.f);
            else seg_set(segs, n, items, 4, nullptr, nullptr, nullptr, nullptr, w1, D, 0, 0, 32, 1708, 1.f);
            seg_set(segs, n, items, 4, nullptr, nullptr, nullptr, nullptr, w1, D, 0, 0, 52, 1740, 1.f);
            seg_set(segs, n, items, 0, win, nullptr, gm, nullptr, w1, D, DIN, 1452, 1792, 1792, 1.f);
            seg_set(segs, n, items, 0, win, nullptr, gm, nullptr, (u16*)(c.ws + O_WGT) + (size_t)l * 3072 * D, D, DIN, 3244, 3072, 0, 1.f);
            u16* ow = (u16*)(c.ws + O_OUTW + l * OUTW_L);
            seg_set(segs, n, items, 0, a->in[I_PFOX] + (size_t)l * 256 * D, nullptr, nullptr, nullptr, ow, 256, D, 0, 1024, 0, 1.f);
            seg_set(segs, n, items, 3, a->in[I_PDSA] + (size_t)l * 256 * D, nullptr, nullptr, a->in[I_WUV] + (size_t)l * 4 * 128 * 64, ow + 1024 * 256, 512, D, 0, 1024, 0, 1.f);
            seg_set(segs, n, items, 0, a->in[I_PRWKV] + (size_t)l * 512 * D, nullptr, nullptr, nullptr, ow + 1024 * 256 + 1024 * 512, 512, D, 0, 1024, 0, 1.f);
            seg_set(segs, n, items, 0, a->in[I_WOUT] + (size_t)l * D * D, nullptr, nullptr, nullptr, ow + 1024 * 256 + 2 * 1024 * 512, D, D, 0, 1024, 0, 1.f);
            u16* wl = (u16*)(c.ws + O_WL + l * WL_L);
            seg_set(segs, n, items, 0, a->in[I_WUP] + (size_t)l * 64 * 512, nullptr, nullptr, nullptr, wl, 64, 512, 0, 512, 0, 1.f);
            seg_set(segs, n, items, 0, a->in[I_AUP] + (size_t)l * 64 * 512, nullptr, nullptr, nullptr, wl + 512 * 64, 64, 512, 0, 512, 0, 1.f);
            seg_set(segs, n, items, 0, a->in[I_GUP] + (size_t)l * 128 * 512, nullptr, nullptr, nullptr, wl + 2 * 512 * 64, 128, 512, 0, 512, 0, 1.f);
            if (l == 1) seg_set(segs, n, items, 5, a->in[I_VUP], nullptr, nullptr, nullptr, wl + 2 * 512 * 64 + 512 * 128, 64, 512, 0, 512, 0, 1.f);
        }
        nfo[0] = n; nfo[1] = items;
    }
    __syncthreads();
    convert_items(segs, 0, nfo[0], nfo[1], (LAS float*)(c.lds + c.wave * 8704), c.gw, c.ngw, c.lane);
    const float* x = a->in[I_X]; float* xr = (float*)(c.ws + O_XR); u16* xb = (u16*)(c.ws + O_XB); float* ssq = (float*)(c.ws + O_SSQ);
    for (int t = c.gw; t < S; t += c.ngw) {
        const f32x4* xp = (const f32x4*)(x + (size_t)t * D) + c.lane; float s = 0.f;
#pragma unroll
        for (int j = 0; j < 4; ++j) { const f32x4 v = xp[64 * j]; s += (v.x * v.x + v.y * v.y) + (v.z * v.z + v.w * v.w);
            ((f32x4*)(xr + (size_t)t * D))[c.lane + 64 * j] = v;
            u32x2 w; w.x = pk_bf16(v.x, v.y); w.y = pk_bf16(v.z, v.w); ((u32x2*)(xb + (size_t)t * D))[c.lane + 64 * j] = w; }
        s = wave_sum(s);
        if (c.lane < 16) ssq[(size_t)t * 16 + c.lane] = (c.lane == 0) ? s : 0.f;
    }
}

__device__ __forceinline__ float log_sigmoid_(float x) { return -(fmaxf(-x, 0.f) + log1pf(__expf(-fabsf(x)))); }
__device__ __forceinline__ void phase_prep(const Ctx& c, CArgsP a, int l) {
    const u16* qkvf = (const u16*)(c.ws + T_QKVF); const float* t56 = (const float*)(c.ws + T_T56); const u16* pr = (const u16*)(c.ws + T_PR);
    float* FL = (float*)(c.ws + T_FL); float* FB = (float*)(c.ws + T_FB); u16* VT = (u16*)(c.ws + T_VT); u16* CKV = (u16*)(c.ws + T_CKV);
    _Float16* QI = (_Float16*)(c.ws + T_QI); _Float16* KI = (_Float16*)(c.ws + T_KI); u32* SG = (u32*)(c.ws + T_SG); float* BC = (float*)(c.ws + T_BC);
    float* RW = (float*)(c.ws + T_RW); _Float16* RKK = (_Float16*)(c.ws + T_RKK); _Float16* RB = (_Float16*)(c.ws + T_RB);
    u16* RK = (u16*)(c.ws + T_RK); u16* RR = (u16*)(c.ws + T_RR); u16* RV = (u16*)(c.ws + T_RV); u16* RG = (u16*)(c.ws + T_RG); u16* VF = (u16*)(c.ws + O_VFIRST);
    const float* fbias = a->in[I_FBIAS] + l * 4; const float* kvn = a->in[I_KVNORM] + l * 128;
    const float* mu = a->in[I_MU] + l * 1792; const float* w0 = a->in[I_W0] + l * 512; const float* wup = a->in[I_WUP] + (size_t)l * 64 * 512;
    const float* a0 = a->in[I_A0] + l * 512; const float* aup = a->in[I_AUP] + (size_t)l * 64 * 512; const float* gup = a->in[I_GUP] + (size_t)l * 128 * 512;
    const float* kkw = a->in[I_KK] + l * 512; const float* kaw = a->in[I_KA] + l * 512; const float* rkw = a->in[I_RK] + l * 512;
    const float* vmu = a->in[I_VMU]; const float* vup = a->in[I_VUP]; const float* vv0 = a->in[I_VV0];
    LAS float* L_lf = (LAS float*)c.lds;
    LAS u16* L_vt = (LAS u16*)(c.lds + 1024);
    LAS u16* L_xl = (LAS u16*)(c.lds + 38912);
    constexpr int XLS = 328;
    const int tid = c.tid;
    LAS float* L_cst = (LAS float*)(c.lds + 81920);
    for (int idx = tid; idx < 9 * 512; idx += NTHR) { const int v = idx >> 9, j = idx & 511;
        const float* sp = v == 0 ? w0 : v == 1 ? a0 : v == 2 ? kkw : v == 3 ? kaw : v == 4 ? rkw : v == 5 ? vv0 : v == 6 ? mu : v == 7 ? mu + 512 : mu + 1024;
        L_cst[idx] = (v == 5 && l == 0) ? 0.f : sp[j]; }
    for (int blk = c.bid; blk < S / 64; blk += c.G) {
        const int t0 = blk * 64;
        __syncthreads();
        if (tid < 256) { const int tok = tid >> 2, h = tid & 3; L_lf[tok * 4 + h] = log_sigmoid_(t56[(size_t)(t0 + tok) * 512 + 256 + 172 - 4 + h] + fbias[h]) * LOG2E; }
        for (int idx = tid; idx < 64 * 32; idx += NTHR) { const int tok = idx >> 5, c8 = (idx & 31) * 8; const u32x4 w = *(const u32x4*)(qkvf + (size_t)(t0 + tok) * 768 + 512 + c8);
            LAS u16* d = L_vt + c8 * 72 + tok;
            d[0] = (u16)w.x; d[72] = (u16)(w.x >> 16); d[144] = (u16)w.y; d[216] = (u16)(w.y >> 16); d[288] = (u16)w.z; d[360] = (u16)(w.z >> 16); d[432] = (u16)w.w; d[504] = (u16)(w.w >> 16); }
        for (int idx = tid; idx < 64 * 32; idx += NTHR) {
            const int tok = idx >> 5, c8 = (idx & 31) * 8, t = t0 + tok; const int col = 1536 + c8;
            const u32x4 wc = *(const u32x4*)(pr + (size_t)t * 1792 + col); u32x4 wp = (u32x4){0u, 0u, 0u, 0u}; if (t > 0) wp = *(const u32x4*)(pr + (size_t)(t - 1) * 1792 + col);
            const f32x4 m0 = *(const f32x4*)(mu + col), m1 = *(const f32x4*)(mu + col + 4);
            float cur[8] = {bflo(wc.x), bfhi(wc.x), bflo(wc.y), bfhi(wc.y), bflo(wc.z), bfhi(wc.z), bflo(wc.w), bfhi(wc.w)};
            float prv[8] = {bflo(wp.x), bfhi(wp.x), bflo(wp.y), bfhi(wp.y), bflo(wp.z), bfhi(wp.z), bflo(wp.w), bfhi(wp.w)};
            float mm[8] = {m0.x, m0.y, m0.z, m0.w, m1.x, m1.y, m1.z, m1.w}; float ov[8];
#pragma unroll
            for (int e = 0; e < 8; ++e) { const float xs = cur[e] + (prv[e] - cur[e]) * mm[e]; ov[e] = c8 < 64 ? tanhf(xs) : (c8 < 128 ? xs : sigmoidf_(xs)); }
            u32x4 o; o.x = pk_bf16(ov[0], ov[1]); o.y = pk_bf16(ov[2], ov[3]); o.z = pk_bf16(ov[4], ov[5]); o.w = pk_bf16(ov[6], ov[7]);
            *(LAS u32x4*)(L_xl + tok * XLS + c8) = o;
        }
        for (int idx = tid; idx < 64 * 64; idx += NTHR) {
            const int tok = idx >> 6, i = idx & 63, t = t0 + tok; float xv = 0.f;
            if (l == 1 && i < 32) { const float cur = t56[(size_t)t * 512 + 256 + 172 + i]; const float prev = t > 0 ? t56[(size_t)(t - 1) * 512 + 256 + 172 + i] : 0.f; xv = cur + (prev - cur) * vmu[i]; }
            L_xl[tok * XLS + 256 + i] = f2bf(xv);
        }
        __syncthreads();
        if (tid < 4) { float run = 0.f; for (int i = 0; i < 64; ++i) { run += L_lf[i * 4 + tid]; FL[(size_t)tid * S + t0 + i] = run; } FB[tid * 256 + blk] = run; }
        for (int idx = tid; idx < 256 * 8; idx += NTHR) { const int cc = idx >> 3, t8 = (idx & 7) * 8; *(u32x4*)(VT + (size_t)cc * S + t0 + t8) = *(const LAS u32x4*)(L_vt + cc * 72 + t8); }
        {
            LAS unsigned* L_mx = (LAS unsigned*)(c.lds + 37888);
            if (tid < 9) L_mx[tid] = 0u;
            __syncthreads();
            const int tok = tid >> 3, sub = tid & 7; const u16* qp = qkvf + (size_t)(t0 + tok) * 768 + (sub >> 2) * 256 + (sub & 3) * 64; float ss = 0.f;
#pragma unroll
            for (int i = 0; i < 8; ++i) { const u32x4 w = *(const u32x4*)(qp + 8 * i); const float e0 = bflo(w.x), e1 = bfhi(w.x), e2 = bflo(w.y), e3 = bfhi(w.y), e4 = bflo(w.z), e5 = bfhi(w.z), e6 = bflo(w.w), e7 = bfhi(w.w);
                ss += (e0 * e0 + e1 * e1) + (e2 * e2 + e3 * e3) + (e4 * e4 + e5 * e5) + (e6 * e6 + e7 * e7); }
            (void)__hip_atomic_fetch_max(L_mx + sub, __float_as_uint(ss), __ATOMIC_RELAXED, __HIP_MEMORY_SCOPE_WORKGROUP);
            { const float* kp = t56 + (size_t)(t0 + tok) * 512 + 256 + 128 + sub * 4; float ks = (kp[0] * kp[0] + kp[1] * kp[1]) + (kp[2] * kp[2] + kp[3] * kp[3]);
              ks += __shfl_xor(ks, 1); ks += __shfl_xor(ks, 2); ks += __shfl_xor(ks, 4);
              if (sub == 0) (void)__hip_atomic_fetch_max(L_mx + 8, __float_as_uint(ks), __ATOMIC_RELAXED, __HIP_MEMORY_SCOPE_WORKGROUP); }
            __syncthreads();
            if (tid < 8) ((float*)(c.ws + T_QKM))[blk * 8 + tid] = __uint_as_float(L_mx[tid]);
            if (tid == 8) ((float*)(c.ws + T_KIM))[blk] = __uint_as_float(L_mx[8]);
        }
        {
            const int tok = tid >> 3, sub = tid & 7, t = t0 + tok; const float* tp = t56 + (size_t)t * 512;
            float cv[16]; float ss = 0.f;
#pragma unroll
            for (int i = 0; i < 16; ++i) { cv[i] = tp[256 + sub * 16 + i]; ss += cv[i] * cv[i]; }
            ss += __shfl_xor(ss, 1); ss += __shfl_xor(ss, 2); ss += __shfl_xor(ss, 4);
            const float rs = 1.0f / sqrtf(ss * (1.0f / 128.f) + RMS_EPS);
            { u32x4 o0, o1; const float* kn = kvn + sub * 16;
              o0.x = pk_bf16(cv[0] * rs * kn[0], cv[1] * rs * kn[1]); o0.y = pk_bf16(cv[2] * rs * kn[2], cv[3] * rs * kn[3]); o0.z = pk_bf16(cv[4] * rs * kn[4], cv[5] * rs * kn[5]); o0.w = pk_bf16(cv[6] * rs * kn[6], cv[7] * rs * kn[7]);
              o1.x = pk_bf16(cv[8] * rs * kn[8], cv[9] * rs * kn[9]); o1.y = pk_bf16(cv[10] * rs * kn[10], cv[11] * rs * kn[11]); o1.z = pk_bf16(cv[12] * rs * kn[12], cv[13] * rs * kn[13]); o1.w = pk_bf16(cv[14] * rs * kn[14], cv[15] * rs * kn[15]);
              *(u32x4*)(CKV + (size_t)t * 128 + sub * 16) = o0; *(u32x4*)(CKV + (size_t)t * 128 + sub * 16 + 8) = o1; }
            const float wv = tp[256 + 160 + sub]; const float sc = 0.5f * 0.0625f;
            const float aw = fabsf(wv) * sc, lw = wv * sc;
            unsigned bit = (wv < 0.f) ? (1u << sub) : 0u; bit |= __shfl_xor(bit, 1); bit |= __shfl_xor(bit, 2); bit |= __shfl_xor(bit, 4);
            if (sub == 0) SG[t] = bit;
            typedef _Float16 f16x4_t __attribute__((ext_vector_type(4)));
            f16x4_t linq = {0, 0, 0, 0};
#pragma unroll
            for (int d8 = 0; d8 < 4; ++d8) {
                const f32x4 q0 = *(const f32x4*)(tp + sub * 32 + d8 * 8), q1 = *(const f32x4*)(tp + sub * 32 + d8 * 8 + 4);
                const float qv[8] = {q0.x, q0.y, q0.z, q0.w, q1.x, q1.y, q1.z, q1.w};
                f16x8 hq;
#pragma unroll
                for (int e = 0; e < 8; ++e) { hq[e] = (_Float16)(qv[e] * aw);
                    float lv = qv[e] * lw; lv += __shfl_xor(lv, 1); lv += __shfl_xor(lv, 2); lv += __shfl_xor(lv, 4);
                    const int d = d8 * 8 + e; if ((d >> 2) == sub) linq[d & 3] = (_Float16)lv; }
                *(f16x8*)(QI + (size_t)t * 288 + sub * 32 + d8 * 8) = hq;
            }
            *(f16x4_t*)(QI + (size_t)t * 288 + 256 + sub * 4) = linq;
            { const f32x4 kq = *(const f32x4*)(tp + 256 + 128 + sub * 4); f16x4_t hk = {(_Float16)kq.x, (_Float16)kq.y, (_Float16)kq.z, (_Float16)kq.w}; *(f16x4_t*)(KI + (size_t)t * 32 + sub * 4) = hk; }
        }
        {
            const u16* wl = (const u16*)(c.ws + O_WL + l * WL_L);
            const int lane = c.lane, hh = c.wave;
            for (int mt = 0; mt < 4; ++mt) {
                int n = lane & 15, g = lane >> 4; asm volatile("" : "+v"(n), "+v"(g));
                f32x4 cw[4], ca[4], cg[4], cv[4];
#pragma unroll
                for (int nt = 0; nt < 4; ++nt) { cw[nt] = (f32x4){0.f, 0.f, 0.f, 0.f}; ca[nt] = cw[nt]; cg[nt] = cw[nt]; cv[nt] = cw[nt]; }
                const LAS u16* xrow = L_xl + (16 * mt + n) * XLS + 8 * g;
#pragma unroll
                for (int ks = 0; ks < 2; ++ks) {
                    const bf16x8 fw = *(const LAS bf16x8*)(xrow + 32 * ks), fa = *(const LAS bf16x8*)(xrow + 64 + 32 * ks);
#pragma unroll
                    for (int nt = 0; nt < 4; ++nt) { const int j = 64 * hh + 16 * nt + n;
                        cw[nt] = __builtin_amdgcn_mfma_f32_16x16x32_bf16(*(const bf16x8*)(wl + (size_t)j * 64 + 32 * ks + 8 * g), fw, cw[nt], 0, 0, 0);
                        ca[nt] = __builtin_amdgcn_mfma_f32_16x16x32_bf16(*(const bf16x8*)(wl + 512 * 64 + (size_t)j * 64 + 32 * ks + 8 * g), fa, ca[nt], 0, 0, 0); }
                }
#pragma unroll
                for (int ks = 0; ks < 4; ++ks) {
                    const bf16x8 fg = *(const LAS bf16x8*)(xrow + 128 + 32 * ks);
#pragma unroll
                    for (int nt = 0; nt < 4; ++nt) { const int j = 64 * hh + 16 * nt + n;
                        cg[nt] = __builtin_amdgcn_mfma_f32_16x16x32_bf16(*(const bf16x8*)(wl + 2 * 512 * 64 + (size_t)j * 128 + 32 * ks + 8 * g), fg, cg[nt], 0, 0, 0); }
                }
                if (l == 1) {
#pragma unroll
                    for (int ks = 0; ks < 2; ++ks) {
                        const bf16x8 fv = *(const LAS bf16x8*)(xrow + 256 + 32 * ks);
#pragma unroll
                        for (int nt = 0; nt < 4; ++nt) { const int j = 64 * hh + 16 * nt + n;
                            cv[nt] = __builtin_amdgcn_mfma_f32_16x16x32_bf16(*(const bf16x8*)(wl + 2 * 512 * 64 + 512 * 128 + (size_t)j * 64 + 32 * ks + 8 * g), fv, cv[nt], 0, 0, 0); }
                    }
                }
                const int t = t0 + 16 * mt + n;
                const u16* pc = pr + (size_t)t * 1792; const u16* pp = pc - 1792;
                float kkr_[16], av_[16]; float nn = 0.f, bc = 0.f;
#pragma unroll
                for (int nt = 0; nt < 4; ++nt) {
                    const int j = 64 * hh + 16 * nt + 4 * g; const size_t o = (size_t)t * 512 + j;
                    const u32x2 rcw = *(const u32x2*)(pc + j), kcw = *(const u32x2*)(pc + 512 + j), vcw = *(const u32x2*)(pc + 1024 + j);
                    u32x2 rpw = (u32x2){0u, 0u}, kpw = rpw, vpw = rpw; if (t > 0) { rpw = *(const u32x2*)(pp + j); kpw = *(const u32x2*)(pp + 512 + j); vpw = *(const u32x2*)(pp + 1024 + j); }
                    const f32x4 w04 = *(const LAS f32x4*)(L_cst + j), a04 = *(const LAS f32x4*)(L_cst + 512 + j), kk4 = *(const LAS f32x4*)(L_cst + 1024 + j), ka4 = *(const LAS f32x4*)(L_cst + 1536 + j), rk4 = *(const LAS f32x4*)(L_cst + 2048 + j),
                                v04 = *(const LAS f32x4*)(L_cst + 2560 + j), mr4 = *(const LAS f32x4*)(L_cst + 3072 + j), mk4 = *(const LAS f32x4*)(L_cst + 3584 + j), mv4 = *(const LAS f32x4*)(L_cst + 4096 + j);
                    const float rc[4] = {bflo(rcw.x), bfhi(rcw.x), bflo(rcw.y), bfhi(rcw.y)}, kc[4] = {bflo(kcw.x), bfhi(kcw.x), bflo(kcw.y), bfhi(kcw.y)}, vc[4] = {bflo(vcw.x), bfhi(vcw.x), bflo(vcw.y), bfhi(vcw.y)};
                    const float rp[4] = {bflo(rpw.x), bfhi(rpw.x), bflo(rpw.y), bfhi(rpw.y)}, kp[4] = {bflo(kpw.x), bfhi(kpw.x), bflo(kpw.y), bfhi(kpw.y)}, vp[4] = {bflo(vpw.x), bfhi(vpw.x), bflo(vpw.y), bfhi(vpw.y)};
                    u32x2 vfw = (u32x2){0u, 0u}; if (l == 1) vfw = *(const u32x2*)(VF + o);
                    const float vf4[4] = {bflo(vfw.x), bfhi(vfw.x), bflo(vfw.y), bfhi(vfw.y)};
                    float dec[4], k2[4], rv[4], vv[4];
#pragma unroll
                    for (int r = 0; r < 4; ++r) {
                        rv[r] = rc[r] + (rp[r] - rc[r]) * mr4[r]; const float k = kc[r] + (kp[r] - kc[r]) * mk4[r]; float v = vc[r] + (vp[r] - vc[r]) * mv4[r];
                        if (l == 1) v = v + (vf4[r] - v) * sigmoidf_(v04[r] + cv[nt][r]);
                        vv[r] = v;
                        const float wpre = w04[r] + cw[nt][r];
                        const float sp = fmaxf(-wpre, 0.f) + log1pf(__expf(-fabsf(wpre)));
                        dec[r] = __expf(-__expf(-sp - 0.5f));
                        const float av2 = sigmoidf_(a04[r] + ca[nt][r]);
                        const float kkr = k * kk4[r]; nn += kkr * kkr;
                        k2[r] = k * (1.0f + (av2 - 1.0f) * ka4[r]);
                        bc += rv[r] * k2[r] * rk4[r];
                        kkr_[4 * nt + r] = kkr; av_[4 * nt + r] = av2;
                    }
                    *(f32x4*)(RW + o) = (f32x4){dec[0], dec[1], dec[2], dec[3]};
                    { u32x2 w2; w2.x = pk_bf16(k2[0], k2[1]); w2.y = pk_bf16(k2[2], k2[3]); *(u32x2*)(RK + o) = w2; w2.x = pk_bf16(rv[0], rv[1]); w2.y = pk_bf16(rv[2], rv[3]); *(u32x2*)(RR + o) = w2;
                      w2.x = pk_bf16(vv[0], vv[1]); w2.y = pk_bf16(vv[2], vv[3]); *(u32x2*)(RV + o) = w2; if (l == 0) *(u32x2*)(VF + o) = w2;
                      w2.x = pk_bf16(cg[nt][0], cg[nt][1]); w2.y = pk_bf16(cg[nt][2], cg[nt][3]); *(u32x2*)(RG + o) = w2; }
                }
                nn += __shfl_xor(nn, 16); nn += __shfl_xor(nn, 32); bc += __shfl_xor(bc, 16); bc += __shfl_xor(bc, 32);
                const float inv = 1.0f / sqrtf(nn + 1e-12f);
                typedef _Float16 f16x4_t __attribute__((ext_vector_type(4)));
#pragma unroll
                for (int nt = 0; nt < 4; ++nt) { const size_t o = (size_t)t * 512 + 64 * hh + 16 * nt + 4 * g;
                    f16x4_t kq, bq;
#pragma unroll
                    for (int r = 0; r < 4; ++r) { const float kkn = kkr_[4 * nt + r] * inv; kq[r] = (_Float16)kkn; bq[r] = (_Float16)(kkn * av_[4 * nt + r]); }
                    *(f16x4_t*)(RKK + o) = kq; *(f16x4_t*)(RB + o) = bq; }
                if (g == 0) BC[(size_t)t * 8 + hh] = bc;
            }
        }
    }
}

__device__ __forceinline__ void fox_unit(const Ctx& c, int u, const LAS float* PB) {
    const u16* qkvf = (const u16*)(c.ws + T_QKVF); const u16* VT = (const u16*)(c.ws + T_VT); const float* FL = (const float*)(c.ws + T_FL); u16* OF = (u16*)(c.ws + T_OF);
    const int lane = c.lane, q = lane & 15, g = lane >> 4;
    const int qb = 511 - (u >> 2), h = u & 3, r0 = qb * 32;
    const u16* Qp = qkvf + (size_t)(r0 + q) * 768 + h * 64 + 8 * g;
    bf16x8 qA[2], qB[2];
    qA[0] = *(const bf16x8*)Qp; qA[1] = *(const bf16x8*)(Qp + 32); qB[0] = *(const bf16x8*)(Qp + 16 * 768); qB[1] = *(const bf16x8*)(Qp + 16 * 768 + 32);
    const float* FLh = FL + (size_t)h * S; const LAS float* PBh = PB + h * 256;
    const float FqA = FLh[r0 + q] + PBh[r0 >> 6], FqB = FLh[r0 + 16 + q] + PBh[r0 >> 6];
    float mA = -INFINITY, mB = -INFINITY, lA = 0.f, lB = 0.f;
    f32x4 oA[4], oB[4];
#pragma unroll
    for (int d = 0; d < 4; ++d) { oA[d] = (f32x4){0.f, 0.f, 0.f, 0.f}; oB[d] = (f32x4){0.f, 0.f, 0.f, 0.f}; }
    const int krow_off = 8 * (q >> 2) + (q & 3);
    const u16* Kbase = qkvf + 256 + h * 64 + 8 * g;
    const u16* Vbase = VT + (size_t)(h * 64 + q) * S + 8 * g;
    int kt0 = 0;
    float qn; float dmin;
    { const u16* kd = Kbase + (size_t)(r0 + q) * 768;
      const u32x4 a0 = __builtin_bit_cast(u32x4, qA[0]), a1 = __builtin_bit_cast(u32x4, qA[1]), b0 = __builtin_bit_cast(u32x4, qB[0]), b1 = __builtin_bit_cast(u32x4, qB[1]);
      const u32x4 k0_ = *(const u32x4*)kd, k1_ = *(const u32x4*)(kd + 32), k2_ = *(const u32x4*)(kd + 16 * 768), k3_ = *(const u32x4*)(kd + 16 * 768 + 32);
      float dA = 0.f, dB = 0.f, nA = 0.f, nB = 0.f;
#pragma unroll
      for (int w = 0; w < 4; ++w) { nA += bflo(a0[w]) * bflo(a0[w]) + bfhi(a0[w]) * bfhi(a0[w]) + bflo(a1[w]) * bflo(a1[w]) + bfhi(a1[w]) * bfhi(a1[w]);
                                    nB += bflo(b0[w]) * bflo(b0[w]) + bfhi(b0[w]) * bfhi(b0[w]) + bflo(b1[w]) * bflo(b1[w]) + bfhi(b1[w]) * bfhi(b1[w]); }
#pragma unroll
      for (int w = 0; w < 4; ++w) { dA += bflo(a0[w]) * bflo(k0_[w]) + bfhi(a0[w]) * bfhi(k0_[w]) + bflo(a1[w]) * bflo(k1_[w]) + bfhi(a1[w]) * bfhi(k1_[w]);
                                    dB += bflo(b0[w]) * bflo(k2_[w]) + bfhi(b0[w]) * bfhi(k2_[w]) + bflo(b1[w]) * bflo(k3_[w]) + bfhi(b1[w]) * bfhi(k3_[w]); }
      dA += __shfl_xor(dA, 16); dA += __shfl_xor(dA, 32); dB += __shfl_xor(dB, 16); dB += __shfl_xor(dB, 32);
      float dm = fminf(dA, dB);
#pragma unroll
      for (int o = 1; o < 16; o <<= 1) dm = fminf(dm, __shfl_xor(dm, o));
      nA += __shfl_xor(nA, 16); nA += __shfl_xor(nA, 32); nB += __shfl_xor(nB, 16); nB += __shfl_xor(nB, 32);
      float nm = fmaxf(nA, nB);
#pragma unroll
      for (int o = 1; o < 16; o <<= 1) nm = fmaxf(nm, __shfl_xor(nm, o));
      qn = sqrtf(__builtin_amdgcn_readfirstlane(nm)) * 1.001f;
      dmin = __builtin_amdgcn_readfirstlane(dm) - 0.5f; }
    { const float thr = __builtin_amdgcn_readfirstlane(FLh[r0] + PBh[r0 >> 6]) + (qn * PB[1024 + h] + 48.0f) - dmin; const int bmax = r0 >> 6; int b = 0;
#pragma unroll
      for (int e = 0; e < 4; ++e) {
          const int bb = lane + 64 * e; const bool cnd = bb < bmax && PBh[bb + 1] > thr;
          const unsigned long long nb = ~__ballot(cnd); const int n = nb ? __builtin_ctzll(nb) : 64;
          if (b == 64 * e) b += n; }
      kt0 = 2 * b; }
    bf16x8 kf[2][2], vf[4]; f32x4 f0, f1;
#define FOX_LOAD(KT) do { const int k0_ = (KT) * 32; \
        _Pragma("unroll") for (int rb = 0; rb < 2; ++rb) { const u16* kp = Kbase + (size_t)(k0_ + krow_off + 4 * rb) * 768; kf[rb][0] = *(const bf16x8*)kp; kf[rb][1] = *(const bf16x8*)(kp + 32); } \
        _Pragma("unroll") for (int d = 0; d < 4; ++d) vf[d] = *(const bf16x8*)(Vbase + (size_t)(16 * d) * S + k0_); \
        f0 = *(const f32x4*)(FLh + k0_ + 8 * g); f1 = *(const f32x4*)(FLh + k0_ + 8 * g + 4); } while (0)
    FOX_LOAD(kt0);
    for (int kt = kt0; kt <= qb; ++kt) {
        const int k0 = kt * 32;
        const float pb = PBh[k0 >> 6];
        float fk[8] = {f0.x + pb, f0.y + pb, f0.z + pb, f0.w + pb, f1.x + pb, f1.y + pb, f1.z + pb, f1.w + pb};
        bf16x8 kc[2][2], vc[4];
#pragma unroll
        for (int rb = 0; rb < 2; ++rb) { kc[rb][0] = kf[rb][0]; kc[rb][1] = kf[rb][1]; }
#pragma unroll
        for (int d = 0; d < 4; ++d) vc[d] = vf[d];
        if (kt < qb) FOX_LOAD(kt + 1);
        f32x4 sA[2], sB[2];
#pragma unroll
        for (int rb = 0; rb < 2; ++rb) {
            sA[rb] = __builtin_amdgcn_mfma_f32_16x16x32_bf16(kc[rb][0], qA[0], (f32x4){0.f, 0.f, 0.f, 0.f}, 0, 0, 0);
            sA[rb] = __builtin_amdgcn_mfma_f32_16x16x32_bf16(kc[rb][1], qA[1], sA[rb], 0, 0, 0);
            sB[rb] = __builtin_amdgcn_mfma_f32_16x16x32_bf16(kc[rb][0], qB[0], (f32x4){0.f, 0.f, 0.f, 0.f}, 0, 0, 0);
            sB[rb] = __builtin_amdgcn_mfma_f32_16x16x32_bf16(kc[rb][1], qB[1], sB[rb], 0, 0, 0);
        }
        float xA[8], xB[8];
#pragma unroll
        for (int j = 0; j < 8; ++j) { xA[j] = sA[j >> 2][j & 3] + (FqA - fk[j]); xB[j] = sB[j >> 2][j & 3] + (FqB - fk[j]); }
        if (kt == qb) {
#pragma unroll
            for (int j = 0; j < 8; ++j) { const int key = 8 * g + j; if (key > q) xA[j] = -INFINITY; if (key > 16 + q) xB[j] = -INFINITY; }
        }
        float mxA = xA[0], mxB = xB[0];
#pragma unroll
        for (int j = 1; j < 8; ++j) { mxA = fmaxf(mxA, xA[j]); mxB = fmaxf(mxB, xB[j]); }
        mxA = fmaxf(mxA, __shfl_xor(mxA, 16)); mxA = fmaxf(mxA, __shfl_xor(mxA, 32));
        mxB = fmaxf(mxB, __shfl_xor(mxB, 16)); mxB = fmaxf(mxB, __shfl_xor(mxB, 32));
        const float mnA = fmaxf(mA, mxA), mnB = fmaxf(mB, mxB);
        const float alA = __builtin_amdgcn_exp2f(mA - mnA), alB = __builtin_amdgcn_exp2f(mB - mnB);
        mA = mnA; mB = mnB;
        float sumA = 0.f, sumB = 0.f;
#pragma unroll
        for (int j = 0; j < 8; ++j) { xA[j] = __builtin_amdgcn_exp2f(xA[j] - mnA); xB[j] = __builtin_amdgcn_exp2f(xB[j] - mnB); sumA += xA[j]; sumB += xB[j]; }
        lA = lA * alA + sumA; lB = lB * alB + sumB;
        u32x4 pwA, pwB;
        pwA.x = pk_bf16(xA[0], xA[1]); pwA.y = pk_bf16(xA[2], xA[3]); pwA.z = pk_bf16(xA[4], xA[5]); pwA.w = pk_bf16(xA[6], xA[7]);
        pwB.x = pk_bf16(xB[0], xB[1]); pwB.y = pk_bf16(xB[2], xB[3]); pwB.z = pk_bf16(xB[4], xB[5]); pwB.w = pk_bf16(xB[6], xB[7]);
        const bf16x8 pA = __builtin_bit_cast(bf16x8, pwA), pB = __builtin_bit_cast(bf16x8, pwB);
#pragma unroll
        for (int d = 0; d < 4; ++d) {
            oA[d] = __builtin_amdgcn_mfma_f32_16x16x32_bf16(vc[d], pA, oA[d] * alA, 0, 0, 0);
            oB[d] = __builtin_amdgcn_mfma_f32_16x16x32_bf16(vc[d], pB, oB[d] * alB, 0, 0, 0);
        }
    }
#undef FOX_LOAD
    lA += __shfl_xor(lA, 16); lA += __shfl_xor(lA, 32); lB += __shfl_xor(lB, 16); lB += __shfl_xor(lB, 32);
    const float iA = 1.0f / lA, iB = 1.0f / lB;
#pragma unroll
    for (int d = 0; d < 4; ++d) {
        u32x2 w; w.x = pk_bf16(oA[d][0] * iA, oA[d][1] * iA); w.y = pk_bf16(oA[d][2] * iA, oA[d][3] * iA);
        *(u32x2*)(OF + (size_t)(r0 + q) * 256 + h * 64 + 16 * d + 4 * g) = w;
        w.x = pk_bf16(oB[d][0] * iB, oB[d][1] * iB); w.y = pk_bf16(oB[d][2] * iB, oB[d][3] * iB);
        *(u32x2*)(OF + (size_t)(r0 + 16 + q) * 256 + h * 64 + 16 * d + 4 * g) = w;
    }
}

__device__ __forceinline__ float r1_gsum(float x) {
    auto a = __builtin_amdgcn_permlane32_swap(__float_as_uint(x), __float_as_uint(x), false, false);
    const float y = __uint_as_float(a[0]) + __uint_as_float(a[1]);
    auto b = __builtin_amdgcn_permlane16_swap(__float_as_uint(y), __float_as_uint(y), false, false);
    return __uint_as_float(b[0]) + __uint_as_float(b[1]);
}
__device__ __forceinline__ void r1_task(const Ctx& c, int task, LAS float* lw) {
    const float* RW = (const float*)(c.ws + T_RW); const _Float16* RKK = (const _Float16*)(c.ws + T_RKK); const _Float16* RB = (const _Float16*)(c.ws + T_RB);
    const u16* RK = (const u16*)(c.ws + T_RK); const u16* RR = (const u16*)(c.ws + T_RR); const u16* RV = (const u16*)(c.ws + T_RV);
    float* YL = (float*)(c.ws + T_YL); u16* RT = (u16*)(c.ws + T_RT); float* PC = (float*)(c.ws + T_PC); float* UC = (float*)(c.ws + T_UC);
    const int lane = c.lane, m = lane & 15, g = lane >> 4, h = task >> 8, ch = task & 255, t0 = ch * 64;
    float U[4][16], P[4][16];
#pragma unroll
    for (int mt = 0; mt < 4; ++mt)
#pragma unroll
        for (int cc = 0; cc < 16; ++cc) { U[mt][cc] = 0.f; P[mt][cc] = (16 * mt + m == 16 * g + cc) ? 1.f : 0.f; }
    for (int blk = 0; blk < 8; ++blk) {
        const int tb = t0 + blk * 8;
        {
            int l2 = lane; asm volatile("" : "+v"(l2)); const int ls = l2 >> 3, lj = (l2 & 7) * 8;
            const size_t o = (size_t)(tb + ls) * 512 + h * 64 + lj;
            const f32x4 w0 = *(const f32x4*)(RW + o), w1 = *(const f32x4*)(RW + o + 4);
            const f16x8 kk = *(const f16x8*)(RKK + o), bb = *(const f16x8*)(RB + o);
            const u32x4 kr = *(const u32x4*)(RK + o), rr = *(const u32x4*)(RR + o), vv = *(const u32x4*)(RV + o);
            LAS float* d = lw + ls * 384 + lj;
            *(LAS f32x4*)(d) = w0; *(LAS f32x4*)(d + 4) = w1;
            *(LAS f32x4*)(d + 64) = (f32x4){(float)kk[0], (float)kk[1], (float)kk[2], (float)kk[3]}; *(LAS f32x4*)(d + 68) = (f32x4){(float)kk[4], (float)kk[5], (float)kk[6], (float)kk[7]};
            *(LAS f32x4*)(d + 128) = (f32x4){(float)bb[0], (float)bb[1], (float)bb[2], (float)bb[3]}; *(LAS f32x4*)(d + 132) = (f32x4){(float)bb[4], (float)bb[5], (float)bb[6], (float)bb[7]};
            *(LAS f32x4*)(d + 192) = (f32x4){bflo(kr.x), bfhi(kr.x), bflo(kr.y), bfhi(kr.y)}; *(LAS f32x4*)(d + 196) = (f32x4){bflo(kr.z), bfhi(kr.z), bflo(kr.w), bfhi(kr.w)};
            *(LAS f32x4*)(d + 256) = (f32x4){bflo(rr.x), bfhi(rr.x), bflo(rr.y), bfhi(rr.y)}; *(LAS f32x4*)(d + 260) = (f32x4){bflo(rr.z), bfhi(rr.z), bflo(rr.w), bfhi(rr.w)};
            *(LAS f32x4*)(d + 320) = (f32x4){bflo(vv.x), bfhi(vv.x), bflo(vv.y), bfhi(vv.y)}; *(LAS f32x4*)(d + 324) = (f32x4){bflo(vv.z), bfhi(vv.z), bflo(vv.w), bfhi(vv.w)};
        }
        asm volatile("s_waitcnt lgkmcnt(0)" ::: "memory");
        for (int s = 0; s < 8; ++s) {
            const LAS float* b = lw + s * 384 + 16 * g; const int t = tb + s;
            float vv_[4], su[4], sp[4];
            {   float a[4] = {0.f, 0.f, 0.f, 0.f}, p[4] = {0.f, 0.f, 0.f, 0.f};
#pragma unroll
                for (int q4 = 0; q4 < 4; ++q4) { const f32x4 kk4 = *(const LAS f32x4*)(b + 64 + 4 * q4);
#pragma unroll
                    for (int mt = 0; mt < 4; ++mt)
#pragma unroll
                        for (int e = 0; e < 4; ++e) { a[mt] = fmaf(U[mt][4 * q4 + e], kk4[e], a[mt]); p[mt] = fmaf(P[mt][4 * q4 + e], kk4[e], p[mt]); } }
#pragma unroll
                for (int mt = 0; mt < 4; ++mt) { vv_[mt] = lw[s * 384 + 320 + 16 * mt + m]; su[mt] = -r1_gsum(a[mt]); sp[mt] = -r1_gsum(p[mt]); } }
            float y[4] = {0.f, 0.f, 0.f, 0.f}, rt[4] = {0.f, 0.f, 0.f, 0.f};
#pragma unroll
            for (int q4 = 0; q4 < 4; ++q4) {
                const f32x4 w4 = *(const LAS f32x4*)(b + 4 * q4), b4 = *(const LAS f32x4*)(b + 128 + 4 * q4), k4 = *(const LAS f32x4*)(b + 192 + 4 * q4), r4 = *(const LAS f32x4*)(b + 256 + 4 * q4);
#pragma unroll
                for (int mt = 0; mt < 4; ++mt)
#pragma unroll
                    for (int e = 0; e < 4; ++e) { const int cc = 4 * q4 + e;
                        float t1 = vv_[mt] * k4[e]; t1 = fmaf(su[mt], b4[e], t1); U[mt][cc] = fmaf(U[mt][cc], w4[e], t1);
                        P[mt][cc] = fmaf(P[mt][cc], w4[e], sp[mt] * b4[e]);
                        y[mt] = fmaf(U[mt][cc], r4[e], y[mt]); rt[mt] = fmaf(P[mt][cc], r4[e], rt[mt]); }
            }
            float yv = 0.f, rv = 0.f;
#pragma unroll
            for (int mt = 0; mt < 4; ++mt) { const float ys = r1_gsum(y[mt]), rs_ = r1_gsum(rt[mt]); if (g == mt) { yv = ys; rv = rs_; } }
            { int l3 = lane; asm volatile("" : "+v"(l3)); const size_t oo = (size_t)t * 512 + h * 64 + l3; YL[oo] = yv; RT[oo] = f2bf(rv); }
        }
    }
    int ln = lane; asm volatile("" : "+v"(ln));
    const int m2 = ln & 15, g2 = ln >> 4;
    u16* ph = (u16*)PC + (size_t)task * 8192;
    LAS u16* lt = (LAS u16*)lw;
#pragma unroll
    for (int mt = 0; mt < 4; ++mt) { const int kpos = 32 * (mt >> 1) + 8 * (m2 >> 2) + 4 * (mt & 1) + (m2 & 3);
#pragma unroll
        for (int cc = 0; cc < 16; ++cc) { const float pv = P[mt][cc]; const u16 hi = f2bf(pv); const u16 lo = f2bf(pv - bf2f(hi)); lt[(16 * g2 + cc) * 64 + kpos] = hi; lt[4096 + (16 * g2 + cc) * 64 + kpos] = lo; } }
    asm volatile("s_waitcnt lgkmcnt(0)" ::: "memory");
#pragma unroll
    for (int i = 0; i < 16; ++i) *(u32x4*)(ph + (size_t)(i * 64 + ln) * 8) = *(const LAS u32x4*)((LAS u16*)lw + (i * 64 + ln) * 8);
    asm volatile("s_waitcnt lgkmcnt(0)" ::: "memory");
#pragma unroll
    for (int mt = 0; mt < 4; ++mt) { float* uc = UC + ((size_t)task * 64 + 16 * mt + m2) * 64 + 16 * g2;
#pragma unroll
        for (int cc = 0; cc < 16; cc += 4) *(f32x4*)(uc + cc) = (f32x4){U[mt][cc], U[mt][cc + 1], U[mt][cc + 2], U[mt][cc + 3]}; }
}

constexpr int R2_SLOT = 20480;
__device__ __forceinline__ void r2_task(const Ctx& c, int h, int rgp) {
    const u16* PHL = (const u16*)(c.ws + T_PC); float* UC = (float*)(c.ws + T_UC);
    volatile LAS unsigned* full = (volatile LAS unsigned*)(c.lds + 7 * R2_SLOT);
    volatile LAS unsigned* freef = full + 8;
    if (c.tid < 16) full[c.tid] = 0u;
    __syncthreads();
    const int lane = c.lane, n = lane & 15, g = lane >> 4, i = 16 * rgp + n;
    if (c.wave == 0) {
        f32x4 s[4];
#pragma unroll
        for (int mt = 0; mt < 4; ++mt) s[mt] = (f32x4){0.f, 0.f, 0.f, 0.f};
        for (int ch = 0; ch < 256; ++ch) {
            const int slot = ch % 7; const LAS unsigned char* sb = c.lds + slot * R2_SLOT;
            { unsigned sp = 0; while (full[slot] != (unsigned)(ch + 1)) { __builtin_amdgcn_s_sleep(1); if (++sp > (1u << 22)) break; } }
            asm volatile("" ::: "memory");
            bf16x8 ah[4][2], al[4][2]; f32x4 u[4];
#pragma unroll
            for (int mt = 0; mt < 4; ++mt) { u[mt] = *(const LAS f32x4*)(sb + 16384 + (mt * 64 + lane) * 16);
#pragma unroll
                for (int ks = 0; ks < 2; ++ks) { ah[mt][ks] = *(const LAS bf16x8*)(sb + ((mt * 2 + ks) * 64 + lane) * 16); al[mt][ks] = *(const LAS bf16x8*)(sb + 8192 + ((mt * 2 + ks) * 64 + lane) * 16); } }
            float* up = UC + ((size_t)(h * 256 + ch) * 64 + i) * 64 + 4 * g;
#pragma unroll
            for (int mt = 0; mt < 4; ++mt) *(f32x4*)(up + 16 * mt) = s[mt];
            bf16x8 bh[2], bl[2];
#pragma unroll
            for (int ks = 0; ks < 2; ++ks) {
                u32x4 wh, wl; float hv[8], lv[8];
#pragma unroll
                for (int j = 0; j < 8; ++j) { const float v = s[2 * ks + (j >> 2)][j & 3]; hv[j] = bf2f(f2bf(v)); lv[j] = v - hv[j]; }
                wh.x = pk_bf16(hv[0], hv[1]); wh.y = pk_bf16(hv[2], hv[3]); wh.z = pk_bf16(hv[4], hv[5]); wh.w = pk_bf16(hv[6], hv[7]);
                wl.x = pk_bf16(lv[0], lv[1]); wl.y = pk_bf16(lv[2], lv[3]); wl.z = pk_bf16(lv[4], lv[5]); wl.w = pk_bf16(lv[6], lv[7]);
                bh[ks] = __builtin_bit_cast(bf16x8, wh); bl[ks] = __builtin_bit_cast(bf16x8, wl);
            }
            asm volatile("s_waitcnt lgkmcnt(0)" ::: "memory");
            if (lane == 0) freef[slot] = (unsigned)(ch + 1);
#pragma unroll
            for (int mt = 0; mt < 4; ++mt) {
                f32x4 acc = u[mt];
#pragma unroll
                for (int ks = 0; ks < 2; ++ks) {
                    acc = __builtin_amdgcn_mfma_f32_16x16x32_bf16(ah[mt][ks], bl[ks], acc, 0, 0, 0);
                    acc = __builtin_amdgcn_mfma_f32_16x16x32_bf16(al[mt][ks], bh[ks], acc, 0, 0, 0);
                    acc = __builtin_amdgcn_mfma_f32_16x16x32_bf16(ah[mt][ks], bh[ks], acc, 0, 0, 0);
                }
                s[mt] = acc;
            }
        }
    } else {
        for (int ch = c.wave - 1; ch < 256; ch += 7) {
            const int slot = ch % 7; LAS unsigned char* sb = c.lds + slot * R2_SLOT;
            const u16* ph = PHL + (size_t)(h * 256 + ch) * 8192; const float* up = UC + ((size_t)(h * 256 + ch) * 64 + i) * 64 + 4 * g;
            bf16x8 ah[4][2], al[4][2]; f32x4 u[4];
#pragma unroll
            for (int mt = 0; mt < 4; ++mt) { u[mt] = *(const f32x4*)(up + 16 * mt);
#pragma unroll
                for (int ks = 0; ks < 2; ++ks) { ah[mt][ks] = *(const bf16x8*)(ph + (16 * mt + n) * 64 + 32 * ks + 8 * g); al[mt][ks] = *(const bf16x8*)(ph + 4096 + (16 * mt + n) * 64 + 32 * ks + 8 * g); } }
            asm volatile("s_waitcnt vmcnt(0)" ::: "memory");
            if (ch >= 7) { unsigned sp = 0; while (freef[slot] != (unsigned)(ch - 6)) { __builtin_amdgcn_s_sleep(1); if (++sp > (1u << 22)) break; } }
            asm volatile("" ::: "memory");
#pragma unroll
            for (int mt = 0; mt < 4; ++mt) { *(LAS f32x4*)(sb + 16384 + (mt * 64 + lane) * 16) = u[mt];
#pragma unroll
                for (int ks = 0; ks < 2; ++ks) { *(LAS bf16x8*)(sb + ((mt * 2 + ks) * 64 + lane) * 16) = ah[mt][ks]; *(LAS bf16x8*)(sb + 8192 + ((mt * 2 + ks) * 64 + lane) * 16) = al[mt][ks]; } }
            asm volatile("s_waitcnt lgkmcnt(0)" ::: "memory");
            if (lane == 0) full[slot] = (unsigned)(ch + 1);
        }
    }
    __syncthreads();
}

__device__ __forceinline__ void r3_task(const Ctx& c, CArgsP a, int l, int task) {
    const float* YL = (const float*)(c.ws + T_YL); const u16* RT = (const u16*)(c.ws + T_RT); const float* S0 = (const float*)(c.ws + T_UC);
    const u16* RV = (const u16*)(c.ws + T_RV); const u16* RG = (const u16*)(c.ws + T_RG); const float* BC = (const float*)(c.ws + T_BC); u16* OR_ = (u16*)(c.ws + T_OR);
    const int lane = c.lane, n = lane & 15, g = lane >> 4, h = task >> 8, ch = task & 255, t0 = ch * 64;
    bf16x8 sh[4][2], sl[4][2];
#pragma unroll
    for (int it = 0; it < 4; ++it)
#pragma unroll
        for (int ks = 0; ks < 2; ++ks) { const float* sp = S0 + ((size_t)task * 64 + 16 * it + n) * 64 + 32 * ks + 8 * g; const f32x4 v0 = *(const f32x4*)sp, v1 = *(const f32x4*)(sp + 4);
            const float v[8] = {v0.x, v0.y, v0.z, v0.w, v1.x, v1.y, v1.z, v1.w}; float hv[8], lv[8];
#pragma unroll
            for (int e = 0; e < 8; ++e) { hv[e] = bf2f(f2bf(v[e])); lv[e] = v[e] - hv[e]; }
            u32x4 wh, wl; wh.x = pk_bf16(hv[0], hv[1]); wh.y = pk_bf16(hv[2], hv[3]); wh.z = pk_bf16(hv[4], hv[5]); wh.w = pk_bf16(hv[6], hv[7]);
            wl.x = pk_bf16(lv[0], lv[1]); wl.y = pk_bf16(lv[2], lv[3]); wl.z = pk_bf16(lv[4], lv[5]); wl.w = pk_bf16(lv[6], lv[7]);
            sh[it][ks] = __builtin_bit_cast(bf16x8, wh); sl[it][ks] = __builtin_bit_cast(bf16x8, wl); }
    const float* lng = a->in[I_LNG] + l * 512 + h * 64; const float* lnb = a->in[I_LNB] + l * 512 + h * 64;
#pragma unroll 1
    for (int tt = 0; tt < 4; ++tt) {
        int n2 = n, g2 = g; asm volatile("" : "+v"(n2), "+v"(g2));
        const int t = t0 + 16 * tt + n2; const size_t ob = (size_t)t * 512 + h * 64 + 4 * g2;
        const bf16x8 r0 = *(const bf16x8*)(RT + (size_t)t * 512 + h * 64 + 8 * g2), r1 = *(const bf16x8*)(RT + (size_t)t * 512 + h * 64 + 32 + 8 * g2);
        f32x4 y[4]; float s1 = 0.f;
#pragma unroll
        for (int it = 0; it < 4; ++it) { f32x4 acc = *(const f32x4*)(YL + ob + 16 * it);
            acc = __builtin_amdgcn_mfma_f32_16x16x32_bf16(sl[it][0], r0, acc, 0, 0, 0); acc = __builtin_amdgcn_mfma_f32_16x16x32_bf16(sl[it][1], r1, acc, 0, 0, 0);
            acc = __builtin_amdgcn_mfma_f32_16x16x32_bf16(sh[it][0], r0, acc, 0, 0, 0); acc = __builtin_amdgcn_mfma_f32_16x16x32_bf16(sh[it][1], r1, acc, 0, 0, 0);
            y[it] = acc; s1 += (acc[0] + acc[1]) + (acc[2] + acc[3]); }
        s1 += __shfl_xor(s1, 16); s1 += __shfl_xor(s1, 32);
        const float mean = s1 * (1.0f / 64.f); float s2 = 0.f;
#pragma unroll
        for (int it = 0; it < 4; ++it)
#pragma unroll
            for (int r = 0; r < 4; ++r) { const float d = y[it][r] - mean; y[it][r] = d; s2 += d * d; }
        s2 += __shfl_xor(s2, 16); s2 += __shfl_xor(s2, 32);
        const float rstd = 1.0f / sqrtf(s2 * (1.0f / 64.f) + 64e-5f); const float bcv = BC[(size_t)t * 8 + h];
#pragma unroll
        for (int it = 0; it < 4; ++it) { const size_t o = ob + 16 * it; const f32x4 g4 = *(const f32x4*)(lng + 16 * it + 4 * g2), b4 = *(const f32x4*)(lnb + 16 * it + 4 * g2);
            const u32x2 vw = *(const u32x2*)(RV + o), gw = *(const u32x2*)(RG + o);
            const float vv[4] = {bflo(vw.x), bfhi(vw.x), bflo(vw.y), bfhi(vw.y)}, gg[4] = {bflo(gw.x), bfhi(gw.x), bflo(gw.y), bfhi(gw.y)}; float ov[4];
#pragma unroll
            for (int r = 0; r < 4; ++r) ov[r] = (y[it][r] * rstd * g4[r] + b4[r] + bcv * vv[r]) * gg[r];
            u32x2 w2; w2.x = pk_bf16(ov[0], ov[1]); w2.y = pk_bf16(ov[2], ov[3]); *(u32x2*)(OR_ + o) = w2; }
    }
}

constexpr int DSA_CAP = 384;
constexpr int L_DSA_IMG = 0;
constexpr int L_DSA_FLAT = 0;
constexpr int L_DSA_CBM = 65536;
constexpr int L_DSA_CAND = 16384;
constexpr int L_DSA_BM = 98304;
constexpr int L_DSA_SEL = 131072;
constexpr int L_DSA_CNT = 131072 + 8192;
__device__ __forceinline__ unsigned ord_of(float s) { const unsigned u = __float_as_uint(s); return (u & 0x80000000u) ? ~u : (u | 0x80000000u); }
__device__ __forceinline__ unsigned img_off(unsigned row, unsigned ch) { return 256u * row + 16u * (ch ^ (((row & 3) << 2) | ((row >> 2) & 3))); }

__device__ __forceinline__ void dsa_score_pass(const Ctx& c, int ntile, const f16x8 (&qf)[9], const float (&sg)[8], float invw, float boff, LAS u32* hist, unsigned char* binrow) {
    const _Float16* KI = (const _Float16*)(c.ws + T_KI);
    int lane = c.lane; asm volatile("" : "+v"(lane));
    const int q = lane & 15, g = lane >> 4;
    const _Float16* kip = KI + (size_t)q * 32 + 8 * g;
    LAS u32* hq = hist + q * 1024; const int rot = 37 * q;
    unsigned* bout = (unsigned*)(binrow + (size_t)q * 16384 + 4 * g);
    const int ntw = (ntile - c.wave + NWAVES - 1) / NWAVES;
    f16x8 k0, k1, k2, k3;
#define DSA_KLOAD(IT) ((IT) < ntw ? *(const f16x8*)(kip + (size_t)(c.wave + NWAVES * (IT)) * 512) : (f16x8){0, 0, 0, 0, 0, 0, 0, 0})
#define DSA_TILE_BODY(KF, IT) do { if ((IT) < ntw) { const int kt = c.wave + NWAVES * (IT); \
        f32x4 xs[9]; \
        _Pragma("unroll") for (int hh = 0; hh < 9; ++hh) xs[hh] = __builtin_amdgcn_mfma_f32_16x16x32_f16(KF, qf[hh], (f32x4){0.f, 0.f, 0.f, 0.f}, 0, 0, 0); \
        KF = DSA_KLOAD((IT) + 4); \
        asm volatile("s_nop 15" : "+v"(xs[0]), "+v"(xs[1]), "+v"(xs[2]), "+v"(xs[3]), "+v"(xs[4]), "+v"(xs[5]), "+v"(xs[6]), "+v"(xs[7]), "+v"(xs[8]));     \
        f32x4 acc = xs[8]; \
        _Pragma("unroll") for (int hh = 0; hh < 8; ++hh) _Pragma("unroll") for (int r = 0; r < 4; ++r) asm volatile("v_fma_f32 %0, |%1|, %2, %0" : "+v"(acc[r]) : "v"(xs[hh][r]), "v"(sg[hh])); \
        unsigned packed = 0; \
        _Pragma("unroll") for (int r = 0; r < 4; ++r) { const float sc = acc[r] + 0.0f; \
            const int bin = min(max((int)__builtin_fmaf(sc, invw, boff), 0), 1023); \
            lds_addu(hq + ((bin + rot) & 1023), 1u); packed |= (unsigned)(bin >> 2) << (8 * r); } \
        bout[kt * 4] = packed; } } while (0)
#define DSA_TILE_BODY_U(KF, IT) do { const int kt = c.wave + NWAVES * (IT); \
        f32x4 xs[9]; \
        _Pragma("unroll") for (int hh = 0; hh < 9; ++hh) xs[hh] = __builtin_amdgcn_mfma_f32_16x16x32_f16(KF, qf[hh], (f32x4){0.f, 0.f, 0.f, 0.f}, 0, 0, 0); \
        KF = *(const f16x8*)(kip + (size_t)(kt + 4 * NWAVES) * 512); \
        asm volatile("s_nop 15" : "+v"(xs[0]), "+v"(xs[1]), "+v"(xs[2]), "+v"(xs[3]), "+v"(xs[4]), "+v"(xs[5]), "+v"(xs[6]), "+v"(xs[7]), "+v"(xs[8])); \
        f32x4 acc = xs[8]; \
        _Pragma("unroll") for (int hh = 0; hh < 8; ++hh) _Pragma("unroll") for (int r = 0; r < 4; ++r) asm volatile("v_fma_f32 %0, |%1|, %2, %0" : "+v"(acc[r]) : "v"(xs[hh][r]), "v"(sg[hh])); \
        unsigned packed = 0; \
        _Pragma("unroll") for (int r = 0; r < 4; ++r) { const float sc = acc[r] + 0.0f; \
            const int bin = min(max((int)__builtin_fmaf(sc, invw, boff), 0), 1023); \
            lds_addu(hq + ((bin + rot) & 1023), 1u); packed |= (unsigned)(bin >> 2) << (8 * r); } \
        bout[kt * 4] = packed; } while (0)
    k0 = DSA_KLOAD(0); k1 = DSA_KLOAD(1); k2 = DSA_KLOAD(2); k3 = DSA_KLOAD(3);
    int it = 0;
    for (; it + 8 <= ntw; it += 4) {
        DSA_TILE_BODY_U(k0, it); DSA_TILE_BODY_U(k1, it + 1); DSA_TILE_BODY_U(k2, it + 2); DSA_TILE_BODY_U(k3, it + 3);
    }
    for (; it < ntw; it += 4) {
        DSA_TILE_BODY(k0, it); DSA_TILE_BODY(k1, it + 1); DSA_TILE_BODY(k2, it + 2); DSA_TILE_BODY(k3, it + 3);
    }
#undef DSA_TILE_BODY_U
#undef DSA_TILE_BODY
#undef DSA_KLOAD
    asm volatile("s_waitcnt vmcnt(0)" ::: "memory");
}
typedef _Float16 h2_t __attribute__((ext_vector_type(2)));
__device__ __forceinline__ float dsa_score_one(const Ctx& c, int t, int key) {
    const _Float16* qp = (const _Float16*)(c.ws + T_QI) + (size_t)t * 288; const _Float16* kp = (const _Float16*)(c.ws + T_KI) + (size_t)key * 32;
    const u32 sb = ((const u32*)(c.ws + T_SG))[t];
    h2_t kv[16];
#pragma unroll
    for (int i = 0; i < 4; ++i) { const u32x4 w = *(const u32x4*)(kp + 8 * i); kv[4 * i] = __builtin_bit_cast(h2_t, w.x); kv[4 * i + 1] = __builtin_bit_cast(h2_t, w.y); kv[4 * i + 2] = __builtin_bit_cast(h2_t, w.z); kv[4 * i + 3] = __builtin_bit_cast(h2_t, w.w); }
    float sc = 0.f;
#pragma unroll
    for (int hh = 8; hh >= 0; --hh) {
        float x = 0.f;
#pragma unroll
        for (int i = 0; i < 4; ++i) { const u32x4 w = *(const u32x4*)(qp + hh * 32 + 8 * i);
            x = __builtin_amdgcn_fdot2(__builtin_bit_cast(h2_t, w.x), kv[4 * i], x, false); x = __builtin_amdgcn_fdot2(__builtin_bit_cast(h2_t, w.y), kv[4 * i + 1], x, false);
            x = __builtin_amdgcn_fdot2(__builtin_bit_cast(h2_t, w.z), kv[4 * i + 2], x, false); x = __builtin_amdgcn_fdot2(__builtin_bit_cast(h2_t, w.w), kv[4 * i + 3], x, false); }
        if (hh == 8) sc = x; else sc = __builtin_fmaf(__builtin_fabsf(x), ((sb >> hh) & 1u) ? -1.f : 1.f, sc);
    }
    return sc + 0.0f;
}
#if PROBE
#define DSTAMP(k) do { if (c.bid == 100 && c.tid == 0) { const u64 now_ = wall_clock64(); ((LAS u64*)(c.lds + L_DSA_CNT + 1024))[k] += now_ - dst_; dst_ = now_; } } while (0)
#else
#define DSTAMP(k) do { } while (0)
#endif
__device__ __forceinline__ void dsa_unit(const Ctx& c, int qt) {
#if PROBE
    u64 dst_ = wall_clock64();
#endif
    const _Float16* QI = (const _Float16*)(c.ws + T_QI); const u32* SG = (const u32*)(c.ws + T_SG);
    const u16* CKV = (const u16*)(c.ws + T_CKV); const u16* QL = (const u16*)(c.ws + T_QL); u16* OD = (u16*)(c.ws + T_OD);
    LAS u32* hist = (LAS u32*)(c.lds + L_DSA_IMG); LAS u64* cand = (LAS u64*)(c.lds + L_DSA_CAND);
    LAS u16* sel = (LAS u16*)(c.lds + L_DSA_SEL); LAS u32* cnts = (LAS u32*)(c.lds + L_DSA_CNT); LAS u32* bm = (LAS u32*)(c.lds + L_DSA_BM);
    int lane = c.lane; asm volatile("" : "+v"(lane)); const int q = lane & 15, g = lane >> 4; int tid = c.tid; asm volatile("" : "+v"(tid));
    const int chunk = qt >> 2, N = 64 * (chunk + 1);
    if (tid < 65) cnts[tid] = 0u;
    if (N > 256) {
        for (int i = tid; i < 16 * 1024; i += NTHR) hist[i] = 0u;
        { LAS u32* cbm0 = (LAS u32*)(c.lds + L_DSA_CBM); for (int i = tid; i < 2 * 16 * 512; i += NTHR) cbm0[i] = 0u; }
        f16x8 qf[9]; float sg[8];
        { const _Float16* qp = QI + (size_t)(qt * 16 + q) * 288 + 8 * g;
#pragma unroll
          for (int hh = 0; hh < 9; ++hh) qf[hh] = *(const f16x8*)(qp + hh * 32);
          const u32 sb = SG[qt * 16 + q];
#pragma unroll
          for (int hh = 0; hh < 8; ++hh) sg[hh] = ((sb >> hh) & 1u) ? -1.f : 1.f; }
        float invw, boff;
        { const _Float16* KIs = (const _Float16*)(c.ws + T_KI); const int ntile = N / 16; float s1 = 0.f, s2 = 0.f;
#pragma unroll
          for (int j = 0; j < 2; ++j) { const int kts = ((2 * c.wave + j) * ntile) >> 4;
              const f16x8 kf = *(const f16x8*)(KIs + (size_t)(kts * 16 + q) * 32 + 8 * g);
              f32x4 acc = __builtin_amdgcn_mfma_f32_16x16x32_f16(kf, qf[8], (f32x4){0.f, 0.f, 0.f, 0.f}, 0, 0, 0);
#pragma unroll
              for (int hh = 0; hh < 8; ++hh) { const f32x4 x = __builtin_amdgcn_mfma_f32_16x16x32_f16(kf, qf[hh], (f32x4){0.f, 0.f, 0.f, 0.f}, 0, 0, 0);
#pragma unroll
                  for (int r = 0; r < 4; ++r) acc[r] = __builtin_fmaf(__builtin_fabsf(x[r]), sg[hh], acc[r]); }
#pragma unroll
              for (int r = 0; r < 4; ++r) { s1 += acc[r]; s2 += acc[r] * acc[r]; } }
          s1 += __shfl_xor(s1, 16); s1 += __shfl_xor(s1, 32); s2 += __shfl_xor(s2, 16); s2 += __shfl_xor(s2, 32);
          LAS float* part = (LAS float*)(c.lds + L_DSA_CNT + 1536);
          if (g == 0) { part[(c.wave * 16 + q) * 2] = s1; part[(c.wave * 16 + q) * 2 + 1] = s2; }
          __syncthreads();
          float t1 = 0.f, t2 = 0.f;
#pragma unroll
          for (int w = 0; w < 8; ++w) { t1 += part[(w * 16 + q) * 2]; t2 += part[(w * 16 + q) * 2 + 1]; }
          const float mean = t1 * (1.0f / 256.f), var = fmaxf(t2 * (1.0f / 256.f) - mean * mean, 1e-30f);
          invw = 512.0f / (6.0f * sqrtf(var)); boff = 512.0f - mean * invw; }
        __syncthreads();
        unsigned char* binrow = c.ws + T_DSB + (size_t)c.bid * (16 * 16384);
        dsa_score_pass(c, N / 16, qf, sg, invw, boff, hist, binrow);
        __syncthreads();
        if (DSA_REP & 1) { for (int i = tid; i < 16 * 1024; i += NTHR) hist[i] = 0u; __syncthreads(); dsa_score_pass(c, N / 16, qf, sg, invw, boff, hist, binrow); __syncthreads(); }
        DSTAMP(0);
        for (int qq = 2 * c.wave; qq < 2 * c.wave + 2; ++qq) {
            int lane = c.lane; asm volatile("" : "+v"(lane));
            const LAS u32* hq = hist + qq * 1024; unsigned cs[4]; unsigned loc = 0;
#pragma unroll
            for (int i = 0; i < 4; ++i) { cs[i] = 0;
#pragma unroll
                for (int e = 0; e < 4; ++e) cs[i] += hq[(lane * 16 + 4 * i + e + 37 * qq) & 1023];
                loc += cs[i]; }
            unsigned suf = loc;
#pragma unroll
            for (int o = 1; o < 64; o <<= 1) { const unsigned v = __shfl_down(suf, o); if (lane + o < 64) suf += v; }
            const u64 bal = __ballot(suf >= 256u);
            const int Ls = 63 - __builtin_clzll(bal);
            if (lane == Ls) { unsigned cab = suf - loc; int b1 = Ls * 4;
                for (int i = 3; i >= 0; --i) { if (cab + cs[i] >= 256u) { b1 = Ls * 4 + i; break; } cab += cs[i]; }
                cnts[32 + qq] = (unsigned)b1; cnts[48 + qq] = 256u - cab; }
        }
        if (c.wave == 0) { __builtin_amdgcn_fence(__ATOMIC_ACQUIRE, "agent"); asm volatile("s_waitcnt vmcnt(0)" ::: "memory"); }
        __syncthreads();
        DSTAMP(1);
        { LAS u32* cbm = (LAS u32*)(c.lds + L_DSA_CBM); const int nch = N >> 4;
          const int tot = 16 * nch;
          for (int base = tid; base < tot; base += 4 * NTHR) {
              u32x4 wq[4]; int qqs[4], chs[4];
#pragma unroll
              for (int u = 0; u < 4; ++u) { const int idx = base + u * NTHR; const int qq = idx < tot ? idx / nch : 0; const int ch = idx < tot ? idx - qq * nch : 0; qqs[u] = qq; chs[u] = ch;
                  wq[u] = *(const u32x4*)(binrow + (size_t)qq * 16384 + ch * 16); }
#pragma unroll
              for (int u = 0; u < 4; ++u) { if (base + u * NTHR >= tot) break;
                  const int qq = qqs[u], ch = chs[u]; const unsigned cb1 = cnts[32 + qq];
#pragma unroll
                  for (int wi = 0; wi < 4; ++wi) { const unsigned w = wq[u][wi];
#pragma unroll
                      for (int bb = 0; bb < 4; ++bb) { const unsigned cb = (w >> (8 * bb)) & 0xffu;
                          if (cb >= cb1) { const int key = ch * 16 + wi * 4 + bb;
                              if (cb > cb1) lds_oru(bm + qq * 512 + (key >> 5), 1u << (key & 31));
                              else lds_oru(cbm + qq * 512 + (key >> 5), 1u << (key & 31)); } } }
              }
          }
        }
        __syncthreads();
        DSTAMP(2);
        for (int rep8_ = 0; rep8_ < ((DSA_REP & 8) ? 2 : 1); ++rep8_)
        for (int qq = 2 * c.wave; qq < 2 * c.wave + 2; ++qq) {
            int lane = c.lane; asm volatile("" : "+v"(lane));
            const unsigned need = cnts[48 + qq]; unsigned C;
            {
                const LAS u32* cbm = (const LAS u32*)(c.lds + L_DSA_CBM) + qq * 512; LAS u16* ck_ = (LAS u16*)(c.lds + L_DSA_FLAT) + qq * DSA_CAP;
                unsigned wv[8]; unsigned cntl = 0;
#pragma unroll
                for (int i = 0; i < 8; ++i) { wv[i] = cbm[lane * 8 + i]; cntl += __builtin_popcount(wv[i]); }
                unsigned inc = cntl;
#pragma unroll
                for (int o = 1; o < 64; o <<= 1) { const unsigned v = __shfl_up(inc, o); if (lane >= o) inc += v; }
                unsigned pos = inc - cntl;
#pragma unroll
                for (int i = 0; i < 8; ++i) { unsigned w = wv[i]; while (w) { const int b = __builtin_ctz(w); if (pos < (unsigned)DSA_CAP) ck_[pos] = (u16)(lane * 256 + i * 32 + b); ++pos; w &= w - 1; } }
                C = min((unsigned)__shfl(inc, 63), (unsigned)DSA_CAP);
                asm volatile("s_waitcnt lgkmcnt(0)" ::: "memory");
            }
            {
                const LAS u16* candk = (const LAS u16*)(c.lds + L_DSA_FLAT) + qq * DSA_CAP; const int n_ = lane & 15, g_ = lane >> 4;
                const _Float16* qp = QI + (size_t)(qt * 16 + qq) * 288 + 8 * g_; const _Float16* KIc = (const _Float16*)(c.ws + T_KI);
                f16x8 q2[9];
#pragma unroll
                for (int hh = 0; hh < 9; ++hh) q2[hh] = *(const f16x8*)(qp + hh * 32);
                const u32 sb2 = SG[qt * 16 + qq];
                for (unsigned base = 0; base < C; base += 64) {
                    f16x8 kfs[4];
#pragma unroll
                    for (int u = 0; u < 4; ++u) { const unsigned j = base + 16 * u + n_; const unsigned key = j < C ? candk[j] : 0u; kfs[u] = *(const f16x8*)(KIc + (size_t)key * 32 + 8 * g_); }
#pragma unroll
                    for (int u = 0; u < 4; ++u) { if (base + 16 * u >= C) break;
                        f32x4 acc = __builtin_amdgcn_mfma_f32_16x16x32_f16(kfs[u], q2[8], (f32x4){0.f, 0.f, 0.f, 0.f}, 0, 0, 0);
#pragma unroll
                        for (int hh = 0; hh < 8; ++hh) { const f32x4 x = __builtin_amdgcn_mfma_f32_16x16x32_f16(kfs[u], q2[hh], (f32x4){0.f, 0.f, 0.f, 0.f}, 0, 0, 0); const float sgn = ((sb2 >> hh) & 1u) ? -1.f : 1.f;
#pragma unroll
                            for (int r = 0; r < 4; ++r) acc[r] = __builtin_fmaf(__builtin_fabsf(x[r]), sgn, acc[r]); }
                        if (n_ == 0) {
#pragma unroll
                            for (int r = 0; r < 4; ++r) { const unsigned jj = base + 16 * u + 4 * g_ + r; if (jj < C) cand[qq * DSA_CAP + jj] = ((u64)ord_of(acc[r] + 0.0f) << 32) | (u64)(0xFFFFFFFFu - (unsigned)candk[jj]); }
                        }
                    }
                }
                asm volatile("s_waitcnt lgkmcnt(0)" ::: "memory");
            }
            if (C <= 64u) {
                const u64 mine = (unsigned)lane < C ? cand[qq * DSA_CAP + lane] : 0ull; unsigned rank = 0;
                const unsigned mlo = (unsigned)mine, mhi = (unsigned)(mine >> 32);
                for (unsigned j = 0; j < C; ++j) { const u64 o = ((u64)(unsigned)__builtin_amdgcn_readlane((int)mhi, (int)j) << 32) | (unsigned)__builtin_amdgcn_readlane((int)mlo, (int)j); rank += (o > mine) ? 1u : 0u; }
                if ((unsigned)lane < C && rank < need) { const unsigned key = 0xFFFFFFFFu - mlo; lds_oru(bm + qq * 512 + (key >> 5), 1u << (key & 31)); }
            } else {
            u64 ck[DSA_CAP / 64];
#pragma unroll
            for (int i = 0; i < DSA_CAP / 64; ++i) { const unsigned idx = lane + 64 * i; ck[i] = idx < C ? cand[qq * DSA_CAP + idx] : 0ull; }
            u64 pre = 0xFFFFC000ull;
            for (int bit = 63; bit >= 0; --bit) {
                if (bit < 32 && bit > 13) continue;
                const u64 trial = pre | (1ull << bit); unsigned cnt = 0;
#pragma unroll
                for (int i = 0; i < DSA_CAP / 64; ++i) cnt += __builtin_popcountll(__ballot(ck[i] >= trial));
                if (cnt >= need) pre = trial;
            }
#pragma unroll
            for (int i = 0; i < DSA_CAP / 64; ++i) if (ck[i] >= pre && ck[i] != 0ull) { const unsigned key = 0xFFFFFFFFu - (unsigned)(ck[i] & 0xFFFFFFFFull); lds_oru(bm + qq * 512 + (key >> 5), 1u << (key & 31)); }
            }
            asm volatile("s_waitcnt lgkmcnt(0)" ::: "memory");
            unsigned wv[8]; unsigned cntl = 0;
#pragma unroll
            for (int i = 0; i < 8; ++i) { wv[i] = bm[qq * 512 + lane * 8 + i]; cntl += __builtin_popcount(wv[i]); }
            unsigned inc = cntl;
#pragma unroll
            for (int o = 1; o < 64; o <<= 1) { const unsigned v = __shfl_up(inc, o); if (lane >= o) inc += v; }
            unsigned pos = inc - cntl;
#pragma unroll
            for (int i = 0; i < 8; ++i) { unsigned w = wv[i]; while (w) { const int b = __builtin_ctz(w); if (pos < 256) sel[qq * 256 + pos] = (u16)(lane * 256 + i * 32 + b); ++pos; w &= w - 1; } }
            if (lane == 63) cnts[qq] = inc;
        }
        __syncthreads();
    } else {
        for (int i = tid; i < 16 * 256; i += NTHR) sel[i] = (u16)((i & 255) < N ? (i & 255) : 0);
        if (tid < 16) cnts[tid] = (unsigned)N;
        __syncthreads();
    }
    DSTAMP(3);
    LAS unsigned char* img = c.lds + L_DSA_IMG + c.wave * 16384;
    for (int rep_ = 0; rep_ < ((DSA_REP & 4) ? 2 : 1); ++rep_)
    for (int qq = 2 * c.wave; qq < 2 * c.wave + 2; ++qq) {
        int lane = c.lane; asm volatile("" : "+v"(lane)); const int q = lane & 15, g = lane >> 4;
        const int t = qt * 16 + qq; const int nsel = (int)min(cnts[qq], 256u); const int ntl = (nsel + 31) >> 5;
        bf16x8 bq[4];
#pragma unroll
        for (int s = 0; s < 4; ++s) { if (q < 4) bq[s] = *(const bf16x8*)(QL + (size_t)t * 512 + q * 128 + 32 * s + 8 * g); else bq[s] = (bf16x8){0, 0, 0, 0, 0, 0, 0, 0}; }
        float m = -INFINITY, lsum = 0.f; f32x4 o[8];
#pragma unroll
        for (int cb = 0; cb < 8; ++cb) o[cb] = (f32x4){0.f, 0.f, 0.f, 0.f};
        u32x4 grA[8], grB[8];
        const int grow = lane >> 4, gchk = lane & 15;
#define DSA_GATHER(TL, GR) do { _Pragma("unroll") for (int i = 0; i < 8; ++i) { const int si = (TL) * 32 + grow + 4 * i; const unsigned key = si < nsel ? sel[qq * 256 + si] : 0u; \
            GR[i] = *(const u32x4*)(CKV + (size_t)key * 128 + gchk * 8); } } while (0)
#define DSA_TILE(TL, GR, IMOFF) do { \
            LAS unsigned char* im = img + (IMOFF); \
            _Pragma("unroll") for (int i = 0; i < 8; ++i) *(LAS u32x4*)(im + img_off(grow + 4 * i, gchk)) = GR[i]; \
            if ((TL) + 2 < ntl) DSA_GATHER((TL) + 2, GR); \
            f32x4 st[2]; \
            _Pragma("unroll") for (int rb = 0; rb < 2; ++rb) { st[rb] = (f32x4){0.f, 0.f, 0.f, 0.f}; const unsigned row = 8 * (q >> 2) + 4 * rb + (q & 3); \
                _Pragma("unroll") for (int s = 0; s < 4; ++s) { const bf16x8 af = *(const LAS bf16x8*)(im + img_off(row, 4 * s + g)); st[rb] = __builtin_amdgcn_mfma_f32_16x16x32_bf16(af, bq[s], st[rb], 0, 0, 0); } } \
            float x[8]; float mx = -INFINITY; \
            _Pragma("unroll") for (int j = 0; j < 8; ++j) { x[j] = st[j >> 2][j & 3]; if ((TL) * 32 + 8 * g + j >= nsel) x[j] = -INFINITY; mx = fmaxf(mx, x[j]); } \
            mx = fmaxf(mx, __shfl_xor(mx, 16)); mx = fmaxf(mx, __shfl_xor(mx, 32)); \
            const float mn = fmaxf(m, mx); const float al = __builtin_amdgcn_exp2f(m - mn); m = mn; float sm = 0.f; \
            _Pragma("unroll") for (int j = 0; j < 8; ++j) { x[j] = __builtin_amdgcn_exp2f(x[j] - mn); sm += x[j]; } \
            lsum = lsum * al + sm; \
            u32x4 pw; pw.x = pk_bf16(x[0], x[1]); pw.y = pk_bf16(x[2], x[3]); pw.z = pk_bf16(x[4], x[5]); pw.w = pk_bf16(x[6], x[7]); \
            const bf16x8 pa = __builtin_bit_cast(bf16x8, pw); \
            float alr[4]; \
            _Pragma("unroll") for (int r = 0; r < 4; ++r) alr[r] = __builtin_bit_cast(float, __builtin_amdgcn_readlane(__builtin_bit_cast(int, al), r)); \
            const unsigned p = lane & 3, qd = (lane & 15) >> 2; \
            _Pragma("unroll") for (int cb = 0; cb < 8; ++cb) { \
                const v4i16_t lo = __builtin_amdgcn_ds_read_tr16_b64_v4i16((LAS v4i16_t*)(im + img_off(8 * g + qd, 2 * cb + (p >> 1)) + 8 * (p & 1))); \
                const v4i16_t hi = __builtin_amdgcn_ds_read_tr16_b64_v4i16((LAS v4i16_t*)(im + img_off(8 * g + 4 + qd, 2 * cb + (p >> 1)) + 8 * (p & 1))); \
                const bf16x8 bw = (bf16x8){lo[0], lo[1], lo[2], lo[3], hi[0], hi[1], hi[2], hi[3]}; \
                f32x4 oc = o[cb]; \
                _Pragma("unroll") for (int r = 0; r < 4; ++r) oc[r] *= alr[r]; \
                o[cb] = __builtin_amdgcn_mfma_f32_16x16x32_bf16(pa, bw, oc, 0, 0, 0); } \
        } while (0)
        typedef short v4i16_t __attribute__((ext_vector_type(4)));
        DSA_GATHER(0, grA);
        if (ntl > 1) DSA_GATHER(1, grB);
        for (int tl = 0; tl < ntl; tl += 2) {
            DSA_TILE(tl, grA, 0);
            if (tl + 1 < ntl) DSA_TILE(tl + 1, grB, 8192);
        }
#undef DSA_TILE
#undef DSA_GATHER
        lsum += __shfl_xor(lsum, 16); lsum += __shfl_xor(lsum, 32);
        float il[4];
#pragma unroll
        for (int r = 0; r < 4; ++r) il[r] = 1.0f / __builtin_bit_cast(float, __builtin_amdgcn_readlane(__builtin_bit_cast(int, lsum), r));
        if (g == 0) {
#pragma unroll
            for (int cb = 0; cb < 8; ++cb)
#pragma unroll
                for (int r = 0; r < 4; ++r) OD[(size_t)t * 512 + r * 128 + 16 * cb + q] = f2bf(o[cb][r] * il[r]);
        }
    }
    __syncthreads();
    DSTAMP(4);
}

__device__ __forceinline__ void phase_route(const Ctx& c, CArgsP a) {
    const float* xr = (const float*)(c.ws + O_XR); const float* ssq = (const float*)(c.ws + O_SSQ);
    const float* rw = a->in[I_RTW]; const float* rb = a->in[I_RTB]; const float* gf = a->in[I_GFFN] + D;
    int* TOPE = (int*)(c.ws + M_TOPE); float* TOPG = (float*)(c.ws + M_TOPG); int* CNT = (int*)(c.ws + M_CNT);
    LAS int* lcnt = (LAS int*)(c.lds + 100000);
    LAS float* rwl = (LAS float*)c.lds;
    for (int idx = c.tid; idx < D * 2; idx += NTHR) { const int k = idx >> 1; const f32x4 w = *(const f32x4*)(rw + (size_t)idx * 4); *(LAS f32x4*)(rwl + idx * 4) = w * gf[k]; }
    for (int blk = c.bid; blk < S / 64; blk += c.G) {
        __syncthreads();
        if (c.tid < 8) lcnt[c.tid] = 0;
        __syncthreads();
        for (int i4 = 0; i4 < 8; i4 += 4) {
            f32x4 xv[4][4];
#pragma unroll
            for (int i = 0; i < 4; ++i)
#pragma unroll
                for (int j = 0; j < 4; ++j) xv[i][j] = *(const f32x4*)(xr + (size_t)(blk * 64 + c.wave * 8 + i4 + i) * D + 16 * c.lane + 4 * j);
            float acc[4][8];
#pragma unroll
            for (int i = 0; i < 4; ++i)
#pragma unroll
                for (int e = 0; e < 8; ++e) acc[i][e] = 0.f;
#pragma unroll
            for (int j = 0; j < 4; ++j)
#pragma unroll
                for (int q = 0; q < 4; ++q) { const LAS float* wp = rwl + (size_t)(16 * c.lane + 4 * j + q) * 8; const f32x4 w0 = *(const LAS f32x4*)wp, w1 = *(const LAS f32x4*)(wp + 4);
#pragma unroll
                    for (int i = 0; i < 4; ++i) { const float x = xv[i][j][q];
#pragma unroll
                        for (int e = 0; e < 4; ++e) { acc[i][e] = fmaf(x, w0[e], acc[i][e]); acc[i][4 + e] = fmaf(x, w1[e], acc[i][4 + e]); } } }
#pragma unroll
            for (int i = 0; i < 4; ++i) {
                const int t = blk * 64 + c.wave * 8 + i4 + i; const float rs = row_rstd(ssq, t); float lg[8];
#pragma unroll
                for (int e = 0; e < 8; ++e) lg[e] = wave_sum(acc[i][e]) * rs + rb[e];
                int e0 = 0; float v0 = lg[0];
#pragma unroll
                for (int e = 1; e < 8; ++e) if (lg[e] > v0) { v0 = lg[e]; e0 = e; }
                int e1 = -1; float v1 = -INFINITY;
#pragma unroll
                for (int e = 0; e < 8; ++e) if (e != e0 && lg[e] > v1) { v1 = lg[e]; e1 = e; }
                const float p1 = 1.0f / (1.0f + __expf(v0 - v1)), p0 = 1.0f - p1;
                if (c.lane == 0) { TOPE[t * 2] = e0; TOPE[t * 2 + 1] = e1; TOPG[t * 2] = p0; TOPG[t * 2 + 1] = p1; lds_addi(&lcnt[e0], 1); lds_addi(&lcnt[e1], 1); }
            }
        }
        __syncthreads();
        if (c.tid < 8) CNT[blk * 8 + c.tid] = lcnt[c.tid];
    }
}
__device__ __forceinline__ void moe_tables(const Ctx& c, LAS int* ebase, LAS int* pexp) {
    const int* CNT = (const int*)(c.ws + M_CNT);
    LAS int* tot = ebase + 16;
    if (c.tid < 8) tot[c.tid] = 0;
    __syncthreads();
    { int s = 0; const int e = c.tid & 7; for (int b = c.tid >> 3; b < 256; b += 64) s += CNT[b * 8 + e]; lds_addi(&tot[e], s); }
    __syncthreads();
    if (c.tid == 0) { int b = 0; for (int e = 0; e < 8; ++e) { ebase[e] = b; const int np = (tot[e] + 255) >> 8; for (int p = 0; p < np; ++p) pexp[(b >> 8) + p] = e; b += np << 8; } ebase[8] = b; }
    __syncthreads();
}
__device__ __forceinline__ void phase_sort(const Ctx& c) {
    const int* CNT = (const int*)(c.ws + M_CNT); const int* TOPE = (const int*)(c.ws + M_TOPE); const float* TOPG = (const float*)(c.ws + M_TOPG);
    const u16* xb = (const u16*)(c.ws + O_XB); const float* ssq = (const float*)(c.ws + O_SSQ);
    u16* XS = (u16*)(c.ws + M_XS); float* RS = (float*)(c.ws + M_RS); float* RGt = (float*)(c.ws + M_RG); int* TOKROW = (int*)(c.ws + M_TOKROW);
    LAS int* ebase = (LAS int*)(c.lds + 100000); LAS int* pexp = ebase + 64; LAS int* boff = ebase + 256; LAS int* rows = ebase + 320;
    moe_tables(c, ebase, pexp);
    for (int blk = c.bid; blk < S / 64; blk += c.G) {
        __syncthreads();
        {
            int s = 0; for (int b = c.lane; b < blk; b += 64) s += CNT[b * 8 + c.wave];
#pragma unroll
            for (int o = 1; o < 64; o <<= 1) s += __shfl_xor(s, o);
            if (c.lane == 0) boff[c.wave] = ebase[c.wave] + s;
        }
        if (c.tid < 128) rows[128 + c.tid] = TOPE[blk * 128 + c.tid];
        __syncthreads();
        if (c.tid < 128) { const int e = rows[128 + c.tid]; int pos = boff[e]; for (int i = 0; i < c.tid; ++i) pos += (rows[128 + i] == e) ? 1 : 0; rows[c.tid] = pos; }
        __syncthreads();
        for (int i0 = c.wave * 16; i0 < c.wave * 16 + 16; i0 += 4) {
            u32x4 v0[4], v1[4]; int rw_[4];
#pragma unroll
            for (int u = 0; u < 4; ++u) { const int i = i0 + u; const int t = blk * 64 + (i >> 1); rw_[u] = rows[i];
                const u32x4* sp = (const u32x4*)(xb + (size_t)t * D); v0[u] = sp[c.lane]; v1[u] = sp[c.lane + 64]; }
#pragma unroll
            for (int u = 0; u < 4; ++u) { u32x4* dp = (u32x4*)(XS + (size_t)rw_[u] * D); dp[c.lane] = v0[u]; dp[c.lane + 64] = v1[u]; }
            if (c.lane < 4) { const int i = i0 + c.lane; const int t = blk * 64 + (i >> 1), row = rows[i]; RS[row] = row_rstd(ssq, t); RGt[row] = TOPG[blk * 128 + i]; TOKROW[blk * 128 + i] = row; }
        }
    }
}
__device__ __forceinline__ void phase_final(const Ctx& c, CArgsP a) {
    const float* xr = (const float*)(c.ws + O_XR); const u16* YS = (const u16*)(c.ws + M_XS); const int* TOKROW = (const int*)(c.ws + M_TOKROW); const float* gfin = a->in[I_GFINAL];
    for (int t = c.gw; t < S; t += c.ngw) {
        const int r0 = TOKROW[t * 2], r1 = TOKROW[t * 2 + 1];
        f32x4 v[4]; float s = 0.f;
#pragma unroll
        for (int j = 0; j < 4; ++j) { const int col = (c.lane + 64 * j) * 4; v[j] = *(const f32x4*)(xr + (size_t)t * D + col);
            const u32x2 y0 = *(const u32x2*)(YS + (size_t)r0 * D + col), y1 = *(const u32x2*)(YS + (size_t)r1 * D + col);
            v[j].x += bflo(y0.x) + bflo(y1.x); v[j].y += bfhi(y0.x) + bfhi(y1.x); v[j].z += bflo(y0.y) + bflo(y1.y); v[j].w += bfhi(y0.y) + bfhi(y1.y);
#pragma unroll
            for (int rr = 0; rr < 2; ++rr) { const int rw = rr ? r1 : r0; if (rw >= 32768) {
#pragma unroll
                for (int s = 0; s < 3; ++s) { const u32x2 yy = *(const u32x2*)((const u16*)(c.ws + M_YS2) + ((size_t)s * YS2_ROWS + (rw - 32768)) * D + col); v[j].x += bflo(yy.x); v[j].y += bfhi(yy.x); v[j].z += bflo(yy.y); v[j].w += bfhi(yy.y); } } }
            s += (v[j].x * v[j].x + v[j].y * v[j].y) + (v[j].z * v[j].z + v[j].w * v[j].w); }
        const float rs = 1.0f / sqrtf(wave_sum(s) * (1.0f / D) + RMS_EPS);
#pragma unroll
        for (int j = 0; j < 4; ++j) { const int col = (c.lane + 64 * j) * 4; const f32x4 gv = *(const f32x4*)(gfin + col); f32x4 ov = v[j] * rs * gv;
#if PROBE
            { const u64* st = (const u64*)(c.ctl + CW_STAMP); const float tot = (float)(st[25] - st[0]);
              const float fa = (PA0 >= 100) ? (float)st[PA0 - 100] / tot : (float)(st[PA1] - st[PA0]) / tot;
              const float fb = (PB0 >= 100) ? (float)st[PB0 - 100] / tot : (float)(st[PB1] - st[PB0]) / tot;
              const float faq = rintf(fa * PQ) / PQ, fbq = rintf(fb * PQ) / PQ; ov = ov * (1.0f + faq); if (t == 0 && col == 0) ov.x += 100.0f * fbq; }
#endif
            *(f32x4*)(a->out + (size_t)t * D + col) = ov; }
    }
}

constexpr int NPHASE_IDS = 26;
extern __shared__ __attribute__((aligned(16))) unsigned char lds_raw[];
#define FRESH() Ctx c; CArgsP ap; { ap = (CArgsP)__builtin_amdgcn_kernarg_segment_ptr(); asm volatile("" : "+s"(ap)); \
        unsigned lb = (unsigned)(uintptr_t)(LAS unsigned char*)lds_raw; asm volatile("" : "+s"(lb)); c.lds = (LAS unsigned char*)(uintptr_t)lb; \
        c.ws = ap->ws; c.ctl = (u32*)(c.ws + O_CTL); int t_ = threadIdx.x; asm volatile("" : "+v"(t_)); \
        c.tid = t_; c.lane = t_ & 63; c.wave = __builtin_amdgcn_readfirstlane(t_ >> 6); c.G = gridDim.x; c.bid = blockIdx.x; c.gw = c.bid * NWAVES + c.wave; c.ngw = c.G * NWAVES; } \
        LAS unsigned char* lds = c.lds; (void)lds; (void)ap
#define IN(k) (lo <= (k) && (k) < hi)
#if MK_PER_PHASE
#define SEAM(k) do { } while (0)
#else
#if PROBE
#define SEAM(k) do { if (IN(k) && IN((k) + 1)) { xcd_barrier(bar); if (blockIdx.x == 0 && threadIdx.x == 0) ((u64*)(bar.bar - CW_BAR + CW_STAMP))[(k) + 1] = wall_clock64(); } } while (0)
#else
#define SEAM(k) do { if (IN(k) && IN((k) + 1)) xcd_barrier(bar); } while (0)
#endif
#endif
template <int l> __device__ __forceinline__ void layer_body(const int lo, const int hi, const XcdBarrier& bar) {
        const int pb = l ? 10 : 1;
        if (SITE(1) && IN(pb + 0)) { FRESH(); const float* ssq = (const float*)(c.ws + O_SSQ); const u16* xb = (const u16*)(c.ws + O_XB); (void)ssq; (void)xb;
            pg8::Gemm g{xb, (const u16*)(c.ws + O_W1) + (size_t)l * NW1 * D, D, D}; pg8::StaticOrder so; so.init(S, NW1, c.G, c.bid);
            EpiG1 e{ssq, (u16*)(c.ws + T_QKVF), (u16*)(c.ws + T_QL), (float*)(c.ws + T_T56), (u16*)(c.ws + T_PR)};
            pg8::gemm_phase(lds, g, so, e);
        }
        SEAM(pb + 0);
        if (SITE(2) && IN(pb + 1)) { FRESH(); phase_prep(c, ap, l); }
        SEAM(pb + 1);
        if (SITE(3) && IN(pb + 2)) { FRESH(); const float* ssq = (const float*)(c.ws + O_SSQ); const u16* xb = (const u16*)(c.ws + O_XB); (void)ssq; (void)xb;
            LAS float* PB = (LAS float*)(lds + 131072);
            { const float* FB = (const float*)(c.ws + T_FB); int lane = c.lane; asm volatile("" : "+v"(lane));
              if (c.wave < 4) {
                  const int hh = c.wave; const f32x4 v = *(const f32x4*)(FB + hh * 256 + 4 * lane);
                  float inc = (v.x + v.y) + (v.z + v.w);
#pragma unroll
                  for (int o = 1; o < 64; o <<= 1) { const float u = __shfl_up(inc, o); if (lane >= o) inc += u; }
                  float ex = __shfl_up(inc, 1); if (lane == 0) ex = 0.f;
                  const float e1 = ex + v.x, e2 = e1 + v.y, e3 = e2 + v.z;
                  *(LAS f32x4*)(PB + hh * 256 + 4 * lane) = (f32x4){ex, e1, e2, e3};
              } else {
                  const int hh = c.wave - 4; const float* qm = (const float*)(c.ws + T_QKM); float mq = 0.f, mk = 0.f;
#pragma unroll
                  for (int i = 0; i < 4; ++i) { mq = fmaxf(mq, qm[(lane + 64 * i) * 8 + hh]); mk = fmaxf(mk, qm[(lane + 64 * i) * 8 + 4 + hh]); }
#pragma unroll
                  for (int o = 1; o < 64; o <<= 1) { mq = fmaxf(mq, __shfl_xor(mq, o)); mk = fmaxf(mk, __shfl_xor(mk, o)); }
                  if (lane == 0) { (void)mq; PB[1024 + hh] = sqrtf(mk) * 1.01f; }
              } }
            __syncthreads();
            for (int rr1_ = 0; rr1_ < ((DSA_REP & 16) ? 2 : 1); ++rr1_)
            for (int task = c.gw; task < 2048; task += c.ngw) r1_task(c, task, (LAS float*)(lds + c.wave * 16384));
            for (int rf_ = 0; rf_ < ((DSA_REP & 32) ? 2 : 1); ++rf_) {
            u32* qctr = c.ctl + CW_Q_FOX + 128 * l + 32 * rf_;
            for (;;) {
                unsigned u = 0; if (c.lane == 0) u = atomicAdd(qctr, 1u);
                u = __builtin_amdgcn_readfirstlane(u);
                if (u >= 2048u) break;
                fox_unit(c, (int)u, PB);
            }
            }
        }
        SEAM(pb + 2);
        if (SITE(4) && IN(pb + 3)) { FRESH(); const float* ssq = (const float*)(c.ws + O_SSQ); const u16* xb = (const u16*)(c.ws + O_XB); (void)ssq; (void)xb;
#if PROBE
            if (c.tid < 8) ((LAS u64*)(lds + L_DSA_CNT + 1024))[c.tid] = 0ull;
#endif
            if (c.bid < 32) { for (int rt_ = c.bid; rt_ < 32; rt_ += (c.G < 32 ? c.G : 32)) r2_task(c, rt_ >> 2, rt_ & 3); }
            __syncthreads();
#if PROBE
            if (l == 0 && c.bid == 0 && c.tid == 0) ((u64*)(c.ctl + CW_STAMP))[24] = wall_clock64();
#endif
            if (c.tid < 64) { const float* kim = (const float*)(c.ws + T_KIM); float mk = fmaxf(fmaxf(kim[c.tid], kim[c.tid + 64]), fmaxf(kim[c.tid + 128], kim[c.tid + 192]));
#pragma unroll
                for (int o = 1; o < 64; o <<= 1) mk = fmaxf(mk, __shfl_xor(mk, o));
                if (c.tid == 0) ((LAS float*)(lds + L_DSA_CNT + 768))[0] = sqrtf(mk) * 1.02f; }
            __syncthreads();
            u32* qctr = c.ctl + CW_Q_DSA + 128 * l; LAS u32* ub = (LAS u32*)(lds + L_DSA_CNT + 512);
            for (;;) {
                if (c.tid == 0) ub[0] = atomicAdd(qctr, 1u);
                __syncthreads();
                const unsigned u = ub[0];
                __syncthreads();
                if (u >= 1024u) break;
                dsa_unit(c, 1023 - (int)u);
            }
#if PROBE
            if (l == 0 && c.bid == 100 && c.tid == 0) { u64* st = (u64*)(c.ctl + CW_STAMP); st[25] = wall_clock64(); for (int k = 0; k < 5; ++k) st[26 + k] = ((LAS u64*)(lds + L_DSA_CNT + 1024))[k]; }
#endif
        }
        SEAM(pb + 3);
        if (SITE(5) && IN(pb + 4)) { FRESH(); for (int task = c.gw; task < 2048; task += c.ngw) r3_task(c, ap, l, task); }
        SEAM(pb + 4);
        if (SITE(6) && IN(pb + 5)) { FRESH(); const float* ssq = (const float*)(c.ws + O_SSQ); const u16* xb = (const u16*)(c.ws + O_XB); (void)ssq; (void)xb;
            if (l == 0) {
                LAS float* scr = (LAS float*)(lds + c.wave * 16640);
                int it0 = convert_seg<1>(ap->in[I_FWG], ap->in[I_FWU], ap->in[I_GFFN], (u16*)(c.ws + T_FFNW), D, FFD, 2 * FFD, 0, scr, c.gw, c.ngw, c.lane);
                (void)convert_seg<0>(ap->in[I_FWD], nullptr, nullptr, (u16*)(c.ws + T_FFNWD), FFD, D, 1024, it0, scr, c.gw, c.ngw, c.lane);
                __syncthreads();
            }
            const u16* wgt = (const u16*)(c.ws + O_WGT) + (size_t)l * 3072 * D; const u16* ow = (const u16*)(c.ws + O_OUTW + l * OUTW_L);
            u16* gt = (u16*)(c.ws + T_GT); float* mgf = (float*)(c.ws + T_MGF); const float* bg = ap->in[I_BGATE] + l * 3072;
            pg8::StaticOrder so; so.init(S, D, c.G, c.bid);
            { pg8::Gemm g{xb, wgt, D, D}; EpiGate e{ssq, bg, gt}; pg8::gemm_phase(lds, g, so, e); }
            { pg8::Gemm g{(const u16*)(c.ws + T_OF), ow, 256, 256}; EpiProj<0> e{gt, mgf}; pg8::gemm_phase(lds, g, so, e); }
            { pg8::Gemm g{xb, wgt + (size_t)1024 * D, D, D}; EpiGate e{ssq, bg + 1024, gt}; pg8::gemm_phase(lds, g, so, e); }
            { pg8::Gemm g{(const u16*)(c.ws + T_OD), ow + 1024 * 256, 512, 512}; EpiProj<1> e{gt, mgf}; pg8::gemm_phase(lds, g, so, e); }
            { pg8::Gemm g{xb, wgt + (size_t)2048 * D, D, D}; EpiGate e{ssq, bg + 2048, gt}; pg8::gemm_phase(lds, g, so, e); }
            { pg8::Gemm g{(const u16*)(c.ws + T_OR), ow + 1024 * 256 + 1024 * 512, 512, 512}; EpiProj<2> e{gt, mgf}; pg8::gemm_phase(lds, g, so, e); }
        }
        SEAM(pb + 5);
        if (SITE(7) && IN(pb + 6)) { FRESH(); const float* ssq = (const float*)(c.ws + O_SSQ); const u16* xb = (const u16*)(c.ws + O_XB); (void)ssq; (void)xb;
            const u16* ow = (const u16*)(c.ws + O_OUTW + l * OUTW_L);
            pg8::Gemm g{(const u16*)(c.ws + T_GT), ow + 1024 * 256 + 2 * 1024 * 512, D, D}; pg8::StaticOrder so; so.init(S, D, c.G, c.bid);
            EpiResid e{(float*)(c.ws + O_XR), (u16*)(c.ws + O_XB), (float*)(c.ws + O_SSQ)};
            pg8::gemm_phase(lds, g, so, e);
        }
        SEAM(pb + 6);
        if (l == 0) {
            if (SITE(8) && IN(pb + 7)) { FRESH(); const float* ssq = (const float*)(c.ws + O_SSQ); const u16* xb = (const u16*)(c.ws + O_XB); (void)ssq; (void)xb;
                pg8::Gemm g{xb, (const u16*)(c.ws + T_FFNW), D, D}; pg8::StaticOrder so; so.init(S, 2 * FFD, c.G, c.bid);
                EpiSwiglu e{ssq, nullptr, (u16*)(c.ws + T_ACT), FFD, 0};
                pg8::gemm_phase(lds, g, so, e);
            }
            SEAM(pb + 7);
            if (SITE(9) && IN(pb + 8)) { FRESH(); const float* ssq = (const float*)(c.ws + O_SSQ); const u16* xb = (const u16*)(c.ws + O_XB); (void)ssq; (void)xb;
                pg8::Gemm g{(const u16*)(c.ws + T_ACT), (const u16*)(c.ws + T_FFNWD), FFD, FFD}; pg8::StaticOrder so; so.init(S, D, c.G, c.bid);
                EpiResid e{(float*)(c.ws + O_XR), (u16*)(c.ws + O_XB), (float*)(c.ws + O_SSQ)};
                pg8::gemm_phase(lds, g, so, e);
            }
            SEAM(pb + 8);
        } else {
            if (SITE(10) && IN(pb + 7)) { FRESH();
                for (int rq_ = 0; rq_ < ((DSA_REP & 64) ? 2 : 1); ++rq_) phase_route(c, ap);
                __syncthreads();
                LAS float* scr = (LAS float*)(lds + c.wave * 16640); int it0 = 0;
                for (int e = 0; e < NEXP; ++e) {
                    it0 = convert_seg<1>(ap->in[I_MWG] + (size_t)e * D * FFE, ap->in[I_MWU] + (size_t)e * D * FFE, ap->in[I_GFFN] + D, (u16*)(c.ws + M_WGU) + (size_t)e * 2 * FFE * D, D, FFE, 2 * FFE, it0, scr, c.gw, c.ngw, c.lane);
                    it0 = convert_seg<0>(ap->in[I_MWD] + (size_t)e * FFE * D, nullptr, nullptr, (u16*)(c.ws + M_WD) + (size_t)e * D * FFE, FFE, D, 1024, it0, scr, c.gw, c.ngw, c.lane);
                }
            }
            SEAM(pb + 7);
            if (SITE(11) && IN(pb + 8)) { FRESH(); for (int rq_ = 0; rq_ < ((DSA_REP & 128) ? 2 : 1); ++rq_) { phase_sort(c); __syncthreads(); } }
            SEAM(pb + 8);
            for (int half = 0; half < 3; ++half) {
                if (!(IN(pb + 9 + 2 * half) || IN(pb + 10 + 2 * half))) continue;
                FRESH();
                LAS int* ebase = (LAS int*)(lds + 135168); LAS int* pexp = ebase + 64;
                moe_tables(c, ebase, pexp);
                const int npanel = ebase[8] >> 8;
                const int p0 = min(64 * half, npanel), np = ((half == 2) ? npanel : min(64 * (half + 1), npanel)) - p0;
                if (SITE(12) && IN(pb + 9 + 2 * half)) {
                    pg8::Gemm g{(const u16*)(c.ws + M_XS), (const u16*)(c.ws + M_WGU), D, D};
                    pg8::MoeOrder mo{p0, np, 28, c.G, c.bid, 28, pexp, 1};
                    EpiSwiglu e{nullptr, (const float*)(c.ws + M_RS), (u16*)(c.ws + M_ACT), FFE, p0 * 256};
                    pg8::gemm_phase(lds, g, mo, e);
                }
                SEAM(pb + 9 + 2 * half);
                if (SITE(13) && IN(pb + 10 + 2 * half)) {
                    const int nks = (half == 2) ? 4 : 1;
                    pg8::Gemm g{(const u16*)(c.ws + M_ACT) - (size_t)p0 * 256 * FFE, (const u16*)(c.ws + M_WD), FFE / nks, FFE};
                    pg8::MoeOrder mo{p0, np, 4, c.G, c.bid, 4, pexp, nks};
                    EpiMoeDown e{(const float*)(c.ws + M_RG), (u16*)(c.ws + M_XS), (u16*)(c.ws + M_YS2)};
                    pg8::gemm_phase(lds, g, mo, e);
                }
                SEAM(pb + 10 + 2 * half);
            }
#if PROBE
            xcd_barrier(bar);
#endif
            if (SITE(14) && IN(pb + 15)) { FRESH(); phase_final(c, ap); }
        }
    }

__global__ void __launch_bounds__(NTHR, 2) mk_fwd(Args a) {
    LAS unsigned char* lds0 = (LAS unsigned char*)lds_raw; u32* ctl0 = (u32*)(a.ws + O_CTL);
    volatile LAS unsigned* MISC = (volatile LAS unsigned*)(lds0 + LDS_MISC);
    if (threadIdx.x < 64) MISC[threadIdx.x] = 0u;
    __syncthreads();
    XcdBarrier bar; bar.bar = ctl0 + CW_BAR; bar.x = 0; bar.st = nullptr;
#if !MK_PER_PHASE
    bar = xcd_barrier_post(ctl0 + CW_BAR, MISC);
#endif
    const int lo = a.ph_lo, hi = a.ph_hi;
#if PROBE
    if (blockIdx.x == 0 && threadIdx.x == 0) ((u64*)(ctl0 + CW_STAMP))[0] = wall_clock64();
#endif
    if (SITE(0) && IN(0)) { FRESH(); phase_prologue(c, ap); }
    SEAM(0);
    layer_body<0>(lo, hi, bar);
    layer_body<1>(lo, hi, bar);
#undef IN
#undef SEAM
}

extern "C" void kernel_launch(void* const* d_in, const int* in_sizes, int n_in, void* d_out, int out_size, void* d_ws, size_t ws_size, hipStream_t stream) {
    static int grid = 0;
    if (grid == 0) {
        if (n_in != 37 || ws_size < WS_NEED) { fprintf(stderr, "kernel_launch: n_in %d ws %zu need %zu\n", n_in, ws_size, (size_t)WS_NEED); grid = -1; return; }
        int dev = 0, cus = 0, per_cu = 0;
        hipGetDevice(&dev); hipDeviceGetAttribute(&cus, hipDeviceAttributeMultiprocessorCount, dev);
        hipFuncSetAttribute((const void*)mk_fwd, hipFuncAttributeMaxDynamicSharedMemorySize, LDS_BYTES);
        hipOccupancyMaxActiveBlocksPerMultiprocessor(&per_cu, (const void*)mk_fwd, NTHR, LDS_BYTES);
        (void)hipGetLastError();
        grid = cus > 0 ? cus : 256;
        if (per_cu < 1) fprintf(stderr, "kernel_launch: occupancy query says %d\n", per_cu);
    }
    if (grid < 0) return;
    hipMemsetAsync((char*)d_ws + O_CTL, 0, 131072, stream);
    Args a{};
    for (int i = 0; i < 37; ++i) a.in[i] = (const float*)d_in[i];
    a.out = (float*)d_out; a.ws = (unsigned char*)d_ws;
#if MK_PER_PHASE
    for (int i = 0; i < NPHASE_IDS; ++i) { a.ph_lo = i; a.ph_hi = i + 1; hipLaunchKernelGGL(mk_fwd, dim3(grid), dim3(NTHR), LDS_BYTES, stream, a); }
#else
    a.ph_lo = 0; a.ph_hi = NPHASE_IDS; hipLaunchKernelGGL(mk_fwd, dim3(grid), dim3(NTHR), LDS_BYTES, stream, a);
#endif
}
```
